# Optimizing an MI355X kernel written in HIP

```python
import math
import jax, jax.numpy as jnp
from jax import lax
import numpy as np

D_MODEL = 2048
BATCH = 4
SEQ = 2048
DEPTH = 2

D_MIX = D_MODEL
SB_HEAD_DIM = 64
SB_WIDTH = D_MIX // 4
SB_HEADS = SB_WIDTH // SB_HEAD_DIM
SSM_WIDTH = D_MIX // 4
SSM_GROUP_CH = 16
SSM_GROUPS = SSM_WIDTH // SSM_GROUP_CH
SSM_STATE = 64
DIFF_WIDTH = D_MIX - SB_WIDTH - SSM_WIDTH
DIFF_HEAD_DIM = 64
DIFF_V_DIM = 2 * DIFF_HEAD_DIM
DIFF_HEADS = DIFF_WIDTH // DIFF_V_DIM
IN_COLS = 3 * SB_WIDTH + SSM_WIDTH + 3 * DIFF_WIDTH
N_GROUPS = 4
EXPERTS_PER_GROUP = 8
N_EXPERTS = N_GROUPS * EXPERTS_PER_GROUP
TOP_K_IN_GROUP = 2
D_EXPERT = D_MODEL // 4
Q_BLOCK = 128
EPS = 1e-6

kernel_name = 'hybrid_sb_s5_diffattn_hmoe'


def rmsnorm(x, g):
    xf = x.astype(jnp.float32)
    y = xf * lax.rsqrt(jnp.mean(xf * xf, axis=-1, keepdims=True) + EPS)
    return (y * g.astype(jnp.float32)).astype(x.dtype)


def stick_breaking_attention(q, k, v):
    seq = q.shape[1]
    scale = q.shape[-1] ** -0.5
    outs = []
    for t0 in range(0, seq, Q_BLOCK):
        t1 = t0 + Q_BLOCK
        z = jnp.einsum('bqhd,bkhd->bhqk', q[:, t0:t1], k[:, :t1]).astype(jnp.float32) * scale
        strict = jnp.arange(t1)[None, :] < (t0 + jnp.arange(Q_BLOCK))[:, None]
        log_fail = jnp.where(strict, jax.nn.log_sigmoid(-z), 0.0)
        log_after = lax.cumsum(log_fail, axis=3, reverse=True) - log_fail
        w = jnp.where(strict, jnp.exp(jax.nn.log_sigmoid(z) + log_after), 0.0)
        outs.append(jnp.einsum('bhqk,bkhd->bqhd', w.astype(v.dtype), v[:, :t1]))
    return jnp.concatenate(outs, axis=1)


def differential_attention(q, k, v, lam):
    seq = q.shape[1]
    scale = q.shape[-1] ** -0.5
    outs = []
    for t0 in range(0, seq, Q_BLOCK):
        t1 = t0 + Q_BLOCK
        s = jnp.einsum('bqhrd,bkhrd->bhrqk', q[:, t0:t1], k[:, :t1]).astype(jnp.float32) * scale
        causal = jnp.arange(t1)[None, :] <= (t0 + jnp.arange(Q_BLOCK))[:, None]
        p = jax.nn.softmax(jnp.where(causal, s, -jnp.inf), axis=-1)
        a = p[:, :, 0] - lam * p[:, :, 1]
        outs.append(jnp.einsum('bhqk,bkhd->bqhd', a.astype(v.dtype), v[:, :t1]))
    return jnp.concatenate(outs, axis=1)


def _diag_combine(e1, e2):
    a1, b1 = e1
    a2, b2 = e2
    return (a1 * a2, a2 * b1 + b2)


def s5_mixer(u, lam_re, lam_im, b_re, b_im, c_re, c_im, d_skip, log_dt, w_glu, b_glu):
    bsz, seq, _ = u.shape
    f32 = jnp.float32
    uf = u.astype(f32).reshape(bsz, seq, SSM_GROUPS, SSM_GROUP_CH)
    lam = lax.complex(lam_re.astype(f32), lam_im.astype(f32))
    dt = jnp.exp(log_dt.astype(f32))[:, None]
    lam_bar = jnp.exp(lam * dt)
    b = lax.complex(b_re.astype(f32), b_im.astype(f32))
    b_bar = ((lam_bar - 1.0) / lam)[:, :, None] * b
    bu = jnp.einsum('blgc,gnc->blgn', uf.astype(jnp.complex64), b_bar)
    a = jnp.broadcast_to(lam_bar, bu.shape)
    _, state = lax.associative_scan(_diag_combine, (a, bu), axis=1)
    c = lax.complex(c_re.astype(f32), c_im.astype(f32))
    y = jnp.einsum('blgn,gcn->blgc', state, c).real + d_skip.astype(f32) * uf
    y = jax.nn.gelu(y.reshape(bsz, seq, SSM_WIDTH))
    y = y * jax.nn.sigmoid(y @ w_glu.astype(f32) + b_glu.astype(f32))
    return y.astype(u.dtype)


def hybrid_mixer(xn, w_in, sb_norm_g, lam_re, lam_im, b_re, b_im, c_re, c_im, d_skip, log_dt,
                 w_glu, b_glu, ssm_norm_g, lq1, lk1, lq2, lk2, diff_subln_g, w_out, lam_init):
    bsz, seq, _ = xn.shape
    f32 = jnp.float32
    proj = xn @ w_in
    cuts = np.cumsum([SB_WIDTH] * 3 + [SSM_WIDTH] + [DIFF_WIDTH] * 2).tolist()
    sb_q, sb_k, sb_v, ssm_u, df_q, df_k, df_v = jnp.split(proj, cuts, axis=-1)
    sb_shape = (bsz, seq, SB_HEADS, SB_HEAD_DIM)
    y_sb = stick_breaking_attention(sb_q.reshape(sb_shape), sb_k.reshape(sb_shape), sb_v.reshape(sb_shape))
    y_sb = rmsnorm(y_sb.reshape(bsz, seq, SB_WIDTH), sb_norm_g)
    y_ssm = rmsnorm(s5_mixer(ssm_u, lam_re, lam_im, b_re, b_im, c_re, c_im, d_skip, log_dt, w_glu, b_glu),
                    ssm_norm_g)
    lam = (jnp.exp(jnp.sum(lq1.astype(f32) * lk1.astype(f32)))
           - jnp.exp(jnp.sum(lq2.astype(f32) * lk2.astype(f32))) + lam_init)
    qk_shape = (bsz, seq, DIFF_HEADS, 2, DIFF_HEAD_DIM)
    y_df = differential_attention(df_q.reshape(qk_shape), df_k.reshape(qk_shape),
                                  df_v.reshape(bsz, seq, DIFF_HEADS, DIFF_V_DIM), lam)
    y_df = (rmsnorm(y_df, diff_subln_g) * (1.0 - lam_init)).reshape(bsz, seq, DIFF_WIDTH)
    y = jnp.concatenate([y_sb, y_ssm, y_df], axis=-1)
    return y @ w_out


def hierarchical_moe(xn, rg_w, rg_b, re_w, re_b, w1, w3, w2):
    bsz, seq, d = xn.shape
    f32 = jnp.float32
    t = xn.reshape(bsz * seq, d)
    g_prob = jax.nn.softmax((t @ rg_w + rg_b).astype(f32), axis=-1)
    g_top, g_idx = lax.top_k(g_prob, 1)
    e_logits_all = (jnp.einsum('td,gde->tge', t, re_w) + re_b).astype(f32)
    e_logits = jnp.take_along_axis(e_logits_all, g_idx[:, :, None], axis=1)[:, 0]
    e_top, e_idx = lax.top_k(jax.nn.softmax(e_logits, axis=-1), TOP_K_IN_GROUP)
    e_w = e_top / jnp.sum(e_top, axis=-1, keepdims=True) * g_top
    expert_id = g_idx * EXPERTS_PER_GROUP + e_idx
    gate = jnp.sum(jax.nn.one_hot(expert_id, N_EXPERTS, dtype=f32) * e_w[..., None], axis=1)
    h = jax.nn.silu(jnp.einsum('td,edf->tef', t, w1)) * jnp.einsum('td,edf->tef', t, w3)
    h = h * gate[:, :, None].astype(h.dtype)
    y = jnp.einsum('tef,efd->td', h, w2)
    return y.reshape(bsz, seq, d)


def setup_inputs(seed: int = 0) -> dict:
    key = jax.random.key(seed)
    ks = jax.random.split(key, 26)
    f32 = jnp.float32

    def nrm(k, shape, scale):
        return jax.random.normal(k, shape, f32) * scale

    L = DEPTH
    G, N, C = SSM_GROUPS, SSM_STATE, SSM_GROUP_CH
    lam_im = jnp.broadcast_to(math.pi * jnp.arange(N, dtype=f32), (L, G, N))
    return {
        'x': nrm(ks[0], (BATCH, SEQ, D_MODEL), 1.0),
        'norm_mix_g': 1.0 + nrm(ks[1], (L, D_MODEL), 0.02),
        'w_in': nrm(ks[2], (L, D_MODEL, IN_COLS), D_MODEL ** -0.5),
        'sb_norm_g': 1.0 + nrm(ks[3], (L, SB_WIDTH), 0.02),
        'ssm_lam_re': -0.5 * jnp.exp(nrm(ks[4], (L, G, N), 0.02)),
        'ssm_lam_im': lam_im,
        'ssm_b_re': nrm(ks[5], (L, G, N, C), (2 * C) ** -0.5),
        'ssm_b_im': nrm(ks[6], (L, G, N, C), (2 * C) ** -0.5),
        'ssm_c_re': nrm(ks[7], (L, G, C, N), N ** -0.5),
        'ssm_c_im': nrm(ks[8], (L, G, C, N), N ** -0.5),
        'ssm_d': nrm(ks[9], (L, G, C), 1.0),
        'ssm_log_dt': jax.random.uniform(ks[10], (L, G), f32, math.log(1e-3), math.log(1e-1)),
        'ssm_w_glu': nrm(ks[11], (L, SSM_WIDTH, SSM_WIDTH), SSM_WIDTH ** -0.5),
        'ssm_b_glu': nrm(ks[12], (L, SSM_WIDTH), 0.01),
        'ssm_norm_g': 1.0 + nrm(ks[13], (L, SSM_WIDTH), 0.02),
        'diff_lq1': nrm(ks[14], (L, DIFF_HEAD_DIM), 0.1),
        'diff_lk1': nrm(ks[15], (L, DIFF_HEAD_DIM), 0.1),
        'diff_lq2': nrm(ks[16], (L, DIFF_HEAD_DIM), 0.1),
        'diff_lk2': nrm(ks[17], (L, DIFF_HEAD_DIM), 0.1),
        'diff_subln_g': 1.0 + nrm(ks[18], (L, DIFF_V_DIM), 0.02),
        'w_out': nrm(ks[19], (L, D_MIX, D_MODEL), D_MIX ** -0.5),
        'norm_ffn_g': 1.0 + nrm(ks[20], (L, D_MODEL), 0.02),
        'router_group_w': nrm(ks[21], (L, D_MODEL, N_GROUPS), D_MODEL ** -0.5),
        'router_group_b': nrm(ks[22], (L, N_GROUPS), 0.01),
        'router_expert_w': nrm(ks[23], (L, N_GROUPS, D_MODEL, EXPERTS_PER_GROUP), D_MODEL ** -0.5),
        'router_expert_b': nrm(ks[24], (L, N_GROUPS, EXPERTS_PER_GROUP), 0.01),
        'expert_w1': nrm(jax.random.fold_in(ks[25], 1), (L, N_EXPERTS, D_MODEL, D_EXPERT), D_MODEL ** -0.5),
        'expert_w3': nrm(jax.random.fold_in(ks[25], 2), (L, N_EXPERTS, D_MODEL, D_EXPERT), D_MODEL ** -0.5),
        'expert_w2': nrm(jax.random.fold_in(ks[25], 3), (L, N_EXPERTS, D_EXPERT, D_MODEL), D_EXPERT ** -0.5),
        'final_norm_g': 1.0 + nrm(jax.random.fold_in(ks[25], 4), (D_MODEL,), 0.02),
    }


def reference(x, norm_mix_g, w_in, sb_norm_g, ssm_lam_re, ssm_lam_im, ssm_b_re, ssm_b_im,
              ssm_c_re, ssm_c_im, ssm_d, ssm_log_dt, ssm_w_glu, ssm_b_glu, ssm_norm_g,
              diff_lq1, diff_lk1, diff_lq2, diff_lk2, diff_subln_g, w_out, norm_ffn_g,
              router_group_w, router_group_b, router_expert_w, router_expert_b,
              expert_w1, expert_w3, expert_w2, final_norm_g):
    for l in range(DEPTH):
        lam_init = 0.8 - 0.6 * math.exp(-0.3 * l)
        h = x + hybrid_mixer(rmsnorm(x, norm_mix_g[l]), w_in[l], sb_norm_g[l],
                             ssm_lam_re[l], ssm_lam_im[l], ssm_b_re[l], ssm_b_im[l],
                             ssm_c_re[l], ssm_c_im[l], ssm_d[l], ssm_log_dt[l],
                             ssm_w_glu[l], ssm_b_glu[l], ssm_norm_g[l],
                             diff_lq1[l], diff_lk1[l], diff_lq2[l], diff_lk2[l],
                             diff_subln_g[l], w_out[l], lam_init)
        x = h + hierarchical_moe(rmsnorm(h, norm_ffn_g[l]), router_group_w[l], router_group_b[l],
                                 router_expert_w[l], router_expert_b[l],
                                 expert_w1[l], expert_w3[l], expert_w2[l])
    return rmsnorm(x, final_norm_g)
```

```cpp
#include <hip/hip_runtime.h>
#include <cstdint>
#include <cstdio>
#include <cmath>

namespace nv {
constexpr int NB = 4, L = 2048, D = 2048, T = NB * L, DEPTH = 2;
constexpr int SBW = 512, SBH = 8, SSMW = 512, SG = 32, SN = 64, SC = 16, DFW = 1024, DFH = 8, DFV = 128;
constexpr int INC = 5120, NEXP = 32, EPG = 8, NGRP = 4, DE = 512;
constexpr int C_SBQ = 0, C_SBK = 512, C_SBV = 1024, C_U = 1536, C_DQ = 2048, C_DK = 3072, C_DV = 4096;
constexpr float EPS = 1e-6f;
constexpr float LOG2E = 1.4426950408889634f;
constexpr float QS_SB = 0.125f, QS_DF = 0.125f * LOG2E;

typedef unsigned short bf16_t;
__device__ __forceinline__ float bf2f(bf16_t v) { return __uint_as_float(((unsigned)v) << 16); }
__device__ __forceinline__ bf16_t f2bf(float f) { unsigned u = __float_as_uint(f); return (bf16_t)((u + 0x7fffu + ((u >> 16) & 1u)) >> 16); }

__device__ __forceinline__ float block_sum(float v, float* red) {
    for (int o = 32; o > 0; o >>= 1) v += __shfl_xor(v, o);
    const int w = threadIdx.x >> 6, nw = blockDim.x >> 6;
    __syncthreads();
    if ((threadIdx.x & 63) == 0) red[w] = v;
    __syncthreads();
    float s = 0.f;
    for (int i = 0; i < nw; ++i) s += red[i];
    return s;
}
__device__ __forceinline__ float block_max(float v, float* red) {
    for (int o = 32; o > 0; o >>= 1) v = fmaxf(v, __shfl_xor(v, o));
    const int w = threadIdx.x >> 6, nw = blockDim.x >> 6;
    __syncthreads();
    if ((threadIdx.x & 63) == 0) red[w] = v;
    __syncthreads();
    float s = -INFINITY;
    for (int i = 0; i < nw; ++i) s = fmaxf(s, red[i]);
    return s;
}

__global__ void __launch_bounds__(256) k_rmsnorm(const float* __restrict__ x, const float* __restrict__ g, bf16_t* __restrict__ out) {
    __shared__ float red[16];
    const int t = blockIdx.x; const float* xr = x + (size_t)t * D;
    float v[8]; float s = 0.f;
    for (int i = 0; i < 8; ++i) { v[i] = xr[threadIdx.x + 256 * i]; s += v[i] * v[i]; }
    s = block_sum(s, red);
    const float r = rsqrtf(s / D + EPS);
    for (int i = 0; i < 8; ++i) out[(size_t)t * D + threadIdx.x + 256 * i] = f2bf(v[i] * r * g[threadIdx.x + 256 * i]);
}

template <int EPI>
__global__ void __launch_bounds__(256) k_gemm(const bf16_t* __restrict__ A, int lda, const float* __restrict__ Bm, int ldb, int K,
                                             void* __restrict__ Cout, int ldc, const float* __restrict__ R) {
    __shared__ float As[16][68];
    __shared__ float Bs[16][68];
    const int tx = threadIdx.x & 15, ty = threadIdx.x >> 4;
    const int m0 = blockIdx.y * 64, n0 = blockIdx.x * 64;
    float acc[4][4];
    for (int i = 0; i < 4; ++i) for (int j = 0; j < 4; ++j) acc[i][j] = 0.f;
    for (int k0 = 0; k0 < K; k0 += 16) {
        for (int e = threadIdx.x; e < 64 * 16; e += 256) { const int r = e >> 4, c = e & 15; As[c][r] = bf2f(A[(size_t)(m0 + r) * lda + k0 + c]); }
        for (int e = threadIdx.x; e < 64 * 16; e += 256) { const int r = e >> 6, c = e & 63; Bs[r][c] = Bm[(size_t)(k0 + r) * ldb + n0 + c]; }
        __syncthreads();
#pragma unroll
        for (int k = 0; k < 16; ++k) {
            float a[4], b[4];
            for (int i = 0; i < 4; ++i) a[i] = As[k][ty * 4 + i];
            for (int j = 0; j < 4; ++j) b[j] = Bs[k][tx * 4 + j];
            for (int i = 0; i < 4; ++i) for (int j = 0; j < 4; ++j) acc[i][j] += a[i] * b[j];
        }
        __syncthreads();
    }
    for (int i = 0; i < 4; ++i) for (int j = 0; j < 4; ++j) {
        const int m = m0 + ty * 4 + i, n = n0 + tx * 4 + j;
        if (EPI == 0) {
            float sc = 1.f; if (n < C_SBK) sc = QS_SB; else if (n >= C_DQ && n < C_DK) sc = QS_DF;
            ((bf16_t*)Cout)[(size_t)m * ldc + n] = f2bf(acc[i][j] * sc);
        } else {
            ((float*)Cout)[(size_t)m * ldc + n] = acc[i][j] + R[(size_t)m * ldc + n];
        }
    }
}

__global__ void __launch_bounds__(256) k_sb_attn(const bf16_t* __restrict__ P, bf16_t* __restrict__ O) {
    __shared__ float zs[L];
    __shared__ float qv[64];
    __shared__ float part[4][64];
    const int t = blockIdx.x, h = blockIdx.y, b = blockIdx.z, tid = threadIdx.x;
    const size_t rowb = (size_t)b * L;
    if (tid < 64) qv[tid] = bf2f(P[(rowb + t) * INC + C_SBQ + h * 64 + tid]);
    __syncthreads();
    for (int s = tid; s < t; s += 256) {
        const bf16_t* kr = P + (rowb + s) * INC + C_SBK + h * 64;
        float z = 0.f;
        for (int d = 0; d < 64; ++d) z += qv[d] * bf2f(kr[d]);
        zs[s] = z;
    }
    __syncthreads();
    if (tid == 0) {
        float Racc = 0.f;
        for (int s = t - 1; s >= 0; --s) {
            const float z = zs[s];
            const float sp = fmaxf(-z, 0.f) + log1pf(expf(-fabsf(z)));
            zs[s] = expf(-sp + Racc);
            Racc += -(sp + z);
        }
    }
    __syncthreads();
    const int d = tid & 63, gq = tid >> 6;
    float o = 0.f;
    for (int s = gq; s < t; s += 4) o += zs[s] * bf2f(P[(rowb + s) * INC + C_SBV + h * 64 + d]);
    part[gq][d] = o;
    __syncthreads();
    if (tid < 64) O[(rowb + t) * SBW + h * 64 + tid] = f2bf(part[0][tid] + part[1][tid] + part[2][tid] + part[3][tid]);
}

__global__ void __launch_bounds__(256) k_diff_attn(const bf16_t* __restrict__ P, bf16_t* __restrict__ O1, bf16_t* __restrict__ O2) {
    __shared__ float ps[L];
    __shared__ float qv[64];
    __shared__ float part[2][128];
    __shared__ float red[16];
    const int t = blockIdx.x, h = blockIdx.y >> 1, mp = blockIdx.y & 1, b = blockIdx.z, tid = threadIdx.x;
    const size_t rowb = (size_t)b * L;
    if (tid < 64) qv[tid] = bf2f(P[(rowb + t) * INC + C_DQ + h * 128 + mp * 64 + tid]);
    __syncthreads();
    float mx = -INFINITY;
    for (int s = tid; s <= t; s += 256) {
        const bf16_t* kr = P + (rowb + s) * INC + C_DK + h * 128 + mp * 64;
        float z = 0.f;
        for (int d = 0; d < 64; ++d) z += qv[d] * bf2f(kr[d]);
        ps[s] = z; mx = fmaxf(mx, z);
    }
    mx = block_max(mx, red);
    float sum = 0.f;
    for (int s = tid; s <= t; s += 256) { const float p = exp2f(ps[s] - mx); ps[s] = p; sum += p; }
    sum = block_sum(sum, red);
    __syncthreads();
    const int d = tid & 127, gq = tid >> 7;
    float o = 0.f;
    for (int s = gq; s <= t; s += 2) o += ps[s] * bf2f(P[(rowb + s) * INC + C_DV + h * 128 + d]);
    part[gq][d] = o;
    __syncthreads();
    if (tid < 128) { bf16_t* O = mp ? O2 : O1; O[(rowb + t) * DFW + h * 128 + tid] = f2bf((part[0][tid] + part[1][tid]) / sum); }
}

__global__ void __launch_bounds__(64) k_s5_scan(const bf16_t* __restrict__ P, const float* lam_re, const float* lam_im, const float* b_re, const float* b_im,
                                                const float* log_dt, float2* __restrict__ ST) {
    const int b = blockIdx.x / SG, g = blockIdx.x % SG, n = threadIdx.x;
    const double dt = exp((double)log_dt[g]);
    const double lr = lam_re[g * SN + n], li = lam_im[g * SN + n];
    const double er = exp(lr * dt), lbr = er * cos(li * dt), lbi = er * sin(li * dt);
    const double nr = lbr - 1.0, ni = lbi, den = lr * lr + li * li;
    const double fr = (nr * lr + ni * li) / den, fi = (ni * lr - nr * li) / den;
    float bbr[SC], bbi[SC];
#pragma unroll
    for (int c = 0; c < SC; ++c) { const double br = b_re[(g * SN + n) * SC + c], bi = b_im[(g * SN + n) * SC + c]; bbr[c] = (float)(fr * br - fi * bi); bbi[c] = (float)(fr * bi + fi * br); }
    const float ar = (float)lbr, ai = (float)lbi;
    float sr = 0.f, si = 0.f;
    for (int t = 0; t < L; ++t) {
        const bf16_t* ur = P + ((size_t)b * L + t) * INC + C_U + g * SC;
        float bur = 0.f, bui = 0.f;
#pragma unroll
        for (int c = 0; c < SC; ++c) { const float u = bf2f(ur[c]); bur += bbr[c] * u; bui += bbi[c] * u; }
        const float nsr = ar * sr - ai * si + bur, nsi = ar * si + ai * sr + bui;
        sr = nsr; si = nsi;
        ST[(((size_t)b * L + t) * SG + g) * SN + n] = make_float2(sr, si);
    }
}
__device__ __forceinline__ float gelu_tanh(float x) { const float u = 0.7978845608028654f * (x + 0.044715f * x * x * x); return 0.5f * x * (1.f + tanhf(u)); }
__global__ void __launch_bounds__(256) k_s5_out(const bf16_t* __restrict__ P, const float2* __restrict__ ST, const float* c_re, const float* c_im, const float* dsk, float* __restrict__ G1) {
    const size_t idx = (size_t)blockIdx.x * 256 + threadIdx.x;
    const int ch = (int)(idx % SSMW); const size_t t = idx / SSMW; const int g = ch / SC, c = ch % SC;
    const float2* st = ST + (t * SG + g) * SN;
    float y = 0.f;
    for (int n = 0; n < SN; ++n) { const float2 s = st[n]; y += c_re[(g * SC + c) * SN + n] * s.x - c_im[(g * SC + c) * SN + n] * s.y; }
    y += dsk[g * SC + c] * bf2f(P[t * INC + C_U + ch]);
    G1[idx] = gelu_tanh(y);
}
__global__ void __launch_bounds__(512) k_glu(const float* __restrict__ G1, const float* __restrict__ w, const float* __restrict__ bg, float* __restrict__ SY) {
    __shared__ float row[SSMW];
    const int t = blockIdx.x, j = threadIdx.x;
    row[j] = G1[(size_t)t * SSMW + j];
    __syncthreads();
    float z = bg[j];
    for (int k = 0; k < SSMW; ++k) z += row[k] * w[(size_t)k * SSMW + j];
    SY[(size_t)t * SSMW + j] = row[j] / (1.f + expf(-z));
}
__global__ void __launch_bounds__(256) k_post(const bf16_t* __restrict__ SBO, const float* __restrict__ SY, const bf16_t* __restrict__ O1, const bf16_t* __restrict__ O2,
                                             const float* sbg, const float* ssmg, const float* dfg, const float* lq1, const float* lk1, const float* lq2, const float* lk2,
                                             float lam_init, bf16_t* __restrict__ Y) {
    __shared__ float red[16];
    const int t = blockIdx.x, tid = threadIdx.x;
    float a = 0.f, c = 0.f;
    if (tid < 64) { a = lq1[tid] * lk1[tid]; c = lq2[tid] * lk2[tid]; }
    a = block_sum(a, red); c = block_sum(c, red);
    const float lam = expf(a) - expf(c) + lam_init;
    { float v0 = bf2f(SBO[(size_t)t * SBW + tid]), v1 = bf2f(SBO[(size_t)t * SBW + 256 + tid]);
      const float s = block_sum(v0 * v0 + v1 * v1, red); const float r = rsqrtf(s / SBW + EPS);
      Y[(size_t)t * D + tid] = f2bf(v0 * r * sbg[tid]); Y[(size_t)t * D + 256 + tid] = f2bf(v1 * r * sbg[256 + tid]); }
    { float v0 = SY[(size_t)t * SSMW + tid], v1 = SY[(size_t)t * SSMW + 256 + tid];
      const float s = block_sum(v0 * v0 + v1 * v1, red); const float r = rsqrtf(s / SSMW + EPS);
      Y[(size_t)t * D + 512 + tid] = f2bf(v0 * r * ssmg[tid]); Y[(size_t)t * D + 768 + tid] = f2bf(v1 * r * ssmg[256 + tid]); }
    for (int i = 0; i < 4; ++i) {
        const int e = tid + 256 * i; const int dv = e & 127;
        const float v = bf2f(O1[(size_t)t * DFW + e]) - lam * bf2f(O2[(size_t)t * DFW + e]);
        float s = v * v;
        for (int o = 32; o > 0; o >>= 1) s += __shfl_xor(s, o);
        __syncthreads();
        if ((tid & 63) == 0) red[tid >> 6] = s;
        __syncthreads();
        const int w = tid >> 6; const float tot = red[w & ~1] + red[(w & ~1) + 1];
        const float r = rsqrtf(tot / DFV + EPS);
        Y[(size_t)t * D + 1024 + e] = f2bf(v * r * dfg[dv] * (1.f - lam_init));
    }
}
__global__ void __launch_bounds__(256) k_route(const float* __restrict__ H, const float* __restrict__ g, const float* __restrict__ rgw, const float* __restrict__ rgb,
                                              const float* __restrict__ rew, const float* __restrict__ reb, bf16_t* __restrict__ HN, int* __restrict__ EI, float* __restrict__ EW) {
    __shared__ float red[16];
    __shared__ float hn[D];
    const int t = blockIdx.x, tid = threadIdx.x;
    float s = 0.f;
    for (int i = 0; i < 8; ++i) { const float v = H[(size_t)t * D + tid + 256 * i]; hn[tid + 256 * i] = v; s += v * v; }
    s = block_sum(s, red);
    const float r = rsqrtf(s / D + EPS);
    for (int i = 0; i < 8; ++i) { const int d = tid + 256 * i; const float v = hn[d] * r * g[d]; hn[d] = v; HN[(size_t)t * D + d] = f2bf(v); }
    __syncthreads();
    float gl[NGRP];
#pragma unroll
    for (int j = 0; j < NGRP; ++j) { float p = 0.f; for (int i = 0; i < 8; ++i) { const int d = tid + 256 * i; p += hn[d] * rgw[(size_t)d * NGRP + j]; } gl[j] = block_sum(p, red) + rgb[j]; }
    int gi = 0; float gm = gl[0];
#pragma unroll
    for (int j = 1; j < NGRP; ++j) if (gl[j] > gm) { gm = gl[j]; gi = j; }
    float gs = 0.f;
#pragma unroll
    for (int j = 0; j < NGRP; ++j) gs += expf(gl[j] - gm);
    const float gtop = 1.f / gs;
    float m0 = -INFINITY, m1 = -INFINITY; int i0 = 0, i1 = 0;
#pragma unroll
    for (int e = 0; e < EPG; ++e) { float p = 0.f; for (int i = 0; i < 8; ++i) { const int d = tid + 256 * i; p += hn[d] * rew[((size_t)gi * D + d) * EPG + e]; }
        const float v = block_sum(p, red) + reb[gi * EPG + e];
        if (v > m0) { m1 = m0; i1 = i0; m0 = v; i0 = e; } else if (v > m1) { m1 = v; i1 = e; } }
    const float p1 = expf(m1 - m0);
    const float w0 = 1.f / (1.f + p1) * gtop, w1 = p1 / (1.f + p1) * gtop;
    if (tid == 0) { EI[t * 2] = gi * EPG + i0; EI[t * 2 + 1] = gi * EPG + i1; EW[t * 2] = w0; EW[t * 2 + 1] = w1; }
}
__global__ void __launch_bounds__(512) k_moe_h(const bf16_t* __restrict__ HN, const int* __restrict__ EI, const float* __restrict__ EW, const float* __restrict__ w1, const float* __restrict__ w3, float* __restrict__ HB) {
    __shared__ float xr[D];
    const int ts = blockIdx.x, t = ts >> 1, f = threadIdx.x;
    for (int i = 0; i < 4; ++i) xr[f + 512 * i] = bf2f(HN[(size_t)t * D + f + 512 * i]);
    __syncthreads();
    const int e = EI[ts]; const float gw = EW[ts];
    const float* a1 = w1 + (size_t)e * D * DE + f; const float* a3 = w3 + (size_t)e * D * DE + f;
    float a = 0.f, b = 0.f;
    for (int d = 0; d < D; ++d) { a += xr[d] * a1[(size_t)d * DE]; b += xr[d] * a3[(size_t)d * DE]; }
    HB[(size_t)ts * DE + f] = a / (1.f + expf(-a)) * b * gw;
}
__global__ void __launch_bounds__(512) k_moe_y(const float* __restrict__ HB, const int* __restrict__ EI, const float* __restrict__ w2, bf16_t* __restrict__ YS) {
    __shared__ float hr[DE];
    const int ts = blockIdx.x, j = threadIdx.x;
    hr[j] = HB[(size_t)ts * DE + j];
    __syncthreads();
    const int e = EI[ts];
    const float* w = w2 + (size_t)e * DE * D;
    float acc[4] = {0.f, 0.f, 0.f, 0.f};
    for (int f = 0; f < DE; ++f) { const float hv = hr[f]; for (int i = 0; i < 4; ++i) acc[i] += hv * w[(size_t)f * D + j + 512 * i]; }
    for (int i = 0; i < 4; ++i) YS[(size_t)ts * D + j + 512 * i] = f2bf(acc[i]);
}
__global__ void __launch_bounds__(256) k_combine(float* __restrict__ H, const bf16_t* __restrict__ YS, const float* __restrict__ g, bf16_t* __restrict__ XN, float* __restrict__ out) {
    __shared__ float red[16];
    const int t = blockIdx.x, tid = threadIdx.x;
    float v[8]; float s = 0.f;
    for (int i = 0; i < 8; ++i) { const int d = tid + 256 * i; v[i] = H[(size_t)t * D + d] + bf2f(YS[((size_t)t * 2) * D + d]) + bf2f(YS[((size_t)t * 2 + 1) * D + d]); s += v[i] * v[i]; }
    s = block_sum(s, red);
    const float r = rsqrtf(s / D + EPS);
    for (int i = 0; i < 8; ++i) { const int d = tid + 256 * i;
        if (out) out[(size_t)t * D + d] = v[i] * r * g[d];
        else { H[(size_t)t * D + d] = v[i]; XN[(size_t)t * D + d] = f2bf(v[i] * r * g[d]); } }
}
}

extern "C" void kernel_launch(void* const* d_in, const int* in_sizes, int n_in, void* d_out, int out_size, void* d_ws, size_t ws_size, hipStream_t stream) {
    using namespace nv;
    const float* x = (const float*)d_in[0];
    const float* norm_mix_g = (const float*)d_in[1]; const float* w_in = (const float*)d_in[2]; const float* sb_norm_g = (const float*)d_in[3];
    const float* lam_re = (const float*)d_in[4]; const float* lam_im = (const float*)d_in[5]; const float* b_re = (const float*)d_in[6]; const float* b_im = (const float*)d_in[7];
    const float* c_re = (const float*)d_in[8]; const float* c_im = (const float*)d_in[9]; const float* ssm_d = (const float*)d_in[10]; const float* log_dt = (const float*)d_in[11];
    const float* w_glu = (const float*)d_in[12]; const float* b_glu = (const float*)d_in[13]; const float* ssm_norm_g = (const float*)d_in[14];
    const float* lq1 = (const float*)d_in[15]; const float* lk1 = (const float*)d_in[16]; const float* lq2 = (const float*)d_in[17]; const float* lk2 = (const float*)d_in[18];
    const float* subln = (const float*)d_in[19]; const float* w_out = (const float*)d_in[20]; const float* norm_ffn_g = (const float*)d_in[21];
    const float* rgw = (const float*)d_in[22]; const float* rgb = (const float*)d_in[23]; const float* rew = (const float*)d_in[24]; const float* reb = (const float*)d_in[25];
    const float* ew1 = (const float*)d_in[26]; const float* ew3 = (const float*)d_in[27]; const float* ew2 = (const float*)d_in[28]; const float* final_g = (const float*)d_in[29];
    char* ws = (char*)d_ws; size_t off = 0;
    auto carve = [&](size_t bytes) { char* p = ws + off; off += (bytes + 255) & ~(size_t)255; return p; };
    bf16_t* XN = (bf16_t*)carve((size_t)T * D * 2);
    bf16_t* PROJ = (bf16_t*)carve((size_t)T * INC * 2);
    bf16_t* SBO = (bf16_t*)carve((size_t)T * SBW * 2);
    bf16_t* O1 = (bf16_t*)carve((size_t)T * DFW * 2);
    bf16_t* O2 = (bf16_t*)carve((size_t)T * DFW * 2);
    float2* ST = (float2*)carve((size_t)T * SG * SN * 8);
    float* G1 = (float*)carve((size_t)T * SSMW * 4);
    float* SY = (float*)carve((size_t)T * SSMW * 4);
    bf16_t* Y = (bf16_t*)carve((size_t)T * D * 2);
    float* H = (float*)carve((size_t)T * D * 4);
    int* EI = (int*)carve((size_t)T * 2 * 4);
    float* EW = (float*)carve((size_t)T * 2 * 4);
    float* HB = (float*)carve((size_t)T * 2 * DE * 4);
    bf16_t* YS = (bf16_t*)carve((size_t)T * 2 * D * 2);
    if (off > ws_size) { fprintf(stderr, "ws too small: need %zu have %zu\n", off, ws_size); return; }

    k_rmsnorm<<<T, 256, 0, stream>>>(x, norm_mix_g, XN);
    for (int l = 0; l < DEPTH; ++l) {
        const float lam_init = 0.8f - 0.6f * expf(-0.3f * (float)l);
        const float* xin = (l == 0) ? x : H;
        k_gemm<0><<<dim3(INC / 64, T / 64), 256, 0, stream>>>(XN, D, w_in + (size_t)l * D * INC, INC, D, PROJ, INC, nullptr);
        k_sb_attn<<<dim3(L, SBH, NB), 256, 0, stream>>>(PROJ, SBO);
        k_diff_attn<<<dim3(L, DFH * 2, NB), 256, 0, stream>>>(PROJ, O1, O2);
        k_s5_scan<<<NB * SG, 64, 0, stream>>>(PROJ, lam_re + l * SG * SN, lam_im + l * SG * SN, b_re + (size_t)l * SG * SN * SC, b_im + (size_t)l * SG * SN * SC, log_dt + l * SG, ST);
        k_s5_out<<<T * SSMW / 256, 256, 0, stream>>>(PROJ, ST, c_re + (size_t)l * SG * SC * SN, c_im + (size_t)l * SG * SC * SN, ssm_d + l * SSMW, G1);
        k_glu<<<T, 512, 0, stream>>>(G1, w_glu + (size_t)l * SSMW * SSMW, b_glu + l * SSMW, SY);
        k_post<<<T, 256, 0, stream>>>(SBO, SY, O1, O2, sb_norm_g + l * SBW, ssm_norm_g + l * SSMW, subln + l * DFV, lq1 + l * 64, lk1 + l * 64, lq2 + l * 64, lk2 + l * 64, lam_init, Y);
        k_gemm<1><<<dim3(D / 64, T / 64), 256, 0, stream>>>(Y, D, w_out + (size_t)l * D * D, D, D, H, D, xin);
        k_route<<<T, 256, 0, stream>>>(H, norm_ffn_g + l * D, rgw + (size_t)l * D * NGRP, rgb + l * NGRP, rew + (size_t)l * NGRP * D * EPG, reb + l * NGRP * EPG, XN, EI, EW);
        k_moe_h<<<T * 2, 512, 0, stream>>>(XN, EI, EW, ew1 + (size_t)l * NEXP * D * DE, ew3 + (size_t)l * NEXP * D * DE, HB);
        k_moe_y<<<T * 2, 512, 0, stream>>>(HB, EI, ew2 + (size_t)l * NEXP * DE * D, YS);
        if (l + 1 < DEPTH) k_combine<<<T, 256, 0, stream>>>(H, YS, norm_mix_g + (l + 1) * D, XN, nullptr);
        else k_combine<<<T, 256, 0, stream>>>(H, YS, final_g, nullptr, (float*)d_out);
    }
}
```

```cpp
#include <hip/hip_runtime.h>
#include <hip/hip_bf16.h>
#include <cstdint>
#include <cstdio>
#include <cmath>
__device__ __forceinline__ int opaque_tid() { int t = threadIdx.x; asm volatile("" : "+v"(t)); return t; }
namespace nv {
constexpr int NB = 4, L = 2048, D = 2048, T = NB * L, DEPTH = 2;
constexpr int SBW = 512, SBH = 8, SSMW = 512, SG = 32, SN = 64, SC = 16, DFW = 1024, DFH = 8, DFV = 128;
constexpr int INC = 5120, NEXP = 32, EPG = 8, NGRP = 4, DE = 512;
constexpr int C_SBQ = 0, C_SBK = 512, C_SBV = 1024, C_U = 1536, C_DQ = 2048, C_DK = 3072, C_DV = 4096;
constexpr float EPS = 1e-6f;
constexpr float LOG2E = 1.4426950408889634f;
constexpr float QS_SB = 0.125f * LOG2E, QS_DF = 0.125f * LOG2E;

typedef unsigned short bf16_t;
__device__ __forceinline__ float bf2f(bf16_t v) { return __uint_as_float(((unsigned)v) << 16); }
__device__ __forceinline__ bf16_t f2bf(float f) { unsigned u = __float_as_uint(f); return (bf16_t)((u + 0x7fffu + ((u >> 16) & 1u)) >> 16); }

__device__ __forceinline__ float block_sum(float v, float* red) {
    for (int o = 32; o > 0; o >>= 1) v += __shfl_xor(v, o);
    const int w = threadIdx.x >> 6, nw = blockDim.x >> 6;
    __syncthreads();
    if ((threadIdx.x & 63) == 0) red[w] = v;
    __syncthreads();
    float s = 0.f;
    for (int i = 0; i < nw; ++i) s += red[i];
    return s;
}
__device__ __forceinline__ float block_max(float v, float* red) {
    for (int o = 32; o > 0; o >>= 1) v = fmaxf(v, __shfl_xor(v, o));
    const int w = threadIdx.x >> 6, nw = blockDim.x >> 6;
    __syncthreads();
    if ((threadIdx.x & 63) == 0) red[w] = v;
    __syncthreads();
    float s = -INFINITY;
    for (int i = 0; i < nw; ++i) s = fmaxf(s, red[i]);
    return s;
}

__global__ void __launch_bounds__(256) k_rmsnorm(const float* __restrict__ x, const float* __restrict__ g, bf16_t* __restrict__ out) {
    __shared__ float red[16];
    const int t = blockIdx.x; const float* xr = x + (size_t)t * D;
    float v[8]; float s = 0.f;
    for (int i = 0; i < 8; ++i) { v[i] = xr[threadIdx.x + 256 * i]; s += v[i] * v[i]; }
    s = block_sum(s, red);
    const float r = rsqrtf(s / D + EPS);
    for (int i = 0; i < 8; ++i) out[(size_t)t * D + threadIdx.x + 256 * i] = f2bf(v[i] * r * g[threadIdx.x + 256 * i]);
}

template <int EPI>
__global__ void __launch_bounds__(256) k_gemm(const bf16_t* __restrict__ A, int lda, const float* __restrict__ Bm, int ldb, int K,
                                             void* __restrict__ Cout, int ldc, const float* __restrict__ R) {
    __shared__ float As[16][68];
    __shared__ float Bs[16][68];
    const int tx = threadIdx.x & 15, ty = threadIdx.x >> 4;
    const int m0 = blockIdx.y * 64, n0 = blockIdx.x * 64;
    float acc[4][4];
    for (int i = 0; i < 4; ++i) for (int j = 0; j < 4; ++j) acc[i][j] = 0.f;
    for (int k0 = 0; k0 < K; k0 += 16) {
        for (int e = threadIdx.x; e < 64 * 16; e += 256) { const int r = e >> 4, c = e & 15; As[c][r] = bf2f(A[(size_t)(m0 + r) * lda + k0 + c]); }
        for (int e = threadIdx.x; e < 64 * 16; e += 256) { const int r = e >> 6, c = e & 63; Bs[r][c] = Bm[(size_t)(k0 + r) * ldb + n0 + c]; }
        __syncthreads();
#pragma unroll
        for (int k = 0; k < 16; ++k) {
            float a[4], b[4];
            for (int i = 0; i < 4; ++i) a[i] = As[k][ty * 4 + i];
            for (int j = 0; j < 4; ++j) b[j] = Bs[k][tx * 4 + j];
            for (int i = 0; i < 4; ++i) for (int j = 0; j < 4; ++j) acc[i][j] += a[i] * b[j];
        }
        __syncthreads();
    }
    for (int i = 0; i < 4; ++i) for (int j = 0; j < 4; ++j) {
        const int m = m0 + ty * 4 + i, n = n0 + tx * 4 + j;
        if (EPI == 0) {
            float sc = 1.f; if (n < C_SBK) sc = QS_SB; else if (n >= C_DQ && n < C_DK) sc = QS_DF;
            ((bf16_t*)Cout)[(size_t)m * ldc + n] = f2bf(acc[i][j] * sc);
        } else {
            ((float*)Cout)[(size_t)m * ldc + n] = acc[i][j] + R[(size_t)m * ldc + n];
        }
    }
}

__global__ void __launch_bounds__(256) k_sb_attn(const bf16_t* __restrict__ P, bf16_t* __restrict__ O) {
    __shared__ float zs[L];
    __shared__ float qv[64];
    __shared__ float part[4][64];
    const int t = blockIdx.x, h = blockIdx.y, b = blockIdx.z, tid = threadIdx.x;
    const size_t rowb = (size_t)b * L;
    if (tid < 64) qv[tid] = bf2f(P[(rowb + t) * INC + C_SBQ + h * 64 + tid]);
    __syncthreads();
    for (int s = tid; s < t; s += 256) {
        const bf16_t* kr = P + (rowb + s) * INC + C_SBK + h * 64;
        float z = 0.f;
        for (int d = 0; d < 64; ++d) z += qv[d] * bf2f(kr[d]);
        zs[s] = z;
    }
    __syncthreads();
    if (tid == 0) {
        float Racc = 0.f;
        for (int s = t - 1; s >= 0; --s) {
            const float z = zs[s];
            const float sp = fmaxf(-z, 0.f) + log1pf(expf(-fabsf(z)));
            zs[s] = expf(-sp + Racc);
            Racc += -(sp + z);
        }
    }
    __syncthreads();
    const int d = tid & 63, gq = tid >> 6;
    float o = 0.f;
    for (int s = gq; s < t; s += 4) o += zs[s] * bf2f(P[(rowb + s) * INC + C_SBV + h * 64 + d]);
    part[gq][d] = o;
    __syncthreads();
    if (tid < 64) O[(rowb + t) * SBW + h * 64 + tid] = f2bf(part[0][tid] + part[1][tid] + part[2][tid] + part[3][tid]);
}

__global__ void __launch_bounds__(256) k_diff_attn(const bf16_t* __restrict__ P, bf16_t* __restrict__ O1, bf16_t* __restrict__ O2) {
    __shared__ float ps[L];
    __shared__ float qv[64];
    __shared__ float part[2][128];
    __shared__ float red[16];
    const int t = blockIdx.x, h = blockIdx.y >> 1, mp = blockIdx.y & 1, b = blockIdx.z, tid = threadIdx.x;
    const size_t rowb = (size_t)b * L;
    if (tid < 64) qv[tid] = bf2f(P[(rowb + t) * INC + C_DQ + h * 128 + mp * 64 + tid]);
    __syncthreads();
    float mx = -INFINITY;
    for (int s = tid; s <= t; s += 256) {
        const bf16_t* kr = P + (rowb + s) * INC + C_DK + h * 128 + mp * 64;
        float z = 0.f;
        for (int d = 0; d < 64; ++d) z += qv[d] * bf2f(kr[d]);
        ps[s] = z; mx = fmaxf(mx, z);
    }
    mx = block_max(mx, red);
    float sum = 0.f;
    for (int s = tid; s <= t; s += 256) { const float p = exp2f(ps[s] - mx); ps[s] = p; sum += p; }
    sum = block_sum(sum, red);
    __syncthreads();
    const int d = tid & 127, gq = tid >> 7;
    float o = 0.f;
    for (int s = gq; s <= t; s += 2) o += ps[s] * bf2f(P[(rowb + s) * INC + C_DV + h * 128 + d]);
    part[gq][d] = o;
    __syncthreads();
    if (tid < 128) { bf16_t* O = mp ? O2 : O1; O[(rowb + t) * DFW + h * 128 + tid] = f2bf((part[0][tid] + part[1][tid]) / sum); }
}

__global__ void __launch_bounds__(64) k_s5_scan(const bf16_t* __restrict__ P, const float* lam_re, const float* lam_im, const float* b_re, const float* b_im,
                                                const float* log_dt, float2* __restrict__ ST) {
    const int b = blockIdx.x / SG, g = blockIdx.x % SG, n = threadIdx.x;
    const double dt = exp((double)log_dt[g]);
    const double lr = lam_re[g * SN + n], li = lam_im[g * SN + n];
    const double er = exp(lr * dt), lbr = er * cos(li * dt), lbi = er * sin(li * dt);
    const double nr = lbr - 1.0, ni = lbi, den = lr * lr + li * li;
    const double fr = (nr * lr + ni * li) / den, fi = (ni * lr - nr * li) / den;
    float bbr[SC], bbi[SC];
#pragma unroll
    for (int c = 0; c < SC; ++c) { const double br = b_re[(g * SN + n) * SC + c], bi = b_im[(g * SN + n) * SC + c]; bbr[c] = (float)(fr * br - fi * bi); bbi[c] = (float)(fr * bi + fi * br); }
    const float ar = (float)lbr, ai = (float)lbi;
    float sr = 0.f, si = 0.f;
    for (int t = 0; t < L; ++t) {
        const bf16_t* ur = P + ((size_t)b * L + t) * INC + C_U + g * SC;
        float bur = 0.f, bui = 0.f;
#pragma unroll
        for (int c = 0; c < SC; ++c) { const float u = bf2f(ur[c]); bur += bbr[c] * u; bui += bbi[c] * u; }
        const float nsr = ar * sr - ai * si + bur, nsi = ar * si + ai * sr + bui;
        sr = nsr; si = nsi;
        ST[(((size_t)b * L + t) * SG + g) * SN + n] = make_float2(sr, si);
    }
}
__device__ __forceinline__ float gelu_tanh(float x) { const float u = 0.7978845608028654f * (x + 0.044715f * x * x * x); return 0.5f * x * (1.f + tanhf(u)); }
__global__ void __launch_bounds__(256) k_s5_out(const bf16_t* __restrict__ P, const float2* __restrict__ ST, const float* c_re, const float* c_im, const float* dsk, float* __restrict__ G1) {
    const size_t idx = (size_t)blockIdx.x * 256 + threadIdx.x;
    const int ch = (int)(idx % SSMW); const size_t t = idx / SSMW; const int g = ch / SC, c = ch % SC;
    const float2* st = ST + (t * SG + g) * SN;
    float y = 0.f;
    for (int n = 0; n < SN; ++n) { const float2 s = st[n]; y += c_re[(g * SC + c) * SN + n] * s.x - c_im[(g * SC + c) * SN + n] * s.y; }
    y += dsk[g * SC + c] * bf2f(P[t * INC + C_U + ch]);
    G1[idx] = gelu_tanh(y);
}
__global__ void __launch_bounds__(512) k_glu(const float* __restrict__ G1, const float* __restrict__ w, const float* __restrict__ bg, float* __restrict__ SY) {
    __shared__ float row[SSMW];
    const int t = blockIdx.x, j = threadIdx.x;
    row[j] = G1[(size_t)t * SSMW + j];
    __syncthreads();
    float z = bg[j];
    for (int k = 0; k < SSMW; ++k) z += row[k] * w[(size_t)k * SSMW + j];
    SY[(size_t)t * SSMW + j] = row[j] / (1.f + expf(-z));
}
__global__ void __launch_bounds__(256) k_post(const bf16_t* __restrict__ SBO, const float* __restrict__ SY, const bf16_t* __restrict__ O1, const bf16_t* __restrict__ O2,
                                             const float* sbg, const float* ssmg, const float* dfg, const float* lq1, const float* lk1, const float* lq2, const float* lk2,
                                             float lam_init, bf16_t* __restrict__ Y) {
    __shared__ float red[16];
    const int t = blockIdx.x, tid = threadIdx.x;
    float a = 0.f, c = 0.f;
    if (tid < 64) { a = lq1[tid] * lk1[tid]; c = lq2[tid] * lk2[tid]; }
    a = block_sum(a, red); c = block_sum(c, red);
    const float lam = expf(a) - expf(c) + lam_init;
    { float v0 = bf2f(SBO[(size_t)t * SBW + tid]), v1 = bf2f(SBO[(size_t)t * SBW + 256 + tid]);
      const float s = block_sum(v0 * v0 + v1 * v1, red); const float r = rsqrtf(s / SBW + EPS);
      Y[(size_t)t * D + tid] = f2bf(v0 * r * sbg[tid]); Y[(size_t)t * D + 256 + tid] = f2bf(v1 * r * sbg[256 + tid]); }
    { float v0 = SY[(size_t)t * SSMW + tid], v1 = SY[(size_t)t * SSMW + 256 + tid];
      const float s = block_sum(v0 * v0 + v1 * v1, red); const float r = rsqrtf(s / SSMW + EPS);
      Y[(size_t)t * D + 512 + tid] = f2bf(v0 * r * ssmg[tid]); Y[(size_t)t * D + 768 + tid] = f2bf(v1 * r * ssmg[256 + tid]); }
    for (int i = 0; i < 4; ++i) {
        const int e = tid + 256 * i; const int dv = e & 127;
        const float v = bf2f(O1[(size_t)t * DFW + e]) - lam * bf2f(O2[(size_t)t * DFW + e]);
        float s = v * v;
        for (int o = 32; o > 0; o >>= 1) s += __shfl_xor(s, o);
        __syncthreads();
        if ((tid & 63) == 0) red[tid >> 6] = s;
        __syncthreads();
        const int w = tid >> 6; const float tot = red[w & ~1] + red[(w & ~1) + 1];
        const float r = rsqrtf(tot / DFV + EPS);
        Y[(size_t)t * D + 1024 + e] = f2bf(v * r * dfg[dv] * (1.f - lam_init));
    }
}
__global__ void __launch_bounds__(256) k_route(const float* __restrict__ H, const float* __restrict__ g, const float* __restrict__ rgw, const float* __restrict__ rgb,
                                              const float* __restrict__ rew, const float* __restrict__ reb, bf16_t* __restrict__ HN, int* __restrict__ EI, float* __restrict__ EW) {
    __shared__ float red[16];
    __shared__ float hn[D];
    const int t = blockIdx.x, tid = threadIdx.x;
    float s = 0.f;
    for (int i = 0; i < 8; ++i) { const float v = H[(size_t)t * D + tid + 256 * i]; hn[tid + 256 * i] = v; s += v * v; }
    s = block_sum(s, red);
    const float r = rsqrtf(s / D + EPS);
    for (int i = 0; i < 8; ++i) { const int d = tid + 256 * i; const float v = hn[d] * r * g[d]; hn[d] = v; HN[(size_t)t * D + d] = f2bf(v); }
    __syncthreads();
    float gl[NGRP];
#pragma unroll
    for (int j = 0; j < NGRP; ++j) { float p = 0.f; for (int i = 0; i < 8; ++i) { const int d = tid + 256 * i; p += hn[d] * rgw[(size_t)d * NGRP + j]; } gl[j] = block_sum(p, red) + rgb[j]; }
    int gi = 0; float gm = gl[0];
#pragma unroll
    for (int j = 1; j < NGRP; ++j) if (gl[j] > gm) { gm = gl[j]; gi = j; }
    float gs = 0.f;
#pragma unroll
    for (int j = 0; j < NGRP; ++j) gs += expf(gl[j] - gm);
    const float gtop = 1.f / gs;
    float m0 = -INFINITY, m1 = -INFINITY; int i0 = 0, i1 = 0;
#pragma unroll
    for (int e = 0; e < EPG; ++e) { float p = 0.f; for (int i = 0; i < 8; ++i) { const int d = tid + 256 * i; p += hn[d] * rew[((size_t)gi * D + d) * EPG + e]; }
        const float v = block_sum(p, red) + reb[gi * EPG + e];
        if (v > m0) { m1 = m0; i1 = i0; m0 = v; i0 = e; } else if (v > m1) { m1 = v; i1 = e; } }
    const float p1 = expf(m1 - m0);
    const float w0 = 1.f / (1.f + p1) * gtop, w1 = p1 / (1.f + p1) * gtop;
    if (tid == 0) { EI[t * 2] = gi * EPG + i0; EI[t * 2 + 1] = gi * EPG + i1; EW[t * 2] = w0; EW[t * 2 + 1] = w1; }
}
__global__ void __launch_bounds__(512) k_moe_h(const bf16_t* __restrict__ HN, const int* __restrict__ EI, const float* __restrict__ EW, const float* __restrict__ w1, const float* __restrict__ w3, float* __restrict__ HB) {
    __shared__ float xr[D];
    const int ts = blockIdx.x, t = ts >> 1, f = threadIdx.x;
    for (int i = 0; i < 4; ++i) xr[f + 512 * i] = bf2f(HN[(size_t)t * D + f + 512 * i]);
    __syncthreads();
    const int e = EI[ts]; const float gw = EW[ts];
    const float* a1 = w1 + (size_t)e * D * DE + f; const float* a3 = w3 + (size_t)e * D * DE + f;
    float a = 0.f, b = 0.f;
    for (int d = 0; d < D; ++d) { a += xr[d] * a1[(size_t)d * DE]; b += xr[d] * a3[(size_t)d * DE]; }
    HB[(size_t)ts * DE + f] = a / (1.f + expf(-a)) * b * gw;
}
__global__ void __launch_bounds__(512) k_moe_y(const float* __restrict__ HB, const int* __restrict__ EI, const float* __restrict__ w2, bf16_t* __restrict__ YS) {
    __shared__ float hr[DE];
    const int ts = blockIdx.x, j = threadIdx.x;
    hr[j] = HB[(size_t)ts * DE + j];
    __syncthreads();
    const int e = EI[ts];
    const float* w = w2 + (size_t)e * DE * D;
    float acc[4] = {0.f, 0.f, 0.f, 0.f};
    for (int f = 0; f < DE; ++f) { const float hv = hr[f]; for (int i = 0; i < 4; ++i) acc[i] += hv * w[(size_t)f * D + j + 512 * i]; }
    for (int i = 0; i < 4; ++i) YS[(size_t)ts * D + j + 512 * i] = f2bf(acc[i]);
}
__global__ void __launch_bounds__(256) k_combine(float* __restrict__ H, const bf16_t* __restrict__ YS, const float* __restrict__ g, bf16_t* __restrict__ XN, float* __restrict__ out) {
    __shared__ float red[16];
    const int t = blockIdx.x, tid = threadIdx.x;
    float v[8]; float s = 0.f;
    for (int i = 0; i < 8; ++i) { const int d = tid + 256 * i; v[i] = H[(size_t)t * D + d] + bf2f(YS[((size_t)t * 2) * D + d]) + bf2f(YS[((size_t)t * 2 + 1) * D + d]); s += v[i] * v[i]; }
    s = block_sum(s, red);
    const float r = rsqrtf(s / D + EPS);
    for (int i = 0; i < 8; ++i) { const int d = tid + 256 * i;
        if (out) out[(size_t)t * D + d] = v[i] * r * g[d];
        else { H[(size_t)t * D + d] = v[i]; XN[(size_t)t * D + d] = f2bf(v[i] * r * g[d]); } }
}
}

namespace pg8 {
#define PG8_LAS __attribute__((address_space(3)))
typedef unsigned short bf16_t;
typedef short bf16x8 __attribute__((ext_vector_type(8)));
typedef float f32x4 __attribute__((ext_vector_type(4)));
typedef unsigned u32x4 __attribute__((ext_vector_type(4)));
constexpr int BM = 256, BK = 64, HALF = 128, HTB = HALF * BK * 2  , STAGE_BYTES = 8 * HTB, NXCD = 8, WGM = 8;

__host__ __device__ __forceinline__ int lds_byte(int r, int c) { const int st = (r >> 4) * 2 + (c >> 5), rr = r & 15, cc = c & 31, ob = rr * 64 + cc * 2; return st * 1024 + (ob ^ (((ob >> 9) & 1) << 5)); }
__host__ __device__ __forceinline__ void stage_rc(int b, int& R, int& C) { const int st = b / 1024, sb = b % 1024, swz = sb ^ (((sb >> 9) & 1) << 5); R = (st >> 1) * 16 + swz / 64; C = (st & 1) * 32 + (swz % 64) / 2; }
__host__ __device__ __forceinline__ int perm32(int rho) { const int n = rho >> 4, i = rho & 15; return 8 * (i >> 2) + 4 * n + (i & 3); }

struct Unit { int pm, pn; };
struct Gemm { const bf16_t* A; const bf16_t* Bt; int M, N, K; };

struct StaticOrder {
    int nM, nN, nwg, G, c;
    __host__ __device__ void init(int M, int N, int G_, int c_) { nM = M / BM; nN = N / BM; nwg = nM * nN; G = G_; c = c_; }
    __host__ __device__ bool next(int i, Unit& u) const {
        const long L = (long)i * G + c; if (L >= nwg) return false;
        int wgid = (int)L; { const int q = nwg / NXCD, r = nwg % NXCD, xcd = wgid % NXCD, off = wgid / NXCD; wgid = (xcd < r ? xcd * (q + 1) : r * (q + 1) + (xcd - r) * q) + off; }
        const int nig = WGM * nN, gid = wgid / nig, fm = gid * WGM, gsz = (nM - fm) < WGM ? (nM - fm) : WGM;
        u.pm = fm + ((wgid % nig) % gsz); u.pn = (wgid % nig) / gsz; return true;
    }
    __device__ __forceinline__ void a_ready(const Unit&) const {}
    __device__ __forceinline__ void done(const Unit&) const {}
};

__device__ __forceinline__ unsigned cvt_pk_bf16(float lo, float hi) { unsigned r; asm volatile("v_cvt_pk_bf16_f32 %0, %1, %2" : "=v"(r) : "v"(lo), "v"(hi)); return r; }
typedef float f32x2 __attribute__((ext_vector_type(2)));
__device__ __forceinline__ f32x2 gelu_pk(f32x2 v) {
    const f32x2 av = __builtin_elementwise_abs(v), d = av * 0.2316418882f + 1.0f;
    f32x2 t; t.x = __builtin_amdgcn_rcpf(d.x); t.y = __builtin_amdgcn_rcpf(d.y);
    f32x2 q = t * 0.5307027145f + (-0.7265760135f); q = q * t + 0.7107068705f; q = q * t + (-0.142248368f); q = q * t + 0.127414796f; q = q * t;
    const f32x2 s = (v * v) * (-0.72134752044f);
    f32x2 e; e.x = __builtin_amdgcn_exp2f(s.x); e.y = __builtin_amdgcn_exp2f(s.y);
    const f32x2 m = v * (q * e), r = v - m;
    f32x2 o; o.x = v.x < 0.f ? m.x : r.x; o.y = v.y < 0.f ? m.y : r.y; return o;
}

template <int ACT  > struct EpiBf16 {
    static constexpr bool PERM = true, AFTER_DRAIN = false; static_assert(ACT == 0 || ACT == 1, "EpiBf16: ACT is 0 (none) or 1 (gelu_pk)");
    bf16_t* O; int ldc; const float* bias; int split_cols; size_t split_stride; float scale0;
    __device__ __forceinline__ void operator()(const f32x4 (&acc)[2][2][4][2], const Unit& u, int wr, int wc, int fr, int fq) const {
        const int row0 = u.pm * BM + wr * 64 + fr; int colt = u.pn * BM; bf16_t* base = O;
        float sc = 1.f; if (split_cols) { const int t = colt / split_cols; base += (size_t)t * split_stride; colt -= t * split_cols; if (t == 0) sc = scale0; }
        const int col0 = colt + wc * 32 + 8 * fq, bcol0 = u.pn * BM + wc * 32 + 8 * fq;
        f32x4 bv[2][2];
#pragma unroll
        for (int bj = 0; bj < 2; ++bj)
#pragma unroll
            for (int n = 0; n < 2; ++n) bv[bj][n] = bias ? *(const f32x4*)(bias + bcol0 + bj * HALF + 4 * n) : (f32x4){0.f, 0.f, 0.f, 0.f};
#pragma unroll
        for (int ai = 0; ai < 2; ++ai)
#pragma unroll
            for (int m = 0; m < 4; ++m) { bf16_t* rowp = base + (size_t)(row0 + ai * HALF + m * 16) * ldc + col0;
#pragma unroll
                for (int bj = 0; bj < 2; ++bj) { f32x4 v0 = acc[ai][bj][m][0] + bv[bj][0], v1 = acc[ai][bj][m][1] + bv[bj][1];
                    if (ACT == 1) { f32x2 a = gelu_pk((f32x2){v0[0], v0[1]}), b = gelu_pk((f32x2){v0[2], v0[3]}), c = gelu_pk((f32x2){v1[0], v1[1]}), d = gelu_pk((f32x2){v1[2], v1[3]});
                        v0 = (f32x4){a.x, a.y, b.x, b.y}; v1 = (f32x4){c.x, c.y, d.x, d.y}; }
                    v0 = v0 * sc; v1 = v1 * sc; u32x4 w; w.x = cvt_pk_bf16(v0[0], v0[1]); w.y = cvt_pk_bf16(v0[2], v0[3]); w.z = cvt_pk_bf16(v1[0], v1[1]); w.w = cvt_pk_bf16(v1[2], v1[3]);
                    *(u32x4*)(rowp + bj * HALF) = w; } }
    }
};
template <class Epi, class Sched, bool ALIGN_EPI = false, bool SP2 = false>
__device__ __forceinline__ void gemm_phase(PG8_LAS unsigned char* lds, const Gemm g, const Sched& S, const Epi& E) {
    const int tid = opaque_tid(), wid = __builtin_amdgcn_readfirstlane(tid >> 6), lane = tid & 63, wr = wid >> 2, wc = wid & 3, fr = lane & 15, fq = lane >> 4;
    const int K = g.K, nt = K / BK;
    unsigned voffA[2], voffB[2];
#pragma unroll
    for (int i = 0; i < 2; ++i) { int R, C; stage_rc(tid * 16 + i * 8192, R, C); const int Rb = Epi::PERM ? ((R & ~31) + perm32(R & 31)) : R;
        voffA[i] = (unsigned)(R * K + C) * 2u; voffB[i] = (unsigned)(Rb * K + C) * 2u; }
    const size_t kstep = (size_t)(BK * 2);
    const size_t hstep = (size_t)HALF * K * 2;
    const size_t tstep = 2 * hstep;
    const unsigned ldsw = (unsigned)wid * 1024u;
    const int aoff = lds_byte(wr * 64 + fr, fq * 8), boff = lds_byte(wc * 32 + fr, fq * 8);
#define PG8_SA(b, h) (((b) * 2 + (h)) * HTB)
#define PG8_SB(b, h) ((4 + (b) * 2 + (h)) * HTB)
#define PG8_STAGE(bufoff, gbase, voff) do { _Pragma("unroll") for (int _i = 0; _i < 2; ++_i) \
        __builtin_amdgcn_global_load_lds((const unsigned*)((const char*)(gbase) + (voff)[_i]), (PG8_LAS unsigned*)(lds + (bufoff) + ldsw + _i * 8192), 16, 0, 0); } while (0)
#define PG8_LDA(dst, b, h) do { _Pragma("unroll") for (int m = 0; m < 4; ++m) _Pragma("unroll") for (int k = 0; k < 2; ++k) dst[m][k] = *(const PG8_LAS bf16x8*)(lds + PG8_SA(b, h) + aoff + m * 2048 + k * 1024); } while (0)
#define PG8_LDB(dst, b, h) do { _Pragma("unroll") for (int n = 0; n < 2; ++n) _Pragma("unroll") for (int k = 0; k < 2; ++k) dst[n][k] = *(const PG8_LAS bf16x8*)(lds + PG8_SB(b, h) + boff + n * 2048 + k * 1024); } while (0)
#define PG8_MMA(ai, bj, At, Bt) do { __builtin_amdgcn_s_setprio(1); _Pragma("unroll") for (int m = 0; m < 4; ++m) _Pragma("unroll") for (int n = 0; n < 2; ++n) _Pragma("unroll") for (int k = 0; k < 2; ++k) \
        acc[ai][bj][m][n] = __builtin_amdgcn_mfma_f32_16x16x32_bf16(Bt[n][k], At[m][k], acc[ai][bj][m][n], 0, 0, 0); __builtin_amdgcn_s_setprio(0); } while (0)
#define PG8_WAIT_V(n) asm volatile("s_waitcnt vmcnt(" #n ")" ::: "memory")
#define PG8_WAIT_L(n) asm volatile("s_waitcnt lgkmcnt(" #n ")" ::: "memory")
#define PG8_BAR __builtin_amdgcn_s_barrier()
#define PG8_SCHED __builtin_amdgcn_sched_barrier(0)
    Unit cur, nxt; int ui = 0;
    if (!S.next(0, cur)) return;
    f32x4 acc[2][2][4][2];
#pragma unroll
    for (int a = 0; a < 2; ++a)
#pragma unroll
        for (int b = 0; b < 2; ++b)
#pragma unroll
            for (int m = 0; m < 4; ++m)
#pragma unroll
                for (int n = 0; n < 2; ++n) acc[a][b][m][n] = (f32x4){0.f, 0.f, 0.f, 0.f};
    bf16x8 At[4][2], B0[2][2], B1[2][2];
    const char* cA = (const char*)g.A + (size_t)cur.pm * tstep; const char* cB = (const char*)g.Bt + (size_t)cur.pn * tstep;
    S.a_ready(cur);
    if constexpr (SP2) {
        PG8_STAGE(PG8_SB(0, 0), cB, voffB); PG8_STAGE(PG8_SB(0, 1), cB + hstep, voffB); PG8_STAGE(PG8_SA(0, 0), cA, voffA); PG8_STAGE(PG8_SA(0, 1), cA + hstep, voffA);
        if (wr == 1) PG8_BAR;
        PG8_WAIT_V(2); PG8_BAR;
        PG8_STAGE(PG8_SB(1, 0), cB + kstep, voffB); PG8_STAGE(PG8_SA(1, 0), cA + kstep, voffA); PG8_STAGE(PG8_SB(1, 1), cB + hstep + kstep, voffB);
        PG8_WAIT_V(6); PG8_BAR;
    } else {
        PG8_STAGE(PG8_SB(0, 0), cB, voffB); PG8_STAGE(PG8_SA(0, 0), cA, voffA); PG8_STAGE(PG8_SB(0, 1), cB + hstep, voffB); PG8_STAGE(PG8_SA(0, 1), cA + hstep, voffA);
        if (wr == 1) PG8_BAR;
        PG8_WAIT_V(4); PG8_BAR;
        PG8_STAGE(PG8_SB(1, 0), cB + kstep, voffB); PG8_STAGE(PG8_SA(1, 0), cA + kstep, voffA); PG8_STAGE(PG8_SB(1, 1), cB + hstep + kstep, voffB);
        PG8_WAIT_V(6); PG8_BAR;
    }
    for (;;) {
        const bool has_next = S.next(ui + 1, nxt);
        const char* nA = has_next ? (const char*)g.A + (size_t)nxt.pm * tstep : cA; const char* nB = has_next ? (const char*)g.Bt + (size_t)nxt.pn * tstep : cB;
        for (int t = 0; t < nt; t += 2) {
            const bool last = (t == nt - 2);
            const char* a1 = cA + (size_t)(t + 1) * kstep;
            const char* a2 = last ? nA : cA + (size_t)(t + 2) * kstep; const char* b2 = last ? nB : cB + (size_t)(t + 2) * kstep;
            const char* a3 = a2 + kstep; const char* b3 = b2 + kstep;
            if (last && has_next) S.a_ready(nxt);
            if constexpr (SP2) {
            PG8_LDB(B0, 0, 0); PG8_LDB(B1, 0, 1); PG8_SCHED; PG8_LDA(At, 0, 0); PG8_STAGE(PG8_SA(1, 1), a1 + hstep, voffA);
            PG8_WAIT_V(8); PG8_WAIT_L(0); PG8_BAR; PG8_MMA(0, 0, At, B0); PG8_MMA(0, 1, At, B1); PG8_BAR; PG8_SCHED;
            PG8_LDA(At, 0, 1); PG8_STAGE(PG8_SB(0, 0), b2, voffB); PG8_STAGE(PG8_SB(0, 1), b2 + hstep, voffB); PG8_STAGE(PG8_SA(0, 0), a2, voffA);
            PG8_WAIT_V(8); PG8_WAIT_L(0); PG8_BAR; PG8_MMA(1, 0, At, B0); PG8_MMA(1, 1, At, B1); PG8_BAR; PG8_SCHED;
            PG8_LDB(B0, 1, 0); PG8_LDB(B1, 1, 1); PG8_SCHED; PG8_LDA(At, 1, 0); PG8_STAGE(PG8_SA(0, 1), a2 + hstep, voffA);
            PG8_WAIT_V(8); PG8_WAIT_L(0); PG8_BAR; PG8_MMA(0, 0, At, B0); PG8_MMA(0, 1, At, B1); PG8_BAR; PG8_SCHED;
            PG8_LDA(At, 1, 1); PG8_STAGE(PG8_SB(1, 0), b3, voffB); PG8_STAGE(PG8_SB(1, 1), b3 + hstep, voffB); PG8_STAGE(PG8_SA(1, 0), a3, voffA);
            PG8_WAIT_V(8); PG8_WAIT_L(0); PG8_BAR; PG8_MMA(1, 0, At, B0); PG8_MMA(1, 1, At, B1); PG8_BAR; PG8_SCHED;
            } else {
            PG8_LDB(B0, 0, 0); PG8_SCHED; PG8_LDA(At, 0, 0); PG8_STAGE(PG8_SA(1, 1), a1 + hstep, voffA);
            PG8_WAIT_L(8); PG8_BAR; PG8_WAIT_L(0); PG8_MMA(0, 0, At, B0); PG8_BAR; PG8_SCHED;
            PG8_LDB(B1, 0, 1); PG8_STAGE(PG8_SB(0, 0), b2, voffB);
            PG8_BAR; PG8_WAIT_L(0); PG8_MMA(0, 1, At, B1); PG8_BAR;
            PG8_LDA(At, 0, 1); PG8_STAGE(PG8_SA(0, 0), a2, voffA);
            PG8_BAR; PG8_WAIT_L(0); PG8_MMA(1, 0, At, B0); PG8_BAR; PG8_SCHED;
            PG8_STAGE(PG8_SB(0, 1), b2 + hstep, voffB);
            PG8_WAIT_V(6); PG8_BAR; PG8_MMA(1, 1, At, B1); PG8_BAR;
            PG8_LDB(B0, 1, 0); PG8_SCHED; PG8_LDA(At, 1, 0); PG8_STAGE(PG8_SA(0, 1), a2 + hstep, voffA);
            PG8_WAIT_L(8); PG8_BAR; PG8_WAIT_L(0); PG8_MMA(0, 0, At, B0); PG8_BAR; PG8_SCHED;
            PG8_LDB(B1, 1, 1); PG8_STAGE(PG8_SB(1, 0), b3, voffB);
            PG8_BAR; PG8_WAIT_L(0); PG8_MMA(0, 1, At, B1); PG8_BAR;
            PG8_LDA(At, 1, 1); PG8_STAGE(PG8_SA(1, 0), a3, voffA);
            PG8_BAR; PG8_WAIT_L(0); PG8_MMA(1, 0, At, B0); PG8_BAR; PG8_SCHED;
            PG8_STAGE(PG8_SB(1, 1), b3 + hstep, voffB);
            PG8_WAIT_V(6); PG8_BAR; PG8_MMA(1, 1, At, B1); PG8_BAR;
            }
        }
        if constexpr (ALIGN_EPI) { if (wr == 0) PG8_BAR; }
        if constexpr (!Epi::AFTER_DRAIN) { E(acc, cur, wr, wc, fr, fq); S.done(cur); }
        if (!has_next) break;
#pragma unroll
        for (int a = 0; a < 2; ++a)
#pragma unroll
            for (int b = 0; b < 2; ++b)
#pragma unroll
                for (int m = 0; m < 4; ++m)
#pragma unroll
                    for (int n = 0; n < 2; ++n) acc[a][b][m][n] = (f32x4){0.f, 0.f, 0.f, 0.f};
        cur = nxt; cA = nA; cB = nB; ++ui;
        if constexpr (ALIGN_EPI) { if (wr == 1) PG8_BAR; }
    }
    PG8_WAIT_V(0);
    if constexpr (!ALIGN_EPI) { if (wr == 0) PG8_BAR; }
    PG8_BAR;
    if constexpr (Epi::AFTER_DRAIN) { E.fused(acc, cur, wr, wc, fr, fq, lds, wid, lane); S.done(cur); }
#undef PG8_SA
#undef PG8_SB
#undef PG8_STAGE
#undef PG8_LDA
#undef PG8_LDB
#undef PG8_MMA
#undef PG8_WAIT_V
#undef PG8_WAIT_L
#undef PG8_BAR
#undef PG8_SCHED
}
}

#ifndef PG8_SP2
#define PG8_SP2 true
#endif
#ifndef PG8_ALIGN
#define PG8_ALIGN true
#endif
namespace pg8 {
struct UnitG { int pm, pn, e, r0, nvalid; unsigned boff; };
struct GroupedOrder {
    const PG8_LAS int* tab; int nN, G, c; unsigned bstride;
    __device__ __forceinline__ bool next(int i, UnitG& u) const {
        const int Lx = i * G + c; const int total = __builtin_amdgcn_readfirstlane(tab[64]) * nN; if (Lx >= total) return false;
        int e = 0;
#pragma unroll 4
        for (int k = 1; k < 32; ++k) { const int s = __builtin_amdgcn_readfirstlane(tab[32 + k]) * nN; if (Lx >= s) e = k; }
        const int m0 = __builtin_amdgcn_readfirstlane(tab[32 + e]), m1 = __builtin_amdgcn_readfirstlane(tab[33 + e]), ce = __builtin_amdgcn_readfirstlane(tab[e]);
        const int idx = Lx - m0 * nN, mte = m1 - m0; const int pn = idx / mte, mtl = idx - pn * mte;
        u.pm = m0 + mtl; u.pn = pn; u.e = e; u.r0 = mtl * 256; u.nvalid = ce - mtl * 256; u.boff = (unsigned)e * bstride; return true;
    }
};
template <class Epi, bool GATHER>
__device__ __forceinline__ void gemm_phase_g(PG8_LAS unsigned char* lds, const Gemm g, const GroupedOrder& S, const Epi& E, const int* __restrict__ LIST) {
    const int tid = opaque_tid(), wid = __builtin_amdgcn_readfirstlane(tid >> 6), lane = tid & 63, wr = wid >> 2, wc = wid & 3, fr = lane & 15, fq = lane >> 4;
    const int K = g.K, nt = K / BK;
    unsigned voffB[2]; int RA[2], CA[2];
#pragma unroll
    for (int i = 0; i < 2; ++i) { int R, C; stage_rc(tid * 16 + i * 8192, R, C); const int Rb = Epi::PERM ? ((R & ~31) + perm32(R & 31)) : R;
        RA[i] = R; CA[i] = C; voffB[i] = (unsigned)(Rb * K + C) * 2u; }
    const size_t kstep = (size_t)(BK * 2);
    const size_t hstepB = (size_t)HALF * K * 2;
    const size_t tstepB = 2 * hstepB;
    const unsigned ldsw = (unsigned)wid * 1024u;
    const int aoff = lds_byte(wr * 64 + fr, fq * 8), boff = lds_byte(wc * 32 + fr, fq * 8);
#define PG8_SA(b, h) (((b) * 2 + (h)) * HTB)
#define PG8_SB(b, h) ((4 + (b) * 2 + (h)) * HTB)
#define PG8_STAGE(bufoff, gbase, voff) do { _Pragma("unroll") for (int _i = 0; _i < 2; ++_i) \
        __builtin_amdgcn_global_load_lds((const unsigned*)((const char*)(gbase) + (voff)[_i]), (PG8_LAS unsigned*)(lds + (bufoff) + ldsw + _i * 8192), 16, 0, 0); } while (0)
#define PG8_LDA(dst, b, h) do { _Pragma("unroll") for (int m = 0; m < 4; ++m) _Pragma("unroll") for (int k = 0; k < 2; ++k) dst[m][k] = *(const PG8_LAS bf16x8*)(lds + PG8_SA(b, h) + aoff + m * 2048 + k * 1024); } while (0)
#define PG8_LDB(dst, b, h) do { _Pragma("unroll") for (int n = 0; n < 2; ++n) _Pragma("unroll") for (int k = 0; k < 2; ++k) dst[n][k] = *(const PG8_LAS bf16x8*)(lds + PG8_SB(b, h) + boff + n * 2048 + k * 1024); } while (0)
#define PG8_MMA(ai, bj, At, Bt) do { __builtin_amdgcn_s_setprio(1); _Pragma("unroll") for (int m = 0; m < 4; ++m) _Pragma("unroll") for (int n = 0; n < 2; ++n) _Pragma("unroll") for (int k = 0; k < 2; ++k) \
        acc[ai][bj][m][n] = __builtin_amdgcn_mfma_f32_16x16x32_bf16(Bt[n][k], At[m][k], acc[ai][bj][m][n], 0, 0, 0); __builtin_amdgcn_s_setprio(0); } while (0)
#define PG8_WAIT_V(n) asm volatile("s_waitcnt vmcnt(" #n ")" ::: "memory")
#define PG8_WAIT_L(n) asm volatile("s_waitcnt lgkmcnt(" #n ")" ::: "memory")
#define PG8_BAR __builtin_amdgcn_s_barrier()
#define PG8_SCHED __builtin_amdgcn_sched_barrier(0)
#define PG8_AOFF(u, vo) do { _Pragma("unroll") for (int _h = 0; _h < 2; ++_h) _Pragma("unroll") for (int _i = 0; _i < 2; ++_i) { const int _r = _h * HALF + RA[_i]; int _row; \
        if (GATHER) { _row = 0; if (_r < (u).nvalid) _row = LIST[(u).e * 8192 + (u).r0 + _r] >> 1; } else _row = (u).pm * BM + _r; \
        (vo)[_h][_i] = (unsigned)(_row * K + CA[_i]) * 2u; } } while (0)
    UnitG cur, nxt; int ui = 0;
    if (!S.next(0, cur)) return;
    f32x4 acc[2][2][4][2];
#pragma unroll
    for (int a = 0; a < 2; ++a)
#pragma unroll
        for (int b = 0; b < 2; ++b)
#pragma unroll
            for (int m = 0; m < 4; ++m)
#pragma unroll
                for (int n = 0; n < 2; ++n) acc[a][b][m][n] = (f32x4){0.f, 0.f, 0.f, 0.f};
    bf16x8 At[4][2], B0[2][2], B1[2][2];
    unsigned vA[2][2], vN[2][2];
    PG8_AOFF(cur, vA);
    const char* gA = (const char*)g.A;
    const char* cB = (const char*)g.Bt + cur.boff + (size_t)cur.pn * tstepB;
    PG8_STAGE(PG8_SB(0, 0), cB, voffB); PG8_STAGE(PG8_SB(0, 1), cB + hstepB, voffB); PG8_STAGE(PG8_SA(0, 0), gA, vA[0]); PG8_STAGE(PG8_SA(0, 1), gA, vA[1]);
    if (wr == 1) PG8_BAR;
    PG8_WAIT_V(2); PG8_BAR;
    PG8_STAGE(PG8_SB(1, 0), cB + kstep, voffB); PG8_STAGE(PG8_SA(1, 0), gA + kstep, vA[0]); PG8_STAGE(PG8_SB(1, 1), cB + hstepB + kstep, voffB);
    PG8_WAIT_V(6); PG8_BAR;
    for (;;) {
        const bool has_next = S.next(ui + 1, nxt);
        if (has_next) { PG8_AOFF(nxt, vN); } else {
#pragma unroll
            for (int _h = 0; _h < 2; ++_h)
#pragma unroll
                for (int _i = 0; _i < 2; ++_i) vN[_h][_i] = vA[_h][_i]; }
        const char* nB = has_next ? (const char*)g.Bt + nxt.boff + (size_t)nxt.pn * tstepB : cB;
        for (int t = 0; t < nt; t += 2) {
            const bool last = (t == nt - 2);
            const char* a1 = gA + (size_t)(t + 1) * kstep;
            const char* a2 = last ? gA : gA + (size_t)(t + 2) * kstep; const char* b2 = last ? nB : cB + (size_t)(t + 2) * kstep;
            const char* a3 = a2 + kstep; const char* b3 = b2 + kstep;
            unsigned v2a[2], v2b[2];
#pragma unroll
            for (int _i = 0; _i < 2; ++_i) { v2a[_i] = last ? vN[0][_i] : vA[0][_i]; v2b[_i] = last ? vN[1][_i] : vA[1][_i]; }
            PG8_LDB(B0, 0, 0); PG8_LDB(B1, 0, 1); PG8_SCHED; PG8_LDA(At, 0, 0); PG8_STAGE(PG8_SA(1, 1), a1, vA[1]);
            PG8_WAIT_V(8); PG8_WAIT_L(0); PG8_BAR; PG8_MMA(0, 0, At, B0); PG8_MMA(0, 1, At, B1); PG8_BAR; PG8_SCHED;
            PG8_LDA(At, 0, 1); PG8_STAGE(PG8_SB(0, 0), b2, voffB); PG8_STAGE(PG8_SB(0, 1), b2 + hstepB, voffB); PG8_STAGE(PG8_SA(0, 0), a2, v2a);
            PG8_WAIT_V(8); PG8_WAIT_L(0); PG8_BAR; PG8_MMA(1, 0, At, B0); PG8_MMA(1, 1, At, B1); PG8_BAR; PG8_SCHED;
            PG8_LDB(B0, 1, 0); PG8_LDB(B1, 1, 1); PG8_SCHED; PG8_LDA(At, 1, 0); PG8_STAGE(PG8_SA(0, 1), a2, v2b);
            PG8_WAIT_V(8); PG8_WAIT_L(0); PG8_BAR; PG8_MMA(0, 0, At, B0); PG8_MMA(0, 1, At, B1); PG8_BAR; PG8_SCHED;
            PG8_LDA(At, 1, 1); PG8_STAGE(PG8_SB(1, 0), b3, voffB); PG8_STAGE(PG8_SB(1, 1), b3 + hstepB, voffB); PG8_STAGE(PG8_SA(1, 0), a3, v2a);
            PG8_WAIT_V(8); PG8_WAIT_L(0); PG8_BAR; PG8_MMA(1, 0, At, B0); PG8_MMA(1, 1, At, B1); PG8_BAR; PG8_SCHED;
        }
        if (wr == 0) PG8_BAR;
        E(acc, cur, wr, wc, fr, fq);
        if (!has_next) break;
#pragma unroll
        for (int a = 0; a < 2; ++a)
#pragma unroll
            for (int b = 0; b < 2; ++b)
#pragma unroll
                for (int m = 0; m < 4; ++m)
#pragma unroll
                    for (int n = 0; n < 2; ++n) acc[a][b][m][n] = (f32x4){0.f, 0.f, 0.f, 0.f};
        cur = nxt; cB = nB; ++ui;
#pragma unroll
        for (int _h = 0; _h < 2; ++_h)
#pragma unroll
            for (int _i = 0; _i < 2; ++_i) vA[_h][_i] = vN[_h][_i];
        if (wr == 1) PG8_BAR;
    }
    PG8_WAIT_V(0);
    PG8_BAR;
#undef PG8_AOFF
#undef PG8_SA
#undef PG8_SB
#undef PG8_STAGE
#undef PG8_LDA
#undef PG8_LDB
#undef PG8_MMA
#undef PG8_WAIT_V
#undef PG8_WAIT_L
#undef PG8_BAR
#undef PG8_SCHED
}
__device__ __forceinline__ float silu_f(float a) { return a * __builtin_amdgcn_rcpf(1.f + __builtin_amdgcn_exp2f(-1.4426950408889634f * a)); }
struct EpiMoe1 {
    static constexpr bool PERM = true, AFTER_DRAIN = false;
    bf16_t* HB; const int* LIST; const float* GATEW;
    __device__ __forceinline__ void operator()(const f32x4 (&acc)[2][2][4][2], const UnitG& u, int wr, int wc, int fr, int fq) const {
#pragma unroll
        for (int ai = 0; ai < 2; ++ai)
#pragma unroll
            for (int m = 0; m < 4; ++m) { const int r = ai * HALF + wr * 64 + m * 16 + fr;
                float gate = 0.f; if (r < u.nvalid) gate = GATEW[LIST[u.e * 8192 + u.r0 + r]];
                bf16_t* rowp = HB + (size_t)(u.pm * BM + r) * 512 + u.pn * 128 + wc * 32 + 8 * fq;
                const f32x4 a0 = acc[ai][0][m][0], a1 = acc[ai][0][m][1], b0 = acc[ai][1][m][0], b1 = acc[ai][1][m][1];
                f32x4 h0, h1;
#pragma unroll
                for (int j = 0; j < 4; ++j) { h0[j] = silu_f(a0[j]) * b0[j] * gate; h1[j] = silu_f(a1[j]) * b1[j] * gate; }
                u32x4 w; w.x = cvt_pk_bf16(h0[0], h0[1]); w.y = cvt_pk_bf16(h0[2], h0[3]); w.z = cvt_pk_bf16(h1[0], h1[1]); w.w = cvt_pk_bf16(h1[2], h1[3]);
                *(u32x4*)rowp = w; }
    }
};
struct EpiMoe2 {
    static constexpr bool PERM = true, AFTER_DRAIN = false;
    bf16_t* YS; const int* LIST;
    __device__ __forceinline__ void operator()(const f32x4 (&acc)[2][2][4][2], const UnitG& u, int wr, int wc, int fr, int fq) const {
#pragma unroll
        for (int ai = 0; ai < 2; ++ai)
#pragma unroll
            for (int m = 0; m < 4; ++m) { const int r = ai * HALF + wr * 64 + m * 16 + fr;
                if (r < u.nvalid) { const int idx = LIST[u.e * 8192 + u.r0 + r];
                    bf16_t* rowp = YS + (size_t)idx * 2048 + u.pn * BM + wc * 32 + 8 * fq;
#pragma unroll
                    for (int bj = 0; bj < 2; ++bj) { const f32x4 v0 = acc[ai][bj][m][0], v1 = acc[ai][bj][m][1];
                        u32x4 w; w.x = cvt_pk_bf16(v0[0], v0[1]); w.y = cvt_pk_bf16(v0[2], v0[3]); w.z = cvt_pk_bf16(v1[0], v1[1]); w.w = cvt_pk_bf16(v1[2], v1[3]);
                        *(u32x4*)(rowp + bj * HALF) = w; } } }
    }
};
}
#include <hip/hip_bf16.h>
#include <cmath>
namespace attn_body {
using bf16=__hip_bfloat16;
using bf16x8=__attribute__((ext_vector_type(8)))short;
using s16x4=__attribute__((ext_vector_type(4)))short;
using f32x16=__attribute__((ext_vector_type(16)))float;
using u32x4=__attribute__((ext_vector_type(4)))unsigned;
constexpr int SEQ=2048,D=64,DM=5120;
constexpr int NW=8,QBLK=32,QB=QBLK*NW,KVBLK=64,NQB=SEQ/QB;
constexpr int ATTN_UNIT_ROWS=QB;
__device__ __forceinline__ int crow(int r,int hi){return (r&3)+8*(r>>2)+4*hi;}
#define SBAR() __builtin_amdgcn_sched_barrier(0)
__device__ __forceinline__ void cmask(f32x16&p0,f32x16&p1,int jb,int qrel,int hi){
  const float NEG=-INFINITY; int kb=64*jb+4*hi;
  #pragma unroll
  for(int r=0;r<16;++r){int kv=kb+(r&3)+8*(r>>2); if(kv>qrel)p0[r]=NEG; if(kv+32>qrel)p1[r]=NEG;}
}

constexpr int NSLOT=3, SLOTB=8192;
constexpr int LDS_K=0, LDS_V=NSLOT*SLOTB, LDS_WS=2*NSLOT*SLOTB, LDS_OST=LDS_WS+NW*64*4, LDS_BYTES=LDS_OST+NW*4096;
constexpr float C2=0.125f*1.4426950408889634f;
__device__ __forceinline__ void glds16(const void*gsrc,unsigned lds_dst){unsigned keep;
  asm volatile("s_mov_b32 %0, m0\n\ts_mov_b32 m0, %2\n\ts_nop 0\n\tglobal_load_lds_dwordx4 %1, off\n\ts_mov_b32 m0, %0":"=&s"(keep):"v"(gsrc),"s"(lds_dst):"memory");}
__device__ __forceinline__ float max3f(float a,float b,float c){float r;asm("v_max3_f32 %0, %1, %2, %3":"=v"(r):"v"(a),"v"(b),"v"(c));return r;}
__device__ __forceinline__ float max2f(float a,float b){float r;asm("v_max_f32_e32 %0, %1, %2":"=v"(r):"v"(a),"v"(b));return r;}
__device__ __forceinline__ float fadd_s(float a,float b){float r;asm("v_add_f32_e32 %0, %1, %2":"=v"(r):"v"(a),"v"(b));return r;}
__device__ __forceinline__ float fsub_s(float a,float b){float r;asm("v_sub_f32_e32 %0, %1, %2":"=v"(r):"v"(a),"v"(b));return r;}
typedef float f32x2_t __attribute__((ext_vector_type(2))); typedef __bf16 bf16x2_t __attribute__((ext_vector_type(2)));
__device__ __forceinline__ unsigned cvtpk_s(float lo,float hi){f32x2_t v={lo,hi};bf16x2_t b=__builtin_convertvector(v,bf16x2_t);return __builtin_bit_cast(unsigned,b);}
#define WAIT_BAR(N) asm volatile("s_waitcnt vmcnt(" #N ") lgkmcnt(0)\n\ts_barrier":::"memory")

__device__ __forceinline__ void qkt(f32x16&p0,f32x16&p1,const char*Kslot,const bf16x8*qr,const f32x16&negm,int r32,int hi){
  const char*kb=Kslot+hi*1024+r32*16;
  #pragma unroll
  for(int d0=0;d0<4;++d0){
    const bf16x8 b0=*reinterpret_cast<const bf16x8*>(kb+d0*2048);
    const bf16x8 b1=*reinterpret_cast<const bf16x8*>(kb+d0*2048+512);
    if(d0==0){p0=__builtin_amdgcn_mfma_f32_32x32x16_bf16(b0,qr[0],negm,0,0,0);p1=__builtin_amdgcn_mfma_f32_32x32x16_bf16(b1,qr[0],negm,0,0,0);}
    else{p0=__builtin_amdgcn_mfma_f32_32x32x16_bf16(b0,qr[d0],p0,0,0,0);p1=__builtin_amdgcn_mfma_f32_32x32x16_bf16(b1,qr[d0],p1,0,0,0);}}
}
typedef __attribute__((address_space(3))) const char* lds_cptr;
typedef short v4i16_t __attribute__((ext_vector_type(4)));
__device__ __forceinline__ void kload8(bf16x8*kf,lds_cptr kp){
  kf[0]=*(const __attribute__((address_space(3))) bf16x8*)(kp);      kf[1]=*(const __attribute__((address_space(3))) bf16x8*)(kp+512);
  kf[2]=*(const __attribute__((address_space(3))) bf16x8*)(kp+2048); kf[3]=*(const __attribute__((address_space(3))) bf16x8*)(kp+2560);
  kf[4]=*(const __attribute__((address_space(3))) bf16x8*)(kp+4096); kf[5]=*(const __attribute__((address_space(3))) bf16x8*)(kp+4608);
  kf[6]=*(const __attribute__((address_space(3))) bf16x8*)(kp+6144); kf[7]=*(const __attribute__((address_space(3))) bf16x8*)(kp+6656);
}
__device__ __forceinline__ void kload2(bf16x8*kf,lds_cptr kp,int j){ kf[2*j]=*(const __attribute__((address_space(3))) bf16x8*)(kp+j*2048); kf[2*j+1]=*(const __attribute__((address_space(3))) bf16x8*)(kp+j*2048+512); }
__device__ __forceinline__ s16x4 vtr(lds_cptr p){ return __builtin_bit_cast(s16x4,__builtin_amdgcn_ds_read_tr16_b64_v4i16((__attribute__((address_space(3))) v4i16_t*)p)); }
__device__ __forceinline__ float rowmax(const f32x16&p0,const f32x16&p1){
  float a=max3f(p0[0],p0[1],p1[0]),b=max3f(p0[2],p0[3],p1[1]);a=max3f(a,p1[2],p1[3]);
  #pragma unroll
  for(int r=4;r<16;r+=4){a=max3f(a,p0[r],p0[r+1]);b=max3f(b,p0[r+2],p0[r+3]);a=max3f(a,p1[r],p1[r+1]);b=max3f(b,p1[r+2],p1[r+3]);}
  const float m=max2f(a,b);
  auto rr=__builtin_amdgcn_permlane32_swap(__float_as_uint(m),__float_as_uint(m),false,false);
  return max2f(__uint_as_float(rr[0]),__uint_as_float(rr[1]));
}
__device__ __forceinline__ void pv(f32x16*o,int vb,bf16x8 pa0,bf16x8 pa1,bf16x8 pa2,bf16x8 pa3){
  #pragma unroll
  for(int d0=0;d0<2;++d0){s16x4 lo[4],hi[4];
    #pragma unroll
    for(int ks=0;ks<4;++ks){
      asm volatile("ds_read_b64_tr_b16 %0,%1 offset:%c2":"=&v"(lo[ks]):"v"(vb),"i"(d0*4096+ks*1024):"memory");
      asm volatile("ds_read_b64_tr_b16 %0,%1 offset:%c2":"=&v"(hi[ks]):"v"(vb),"i"(d0*4096+ks*1024+512):"memory");}
    asm volatile("s_waitcnt lgkmcnt(0)":::"memory");SBAR();
    #define PK(k) (bf16x8){lo[k][0],lo[k][1],lo[k][2],lo[k][3],hi[k][0],hi[k][1],hi[k][2],hi[k][3]}
    o[d0]=__builtin_amdgcn_mfma_f32_32x32x16_bf16(pa0,PK(0),o[d0],0,0,0);
    o[d0]=__builtin_amdgcn_mfma_f32_32x32x16_bf16(pa1,PK(1),o[d0],0,0,0);
    o[d0]=__builtin_amdgcn_mfma_f32_32x32x16_bf16(pa2,PK(2),o[d0],0,0,0);
    o[d0]=__builtin_amdgcn_mfma_f32_32x32x16_bf16(pa3,PK(3),o[d0],0,0,0);
    #undef PK
  }
}

#ifndef ATTN_STORE16
#define ATTN_STORE16(p,v) (*(u32x4*)(p)=(v))
#endif
template<int THRL> __device__ __forceinline__ void attn_unit(int b,int qb,const bf16*Q,const bf16*__restrict__ K,const bf16*__restrict__ V,bf16*O,int opitch,char*shm){
  const int tid=opaque_tid(),lane=tid&63,r32=lane&31,hi=lane>>5; const int wid=__builtin_amdgcn_readfirstlane(tid>>6);
  const long rowbase=(long)b*SEQ; const int q0=qb*QB;
  const bf16*Qw=Q+(rowbase+q0+wid*QBLK)*DM;
  const bf16*Kh=K+rowbase*DM,*Vh=V+rowbase*DM;
  const unsigned lds0=(unsigned)(uintptr_t)shm;
  float*wsf=(float*)(shm+LDS_WS)+wid*64;
  const bf16*ksrc=Kh+(long)lane*DM+wid*8;
  const bf16*vsrc=Vh+(long)(16*(wid&3)+(lane>>2))*DM+(wid>>2)*32+(lane&3)*8;
  const unsigned kdst=lds0+LDS_K+wid*1024, vdst=lds0+LDS_V+wid*1024;
  #define DMA_K(t,slot) glds16(ksrc+(long)(t)*KVBLK*DM,(unsigned)__builtin_amdgcn_readfirstlane(kdst+(slot)))
  #define DMA_V(t,slot) glds16(vsrc+(long)(t)*KVBLK*DM,(unsigned)__builtin_amdgcn_readfirstlane(vdst+(slot)))
  const int vb0=(int)(lds0+LDS_V)+((lane>>4)&1)*32+(lane&3)*8+(4*hi+((lane&15)>>2))*64;
  const char*Kbase=shm+LDS_K; bf16x8 kf[8];
  const lds_cptr shm3=(lds_cptr)shm; const lds_cptr kp0=shm3+LDS_K+hi*1024+r32*16; const lds_cptr vp0=shm3+LDS_V+((lane>>4)&1)*32+(lane&3)*8+(4*hi+((lane&15)>>2))*64;
  const int NT=(q0+QB)/KVBLK;
  DMA_K(0,0);DMA_V(0,0);DMA_K(1,SLOTB);
  bf16x8 qr[4];
  #pragma unroll
  for(int d0=0;d0<4;++d0)qr[d0]=*reinterpret_cast<const bf16x8*>(&Qw[(long)r32*DM+d0*16+hi*8]);
  float mhat=0.f,l_reg=0.f;f32x16 o[2];o[0]=f32x16{};o[1]=f32x16{};f32x16 negm=f32x16{};asm volatile("":"+v"(negm));
  const int qrel=wid*QBLK+r32;
  #define CMASK(P0,P1,t) do{int jb_=(t)-(NT-4); if(jb_>=0)cmask(P0,P1,jb_,qrel,hi);}while(0)
  bool resc=false;
  #define START(P0,P1) do{ const float rm=rowmax(P0,P1); resc=false; \
    { const float dl=rm; mhat=fadd_s(mhat,dl); \
      _Pragma("unroll") for(int r=0;r<16;++r){P0[r]=fsub_s(P0[r],dl);P1[r]=fsub_s(P1[r],dl);} \
      _Pragma("unroll") for(int r=0;r<16;++r)negm[r]=-mhat; asm volatile("":"+v"(negm)); } \
    _Pragma("unroll") for(int r=0;r<16;++r)P0[r]=__builtin_amdgcn_exp2f(P0[r]); }while(0)
  #define RESC() do{ if(resc){ asm volatile("s_waitcnt lgkmcnt(0)":::"memory"); \
      _Pragma("unroll") for(int d_=0;d_<2;++d_) _Pragma("unroll") for(int r=0;r<16;++r)o[d_][r]*=wsf[crow(r,hi)]; } }while(0)
  f32x16 pA0,pA1,pB0,pB1;
  int sl_prev=0,sl_cur=0,sl_next=SLOTB;
  #define ROT() do{sl_prev=sl_cur;sl_cur=sl_next;sl_next=(sl_next==(NSLOT-1)*SLOTB)?0:sl_next+SLOTB;}while(0)
  DMA_K(2,2*SLOTB);
  WAIT_BAR(3);
  qkt(pA0,pA1,Kbase,qr,negm,r32,hi);asm volatile("s_nop 15\n\ts_nop 7":"+v"(pA0),"+v"(pA1));CMASK(pA0,pA1,0);
  START(pA0,pA1);
  _Pragma("unroll") for(int r=0;r<16;++r)pA1[r]=__builtin_amdgcn_exp2f(pA1[r]);
  WAIT_BAR(0);
  DMA_K(3,0);DMA_V(1,SLOTB);
  ROT();
  kload8(kf,kp0+sl_cur);
  WAIT_BAR(2);
  s16x4 vlo[8],vhi[8]; u32x4 pw0,pw1,pw2,pw3;
  #define PKW(P,B) cvtpk_s(P[B],P[B+1])
  #define PAF(k) __builtin_bit_cast(bf16x8,pw##k)
  #define VFR(i) (bf16x8){vlo[i][0],vlo[i][1],vlo[i][2],vlo[i][3],vhi[i][0],vhi[i][1],vhi[i][2],vhi[i][3]}
  #define PIN(x) asm volatile("":"+v"(x))
  #define MX3(a,b,c) __builtin_fmaxf(__builtin_fmaxf((a),(b)),(c))
  #define GAPA(MF,A0,A1,A2,A3,W0,W1,PW) do{ MF; sacc+=A0; sacc+=A1; sacc+=A2; sacc+=A3; PIN(sacc); W0; W1; PIN(PW); SBAR(); }while(0)
  #define EX(v) __builtin_amdgcn_exp2f(v)
  #define GAPB(MF,X,B) do{ MF; X[B]=EX(X[B]); X[B+1]=EX(X[B+1]); X[B+2]=EX(X[B+2]); X[B+3]=EX(X[B+3]); PIN(X); SBAR(); }while(0)
  #define VRD(i) do{ vlo[i]=vtr(vp_+(((i)>>2)*4096+((i)&3)*1024)); vhi[i]=vtr(vp_+(((i)>>2)*4096+((i)&3)*1024+512)); }while(0)
  #define KRD(G,j) do{ if(G){ kload2(kf,kp0+sl_next,j); SBAR(); } }while(0)
  #define STEP(C0,C1,P0,P1,t,GK,GV,GL) do{ SBAR(); \
    const lds_cptr vp_=vp0+sl_prev; \
    VRD(0); SBAR(); float sacc=(P0[0]+P0[1]); \
    GAPA(C0=__builtin_amdgcn_mfma_f32_32x32x16_bf16(kf[0],qr[0],negm,0,0,0), P0[2],P0[3],P0[4],P0[5],     pw0[0]=PKW(P0,0), pw0[1]=PKW(P0,2), pw0); \
    VRD(4); SBAR(); GAPA(C1=__builtin_amdgcn_mfma_f32_32x32x16_bf16(kf[1],qr[0],negm,0,0,0), P0[6],P0[7],P0[8],P0[9],     pw0[2]=PKW(P0,4), pw0[3]=PKW(P0,6), pw0); \
    VRD(1); SBAR(); GAPA(C0=__builtin_amdgcn_mfma_f32_32x32x16_bf16(kf[2],qr[1],C0,0,0,0),   P0[10],P0[11],P0[12],P0[13], pw1[0]=PKW(P0,8), pw1[1]=PKW(P0,10), pw1); \
    VRD(5); SBAR(); GAPA(C1=__builtin_amdgcn_mfma_f32_32x32x16_bf16(kf[3],qr[1],C1,0,0,0),   P0[14],P0[15],P1[0],P1[1],   pw1[2]=PKW(P0,12),pw1[3]=PKW(P0,14), pw1); \
    VRD(2); SBAR(); GAPA(C0=__builtin_amdgcn_mfma_f32_32x32x16_bf16(kf[4],qr[2],C0,0,0,0),   P1[2],P1[3],P1[4],P1[5],     pw2[0]=PKW(P1,0), pw2[1]=PKW(P1,2), pw2); \
    VRD(6); SBAR(); GAPA(C1=__builtin_amdgcn_mfma_f32_32x32x16_bf16(kf[5],qr[2],C1,0,0,0),   P1[6],P1[7],P1[8],P1[9],     pw2[2]=PKW(P1,4), pw2[3]=PKW(P1,6), pw2); \
    VRD(3); SBAR(); GAPA(C0=__builtin_amdgcn_mfma_f32_32x32x16_bf16(kf[6],qr[3],C0,0,0,0),   P1[10],P1[11],P1[12],P1[13], pw3[0]=PKW(P1,8), pw3[1]=PKW(P1,10), pw3); \
    VRD(7); SBAR(); GAPA(C1=__builtin_amdgcn_mfma_f32_32x32x16_bf16(kf[7],qr[3],C1,0,0,0),   P1[14],P1[15],0.f,0.f,       pw3[2]=PKW(P1,12),pw3[3]=PKW(P1,14), pw3); \
    l_reg+=sacc; \
    if(GK){DMA_K((t)+3,sl_cur);} if(GV){DMA_V((t)+1,sl_next);} \
    CMASK(C0,C1,t); \
    { float a=MX3(C0[0],C0[1],C1[0]),b=MX3(C0[2],C0[3],C1[1]); a=MX3(a,C1[2],C1[3]); \
      _Pragma("unroll") for(int r=4;r<16;r+=4){a=MX3(a,C0[r],C0[r+1]);b=MX3(b,C0[r+2],C0[r+3]);a=MX3(a,C1[r],C1[r+1]);b=MX3(b,C1[r+2],C1[r+3]);} \
      float rm=__builtin_fmaxf(a,b); { auto rr=__builtin_amdgcn_permlane32_swap(__float_as_uint(rm),__float_as_uint(rm),false,false); rm=__builtin_fmaxf(__uint_as_float(rr[0]),__uint_as_float(rr[1])); } \
      resc=false; \
      if(__builtin_expect(__any(rm>(float)THRL),0)){ const float dl=__builtin_fmaxf(rm,0.f); mhat+=dl; \
        _Pragma("unroll") for(int r=0;r<16;++r){C0[r]-=dl;C1[r]-=dl;} \
        _Pragma("unroll") for(int r=0;r<16;++r)negm[r]=-mhat; asm volatile("":"+v"(negm)); \
        const float f=__builtin_amdgcn_exp2f(-dl); l_reg*=f; if(hi==0)wsf[r32]=f; resc=true; } } \
    SBAR(); \
    GAPB(o[0]=__builtin_amdgcn_mfma_f32_32x32x16_bf16(PAF(0),VFR(0),o[0],0,0,0), C0,0); \
    GAPB(o[1]=__builtin_amdgcn_mfma_f32_32x32x16_bf16(PAF(0),VFR(4),o[1],0,0,0), C0,4); \
    KRD(GL,0); GAPB(o[0]=__builtin_amdgcn_mfma_f32_32x32x16_bf16(PAF(1),VFR(1),o[0],0,0,0), C0,8); \
    KRD(GL,1); GAPB(o[1]=__builtin_amdgcn_mfma_f32_32x32x16_bf16(PAF(1),VFR(5),o[1],0,0,0), C0,12); \
    KRD(GL,2); GAPB(o[0]=__builtin_amdgcn_mfma_f32_32x32x16_bf16(PAF(2),VFR(2),o[0],0,0,0), C1,0); \
    KRD(GL,3); GAPB(o[1]=__builtin_amdgcn_mfma_f32_32x32x16_bf16(PAF(2),VFR(6),o[1],0,0,0), C1,4); \
    GAPB(o[0]=__builtin_amdgcn_mfma_f32_32x32x16_bf16(PAF(3),VFR(3),o[0],0,0,0), C1,8); \
    GAPB(o[1]=__builtin_amdgcn_mfma_f32_32x32x16_bf16(PAF(3),VFR(7),o[1],0,0,0), C1,12); \
    }while(0)
  int t=1;
  #undef CMASK
  #define CMASK(P0,P1,t) do{}while(0)
  for(;t+5<NT;t+=2){
    STEP(pB0,pB1,pA0,pA1,t,true,true,true);     WAIT_BAR(2); RESC(); ROT();
    STEP(pA0,pA1,pB0,pB1,t+1,true,true,true);   WAIT_BAR(2); RESC(); ROT();
  }
  #undef CMASK
  #define CMASK(P0,P1,t) do{int jb_=(t)-(NT-4); if(jb_>=0)cmask(P0,P1,jb_,qrel,hi);}while(0)
  #define ENDW(tt) do{ if((tt)+3<NT){WAIT_BAR(2);} else if((tt)+2<NT){WAIT_BAR(1);} else {WAIT_BAR(0);} }while(0)
  for(;t+1<NT;t+=2){
    STEP(pB0,pB1,pA0,pA1,t,(t+3<NT),(t+1<NT),(t+1<NT));       ENDW(t);   RESC(); ROT();
    STEP(pA0,pA1,pB0,pB1,t+1,(t+4<NT),(t+2<NT),(t+2<NT));     ENDW(t+1); RESC(); ROT();
  }
  STEP(pB0,pB1,pA0,pA1,NT-1,false,false,false); RESC();
  { float sacc=pB0[0]+pB0[1]; _Pragma("unroll") for(int r=2;r<16;++r)sacc+=pB0[r]; _Pragma("unroll") for(int r=0;r<16;++r)sacc+=pB1[r]; l_reg+=sacc;
    pw0=(u32x4){PKW(pB0,0),PKW(pB0,2),PKW(pB0,4),PKW(pB0,6)};pw1=(u32x4){PKW(pB0,8),PKW(pB0,10),PKW(pB0,12),PKW(pB0,14)};pw2=(u32x4){PKW(pB1,0),PKW(pB1,2),PKW(pB1,4),PKW(pB1,6)};pw3=(u32x4){PKW(pB1,8),PKW(pB1,10),PKW(pB1,12),PKW(pB1,14)};
    SBAR(); pv(o,vb0+sl_cur,PAF(0),PAF(1),PAF(2),PAF(3)); }
  #undef PKW
  #undef PAF
  #undef VFR
  #undef PIN
  #undef MX3
  #undef GAPA
  #undef GAPB
  #undef EX
  #undef VRD
  #undef KRD
  #undef STEP
  #undef ENDW
  {auto rr=__builtin_amdgcn_permlane32_swap(__float_as_uint(l_reg),__float_as_uint(l_reg),false,false);l_reg=__uint_as_float(rr[0])+__uint_as_float(rr[1]);}
  if(hi==0)wsf[32+r32]=l_reg;asm volatile("s_waitcnt lgkmcnt(0)":::"memory");
  float rli[16];
  #pragma unroll
  for(int r=0;r<16;++r)rli[r]=__builtin_amdgcn_rcpf(wsf[32+crow(r,hi)]);
  bf16*Ow=O+(rowbase+q0+wid*QBLK)*opitch;
  { bf16*stg=(bf16*)(shm+LDS_OST)+wid*2048;
    #pragma unroll
    for(int r=0;r<16;++r){const int orow=crow(r,hi);
      #pragma unroll
      for(int d0=0;d0<2;++d0)stg[orow*64+d0*32+r32]=__float2bfloat16(o[d0][r]*rli[r]);}
    asm volatile("s_waitcnt lgkmcnt(0)":::"memory");
    #pragma unroll
    for(int i=0;i<4;++i){const int row=i*8+(lane>>3),ch=lane&7; const u32x4 v=*(const u32x4*)(stg+row*64+ch*8); ATTN_STORE16(Ow+(long)row*opitch+ch*8,v);} }
  asm volatile("s_waitcnt lgkmcnt(0)\n\ts_barrier":::"memory");
  #undef DMA_K
  #undef DMA_V
  #undef CMASK
  #undef START
  #undef RESC
  #undef ROT
}

__device__ __forceinline__ void sb_unit(int b,int qb,const bf16*Q,const bf16*__restrict__ K,const bf16*__restrict__ V,bf16*O,int opitch,char*shm){
  const int tid=opaque_tid(),lane=tid&63,r32=lane&31,hi=lane>>5; const int wid=__builtin_amdgcn_readfirstlane(tid>>6);
  const long rowbase=(long)b*SEQ; const int q0=qb*QB;
  const bf16*Qw=Q+(rowbase+q0+wid*QBLK)*DM;
  const bf16*Kh=K+rowbase*DM,*Vh=V+rowbase*DM;
  const unsigned lds0=(unsigned)(uintptr_t)shm;
  const bf16*ksrc=Kh+(long)lane*DM+wid*8;
  const bf16*vsrc=Vh+(long)(16*(wid&3)+(lane>>2))*DM+(wid>>2)*32+(lane&3)*8;
  const unsigned kdst=lds0+LDS_K+wid*1024, vdst=lds0+LDS_V+wid*1024;
  #define DMA_K(t,slot) glds16(ksrc+(long)(t)*KVBLK*DM,(unsigned)__builtin_amdgcn_readfirstlane(kdst+(slot)))
  #define DMA_V(t,slot) glds16(vsrc+(long)(t)*KVBLK*DM,(unsigned)__builtin_amdgcn_readfirstlane(vdst+(slot)))
  const int vb0=(int)(lds0+LDS_V)+((lane>>4)&1)*32+(lane&3)*8+(4*hi+((lane&15)>>2))*64;
  const char*Kbase=shm+LDS_K;
  const int NT=(q0+QB)/KVBLK;
  int j=NT-1;
  DMA_K(j,(j&1)*SLOTB);DMA_V(j,(j&1)*SLOTB);
  bf16x8 qr[4];
  #pragma unroll
  for(int d0=0;d0<4;++d0)qr[d0]=*reinterpret_cast<const bf16x8*>(&Qw[(long)r32*DM+d0*16+hi*8]);
  f32x16 o[2];o[0]=f32x16{};o[1]=f32x16{};
  float R=0.f;
  const int trow=q0+wid*QBLK+r32;
  const int wmax=q0+wid*QBLK+QBLK-1;
  const float selhi=(hi==0)?1.f:0.f;
  #pragma unroll 1
  for(;j>=0;--j){
    WAIT_BAR(0);
    if(j>0){DMA_K(j-1,((j-1)&1)*SLOTB);DMA_V(j-1,((j-1)&1)*SLOTB);}
    const int slot=(j&1)*SLOTB;
    if(64*j<wmax){
      f32x16 p0,p1; const f32x16 zero=f32x16{};
      qkt(p0,p1,Kbase+slot,qr,zero,r32,hi);
      const int thr=trow-64*j-4*hi;
      f32x16 l0,l1;
      #pragma unroll
      for(int r=0;r<16;++r){
        { const float z=p0[r]; const float lg=__builtin_amdgcn_logf(1.f+__builtin_amdgcn_exp2f(-__builtin_fabsf(z))); const float sp=__builtin_fmaxf(-z,0.f)+lg;
          const bool ok=((r&3)+8*(r>>2))<thr; l0[r]=ok?-(sp+z):0.f; p0[r]=ok?-sp:-INFINITY; }
        { const float z=p1[r]; const float lg=__builtin_amdgcn_logf(1.f+__builtin_amdgcn_exp2f(-__builtin_fabsf(z))); const float sp=__builtin_fmaxf(-z,0.f)+lg;
          const bool ok=((r&3)+8*(r>>2)+32)<thr; l1[r]=ok?-(sp+z):0.f; p1[r]=ok?-sp:-INFINITY; }
      }
      float gs[8],pt[8];
      #pragma unroll
      for(int g=0;g<4;++g){ gs[g]=(l0[4*g]+l0[4*g+1])+(l0[4*g+2]+l0[4*g+3]); gs[4+g]=(l1[4*g]+l1[4*g+1])+(l1[4*g+2]+l1[4*g+3]); }
      #pragma unroll
      for(int g=0;g<8;++g){ auto rr=__builtin_amdgcn_permlane32_swap(__float_as_uint(gs[g]),__float_as_uint(gs[g]),false,false); pt[g]=__uint_as_float(rr[0])+__uint_as_float(rr[1]); }
      float base[8]; float run=R;
      #pragma unroll
      for(int g=7;g>=0;--g){ base[g]=run+selhi*(pt[g]-gs[g]); run+=pt[g]; }
      R=run;
      #pragma unroll
      for(int g=0;g<4;++g){
        { float a=base[g]; p0[4*g+3]=__builtin_amdgcn_exp2f(p0[4*g+3]+a); a+=l0[4*g+3]; p0[4*g+2]=__builtin_amdgcn_exp2f(p0[4*g+2]+a); a+=l0[4*g+2]; p0[4*g+1]=__builtin_amdgcn_exp2f(p0[4*g+1]+a); a+=l0[4*g+1]; p0[4*g]=__builtin_amdgcn_exp2f(p0[4*g]+a); }
        { float a=base[4+g]; p1[4*g+3]=__builtin_amdgcn_exp2f(p1[4*g+3]+a); a+=l1[4*g+3]; p1[4*g+2]=__builtin_amdgcn_exp2f(p1[4*g+2]+a); a+=l1[4*g+2]; p1[4*g+1]=__builtin_amdgcn_exp2f(p1[4*g+1]+a); a+=l1[4*g+1]; p1[4*g]=__builtin_amdgcn_exp2f(p1[4*g]+a); }
      }
      u32x4 pw0,pw1,pw2,pw3;
      pw0=(u32x4){cvtpk_s(p0[0],p0[1]),cvtpk_s(p0[2],p0[3]),cvtpk_s(p0[4],p0[5]),cvtpk_s(p0[6],p0[7])};
      pw1=(u32x4){cvtpk_s(p0[8],p0[9]),cvtpk_s(p0[10],p0[11]),cvtpk_s(p0[12],p0[13]),cvtpk_s(p0[14],p0[15])};
      pw2=(u32x4){cvtpk_s(p1[0],p1[1]),cvtpk_s(p1[2],p1[3]),cvtpk_s(p1[4],p1[5]),cvtpk_s(p1[6],p1[7])};
      pw3=(u32x4){cvtpk_s(p1[8],p1[9]),cvtpk_s(p1[10],p1[11]),cvtpk_s(p1[12],p1[13]),cvtpk_s(p1[14],p1[15])};
      SBAR();
      pv(o,vb0+slot,__builtin_bit_cast(bf16x8,pw0),__builtin_bit_cast(bf16x8,pw1),__builtin_bit_cast(bf16x8,pw2),__builtin_bit_cast(bf16x8,pw3));
    }
  }
  bf16*Ow=O+(rowbase+q0+wid*QBLK)*opitch;
  { bf16*stg=(bf16*)(shm+LDS_OST)+wid*2048;
    #pragma unroll
    for(int r=0;r<16;++r){const int orow=crow(r,hi);
      #pragma unroll
      for(int d0=0;d0<2;++d0)stg[orow*64+d0*32+r32]=__float2bfloat16(o[d0][r]);}
    asm volatile("s_waitcnt lgkmcnt(0)":::"memory");
    #pragma unroll
    for(int i=0;i<4;++i){const int row=i*8+(lane>>3),ch=lane&7; const u32x4 v=*(const u32x4*)(stg+row*64+ch*8); ATTN_STORE16(Ow+(long)row*opitch+ch*8,v);} }
  asm volatile("s_waitcnt lgkmcnt(0)\n\ts_barrier":::"memory");
  #undef DMA_K
  #undef DMA_V
}
constexpr int ATTN_LDS_BYTES=LDS_BYTES;
#undef SBAR
#undef WAIT_BAR
}
namespace mk {
using nv::NB; using nv::L; using nv::D; using nv::T; using nv::DEPTH; using nv::INC; using nv::EPS;
constexpr int NWAVES = 8;
constexpr size_t MiB = 1u << 20;
constexpr size_t WS_CTL = 0, CTL_ZERO_BYTES = 1 * MiB;
constexpr size_t WS_WIN = 1 * MiB;
constexpr size_t WS_WOUT = WS_WIN + 40 * MiB;
constexpr size_t WS_XN = WS_WOUT + 16 * MiB;
constexpr size_t WS_PROJ = WS_XN + 32 * MiB;
constexpr size_t WS_SBO = WS_PROJ + 80 * MiB;
constexpr size_t WS_O1 = WS_SBO + 8 * MiB;
constexpr size_t WS_O2 = WS_O1 + 16 * MiB;
constexpr size_t WS_Y = WS_O2 + 16 * MiB;
constexpr size_t WS_H = WS_Y + 32 * MiB;
constexpr size_t WS_YS = WS_H + 64 * MiB;
constexpr size_t WS_HB = WS_YS + 64 * MiB;
constexpr size_t WS_ROUTE = WS_HB + 24 * MiB;
constexpr size_t WS_S5 = WS_ROUTE + 2 * MiB;
constexpr size_t WS_W13 = WS_S5 + 160 * MiB;
constexpr size_t WS_W2 = WS_W13 + 256 * MiB;
constexpr size_t WS_END = WS_W2 + 128 * MiB;
static_assert(WS_END <= 1024 * MiB, "d_ws map must fit 1 GiB");
constexpr int CW_TMO = 0, CW_CODE = 1;
constexpr int CW_BAR = 4096;
constexpr int MAX_BAR_REGIONS = 40;
constexpr int CW_CNT = 2048;
constexpr int RING_OFF = 0, RING_BYTES = 131072;
constexpr int LDSCTL_OFF = 143360, MISC_OFF = LDSCTL_OFF + 320;
constexpr int LDS_BYTES = 147456;

#define GAS __attribute__((address_space(1)))
#define LAS __attribute__((address_space(3)))
typedef unsigned short bf16;
typedef unsigned v4u __attribute__((ext_vector_type(4)));
typedef float f32x4 __attribute__((ext_vector_type(4)));
typedef short bf16x8 __attribute__((ext_vector_type(8)));
typedef GAS unsigned gu32;
typedef GAS unsigned long long gu64;
#define RLX_AGENT __ATOMIC_RELAXED, __HIP_MEMORY_SCOPE_AGENT
#define LDS_WAIT() asm volatile("s_waitcnt lgkmcnt(0)" ::: "memory")
#define VM_WAIT() asm volatile("s_waitcnt vmcnt(0)" ::: "memory")
__device__ __forceinline__ unsigned long long rt() { return __builtin_amdgcn_s_memrealtime(); }
__device__ __forceinline__ unsigned f2bf(float f) { unsigned u = __builtin_bit_cast(unsigned, f); return (u + 0x7fffu + ((u >> 16) & 1u)) >> 16; }
__device__ __forceinline__ unsigned pk2(float lo, float hi) { return f2bf(lo) | (f2bf(hi) << 16); }

#define XB_TMO      128
#define XB_XCNT(j)  (256  + 64 * (j))
#define XB_XSUB(j)  (1280 + 64 * (j))
#define XB_XGEN(j)  (2304 + 64 * (j))
#define XB_TOP      3328
#define XB_TOPGEN   3392
#define XCD_BAR_WORDS 3456
#define XB_SPIN_CAP (1u << 18)

__device__ __forceinline__ unsigned xb_ld(unsigned* p)              { return __hip_atomic_load(p, __ATOMIC_RELAXED, __HIP_MEMORY_SCOPE_AGENT); }
__device__ __forceinline__ unsigned xb_add(unsigned* p, unsigned v) { return __hip_atomic_fetch_add(p, v, __ATOMIC_RELAXED, __HIP_MEMORY_SCOPE_AGENT); }
__device__ __forceinline__ unsigned xb_xcc_id() { return (unsigned)__builtin_amdgcn_s_getreg((3 << 11) | 20) & 0xFu; }
#define XB_SPIN(cond, bar) do { unsigned _sp = 0; while (cond) { __builtin_amdgcn_s_sleep(1); \
    if ((++_sp & 255u) == 0u) { if (xb_ld(&(bar)[XB_TMO])) break; if (_sp > XB_SPIN_CAP) { atomicAdd(&(bar)[XB_TMO], 1u); break; } } } } while (0)

struct XcdBarrier {
    unsigned* bar; unsigned x;
    volatile LAS unsigned* st;
};

__device__ __forceinline__ XcdBarrier xcd_barrier_post(unsigned* bar, volatile LAS unsigned* st) {
    XcdBarrier b; b.bar = bar; b.x = xb_xcc_id(); b.st = st;
    if (threadIdx.x == 0) (void)xb_add(&bar[XB_XCNT(b.x)], 1u);
    return b;
}
__device__ __forceinline__ void xcd_barrier_complete(unsigned* bar, unsigned x, unsigned& nloc, unsigned& nx) {
    const unsigned G = gridDim.x * gridDim.y * gridDim.z;
    unsigned sum, cnt, mine, sp = 0u;
    for (;;) {
        sum = 0u; cnt = 0u; mine = 0u;
#pragma unroll
        for (unsigned j = 0; j < 16; ++j) { const unsigned c = xb_ld(&bar[XB_XCNT(j)]); sum += c; cnt += (c > 0u) ? 1u : 0u; mine = (j == x) ? c : mine; }
        if (sum == G) break;
        __builtin_amdgcn_s_sleep(1);
        if ((++sp & 255u) == 0u) { if (xb_ld(&bar[XB_TMO])) break; if (sp > XB_SPIN_CAP) { atomicAdd(&bar[XB_TMO], 1u); break; } }
    }
    nloc = mine > 0u ? mine : 1u; nx = cnt > 0u ? cnt : 1u;
}

__device__ __forceinline__ void xcd_barrier(const XcdBarrier& b) {
    asm volatile("s_waitcnt vmcnt(0)" ::: "memory");
    __syncthreads();
    if (threadIdx.x == 0) {
        unsigned* bar = b.bar;
        __builtin_amdgcn_s_waitcnt(0);
        unsigned nloc = b.st[0], nx = b.st[1];
        if (nloc == 0u) { xcd_barrier_complete(bar, b.x, nloc, nx); b.st[0] = nloc; b.st[1] = nx; }
        const unsigned old = xb_add(&bar[XB_XSUB(b.x)], 1u);
        const unsigned gen = old / nloc;
        if (old + 1u == (gen + 1u) * nloc) {
            __builtin_amdgcn_fence(__ATOMIC_RELEASE, "agent");
            asm volatile("s_waitcnt vmcnt(0)" ::: "memory");
            const unsigned og = xb_add(&bar[XB_TOP], 1u);
            const unsigned tg = og / nx;
            if (og + 1u == (tg + 1u) * nx) xb_add(&bar[XB_TOPGEN], 1u);
            else XB_SPIN(xb_ld(&bar[XB_TOPGEN]) == tg, bar);
            __builtin_amdgcn_fence(__ATOMIC_ACQUIRE, "agent");
            xb_add(&bar[XB_XGEN(b.x)], 1u);
            asm volatile("s_waitcnt vmcnt(0)" ::: "memory");
        } else {
            XB_SPIN(xb_ld(&bar[XB_XGEN(b.x)]) == gen, bar);
            __builtin_amdgcn_fence(__ATOMIC_ACQUIRE, "agent");
            asm volatile("s_waitcnt vmcnt(0)" ::: "memory");
        }
    }
    __syncthreads();
}
static_assert((CW_BAR + MAX_BAR_REGIONS * XCD_BAR_WORDS) * 4 <= (int)CTL_ZERO_BYTES, "barrier regions inside the memset region");

__device__ __forceinline__ float wave_sum(float v) {
#pragma unroll
    for (int o = 1; o < 64; o <<= 1) v += __shfl_xor(v, o);
    return v;
}
__device__ __forceinline__ void transpose_tile(const float* __restrict__ W, int N, int k0, int n0, bf16* __restrict__ dst, int Kd, LAS float* scr, int lane) {
    const int kr = lane >> 4, n4 = (lane & 15) * 4;
    f32x4 v[16];
#pragma unroll
    for (int i = 0; i < 16; ++i) v[i] = *(const GAS f32x4*)(W + (size_t)(k0 + i * 4 + kr) * N + n0 + n4);
#pragma unroll
    for (int i = 0; i < 16; ++i) { LAS float* s = scr + (i * 4 + kr) * 65 + n4; s[0] = v[i].x; s[1] = v[i].y; s[2] = v[i].z; s[3] = v[i].w; }
    LDS_WAIT(); asm volatile("" ::: "memory");
    const int c = lane & 7;
#pragma unroll
    for (int j = 0; j < 8; ++j) { const int n = (lane >> 3) + 8 * j; const LAS float* s = scr + (8 * c) * 65 + n;
        v4u o; o.x = pk2(s[0 * 65], s[1 * 65]); o.y = pk2(s[2 * 65], s[3 * 65]); o.z = pk2(s[4 * 65], s[5 * 65]); o.w = pk2(s[6 * 65], s[7 * 65]);
        *(GAS v4u*)(dst + (size_t)n * Kd + k0 + 8 * c) = o; }
    LDS_WAIT(); asm volatile("" ::: "memory");
}
__device__ __forceinline__ void rms_row_to_bf16(const float* xrow, const float* g, bf16* orow, int lane) {
    const GAS f32x4* xr = (const GAS f32x4*)xrow + lane; const GAS f32x4* gr = (const GAS f32x4*)g + lane;
    f32x4 v[8]; float s = 0.f;
#pragma unroll
    for (int j = 0; j < 8; ++j) { v[j] = xr[64 * j]; s += (v[j].x * v[j].x + v[j].y * v[j].y) + (v[j].z * v[j].z + v[j].w * v[j].w); }
    const float r = rsqrtf(wave_sum(s) * (1.f / D) + EPS);
    GAS unsigned long long* o8 = (GAS unsigned long long*)orow + lane;
#pragma unroll
    for (int j = 0; j < 8; ++j) { const f32x4 gg = gr[64 * j]; o8[64 * j] = (unsigned long long)pk2(v[j].x * r * gg.x, v[j].y * r * gg.y) | ((unsigned long long)pk2(v[j].z * r * gg.z, v[j].w * r * gg.w) << 32); }
}
}

namespace pg8 {
struct EpiProj {
    static constexpr bool PERM = true, AFTER_DRAIN = false;
    bf16_t* O; int ldc;
    __device__ __forceinline__ void operator()(const f32x4 (&acc)[2][2][4][2], const Unit& u, int wr, int wc, int fr, int fq) const {
        const int row0 = u.pm * BM + wr * 64 + fr; const int colt = u.pn * BM;
        const float sc = (u.pn < 2) ? nv::QS_SB : ((u.pn >= 8 && u.pn < 12) ? nv::QS_DF : 1.f);
        const int col0 = colt + wc * 32 + 8 * fq;
#pragma unroll
        for (int ai = 0; ai < 2; ++ai)
#pragma unroll
            for (int m = 0; m < 4; ++m) { bf16_t* rowp = O + (size_t)(row0 + ai * HALF + m * 16) * ldc + col0;
#pragma unroll
                for (int bj = 0; bj < 2; ++bj) { const f32x4 v0 = acc[ai][bj][m][0] * sc, v1 = acc[ai][bj][m][1] * sc;
                    u32x4 w; w.x = cvt_pk_bf16(v0[0], v0[1]); w.y = cvt_pk_bf16(v0[2], v0[3]); w.z = cvt_pk_bf16(v1[0], v1[1]); w.w = cvt_pk_bf16(v1[2], v1[3]);
                    *(u32x4*)(rowp + bj * HALF) = w; } }
    }
};
struct EpiResF32 {
    static constexpr bool PERM = false, AFTER_DRAIN = false;
    const float* R; float* out; int ldc;
    __device__ __forceinline__ void operator()(const f32x4 (&acc)[2][2][4][2], const Unit& u, int wr, int wc, int fr, int fq) const {
        const int col0 = u.pn * BM + wc * 32 + 4 * fq;
#pragma unroll
        for (int ai = 0; ai < 2; ++ai)
#pragma unroll
            for (int m = 0; m < 4; ++m) { const size_t off = (size_t)(u.pm * BM + ai * HALF + wr * 64 + m * 16 + fr) * ldc + col0;
#pragma unroll
                for (int bj = 0; bj < 2; ++bj)
#pragma unroll
                    for (int n = 0; n < 2; ++n) { const f32x4 r = *(const f32x4*)(R + off + bj * HALF + n * 16); *(f32x4*)(out + off + bj * HALF + n * 16) = acc[ai][bj][m][n] + r; }
                asm volatile("" ::: "memory"); }
    }
};
}

namespace mk {
struct MArgs { const float* in[30]; float* out; unsigned char* ws; int ph_lo, ph_hi, li, pad; };
constexpr int NPHASE = 1 + 8 * DEPTH;

__global__ void __launch_bounds__(NWAVES * 64, 2) mk_fwd(MArgs args) {
    extern __shared__ __attribute__((aligned(16))) unsigned char lds[];
    LAS unsigned char* ldsl = (LAS unsigned char*)lds;
    volatile LAS unsigned* MISC = (volatile LAS unsigned*)(ldsl + MISC_OFF);
    const int tid = threadIdx.x, wave = __builtin_amdgcn_readfirstlane(tid >> 6);
    const int G = gridDim.x; const int bx = blockIdx.x; const int vcu = (G % 8 == 0) ? (bx % 8) * (G / 8) + bx / 8 : bx;
    unsigned char* ws = args.ws;
    gu32* ctl = (gu32*)(ws + WS_CTL);
    for (int u = tid; u < (LDS_BYTES - LDSCTL_OFF) / 4; u += NWAVES * 64) ((LAS unsigned*)(ldsl + LDSCTL_OFF))[u] = 0u;
    __syncthreads();
    XcdBarrier bar = xcd_barrier_post((unsigned*)(ctl + CW_BAR) + args.li * XCD_BAR_WORDS, MISC + 8);
    const int lo = args.ph_lo, hi = args.ph_hi;
#define IN(k) (lo <= (k) && (k) < hi)
#define SEAM(k) do { if (IN(k) && IN((k) + 1)) xcd_barrier(bar); } while (0)
    bf16* WinT = (bf16*)(ws + WS_WIN); bf16* WoutT = (bf16*)(ws + WS_WOUT); bf16* XN = (bf16*)(ws + WS_XN); bf16* PROJ = (bf16*)(ws + WS_PROJ);
    bf16* Y = (bf16*)(ws + WS_Y); float* H = (float*)(ws + WS_H); bf16* YS = (bf16*)(ws + WS_YS); bf16* HB = (bf16*)(ws + WS_HB);
    bf16* W13T = (bf16*)(ws + WS_W13); bf16* W2T = (bf16*)(ws + WS_W2); int* LIST = (int*)(ws + WS_ROUTE); float* GATEW = (float*)(ws + WS_ROUTE + MiB);
    int* EI = (int*)(ws + WS_ROUTE + MiB + 256 * 1024); float* EW = (float*)(ws + WS_ROUTE + MiB + 512 * 1024);
    LAS int* tab = (LAS int*)(ldsl + LDSCTL_OFF + 1024);
    const int NGW = G * NWAVES;
#define PHASE_IDS() const int tid_ = opaque_tid(); const int lane = tid_ & 63; const int gw = vcu * NWAVES + wave; (void)gw; (void)lane

    if (IN(0)) { PHASE_IDS();
        LAS float* scr = (LAS float*)(ldsl + RING_OFF + wave * 16640);
        constexpr int I_IN = (D / 64) * (INC / 64), I_OUT = (D / 64) * (D / 64);
        constexpr int NIT = DEPTH * (I_IN + I_OUT);
        for (int it = gw; it < NIT; it += NGW) {
            int r = it; const int l = r / (I_IN + I_OUT); r -= l * (I_IN + I_OUT);
            if (r < I_IN) { const int nb = r % (INC / 64), kb = r / (INC / 64);
                transpose_tile(args.in[2] + (size_t)l * D * INC, INC, kb * 64, nb * 64, WinT + ((size_t)l * INC + nb * 64) * D, D, scr, lane); }
            else { r -= I_IN; const int nb = r % (D / 64), kb = r / (D / 64);
                transpose_tile(args.in[20] + (size_t)l * D * D, D, kb * 64, nb * 64, WoutT + ((size_t)l * D + nb * 64) * D, D, scr, lane); }
        }
        for (int m = gw; m < T; m += NGW) rms_row_to_bf16(args.in[0] + (size_t)m * D, args.in[1], XN + (size_t)m * D, lane);
        constexpr int NEX = DEPTH * nv::NEXP * 768;
        for (int it = gw; it < NEX; it += NGW) {
            const int le = it / 768; int r = it - le * 768;
            if (r < 512) { const int w3 = r >> 8; r &= 255; const int nb = r & 7, kb = r >> 3; const int n0 = nb * 64;
                const float* W = args.in[w3 ? 27 : 26] + (size_t)le * D * nv::DE;
                transpose_tile(W, nv::DE, kb * 64, n0, W13T + ((size_t)le * 1024 + (n0 >> 7) * 256 + w3 * 128 + (n0 & 127)) * D, D, scr, lane); }
            else { r -= 512; const int nb = r & 31, kb = r >> 5;
                transpose_tile(args.in[28] + (size_t)le * nv::DE * D, D, kb * 64, nb * 64, W2T + ((size_t)le * D + nb * 64) * nv::DE, nv::DE, scr, lane); }
        }
    }
    SEAM(0);
    for (int l = 0; l < DEPTH; ++l) {
        const int pb = 1 + 8 * l;
        if (IN(pb + 0)) {
            pg8::Gemm g{XN, WinT + (size_t)l * INC * D, T, INC, D}; pg8::StaticOrder S; S.init(T, INC, G, bx);
            pg8::EpiProj E{PROJ, INC};
            pg8::gemm_phase<pg8::EpiProj, pg8::StaticOrder, PG8_ALIGN, PG8_SP2>(ldsl + RING_OFF, g, S, E);
        }
        SEAM(pb + 0);
        if (IN(pb + 1)) {
            bf16* O1 = (bf16*)(ws + WS_O1); bf16* O2 = (bf16*)(ws + WS_O2);
#pragma unroll 1
            for (int u = vcu; u < 1024; u += G) { const int i = u >> 8, v = u & 255, combo = v >> 1, sub = v & 1;
                const int qb = ((sub ? 0x4352 : 0x6170) >> (4 * i)) & 7;
                const int b = combo >> 5, rem = combo & 31, h = rem >> 2, mp = (rem >> 1) & 1, vh = rem & 1;
                attn_body::attn_unit<8>(b, qb, (const attn_body::bf16*)(PROJ + nv::C_DQ + h * 128 + mp * 64), (const attn_body::bf16*)(PROJ + nv::C_DK + h * 128 + mp * 64),
                                        (const attn_body::bf16*)(PROJ + nv::C_DV + h * 128 + vh * 64), (attn_body::bf16*)((mp ? O2 : O1) + h * 128 + vh * 64), 1024, (char*)lds + RING_OFF); }
        }
#if !defined(NO_MK_SB)
        if (IN(pb + 1)) {
            bf16* SBO = (bf16*)(ws + WS_SBO);
#pragma unroll 1
            for (int u = vcu; u < 256; u += G) { const int bh = u >> 3, qb = u & 7, b = bh >> 3, h = bh & 7;
                attn_body::sb_unit(b, qb, (const attn_body::bf16*)(PROJ + nv::C_SBQ + h * 64), (const attn_body::bf16*)(PROJ + nv::C_SBK + h * 64),
                                   (const attn_body::bf16*)(PROJ + nv::C_SBV + h * 64), (attn_body::bf16*)(SBO + h * 64), 512, (char*)lds + RING_OFF); }
        }
#endif
        SEAM(pb + 1);
        SEAM(pb + 2);
        if (IN(pb + 3)) {
            pg8::Gemm g{Y, WoutT + (size_t)l * D * D, T, D, D}; pg8::StaticOrder S; S.init(T, D, G, bx);
            pg8::EpiResF32 E{l == 0 ? args.in[0] : (const float*)H, H, D};
            pg8::gemm_phase<pg8::EpiResF32, pg8::StaticOrder, PG8_ALIGN, PG8_SP2>(ldsl + RING_OFF, g, S, E);
        }
        SEAM(pb + 3);
        gu32* cnt = ctl + CW_CNT + 64 * l;
        if (IN(pb + 4)) { PHASE_IDS();
            const float* gF = args.in[21] + (size_t)l * D; const float* rgw = args.in[22] + (size_t)l * D * 4; const float* rgb = args.in[23] + l * 4;
            const float* rew = args.in[24] + (size_t)l * 4 * D * 8; const float* reb = args.in[25] + l * 32;
            LAS float* hrow = (LAS float*)(ldsl + RING_OFF + wave * 8192);
#pragma unroll 1
            for (int m = gw; m < T; m += NGW) {
                float r;
                { const GAS f32x4* hr = (const GAS f32x4*)(H + (size_t)m * D) + lane; const GAS f32x4* gr = (const GAS f32x4*)gF + lane;
                  f32x4 v[8]; float s = 0.f;
#pragma unroll
                  for (int j = 0; j < 8; ++j) { v[j] = hr[64 * j]; s += (v[j].x * v[j].x + v[j].y * v[j].y) + (v[j].z * v[j].z + v[j].w * v[j].w); }
                  r = rsqrtf(wave_sum(s) * (1.f / D) + EPS);
                  GAS unsigned long long* o8 = (GAS unsigned long long*)(XN + (size_t)m * D) + lane;
#pragma unroll
                  for (int j = 0; j < 8; ++j) { const f32x4 gg = gr[64 * j]; const f32x4 o = v[j] * r * gg;
                      o8[64 * j] = (unsigned long long)pk2(o.x, o.y) | ((unsigned long long)pk2(o.z, o.w) << 32);
                      *(LAS f32x4*)(hrow + 256 * j + 4 * lane) = o; } }
                LDS_WAIT(); asm volatile("" ::: "memory");
                float gl0 = 0.f, gl1 = 0.f, gl2 = 0.f, gl3 = 0.f;
#pragma unroll 4
                for (int jj = 0; jj < 32; ++jj) { const int d = jj * 64 + lane; const float hv = hrow[d]; const f32x4 w = *(const GAS f32x4*)(rgw + (size_t)d * 4);
                    gl0 += hv * w.x; gl1 += hv * w.y; gl2 += hv * w.z; gl3 += hv * w.w; }
                gl0 = wave_sum(gl0) + rgb[0]; gl1 = wave_sum(gl1) + rgb[1]; gl2 = wave_sum(gl2) + rgb[2]; gl3 = wave_sum(gl3) + rgb[3];
                int gi = 0; float gm = gl0;
                if (gl1 > gm) { gm = gl1; gi = 1; } if (gl2 > gm) { gm = gl2; gi = 2; } if (gl3 > gm) { gm = gl3; gi = 3; }
                const float gtop = 1.f / (expf(gl0 - gm) + expf(gl1 - gm) + expf(gl2 - gm) + expf(gl3 - gm));
                gi = __builtin_amdgcn_readfirstlane(gi);
                const float* rw = rew + (size_t)gi * D * 8;
                float e0 = 0.f, e1 = 0.f, e2 = 0.f, e3 = 0.f, e4 = 0.f, e5 = 0.f, e6 = 0.f, e7 = 0.f;
#pragma unroll 4
                for (int jj = 0; jj < 32; ++jj) { const int d = jj * 64 + lane; const float hv = hrow[d]; const GAS f32x4* wp = (const GAS f32x4*)(rw + (size_t)d * 8); const f32x4 w0 = wp[0], w1 = wp[1];
                    e0 += hv * w0.x; e1 += hv * w0.y; e2 += hv * w0.z; e3 += hv * w0.w; e4 += hv * w1.x; e5 += hv * w1.y; e6 += hv * w1.z; e7 += hv * w1.w; }
                float m0 = -INFINITY, m1 = -INFINITY; int i0 = 0, i1 = 0;
#define TOP2(ev, q) do { const float lv = wave_sum(ev) + reb[gi * 8 + (q)]; if (lv > m0) { m1 = m0; i1 = i0; m0 = lv; i0 = (q); } else if (lv > m1) { m1 = lv; i1 = (q); } } while (0)
                TOP2(e0, 0); TOP2(e1, 1); TOP2(e2, 2); TOP2(e3, 3); TOP2(e4, 4); TOP2(e5, 5); TOP2(e6, 6); TOP2(e7, 7);
#undef TOP2
                const float p1 = expf(m1 - m0); const float w0 = 1.f / (1.f + p1) * gtop, w1 = p1 / (1.f + p1) * gtop;
                if (lane == 0) { const int x0 = gi * 8 + i0, x1 = gi * 8 + i1;
                    const unsigned q0 = __hip_atomic_fetch_add(cnt + x0, 1u, RLX_AGENT), q1 = __hip_atomic_fetch_add(cnt + x1, 1u, RLX_AGENT);
                    LIST[x0 * 8192 + q0] = 2 * m; LIST[x1 * 8192 + q1] = 2 * m + 1; GATEW[2 * m] = w0; GATEW[2 * m + 1] = w1;
                    EI[2 * m] = x0; EI[2 * m + 1] = x1; EW[2 * m] = w0; EW[2 * m + 1] = w1; }
                asm volatile("" ::: "memory");
            }
        }
        SEAM(pb + 4);
#define BUILD_TAB() do { PHASE_IDS(); if (wave == 0) { const int c_ = (lane < 32) ? (int)__hip_atomic_load(cnt + (lane & 31), RLX_AGENT) : 0; int incl = (c_ + 255) >> 8; \
            _Pragma("unroll") for (int o = 1; o < 32; o <<= 1) { const int t_ = __shfl_up(incl, o); if (lane >= o) incl += t_; } \
            if (lane < 32) { tab[lane] = c_; tab[33 + lane] = incl; } if (lane == 0) tab[32] = 0; } LDS_WAIT(); __syncthreads(); } while (0)
        if (IN(pb + 5)) {
            BUILD_TAB();
            pg8::GroupedOrder S{(const LAS int*)tab, 4, G, bx, 1024u * 2048u * 2u};
            pg8::Gemm g{XN, W13T + (size_t)l * nv::NEXP * 1024 * D, 0, 0, D};
            pg8::EpiMoe1 E{HB, LIST, GATEW};
            pg8::gemm_phase_g<pg8::EpiMoe1, true>(ldsl + RING_OFF, g, S, E, LIST);
        }
        SEAM(pb + 5);
        if (IN(pb + 6)) {
            BUILD_TAB();
            pg8::GroupedOrder S{(const LAS int*)tab, 8, G, bx, 2048u * 512u * 2u};
            pg8::Gemm g{HB, W2T + (size_t)l * nv::NEXP * D * nv::DE, 0, 0, nv::DE};
            pg8::EpiMoe2 E{YS, LIST};
            pg8::gemm_phase_g<pg8::EpiMoe2, false>(ldsl + RING_OFF, g, S, E, LIST);
        }
        SEAM(pb + 6);
        if (IN(pb + 7)) { PHASE_IDS();
            const bool fin = (l + 1 == DEPTH); const float* gN = fin ? args.in[29] : args.in[1] + (size_t)(l + 1) * D;
            for (int m = gw; m < T; m += NGW) {
                GAS f32x4* hr = (GAS f32x4*)(H + (size_t)m * D) + lane; const GAS f32x4* gr = (const GAS f32x4*)gN + lane;
                typedef unsigned u32x2_t __attribute__((ext_vector_type(2))); const GAS u32x2_t* y0 = (const GAS u32x2_t*)(YS + (size_t)(2 * m) * D) + lane; const GAS u32x2_t* y1 = (const GAS u32x2_t*)(YS + (size_t)(2 * m + 1) * D) + lane;
                f32x4 v[8]; float s = 0.f;
#pragma unroll
                for (int j = 0; j < 8; ++j) { const f32x4 h4 = hr[64 * j]; const u32x2_t a = y0[64 * j], b = y1[64 * j];
                    v[j].x = h4.x + __uint_as_float(a.x << 16) + __uint_as_float(b.x << 16); v[j].y = h4.y + __uint_as_float(a.x & 0xffff0000u) + __uint_as_float(b.x & 0xffff0000u);
                    v[j].z = h4.z + __uint_as_float(a.y << 16) + __uint_as_float(b.y << 16); v[j].w = h4.w + __uint_as_float(a.y & 0xffff0000u) + __uint_as_float(b.y & 0xffff0000u);
                    s += (v[j].x * v[j].x + v[j].y * v[j].y) + (v[j].z * v[j].z + v[j].w * v[j].w); }
                const float r = rsqrtf(wave_sum(s) * (1.f / D) + EPS);
                if (fin) { GAS f32x4* orow = (GAS f32x4*)(args.out + (size_t)m * D) + lane;
#pragma unroll
                    for (int j = 0; j < 8; ++j) orow[64 * j] = v[j] * r * gr[64 * j]; }
                else { GAS unsigned long long* o8 = (GAS unsigned long long*)(XN + (size_t)m * D) + lane;
#pragma unroll
                    for (int j = 0; j < 8; ++j) { hr[64 * j] = v[j]; const f32x4 o = v[j] * r * gr[64 * j]; o8[64 * j] = (unsigned long long)pk2(o.x, o.y) | ((unsigned long long)pk2(o.z, o.w) << 32); } }
            }
        }
        SEAM(pb + 7);
    }
#undef IN
#undef SEAM
}

static int g_grid = 0;
static bool mk_setup() {
    if (g_grid != 0) return g_grid > 0;
    int dev = 0, cus = 0, per_cu = 0;
    if (hipGetDevice(&dev) != hipSuccess || hipDeviceGetAttribute(&cus, hipDeviceAttributeMultiprocessorCount, dev) != hipSuccess) { g_grid = -1; return false; }
    if (hipFuncSetAttribute((const void*)mk_fwd, hipFuncAttributeMaxDynamicSharedMemorySize, LDS_BYTES) != hipSuccess) { fprintf(stderr, "mk: hipFuncSetAttribute failed\n"); g_grid = -1; return false; }
    if (hipOccupancyMaxActiveBlocksPerMultiprocessor(&per_cu, (const void*)mk_fwd, NWAVES * 64, LDS_BYTES) != hipSuccess || per_cu < 1) { fprintf(stderr, "mk: occupancy query says %d\n", per_cu); }
    (void)hipGetLastError();
    g_grid = cus;
    return true;
}
static void mk_launch(const MArgs& base, int lo, int hi, int& li, hipStream_t stream) {
    MArgs a = base; a.ph_lo = lo; a.ph_hi = hi; a.li = li++; a.pad = 0;
    hipLaunchKernelGGL(mk_fwd, dim3(g_grid), dim3(NWAVES * 64), LDS_BYTES, stream, a);
}
}
extern "C" void kernel_launch(void* const* d_in, const int* in_sizes, int n_in, void* d_out, int out_size, void* d_ws, size_t ws_size, hipStream_t stream) {
    using namespace nv;
    if (n_in != 30 || ws_size < mk::WS_END) { fprintf(stderr, "kernel_launch: unexpected n_in %d / ws %zu\n", n_in, ws_size); return; }
    if (!mk::mk_setup()) return;
    const float* x = (const float*)d_in[0];
    const float* norm_mix_g = (const float*)d_in[1]; const float* sb_norm_g = (const float*)d_in[3];
    const float* lam_re = (const float*)d_in[4]; const float* lam_im = (const float*)d_in[5]; const float* b_re = (const float*)d_in[6]; const float* b_im = (const float*)d_in[7];
    const float* c_re = (const float*)d_in[8]; const float* c_im = (const float*)d_in[9]; const float* ssm_d = (const float*)d_in[10]; const float* log_dt = (const float*)d_in[11];
    const float* w_glu = (const float*)d_in[12]; const float* b_glu = (const float*)d_in[13]; const float* ssm_norm_g = (const float*)d_in[14];
    const float* lq1 = (const float*)d_in[15]; const float* lk1 = (const float*)d_in[16]; const float* lq2 = (const float*)d_in[17]; const float* lk2 = (const float*)d_in[18];
    const float* subln = (const float*)d_in[19]; const float* norm_ffn_g = (const float*)d_in[21];
    const float* rgw = (const float*)d_in[22]; const float* rgb = (const float*)d_in[23]; const float* rew = (const float*)d_in[24]; const float* reb = (const float*)d_in[25];
    const float* ew1 = (const float*)d_in[26]; const float* ew3 = (const float*)d_in[27]; const float* ew2 = (const float*)d_in[28]; const float* final_g = (const float*)d_in[29];
    char* ws = (char*)d_ws;
    bf16_t* XN = (bf16_t*)(ws + mk::WS_XN); bf16_t* PROJ = (bf16_t*)(ws + mk::WS_PROJ); bf16_t* SBO = (bf16_t*)(ws + mk::WS_SBO);
    bf16_t* O1 = (bf16_t*)(ws + mk::WS_O1); bf16_t* O2 = (bf16_t*)(ws + mk::WS_O2); bf16_t* Y = (bf16_t*)(ws + mk::WS_Y); float* H = (float*)(ws + mk::WS_H);
    bf16_t* YS = (bf16_t*)(ws + mk::WS_YS);
    float2* ST = (float2*)(ws + mk::WS_S5); float* G1 = (float*)(ws + mk::WS_S5 + 128 * mk::MiB); float* SY = (float*)(ws + mk::WS_S5 + 144 * mk::MiB);
    (void)hipMemsetAsync(ws + mk::WS_CTL, 0, mk::CTL_ZERO_BYTES, stream);
    mk::MArgs a{};
    for (int i = 0; i < 30; ++i) a.in[i] = (const float*)d_in[i];
    a.out = (float*)d_out; a.ws = (unsigned char*)d_ws;
    int li = 0;
    mk::mk_launch(a, 0, 1, li, stream);
    for (int l = 0; l < DEPTH; ++l) {
        const float lam_init = 0.8f - 0.6f * expf(-0.3f * (float)l);
        const int pb = 1 + 8 * l;
        mk::mk_launch(a, pb + 0, pb + 1, li, stream);
        mk::mk_launch(a, pb + 1, pb + 2, li, stream);
        k_s5_scan<<<NB * SG, 64, 0, stream>>>(PROJ, lam_re + l * SG * SN, lam_im + l * SG * SN, b_re + (size_t)l * SG * SN * SC, b_im + (size_t)l * SG * SN * SC, log_dt + l * SG, ST);
        k_s5_out<<<T * SSMW / 256, 256, 0, stream>>>(PROJ, ST, c_re + (size_t)l * SG * SC * SN, c_im + (size_t)l * SG * SC * SN, ssm_d + l * SSMW, G1);
        k_glu<<<T, 512, 0, stream>>>(G1, w_glu + (size_t)l * SSMW * SSMW, b_glu + l * SSMW, SY);
        k_post<<<T, 256, 0, stream>>>(SBO, SY, O1, O2, sb_norm_g + l * SBW, ssm_norm_g + l * SSMW, subln + l * DFV, lq1 + l * 64, lk1 + l * 64, lq2 + l * 64, lk2 + l * 64, lam_init, Y);
        mk::mk_launch(a, pb + 3, pb + 4, li, stream);
        mk::mk_launch(a, pb + 4, pb + 5, li, stream);
        mk::mk_launch(a, pb + 5, pb + 6, li, stream);
        mk::mk_launch(a, pb + 6, pb + 7, li, stream);
        mk::mk_launch(a, pb + 7, pb + 8, li, stream);
    }
}
```

```cpp
#include <hip/hip_runtime.h>
#include <hip/hip_bf16.h>
#include <cstdint>
#include <cstdio>
#include <cmath>
__device__ __forceinline__ int opaque_tid() { int t = threadIdx.x; asm volatile("" : "+v"(t)); return t; }
namespace nv {
constexpr int NB = 4, L = 2048, D = 2048, T = NB * L, DEPTH = 2;
constexpr int SBW = 512, SBH = 8, SSMW = 512, SG = 32, SN = 64, SC = 16, DFW = 1024, DFH = 8, DFV = 128;
constexpr int INC = 5120, NEXP = 32, EPG = 8, NGRP = 4, DE = 512;
constexpr int C_SBQ = 0, C_SBK = 512, C_SBV = 1024, C_U = 1536, C_DQ = 2048, C_DK = 3072, C_DV = 4096;
constexpr float EPS = 1e-6f;
constexpr float LOG2E = 1.4426950408889634f;
constexpr float QS_SB = 0.125f * LOG2E, QS_DF = 0.125f * LOG2E;

typedef unsigned short bf16_t;
__device__ __forceinline__ float bf2f(bf16_t v) { return __uint_as_float(((unsigned)v) << 16); }
__device__ __forceinline__ bf16_t f2bf(float f) { unsigned u = __float_as_uint(f); return (bf16_t)((u + 0x7fffu + ((u >> 16) & 1u)) >> 16); }

__device__ __forceinline__ float block_sum(float v, float* red) {
    for (int o = 32; o > 0; o >>= 1) v += __shfl_xor(v, o);
    const int w = threadIdx.x >> 6, nw = blockDim.x >> 6;
    __syncthreads();
    if ((threadIdx.x & 63) == 0) red[w] = v;
    __syncthreads();
    float s = 0.f;
    for (int i = 0; i < nw; ++i) s += red[i];
    return s;
}
__device__ __forceinline__ float block_max(float v, float* red) {
    for (int o = 32; o > 0; o >>= 1) v = fmaxf(v, __shfl_xor(v, o));
    const int w = threadIdx.x >> 6, nw = blockDim.x >> 6;
    __syncthreads();
    if ((threadIdx.x & 63) == 0) red[w] = v;
    __syncthreads();
    float s = -INFINITY;
    for (int i = 0; i < nw; ++i) s = fmaxf(s, red[i]);
    return s;
}

__global__ void __launch_bounds__(256) k_rmsnorm(const float* __restrict__ x, const float* __restrict__ g, bf16_t* __restrict__ out) {
    __shared__ float red[16];
    const int t = blockIdx.x; const float* xr = x + (size_t)t * D;
    float v[8]; float s = 0.f;
    for (int i = 0; i < 8; ++i) { v[i] = xr[threadIdx.x + 256 * i]; s += v[i] * v[i]; }
    s = block_sum(s, red);
    const float r = rsqrtf(s / D + EPS);
    for (int i = 0; i < 8; ++i) out[(size_t)t * D + threadIdx.x + 256 * i] = f2bf(v[i] * r * g[threadIdx.x + 256 * i]);
}

template <int EPI>
__global__ void __launch_bounds__(256) k_gemm(const bf16_t* __restrict__ A, int lda, const float* __restrict__ Bm, int ldb, int K,
                                             void* __restrict__ Cout, int ldc, const float* __restrict__ R) {
    __shared__ float As[16][68];
    __shared__ float Bs[16][68];
    const int tx = threadIdx.x & 15, ty = threadIdx.x >> 4;
    const int m0 = blockIdx.y * 64, n0 = blockIdx.x * 64;
    float acc[4][4];
    for (int i = 0; i < 4; ++i) for (int j = 0; j < 4; ++j) acc[i][j] = 0.f;
    for (int k0 = 0; k0 < K; k0 += 16) {
        for (int e = threadIdx.x; e < 64 * 16; e += 256) { const int r = e >> 4, c = e & 15; As[c][r] = bf2f(A[(size_t)(m0 + r) * lda + k0 + c]); }
        for (int e = threadIdx.x; e < 64 * 16; e += 256) { const int r = e >> 6, c = e & 63; Bs[r][c] = Bm[(size_t)(k0 + r) * ldb + n0 + c]; }
        __syncthreads();
#pragma unroll
        for (int k = 0; k < 16; ++k) {
            float a[4], b[4];
            for (int i = 0; i < 4; ++i) a[i] = As[k][ty * 4 + i];
            for (int j = 0; j < 4; ++j) b[j] = Bs[k][tx * 4 + j];
            for (int i = 0; i < 4; ++i) for (int j = 0; j < 4; ++j) acc[i][j] += a[i] * b[j];
        }
        __syncthreads();
    }
    for (int i = 0; i < 4; ++i) for (int j = 0; j < 4; ++j) {
        const int m = m0 + ty * 4 + i, n = n0 + tx * 4 + j;
        if (EPI == 0) {
            float sc = 1.f; if (n < C_SBK) sc = QS_SB; else if (n >= C_DQ && n < C_DK) sc = QS_DF;
            ((bf16_t*)Cout)[(size_t)m * ldc + n] = f2bf(acc[i][j] * sc);
        } else {
            ((float*)Cout)[(size_t)m * ldc + n] = acc[i][j] + R[(size_t)m * ldc + n];
        }
    }
}

__global__ void __launch_bounds__(256) k_sb_attn(const bf16_t* __restrict__ P, bf16_t* __restrict__ O) {
    __shared__ float zs[L];
    __shared__ float qv[64];
    __shared__ float part[4][64];
    const int t = blockIdx.x, h = blockIdx.y, b = blockIdx.z, tid = threadIdx.x;
    const size_t rowb = (size_t)b * L;
    if (tid < 64) qv[tid] = bf2f(P[(rowb + t) * INC + C_SBQ + h * 64 + tid]);
    __syncthreads();
    for (int s = tid; s < t; s += 256) {
        const bf16_t* kr = P + (rowb + s) * INC + C_SBK + h * 64;
        float z = 0.f;
        for (int d = 0; d < 64; ++d) z += qv[d] * bf2f(kr[d]);
        zs[s] = z;
    }
    __syncthreads();
    if (tid == 0) {
        float Racc = 0.f;
        for (int s = t - 1; s >= 0; --s) {
            const float z = zs[s];
            const float sp = fmaxf(-z, 0.f) + log1pf(expf(-fabsf(z)));
            zs[s] = expf(-sp + Racc);
            Racc += -(sp + z);
        }
    }
    __syncthreads();
    const int d = tid & 63, gq = tid >> 6;
    float o = 0.f;
    for (int s = gq; s < t; s += 4) o += zs[s] * bf2f(P[(rowb + s) * INC + C_SBV + h * 64 + d]);
    part[gq][d] = o;
    __syncthreads();
    if (tid < 64) O[(rowb + t) * SBW + h * 64 + tid] = f2bf(part[0][tid] + part[1][tid] + part[2][tid] + part[3][tid]);
}

__global__ void __launch_bounds__(256) k_diff_attn(const bf16_t* __restrict__ P, bf16_t* __restrict__ O1, bf16_t* __restrict__ O2) {
    __shared__ float ps[L];
    __shared__ float qv[64];
    __shared__ float part[2][128];
    __shared__ float red[16];
    const int t = blockIdx.x, h = blockIdx.y >> 1, mp = blockIdx.y & 1, b = blockIdx.z, tid = threadIdx.x;
    const size_t rowb = (size_t)b * L;
    if (tid < 64) qv[tid] = bf2f(P[(rowb + t) * INC + C_DQ + h * 128 + mp * 64 + tid]);
    __syncthreads();
    float mx = -INFINITY;
    for (int s = tid; s <= t; s += 256) {
        const bf16_t* kr = P + (rowb + s) * INC + C_DK + h * 128 + mp * 64;
        float z = 0.f;
        for (int d = 0; d < 64; ++d) z += qv[d] * bf2f(kr[d]);
        ps[s] = z; mx = fmaxf(mx, z);
    }
    mx = block_max(mx, red);
    float sum = 0.f;
    for (int s = tid; s <= t; s += 256) { const float p = exp2f(ps[s] - mx); ps[s] = p; sum += p; }
    sum = block_sum(sum, red);
    __syncthreads();
    const int d = tid & 127, gq = tid >> 7;
    float o = 0.f;
    for (int s = gq; s <= t; s += 2) o += ps[s] * bf2f(P[(rowb + s) * INC + C_DV + h * 128 + d]);
    part[gq][d] = o;
    __syncthreads();
    if (tid < 128) { bf16_t* O = mp ? O2 : O1; O[(rowb + t) * DFW + h * 128 + tid] = f2bf((part[0][tid] + part[1][tid]) / sum); }
}

__global__ void __launch_bounds__(64) k_s5_scan(const bf16_t* __restrict__ P, const float* lam_re, const float* lam_im, const float* b_re, const float* b_im,
                                                const float* log_dt, float2* __restrict__ ST) {
    const int b = blockIdx.x / SG, g = blockIdx.x % SG, n = threadIdx.x;
    const double dt = exp((double)log_dt[g]);
    const double lr = lam_re[g * SN + n], li = lam_im[g * SN + n];
    const double er = exp(lr * dt), lbr = er * cos(li * dt), lbi = er * sin(li * dt);
    const double nr = lbr - 1.0, ni = lbi, den = lr * lr + li * li;
    const double fr = (nr * lr + ni * li) / den, fi = (ni * lr - nr * li) / den;
    float bbr[SC], bbi[SC];
#pragma unroll
    for (int c = 0; c < SC; ++c) { const double br = b_re[(g * SN + n) * SC + c], bi = b_im[(g * SN + n) * SC + c]; bbr[c] = (float)(fr * br - fi * bi); bbi[c] = (float)(fr * bi + fi * br); }
    const float ar = (float)lbr, ai = (float)lbi;
    float sr = 0.f, si = 0.f;
    for (int t = 0; t < L; ++t) {
        const bf16_t* ur = P + ((size_t)b * L + t) * INC + C_U + g * SC;
        float bur = 0.f, bui = 0.f;
#pragma unroll
        for (int c = 0; c < SC; ++c) { const float u = bf2f(ur[c]); bur += bbr[c] * u; bui += bbi[c] * u; }
        const float nsr = ar * sr - ai * si + bur, nsi = ar * si + ai * sr + bui;
        sr = nsr; si = nsi;
        ST[(((size_t)b * L + t) * SG + g) * SN + n] = make_float2(sr, si);
    }
}
__device__ __forceinline__ float gelu_tanh(float x) { const float u = 0.7978845608028654f * (x + 0.044715f * x * x * x); return 0.5f * x * (1.f + tanhf(u)); }
__global__ void __launch_bounds__(256) k_s5_out(const bf16_t* __restrict__ P, const float2* __restrict__ ST, const float* c_re, const float* c_im, const float* dsk, float* __restrict__ G1) {
    const size_t idx = (size_t)blockIdx.x * 256 + threadIdx.x;
    const int ch = (int)(idx % SSMW); const size_t t = idx / SSMW; const int g = ch / SC, c = ch % SC;
    const float2* st = ST + (t * SG + g) * SN;
    float y = 0.f;
    for (int n = 0; n < SN; ++n) { const float2 s = st[n]; y += c_re[(g * SC + c) * SN + n] * s.x - c_im[(g * SC + c) * SN + n] * s.y; }
    y += dsk[g * SC + c] * bf2f(P[t * INC + C_U + ch]);
    G1[idx] = gelu_tanh(y);
}
__global__ void __launch_bounds__(512) k_glu(const float* __restrict__ G1, const float* __restrict__ w, const float* __restrict__ bg, float* __restrict__ SY) {
    __shared__ float row[SSMW];
    const int t = blockIdx.x, j = threadIdx.x;
    row[j] = G1[(size_t)t * SSMW + j];
    __syncthreads();
    float z = bg[j];
    for (int k = 0; k < SSMW; ++k) z += row[k] * w[(size_t)k * SSMW + j];
    SY[(size_t)t * SSMW + j] = row[j] / (1.f + expf(-z));
}
__global__ void __launch_bounds__(256) k_post(const bf16_t* __restrict__ SBO, const float* __restrict__ SY, const bf16_t* __restrict__ O1, const bf16_t* __restrict__ O2,
                                             const float* sbg, const float* ssmg, const float* dfg, const float* lq1, const float* lk1, const float* lq2, const float* lk2,
                                             float lam_init, bf16_t* __restrict__ Y) {
    __shared__ float red[16];
    const int t = blockIdx.x, tid = threadIdx.x;
    float a = 0.f, c = 0.f;
    if (tid < 64) { a = lq1[tid] * lk1[tid]; c = lq2[tid] * lk2[tid]; }
    a = block_sum(a, red); c = block_sum(c, red);
    const float lam = expf(a) - expf(c) + lam_init;
    { float v0 = bf2f(SBO[(size_t)t * SBW + tid]), v1 = bf2f(SBO[(size_t)t * SBW + 256 + tid]);
      const float s = block_sum(v0 * v0 + v1 * v1, red); const float r = rsqrtf(s / SBW + EPS);
      Y[(size_t)t * D + tid] = f2bf(v0 * r * sbg[tid]); Y[(size_t)t * D + 256 + tid] = f2bf(v1 * r * sbg[256 + tid]); }
    { float v0 = SY[(size_t)t * SSMW + tid], v1 = SY[(size_t)t * SSMW + 256 + tid];
      const float s = block_sum(v0 * v0 + v1 * v1, red); const float r = rsqrtf(s / SSMW + EPS);
      Y[(size_t)t * D + 512 + tid] = f2bf(v0 * r * ssmg[tid]); Y[(size_t)t * D + 768 + tid] = f2bf(v1 * r * ssmg[256 + tid]); }
    for (int i = 0; i < 4; ++i) {
        const int e = tid + 256 * i; const int dv = e & 127;
        const float v = bf2f(O1[(size_t)t * DFW + e]) - lam * bf2f(O2[(size_t)t * DFW + e]);
        float s = v * v;
        for (int o = 32; o > 0; o >>= 1) s += __shfl_xor(s, o);
        __syncthreads();
        if ((tid & 63) == 0) red[tid >> 6] = s;
        __syncthreads();
        const int w = tid >> 6; const float tot = red[w & ~1] + red[(w & ~1) + 1];
        const float r = rsqrtf(tot / DFV + EPS);
        Y[(size_t)t * D + 1024 + e] = f2bf(v * r * dfg[dv] * (1.f - lam_init));
    }
}
__global__ void __launch_bounds__(256) k_route(const float* __restrict__ H, const float* __restrict__ g, const float* __restrict__ rgw, const float* __restrict__ rgb,
                                              const float* __restrict__ rew, const float* __restrict__ reb, bf16_t* __restrict__ HN, int* __restrict__ EI, float* __restrict__ EW) {
    __shared__ float red[16];
    __shared__ float hn[D];
    const int t = blockIdx.x, tid = threadIdx.x;
    float s = 0.f;
    for (int i = 0; i < 8; ++i) { const float v = H[(size_t)t * D + tid + 256 * i]; hn[tid + 256 * i] = v; s += v * v; }
    s = block_sum(s, red);
    const float r = rsqrtf(s / D + EPS);
    for (int i = 0; i < 8; ++i) { const int d = tid + 256 * i; const float v = hn[d] * r * g[d]; hn[d] = v; HN[(size_t)t * D + d] = f2bf(v); }
    __syncthreads();
    float gl[NGRP];
#pragma unroll
    for (int j = 0; j < NGRP; ++j) { float p = 0.f; for (int i = 0; i < 8; ++i) { const int d = tid + 256 * i; p += hn[d] * rgw[(size_t)d * NGRP + j]; } gl[j] = block_sum(p, red) + rgb[j]; }
    int gi = 0; float gm = gl[0];
#pragma unroll
    for (int j = 1; j < NGRP; ++j) if (gl[j] > gm) { gm = gl[j]; gi = j; }
    float gs = 0.f;
#pragma unroll
    for (int j = 0; j < NGRP; ++j) gs += expf(gl[j] - gm);
    const float gtop = 1.f / gs;
    float m0 = -INFINITY, m1 = -INFINITY; int i0 = 0, i1 = 0;
#pragma unroll
    for (int e = 0; e < EPG; ++e) { float p = 0.f; for (int i = 0; i < 8; ++i) { const int d = tid + 256 * i; p += hn[d] * rew[((size_t)gi * D + d) * EPG + e]; }
        const float v = block_sum(p, red) + reb[gi * EPG + e];
        if (v > m0) { m1 = m0; i1 = i0; m0 = v; i0 = e; } else if (v > m1) { m1 = v; i1 = e; } }
    const float p1 = expf(m1 - m0);
    const float w0 = 1.f / (1.f + p1) * gtop, w1 = p1 / (1.f + p1) * gtop;
    if (tid == 0) { EI[t * 2] = gi * EPG + i0; EI[t * 2 + 1] = gi * EPG + i1; EW[t * 2] = w0; EW[t * 2 + 1] = w1; }
}
__global__ void __launch_bounds__(512) k_moe_h(const bf16_t* __restrict__ HN, const int* __restrict__ EI, const float* __restrict__ EW, const float* __restrict__ w1, const float* __restrict__ w3, float* __restrict__ HB) {
    __shared__ float xr[D];
    const int ts = blockIdx.x, t = ts >> 1, f = threadIdx.x;
    for (int i = 0; i < 4; ++i) xr[f + 512 * i] = bf2f(HN[(size_t)t * D + f + 512 * i]);
    __syncthreads();
    const int e = EI[ts]; const float gw = EW[ts];
    const float* a1 = w1 + (size_t)e * D * DE + f; const float* a3 = w3 + (size_t)e * D * DE + f;
    float a = 0.f, b = 0.f;
    for (int d = 0; d < D; ++d) { a += xr[d] * a1[(size_t)d * DE]; b += xr[d] * a3[(size_t)d * DE]; }
    HB[(size_t)ts * DE + f] = a / (1.f + expf(-a)) * b * gw;
}
__global__ void __launch_bounds__(512) k_moe_y(const float* __restrict__ HB, const int* __restrict__ EI, const float* __restrict__ w2, bf16_t* __restrict__ YS) {
    __shared__ float hr[DE];
    const int ts = blockIdx.x, j = threadIdx.x;
    hr[j] = HB[(size_t)ts * DE + j];
    __syncthreads();
    const int e = EI[ts];
    const float* w = w2 + (size_t)e * DE * D;
    float acc[4] = {0.f, 0.f, 0.f, 0.f};
    for (int f = 0; f < DE; ++f) { const float hv = hr[f]; for (int i = 0; i < 4; ++i) acc[i] += hv * w[(size_t)f * D + j + 512 * i]; }
    for (int i = 0; i < 4; ++i) YS[(size_t)ts * D + j + 512 * i] = f2bf(acc[i]);
}
__global__ void __launch_bounds__(256) k_combine(float* __restrict__ H, const bf16_t* __restrict__ YS, const float* __restrict__ g, bf16_t* __restrict__ XN, float* __restrict__ out) {
    __shared__ float red[16];
    const int t = blockIdx.x, tid = threadIdx.x;
    float v[8]; float s = 0.f;
    for (int i = 0; i < 8; ++i) { const int d = tid + 256 * i; v[i] = H[(size_t)t * D + d] + bf2f(YS[((size_t)t * 2) * D + d]) + bf2f(YS[((size_t)t * 2 + 1) * D + d]); s += v[i] * v[i]; }
    s = block_sum(s, red);
    const float r = rsqrtf(s / D + EPS);
    for (int i = 0; i < 8; ++i) { const int d = tid + 256 * i;
        if (out) out[(size_t)t * D + d] = v[i] * r * g[d];
        else { H[(size_t)t * D + d] = v[i]; XN[(size_t)t * D + d] = f2bf(v[i] * r * g[d]); } }
}
}

namespace pg8 {
#define PG8_LAS __attribute__((address_space(3)))
typedef unsigned short bf16_t;
typedef short bf16x8 __attribute__((ext_vector_type(8)));
typedef float f32x4 __attribute__((ext_vector_type(4)));
typedef unsigned u32x4 __attribute__((ext_vector_type(4)));
constexpr int BM = 256, BK = 64, HALF = 128, HTB = HALF * BK * 2  , STAGE_BYTES = 8 * HTB, NXCD = 8, WGM = 8;

__host__ __device__ __forceinline__ int lds_byte(int r, int c) { const int st = (r >> 4) * 2 + (c >> 5), rr = r & 15, cc = c & 31, ob = rr * 64 + cc * 2; return st * 1024 + (ob ^ (((ob >> 9) & 1) << 5)); }
__host__ __device__ __forceinline__ void stage_rc(int b, int& R, int& C) { const int st = b / 1024, sb = b % 1024, swz = sb ^ (((sb >> 9) & 1) << 5); R = (st >> 1) * 16 + swz / 64; C = (st & 1) * 32 + (swz % 64) / 2; }
__host__ __device__ __forceinline__ int perm32(int rho) { const int n = rho >> 4, i = rho & 15; return 8 * (i >> 2) + 4 * n + (i & 3); }

struct Unit { int pm, pn; };
struct Gemm { const bf16_t* A; const bf16_t* Bt; int M, N, K; };

struct StaticOrder {
    int nM, nN, nwg, G, c;
    __host__ __device__ void init(int M, int N, int G_, int c_) { nM = M / BM; nN = N / BM; nwg = nM * nN; G = G_; c = c_; }
    __host__ __device__ bool next(int i, Unit& u) const {
        const long L = (long)i * G + c; if (L >= nwg) return false;
        int wgid = (int)L; { const int q = nwg / NXCD, r = nwg % NXCD, xcd = wgid % NXCD, off = wgid / NXCD; wgid = (xcd < r ? xcd * (q + 1) : r * (q + 1) + (xcd - r) * q) + off; }
        const int nig = WGM * nN, gid = wgid / nig, fm = gid * WGM, gsz = (nM - fm) < WGM ? (nM - fm) : WGM;
        u.pm = fm + ((wgid % nig) % gsz); u.pn = (wgid % nig) / gsz; return true;
    }
    __device__ __forceinline__ void a_ready(const Unit&) const {}
    __device__ __forceinline__ void done(const Unit&) const {}
};

__device__ __forceinline__ unsigned cvt_pk_bf16(float lo, float hi) { unsigned r; asm volatile("v_cvt_pk_bf16_f32 %0, %1, %2" : "=v"(r) : "v"(lo), "v"(hi)); return r; }
typedef float f32x2 __attribute__((ext_vector_type(2)));
__device__ __forceinline__ f32x2 gelu_pk(f32x2 v) {
    const f32x2 av = __builtin_elementwise_abs(v), d = av * 0.2316418882f + 1.0f;
    f32x2 t; t.x = __builtin_amdgcn_rcpf(d.x); t.y = __builtin_amdgcn_rcpf(d.y);
    f32x2 q = t * 0.5307027145f + (-0.7265760135f); q = q * t + 0.7107068705f; q = q * t + (-0.142248368f); q = q * t + 0.127414796f; q = q * t;
    const f32x2 s = (v * v) * (-0.72134752044f);
    f32x2 e; e.x = __builtin_amdgcn_exp2f(s.x); e.y = __builtin_amdgcn_exp2f(s.y);
    const f32x2 m = v * (q * e), r = v - m;
    f32x2 o; o.x = v.x < 0.f ? m.x : r.x; o.y = v.y < 0.f ? m.y : r.y; return o;
}

template <int ACT  > struct EpiBf16 {
    static constexpr bool PERM = true, AFTER_DRAIN = false; static_assert(ACT == 0 || ACT == 1, "EpiBf16: ACT is 0 (none) or 1 (gelu_pk)");
    bf16_t* O; int ldc; const float* bias; int split_cols; size_t split_stride; float scale0;
    __device__ __forceinline__ void operator()(const f32x4 (&acc)[2][2][4][2], const Unit& u, int wr, int wc, int fr, int fq) const {
        const int row0 = u.pm * BM + wr * 64 + fr; int colt = u.pn * BM; bf16_t* base = O;
        float sc = 1.f; if (split_cols) { const int t = colt / split_cols; base += (size_t)t * split_stride; colt -= t * split_cols; if (t == 0) sc = scale0; }
        const int col0 = colt + wc * 32 + 8 * fq, bcol0 = u.pn * BM + wc * 32 + 8 * fq;
        f32x4 bv[2][2];
#pragma unroll
        for (int bj = 0; bj < 2; ++bj)
#pragma unroll
            for (int n = 0; n < 2; ++n) bv[bj][n] = bias ? *(const f32x4*)(bias + bcol0 + bj * HALF + 4 * n) : (f32x4){0.f, 0.f, 0.f, 0.f};
#pragma unroll
        for (int ai = 0; ai < 2; ++ai)
#pragma unroll
            for (int m = 0; m < 4; ++m) { bf16_t* rowp = base + (size_t)(row0 + ai * HALF + m * 16) * ldc + col0;
#pragma unroll
                for (int bj = 0; bj < 2; ++bj) { f32x4 v0 = acc[ai][bj][m][0] + bv[bj][0], v1 = acc[ai][bj][m][1] + bv[bj][1];
                    if (ACT == 1) { f32x2 a = gelu_pk((f32x2){v0[0], v0[1]}), b = gelu_pk((f32x2){v0[2], v0[3]}), c = gelu_pk((f32x2){v1[0], v1[1]}), d = gelu_pk((f32x2){v1[2], v1[3]});
                        v0 = (f32x4){a.x, a.y, b.x, b.y}; v1 = (f32x4){c.x, c.y, d.x, d.y}; }
                    v0 = v0 * sc; v1 = v1 * sc; u32x4 w; w.x = cvt_pk_bf16(v0[0], v0[1]); w.y = cvt_pk_bf16(v0[2], v0[3]); w.z = cvt_pk_bf16(v1[0], v1[1]); w.w = cvt_pk_bf16(v1[2], v1[3]);
                    *(u32x4*)(rowp + bj * HALF) = w; } }
    }
};
template <class Epi, class Sched, bool ALIGN_EPI = false, bool SP2 = false>
__device__ __forceinline__ void gemm_phase(PG8_LAS unsigned char* lds, const Gemm g, const Sched& S, const Epi& E) {
    const int tid = opaque_tid(), wid = __builtin_amdgcn_readfirstlane(tid >> 6), lane = tid & 63, wr = wid >> 2, wc = wid & 3, fr = lane & 15, fq = lane >> 4;
    const int K = g.K, nt = K / BK;
    unsigned voffA[2], voffB[2];
#pragma unroll
    for (int i = 0; i < 2; ++i) { int R, C; stage_rc(tid * 16 + i * 8192, R, C); const int Rb = Epi::PERM ? ((R & ~31) + perm32(R & 31)) : R;
        voffA[i] = (unsigned)(R * K + C) * 2u; voffB[i] = (unsigned)(Rb * K + C) * 2u; }
    const size_t kstep = (size_t)(BK * 2);
    const size_t hstep = (size_t)HALF * K * 2;
    const size_t tstep = 2 * hstep;
    const unsigned ldsw = (unsigned)wid * 1024u;
    const int aoff = lds_byte(wr * 64 + fr, fq * 8), boff = lds_byte(wc * 32 + fr, fq * 8);
#define PG8_SA(b, h) (((b) * 2 + (h)) * HTB)
#define PG8_SB(b, h) ((4 + (b) * 2 + (h)) * HTB)
#define PG8_STAGE(bufoff, gbase, voff) do { _Pragma("unroll") for (int _i = 0; _i < 2; ++_i) \
        __builtin_amdgcn_global_load_lds((const unsigned*)((const char*)(gbase) + (voff)[_i]), (PG8_LAS unsigned*)(lds + (bufoff) + ldsw + _i * 8192), 16, 0, 0); } while (0)
#define PG8_LDA(dst, b, h) do { _Pragma("unroll") for (int m = 0; m < 4; ++m) _Pragma("unroll") for (int k = 0; k < 2; ++k) dst[m][k] = *(const PG8_LAS bf16x8*)(lds + PG8_SA(b, h) + aoff + m * 2048 + k * 1024); } while (0)
#define PG8_LDB(dst, b, h) do { _Pragma("unroll") for (int n = 0; n < 2; ++n) _Pragma("unroll") for (int k = 0; k < 2; ++k) dst[n][k] = *(const PG8_LAS bf16x8*)(lds + PG8_SB(b, h) + boff + n * 2048 + k * 1024); } while (0)
#define PG8_MMA(ai, bj, At, Bt) do { __builtin_amdgcn_s_setprio(1); _Pragma("unroll") for (int m = 0; m < 4; ++m) _Pragma("unroll") for (int n = 0; n < 2; ++n) _Pragma("unroll") for (int k = 0; k < 2; ++k) \
        acc[ai][bj][m][n] = __builtin_amdgcn_mfma_f32_16x16x32_bf16(Bt[n][k], At[m][k], acc[ai][bj][m][n], 0, 0, 0); __builtin_amdgcn_s_setprio(0); } while (0)
#define PG8_WAIT_V(n) asm volatile("s_waitcnt vmcnt(" #n ")" ::: "memory")
#define PG8_WAIT_L(n) asm volatile("s_waitcnt lgkmcnt(" #n ")" ::: "memory")
#define PG8_BAR __builtin_amdgcn_s_barrier()
#define PG8_SCHED __builtin_amdgcn_sched_barrier(0)
    Unit cur, nxt; int ui = 0;
    if (!S.next(0, cur)) return;
    f32x4 acc[2][2][4][2];
#pragma unroll
    for (int a = 0; a < 2; ++a)
#pragma unroll
        for (int b = 0; b < 2; ++b)
#pragma unroll
            for (int m = 0; m < 4; ++m)
#pragma unroll
                for (int n = 0; n < 2; ++n) acc[a][b][m][n] = (f32x4){0.f, 0.f, 0.f, 0.f};
    bf16x8 At[4][2], B0[2][2], B1[2][2];
    const char* cA = (const char*)g.A + (size_t)cur.pm * tstep; const char* cB = (const char*)g.Bt + (size_t)cur.pn * tstep;
    S.a_ready(cur);
    if constexpr (SP2) {
        PG8_STAGE(PG8_SB(0, 0), cB, voffB); PG8_STAGE(PG8_SB(0, 1), cB + hstep, voffB); PG8_STAGE(PG8_SA(0, 0), cA, voffA); PG8_STAGE(PG8_SA(0, 1), cA + hstep, voffA);
        if (wr == 1) PG8_BAR;
        PG8_WAIT_V(2); PG8_BAR;
        PG8_STAGE(PG8_SB(1, 0), cB + kstep, voffB); PG8_STAGE(PG8_SA(1, 0), cA + kstep, voffA); PG8_STAGE(PG8_SB(1, 1), cB + hstep + kstep, voffB);
        PG8_WAIT_V(6); PG8_BAR;
    } else {
        PG8_STAGE(PG8_SB(0, 0), cB, voffB); PG8_STAGE(PG8_SA(0, 0), cA, voffA); PG8_STAGE(PG8_SB(0, 1), cB + hstep, voffB); PG8_STAGE(PG8_SA(0, 1), cA + hstep, voffA);
        if (wr == 1) PG8_BAR;
        PG8_WAIT_V(4); PG8_BAR;
        PG8_STAGE(PG8_SB(1, 0), cB + kstep, voffB); PG8_STAGE(PG8_SA(1, 0), cA + kstep, voffA); PG8_STAGE(PG8_SB(1, 1), cB + hstep + kstep, voffB);
        PG8_WAIT_V(6); PG8_BAR;
    }
    for (;;) {
        const bool has_next = S.next(ui + 1, nxt);
        const char* nA = has_next ? (const char*)g.A + (size_t)nxt.pm * tstep : cA; const char* nB = has_next ? (const char*)g.Bt + (size_t)nxt.pn * tstep : cB;
        for (int t = 0; t < nt; t += 2) {
            const bool last = (t == nt - 2);
            const char* a1 = cA + (size_t)(t + 1) * kstep;
            const char* a2 = last ? nA : cA + (size_t)(t + 2) * kstep; const char* b2 = last ? nB : cB + (size_t)(t + 2) * kstep;
            const char* a3 = a2 + kstep; const char* b3 = b2 + kstep;
            if (last && has_next) S.a_ready(nxt);
            if constexpr (SP2) {
            PG8_LDB(B0, 0, 0); PG8_LDB(B1, 0, 1); PG8_SCHED; PG8_LDA(At, 0, 0); PG8_STAGE(PG8_SA(1, 1), a1 + hstep, voffA);
            PG8_WAIT_V(8); PG8_WAIT_L(0); PG8_BAR; PG8_MMA(0, 0, At, B0); PG8_MMA(0, 1, At, B1); PG8_BAR; PG8_SCHED;
            PG8_LDA(At, 0, 1); PG8_STAGE(PG8_SB(0, 0), b2, voffB); PG8_STAGE(PG8_SB(0, 1), b2 + hstep, voffB); PG8_STAGE(PG8_SA(0, 0), a2, voffA);
            PG8_WAIT_V(8); PG8_WAIT_L(0); PG8_BAR; PG8_MMA(1, 0, At, B0); PG8_MMA(1, 1, At, B1); PG8_BAR; PG8_SCHED;
            PG8_LDB(B0, 1, 0); PG8_LDB(B1, 1, 1); PG8_SCHED; PG8_LDA(At, 1, 0); PG8_STAGE(PG8_SA(0, 1), a2 + hstep, voffA);
            PG8_WAIT_V(8); PG8_WAIT_L(0); PG8_BAR; PG8_MMA(0, 0, At, B0); PG8_MMA(0, 1, At, B1); PG8_BAR; PG8_SCHED;
            PG8_LDA(At, 1, 1); PG8_STAGE(PG8_SB(1, 0), b3, voffB); PG8_STAGE(PG8_SB(1, 1), b3 + hstep, voffB); PG8_STAGE(PG8_SA(1, 0), a3, voffA);
            PG8_WAIT_V(8); PG8_WAIT_L(0); PG8_BAR; PG8_MMA(1, 0, At, B0); PG8_MMA(1, 1, At, B1); PG8_BAR; PG8_SCHED;
            } else {
            PG8_LDB(B0, 0, 0); PG8_SCHED; PG8_LDA(At, 0, 0); PG8_STAGE(PG8_SA(1, 1), a1 + hstep, voffA);
            PG8_WAIT_L(8); PG8_BAR; PG8_WAIT_L(0); PG8_MMA(0, 0, At, B0); PG8_BAR; PG8_SCHED;
            PG8_LDB(B1, 0, 1); PG8_STAGE(PG8_SB(0, 0), b2, voffB);
            PG8_BAR; PG8_WAIT_L(0); PG8_MMA(0, 1, At, B1); PG8_BAR;
            PG8_LDA(At, 0, 1); PG8_STAGE(PG8_SA(0, 0), a2, voffA);
            PG8_BAR; PG8_WAIT_L(0); PG8_MMA(1, 0, At, B0); PG8_BAR; PG8_SCHED;
            PG8_STAGE(PG8_SB(0, 1), b2 + hstep, voffB);
            PG8_WAIT_V(6); PG8_BAR; PG8_MMA(1, 1, At, B1); PG8_BAR;
            PG8_LDB(B0, 1, 0); PG8_SCHED; PG8_LDA(At, 1, 0); PG8_STAGE(PG8_SA(0, 1), a2 + hstep, voffA);
            PG8_WAIT_L(8); PG8_BAR; PG8_WAIT_L(0); PG8_MMA(0, 0, At, B0); PG8_BAR; PG8_SCHED;
            PG8_LDB(B1, 1, 1); PG8_STAGE(PG8_SB(1, 0), b3, voffB);
            PG8_BAR; PG8_WAIT_L(0); PG8_MMA(0, 1, At, B1); PG8_BAR;
            PG8_LDA(At, 1, 1); PG8_STAGE(PG8_SA(1, 0), a3, voffA);
            PG8_BAR; PG8_WAIT_L(0); PG8_MMA(1, 0, At, B0); PG8_BAR; PG8_SCHED;
            PG8_STAGE(PG8_SB(1, 1), b3 + hstep, voffB);
            PG8_WAIT_V(6); PG8_BAR; PG8_MMA(1, 1, At, B1); PG8_BAR;
            }
        }
        if constexpr (ALIGN_EPI) { if (wr == 0) PG8_BAR; }
        if constexpr (!Epi::AFTER_DRAIN) { E(acc, cur, wr, wc, fr, fq); S.done(cur); }
        if (!has_next) break;
#pragma unroll
        for (int a = 0; a < 2; ++a)
#pragma unroll
            for (int b = 0; b < 2; ++b)
#pragma unroll
                for (int m = 0; m < 4; ++m)
#pragma unroll
                    for (int n = 0; n < 2; ++n) acc[a][b][m][n] = (f32x4){0.f, 0.f, 0.f, 0.f};
        cur = nxt; cA = nA; cB = nB; ++ui;
        if constexpr (ALIGN_EPI) { if (wr == 1) PG8_BAR; }
    }
    PG8_WAIT_V(0);
    if constexpr (!ALIGN_EPI) { if (wr == 0) PG8_BAR; }
    PG8_BAR;
    if constexpr (Epi::AFTER_DRAIN) { E.fused(acc, cur, wr, wc, fr, fq, lds, wid, lane); S.done(cur); }
#undef PG8_SA
#undef PG8_SB
#undef PG8_STAGE
#undef PG8_LDA
#undef PG8_LDB
#undef PG8_MMA
#undef PG8_WAIT_V
#undef PG8_WAIT_L
#undef PG8_BAR
#undef PG8_SCHED
}
}

#ifndef PG8_SP2
#define PG8_SP2 true
#endif
#ifndef PG8_ALIGN
#define PG8_ALIGN true
#endif
namespace pg8 {
struct UnitG { int pm, pn, e, r0, nvalid; unsigned boff; };
struct GroupedOrder {
    const PG8_LAS int* tab; int nN, G, c; unsigned bstride;
    __device__ __forceinline__ bool next(int i, UnitG& u) const {
        const int Lx = i * G + c; const int total = __builtin_amdgcn_readfirstlane(tab[64]) * nN; if (Lx >= total) return false;
        int e = 0;
#pragma unroll 4
        for (int k = 1; k < 32; ++k) { const int s = __builtin_amdgcn_readfirstlane(tab[32 + k]) * nN; if (Lx >= s) e = k; }
        const int m0 = __builtin_amdgcn_readfirstlane(tab[32 + e]), m1 = __builtin_amdgcn_readfirstlane(tab[33 + e]), ce = __builtin_amdgcn_readfirstlane(tab[e]);
        const int idx = Lx - m0 * nN, mte = m1 - m0; const int pn = idx / mte, mtl = idx - pn * mte;
        u.pm = m0 + mtl; u.pn = pn; u.e = e; u.r0 = mtl * 256; u.nvalid = ce - mtl * 256; u.boff = (unsigned)e * bstride; return true;
    }
};
template <class Epi, bool GATHER>
__device__ __forceinline__ void gemm_phase_g(PG8_LAS unsigned char* lds, const Gemm g, const GroupedOrder& S, const Epi& E, const int* __restrict__ LIST) {
    const int tid = opaque_tid(), wid = __builtin_amdgcn_readfirstlane(tid >> 6), lane = tid & 63, wr = wid >> 2, wc = wid & 3, fr = lane & 15, fq = lane >> 4;
    const int K = g.K, nt = K / BK;
    unsigned voffB[2]; int RA[2], CA[2];
#pragma unroll
    for (int i = 0; i < 2; ++i) { int R, C; stage_rc(tid * 16 + i * 8192, R, C); const int Rb = Epi::PERM ? ((R & ~31) + perm32(R & 31)) : R;
        RA[i] = R; CA[i] = C; voffB[i] = (unsigned)(Rb * K + C) * 2u; }
    const size_t kstep = (size_t)(BK * 2);
    const size_t hstepB = (size_t)HALF * K * 2;
    const size_t tstepB = 2 * hstepB;
    const unsigned ldsw = (unsigned)wid * 1024u;
    const int aoff = lds_byte(wr * 64 + fr, fq * 8), boff = lds_byte(wc * 32 + fr, fq * 8);
#define PG8_SA(b, h) (((b) * 2 + (h)) * HTB)
#define PG8_SB(b, h) ((4 + (b) * 2 + (h)) * HTB)
#define PG8_STAGE(bufoff, gbase, voff) do { _Pragma("unroll") for (int _i = 0; _i < 2; ++_i) \
        __builtin_amdgcn_global_load_lds((const unsigned*)((const char*)(gbase) + (voff)[_i]), (PG8_LAS unsigned*)(lds + (bufoff) + ldsw + _i * 8192), 16, 0, 0); } while (0)
#define PG8_LDA(dst, b, h) do { _Pragma("unroll") for (int m = 0; m < 4; ++m) _Pragma("unroll") for (int k = 0; k < 2; ++k) dst[m][k] = *(const PG8_LAS bf16x8*)(lds + PG8_SA(b, h) + aoff + m * 2048 + k * 1024); } while (0)
#define PG8_LDB(dst, b, h) do { _Pragma("unroll") for (int n = 0; n < 2; ++n) _Pragma("unroll") for (int k = 0; k < 2; ++k) dst[n][k] = *(const PG8_LAS bf16x8*)(lds + PG8_SB(b, h) + boff + n * 2048 + k * 1024); } while (0)
#define PG8_MMA(ai, bj, At, Bt) do { __builtin_amdgcn_s_setprio(1); _Pragma("unroll") for (int m = 0; m < 4; ++m) _Pragma("unroll") for (int n = 0; n < 2; ++n) _Pragma("unroll") for (int k = 0; k < 2; ++k) \
        acc[ai][bj][m][n] = __builtin_amdgcn_mfma_f32_16x16x32_bf16(Bt[n][k], At[m][k], acc[ai][bj][m][n], 0, 0, 0); __builtin_amdgcn_s_setprio(0); } while (0)
#define PG8_WAIT_V(n) asm volatile("s_waitcnt vmcnt(" #n ")" ::: "memory")
#define PG8_WAIT_L(n) asm volatile("s_waitcnt lgkmcnt(" #n ")" ::: "memory")
#define PG8_BAR __builtin_amdgcn_s_barrier()
#define PG8_SCHED __builtin_amdgcn_sched_barrier(0)
#define PG8_AOFF(u, vo) do { _Pragma("unroll") for (int _h = 0; _h < 2; ++_h) _Pragma("unroll") for (int _i = 0; _i < 2; ++_i) { const int _r = _h * HALF + RA[_i]; int _row; \
        if (GATHER) { _row = 0; if (_r < (u).nvalid) _row = LIST[(u).e * 8192 + (u).r0 + _r] >> 1; } else _row = (u).pm * BM + _r; \
        (vo)[_h][_i] = (unsigned)(_row * K + CA[_i]) * 2u; } } while (0)
    UnitG cur, nxt; int ui = 0;
    if (!S.next(0, cur)) return;
    f32x4 acc[2][2][4][2];
#pragma unroll
    for (int a = 0; a < 2; ++a)
#pragma unroll
        for (int b = 0; b < 2; ++b)
#pragma unroll
            for (int m = 0; m < 4; ++m)
#pragma unroll
                for (int n = 0; n < 2; ++n) acc[a][b][m][n] = (f32x4){0.f, 0.f, 0.f, 0.f};
    bf16x8 At[4][2], B0[2][2], B1[2][2];
    unsigned vA[2][2], vN[2][2];
    PG8_AOFF(cur, vA);
    const char* gA = (const char*)g.A;
    const char* cB = (const char*)g.Bt + cur.boff + (size_t)cur.pn * tstepB;
    PG8_STAGE(PG8_SB(0, 0), cB, voffB); PG8_STAGE(PG8_SB(0, 1), cB + hstepB, voffB); PG8_STAGE(PG8_SA(0, 0), gA, vA[0]); PG8_STAGE(PG8_SA(0, 1), gA, vA[1]);
    if (wr == 1) PG8_BAR;
    PG8_WAIT_V(2); PG8_BAR;
    PG8_STAGE(PG8_SB(1, 0), cB + kstep, voffB); PG8_STAGE(PG8_SA(1, 0), gA + kstep, vA[0]); PG8_STAGE(PG8_SB(1, 1), cB + hstepB + kstep, voffB);
    PG8_WAIT_V(6); PG8_BAR;
    for (;;) {
        const bool has_next = S.next(ui + 1, nxt);
        if (has_next) { PG8_AOFF(nxt, vN); } else {
#pragma unroll
            for (int _h = 0; _h < 2; ++_h)
#pragma unroll
                for (int _i = 0; _i < 2; ++_i) vN[_h][_i] = vA[_h][_i]; }
        const char* nB = has_next ? (const char*)g.Bt + nxt.boff + (size_t)nxt.pn * tstepB : cB;
        for (int t = 0; t < nt; t += 2) {
            const bool last = (t == nt - 2);
            const char* a1 = gA + (size_t)(t + 1) * kstep;
            const char* a2 = last ? gA : gA + (size_t)(t + 2) * kstep; const char* b2 = last ? nB : cB + (size_t)(t + 2) * kstep;
            const char* a3 = a2 + kstep; const char* b3 = b2 + kstep;
            unsigned v2a[2], v2b[2];
#pragma unroll
            for (int _i = 0; _i < 2; ++_i) { v2a[_i] = last ? vN[0][_i] : vA[0][_i]; v2b[_i] = last ? vN[1][_i] : vA[1][_i]; }
            PG8_LDB(B0, 0, 0); PG8_LDB(B1, 0, 1); PG8_SCHED; PG8_LDA(At, 0, 0); PG8_STAGE(PG8_SA(1, 1), a1, vA[1]);
            PG8_WAIT_V(8); PG8_WAIT_L(0); PG8_BAR; PG8_MMA(0, 0, At, B0); PG8_MMA(0, 1, At, B1); PG8_BAR; PG8_SCHED;
            PG8_LDA(At, 0, 1); PG8_STAGE(PG8_SB(0, 0), b2, voffB); PG8_STAGE(PG8_SB(0, 1), b2 + hstepB, voffB); PG8_STAGE(PG8_SA(0, 0), a2, v2a);
            PG8_WAIT_V(8); PG8_WAIT_L(0); PG8_BAR; PG8_MMA(1, 0, At, B0); PG8_MMA(1, 1, At, B1); PG8_BAR; PG8_SCHED;
            PG8_LDB(B0, 1, 0); PG8_LDB(B1, 1, 1); PG8_SCHED; PG8_LDA(At, 1, 0); PG8_STAGE(PG8_SA(0, 1), a2, v2b);
            PG8_WAIT_V(8); PG8_WAIT_L(0); PG8_BAR; PG8_MMA(0, 0, At, B0); PG8_MMA(0, 1, At, B1); PG8_BAR; PG8_SCHED;
            PG8_LDA(At, 1, 1); PG8_STAGE(PG8_SB(1, 0), b3, voffB); PG8_STAGE(PG8_SB(1, 1), b3 + hstepB, voffB); PG8_STAGE(PG8_SA(1, 0), a3, v2a);
            PG8_WAIT_V(8); PG8_WAIT_L(0); PG8_BAR; PG8_MMA(1, 0, At, B0); PG8_MMA(1, 1, At, B1); PG8_BAR; PG8_SCHED;
        }
        if (wr == 0) PG8_BAR;
        E(acc, cur, wr, wc, fr, fq);
        if (!has_next) break;
#pragma unroll
        for (int a = 0; a < 2; ++a)
#pragma unroll
            for (int b = 0; b < 2; ++b)
#pragma unroll
                for (int m = 0; m < 4; ++m)
#pragma unroll
                    for (int n = 0; n < 2; ++n) acc[a][b][m][n] = (f32x4){0.f, 0.f, 0.f, 0.f};
        cur = nxt; cB = nB; ++ui;
#pragma unroll
        for (int _h = 0; _h < 2; ++_h)
#pragma unroll
            for (int _i = 0; _i < 2; ++_i) vA[_h][_i] = vN[_h][_i];
        if (wr == 1) PG8_BAR;
    }
    PG8_WAIT_V(0);
    PG8_BAR;
#undef PG8_AOFF
#undef PG8_SA
#undef PG8_SB
#undef PG8_STAGE
#undef PG8_LDA
#undef PG8_LDB
#undef PG8_MMA
#undef PG8_WAIT_V
#undef PG8_WAIT_L
#undef PG8_BAR
#undef PG8_SCHED
}
__device__ __forceinline__ float silu_f(float a) { return a * __builtin_amdgcn_rcpf(1.f + __builtin_amdgcn_exp2f(-1.4426950408889634f * a)); }
struct EpiMoe1 {
    static constexpr bool PERM = true, AFTER_DRAIN = false;
    bf16_t* HB; const int* LIST; const float* GATEW;
    __device__ __forceinline__ void operator()(const f32x4 (&acc)[2][2][4][2], const UnitG& u, int wr, int wc, int fr, int fq) const {
#pragma unroll
        for (int ai = 0; ai < 2; ++ai)
#pragma unroll
            for (int m = 0; m < 4; ++m) { const int r = ai * HALF + wr * 64 + m * 16 + fr;
                float gate = 0.f; if (r < u.nvalid) gate = GATEW[LIST[u.e * 8192 + u.r0 + r]];
                bf16_t* rowp = HB + (size_t)(u.pm * BM + r) * 512 + u.pn * 128 + wc * 32 + 8 * fq;
                const f32x4 a0 = acc[ai][0][m][0], a1 = acc[ai][0][m][1], b0 = acc[ai][1][m][0], b1 = acc[ai][1][m][1];
                f32x4 h0, h1;
#pragma unroll
                for (int j = 0; j < 4; ++j) { h0[j] = silu_f(a0[j]) * b0[j] * gate; h1[j] = silu_f(a1[j]) * b1[j] * gate; }
                u32x4 w; w.x = cvt_pk_bf16(h0[0], h0[1]); w.y = cvt_pk_bf16(h0[2], h0[3]); w.z = cvt_pk_bf16(h1[0], h1[1]); w.w = cvt_pk_bf16(h1[2], h1[3]);
                *(u32x4*)rowp = w; }
    }
};
struct EpiMoe2 {
    static constexpr bool PERM = true, AFTER_DRAIN = false;
    bf16_t* YS; const int* LIST;
    __device__ __forceinline__ void operator()(const f32x4 (&acc)[2][2][4][2], const UnitG& u, int wr, int wc, int fr, int fq) const {
#pragma unroll
        for (int ai = 0; ai < 2; ++ai)
#pragma unroll
            for (int m = 0; m < 4; ++m) { const int r = ai * HALF + wr * 64 + m * 16 + fr;
                if (r < u.nvalid) { const int idx = LIST[u.e * 8192 + u.r0 + r];
                    bf16_t* rowp = YS + (size_t)idx * 2048 + u.pn * BM + wc * 32 + 8 * fq;
#pragma unroll
                    for (int bj = 0; bj < 2; ++bj) { const f32x4 v0 = acc[ai][bj][m][0], v1 = acc[ai][bj][m][1];
                        u32x4 w; w.x = cvt_pk_bf16(v0[0], v0[1]); w.y = cvt_pk_bf16(v0[2], v0[3]); w.z = cvt_pk_bf16(v1[0], v1[1]); w.w = cvt_pk_bf16(v1[2], v1[3]);
                        *(u32x4*)(rowp + bj * HALF) = w; } } }
    }
};
}
#include <hip/hip_bf16.h>
#include <cmath>
namespace attn_body {
using bf16=__hip_bfloat16;
using bf16x8=__attribute__((ext_vector_type(8)))short;
using s16x4=__attribute__((ext_vector_type(4)))short;
using f32x16=__attribute__((ext_vector_type(16)))float;
using u32x4=__attribute__((ext_vector_type(4)))unsigned;
constexpr int SEQ=2048,D=64,DM=5120;
constexpr int NW=8,QBLK=32,QB=QBLK*NW,KVBLK=64,NQB=SEQ/QB;
constexpr int ATTN_UNIT_ROWS=QB;
__device__ __forceinline__ int crow(int r,int hi){return (r&3)+8*(r>>2)+4*hi;}
#define SBAR() __builtin_amdgcn_sched_barrier(0)
__device__ __forceinline__ void cmask(f32x16&p0,f32x16&p1,int jb,int qrel,int hi){
  const float NEG=-INFINITY; int kb=64*jb+4*hi;
  #pragma unroll
  for(int r=0;r<16;++r){int kv=kb+(r&3)+8*(r>>2); if(kv>qrel)p0[r]=NEG; if(kv+32>qrel)p1[r]=NEG;}
}

constexpr int NSLOT=3, SLOTB=8192;
constexpr int LDS_K=0, LDS_V=NSLOT*SLOTB, LDS_WS=2*NSLOT*SLOTB, LDS_OST=LDS_WS+NW*64*4, LDS_BYTES=LDS_OST+NW*4096;
constexpr float C2=0.125f*1.4426950408889634f;
__device__ __forceinline__ void glds16(const void*gsrc,unsigned lds_dst){unsigned keep;
  asm volatile("s_mov_b32 %0, m0\n\ts_mov_b32 m0, %2\n\ts_nop 0\n\tglobal_load_lds_dwordx4 %1, off\n\ts_mov_b32 m0, %0":"=&s"(keep):"v"(gsrc),"s"(lds_dst):"memory");}
__device__ __forceinline__ float max3f(float a,float b,float c){float r;asm("v_max3_f32 %0, %1, %2, %3":"=v"(r):"v"(a),"v"(b),"v"(c));return r;}
__device__ __forceinline__ float max2f(float a,float b){float r;asm("v_max_f32_e32 %0, %1, %2":"=v"(r):"v"(a),"v"(b));return r;}
__device__ __forceinline__ float fadd_s(float a,float b){float r;asm("v_add_f32_e32 %0, %1, %2":"=v"(r):"v"(a),"v"(b));return r;}
__device__ __forceinline__ float fsub_s(float a,float b){float r;asm("v_sub_f32_e32 %0, %1, %2":"=v"(r):"v"(a),"v"(b));return r;}
typedef float f32x2_t __attribute__((ext_vector_type(2))); typedef __bf16 bf16x2_t __attribute__((ext_vector_type(2)));
__device__ __forceinline__ unsigned cvtpk_s(float lo,float hi){f32x2_t v={lo,hi};bf16x2_t b=__builtin_convertvector(v,bf16x2_t);return __builtin_bit_cast(unsigned,b);}
#define WAIT_BAR(N) asm volatile("s_waitcnt vmcnt(" #N ") lgkmcnt(0)\n\ts_barrier":::"memory")

__device__ __forceinline__ void qkt(f32x16&p0,f32x16&p1,const char*Kslot,const bf16x8*qr,const f32x16&negm,int r32,int hi){
  const char*kb=Kslot+hi*1024+r32*16;
  #pragma unroll
  for(int d0=0;d0<4;++d0){
    const bf16x8 b0=*reinterpret_cast<const bf16x8*>(kb+d0*2048);
    const bf16x8 b1=*reinterpret_cast<const bf16x8*>(kb+d0*2048+512);
    if(d0==0){p0=__builtin_amdgcn_mfma_f32_32x32x16_bf16(b0,qr[0],negm,0,0,0);p1=__builtin_amdgcn_mfma_f32_32x32x16_bf16(b1,qr[0],negm,0,0,0);}
    else{p0=__builtin_amdgcn_mfma_f32_32x32x16_bf16(b0,qr[d0],p0,0,0,0);p1=__builtin_amdgcn_mfma_f32_32x32x16_bf16(b1,qr[d0],p1,0,0,0);}}
}
typedef __attribute__((address_space(3))) const char* lds_cptr;
typedef short v4i16_t __attribute__((ext_vector_type(4)));
__device__ __forceinline__ void kload8(bf16x8*kf,lds_cptr kp){
  kf[0]=*(const __attribute__((address_space(3))) bf16x8*)(kp);      kf[1]=*(const __attribute__((address_space(3))) bf16x8*)(kp+512);
  kf[2]=*(const __attribute__((address_space(3))) bf16x8*)(kp+2048); kf[3]=*(const __attribute__((address_space(3))) bf16x8*)(kp+2560);
  kf[4]=*(const __attribute__((address_space(3))) bf16x8*)(kp+4096); kf[5]=*(const __attribute__((address_space(3))) bf16x8*)(kp+4608);
  kf[6]=*(const __attribute__((address_space(3))) bf16x8*)(kp+6144); kf[7]=*(const __attribute__((address_space(3))) bf16x8*)(kp+6656);
}
__device__ __forceinline__ void kload2(bf16x8*kf,lds_cptr kp,int j){ kf[2*j]=*(const __attribute__((address_space(3))) bf16x8*)(kp+j*2048); kf[2*j+1]=*(const __attribute__((address_space(3))) bf16x8*)(kp+j*2048+512); }
__device__ __forceinline__ s16x4 vtr(lds_cptr p){ return __builtin_bit_cast(s16x4,__builtin_amdgcn_ds_read_tr16_b64_v4i16((__attribute__((address_space(3))) v4i16_t*)p)); }
__device__ __forceinline__ float rowmax(const f32x16&p0,const f32x16&p1){
  float a=max3f(p0[0],p0[1],p1[0]),b=max3f(p0[2],p0[3],p1[1]);a=max3f(a,p1[2],p1[3]);
  #pragma unroll
  for(int r=4;r<16;r+=4){a=max3f(a,p0[r],p0[r+1]);b=max3f(b,p0[r+2],p0[r+3]);a=max3f(a,p1[r],p1[r+1]);b=max3f(b,p1[r+2],p1[r+3]);}
  const float m=max2f(a,b);
  auto rr=__builtin_amdgcn_permlane32_swap(__float_as_uint(m),__float_as_uint(m),false,false);
  return max2f(__uint_as_float(rr[0]),__uint_as_float(rr[1]));
}
__device__ __forceinline__ void pv(f32x16*o,int vb,bf16x8 pa0,bf16x8 pa1,bf16x8 pa2,bf16x8 pa3){
  #pragma unroll
  for(int d0=0;d0<2;++d0){s16x4 lo[4],hi[4];
    #pragma unroll
    for(int ks=0;ks<4;++ks){
      asm volatile("ds_read_b64_tr_b16 %0,%1 offset:%c2":"=&v"(lo[ks]):"v"(vb),"i"(d0*4096+ks*1024):"memory");
      asm volatile("ds_read_b64_tr_b16 %0,%1 offset:%c2":"=&v"(hi[ks]):"v"(vb),"i"(d0*4096+ks*1024+512):"memory");}
    asm volatile("s_waitcnt lgkmcnt(0)":::"memory");SBAR();
    #define PK(k) (bf16x8){lo[k][0],lo[k][1],lo[k][2],lo[k][3],hi[k][0],hi[k][1],hi[k][2],hi[k][3]}
    o[d0]=__builtin_amdgcn_mfma_f32_32x32x16_bf16(pa0,PK(0),o[d0],0,0,0);
    o[d0]=__builtin_amdgcn_mfma_f32_32x32x16_bf16(pa1,PK(1),o[d0],0,0,0);
    o[d0]=__builtin_amdgcn_mfma_f32_32x32x16_bf16(pa2,PK(2),o[d0],0,0,0);
    o[d0]=__builtin_amdgcn_mfma_f32_32x32x16_bf16(pa3,PK(3),o[d0],0,0,0);
    #undef PK
  }
}

#ifndef ATTN_STORE16
#define ATTN_STORE16(p,v) (*(u32x4*)(p)=(v))
#endif
template<int THRL> __device__ __forceinline__ void attn_unit(int b,int qb,const bf16*Q,const bf16*__restrict__ K,const bf16*__restrict__ V,bf16*O,int opitch,char*shm){
  const int tid=opaque_tid(),lane=tid&63,r32=lane&31,hi=lane>>5; const int wid=__builtin_amdgcn_readfirstlane(tid>>6);
  const long rowbase=(long)b*SEQ; const int q0=qb*QB;
  const bf16*Qw=Q+(rowbase+q0+wid*QBLK)*DM;
  const bf16*Kh=K+rowbase*DM,*Vh=V+rowbase*DM;
  const unsigned lds0=(unsigned)(uintptr_t)shm;
  float*wsf=(float*)(shm+LDS_WS)+wid*64;
  const bf16*ksrc=Kh+(long)lane*DM+wid*8;
  const bf16*vsrc=Vh+(long)(16*(wid&3)+(lane>>2))*DM+(wid>>2)*32+(lane&3)*8;
  const unsigned kdst=lds0+LDS_K+wid*1024, vdst=lds0+LDS_V+wid*1024;
  #define DMA_K(t,slot) glds16(ksrc+(long)(t)*KVBLK*DM,(unsigned)__builtin_amdgcn_readfirstlane(kdst+(slot)))
  #define DMA_V(t,slot) glds16(vsrc+(long)(t)*KVBLK*DM,(unsigned)__builtin_amdgcn_readfirstlane(vdst+(slot)))
  const int vb0=(int)(lds0+LDS_V)+((lane>>4)&1)*32+(lane&3)*8+(4*hi+((lane&15)>>2))*64;
  const char*Kbase=shm+LDS_K; bf16x8 kf[8];
  const lds_cptr shm3=(lds_cptr)shm; const lds_cptr kp0=shm3+LDS_K+hi*1024+r32*16; const lds_cptr vp0=shm3+LDS_V+((lane>>4)&1)*32+(lane&3)*8+(4*hi+((lane&15)>>2))*64;
  const int NT=(q0+QB)/KVBLK;
  DMA_K(0,0);DMA_V(0,0);DMA_K(1,SLOTB);
  bf16x8 qr[4];
  #pragma unroll
  for(int d0=0;d0<4;++d0)qr[d0]=*reinterpret_cast<const bf16x8*>(&Qw[(long)r32*DM+d0*16+hi*8]);
  float mhat=0.f,l_reg=0.f;f32x16 o[2];o[0]=f32x16{};o[1]=f32x16{};f32x16 negm=f32x16{};asm volatile("":"+v"(negm));
  const int qrel=wid*QBLK+r32;
  #define CMASK(P0,P1,t) do{int jb_=(t)-(NT-4); if(jb_>=0)cmask(P0,P1,jb_,qrel,hi);}while(0)
  bool resc=false;
  #define START(P0,P1) do{ const float rm=rowmax(P0,P1); resc=false; \
    { const float dl=rm; mhat=fadd_s(mhat,dl); \
      _Pragma("unroll") for(int r=0;r<16;++r){P0[r]=fsub_s(P0[r],dl);P1[r]=fsub_s(P1[r],dl);} \
      _Pragma("unroll") for(int r=0;r<16;++r)negm[r]=-mhat; asm volatile("":"+v"(negm)); } \
    _Pragma("unroll") for(int r=0;r<16;++r)P0[r]=__builtin_amdgcn_exp2f(P0[r]); }while(0)
  #define RESC() do{ if(resc){ asm volatile("s_waitcnt lgkmcnt(0)":::"memory"); \
      _Pragma("unroll") for(int d_=0;d_<2;++d_) _Pragma("unroll") for(int r=0;r<16;++r)o[d_][r]*=wsf[crow(r,hi)]; } }while(0)
  f32x16 pA0,pA1,pB0,pB1;
  int sl_prev=0,sl_cur=0,sl_next=SLOTB;
  #define ROT() do{sl_prev=sl_cur;sl_cur=sl_next;sl_next=(sl_next==(NSLOT-1)*SLOTB)?0:sl_next+SLOTB;}while(0)
  DMA_K(2,2*SLOTB);
  WAIT_BAR(3);
  qkt(pA0,pA1,Kbase,qr,negm,r32,hi);asm volatile("s_nop 15\n\ts_nop 7":"+v"(pA0),"+v"(pA1));CMASK(pA0,pA1,0);
  START(pA0,pA1);
  _Pragma("unroll") for(int r=0;r<16;++r)pA1[r]=__builtin_amdgcn_exp2f(pA1[r]);
  WAIT_BAR(0);
  DMA_K(3,0);DMA_V(1,SLOTB);
  ROT();
  kload8(kf,kp0+sl_cur);
  WAIT_BAR(2);
  s16x4 vlo[8],vhi[8]; u32x4 pw0,pw1,pw2,pw3;
  #define PKW(P,B) cvtpk_s(P[B],P[B+1])
  #define PAF(k) __builtin_bit_cast(bf16x8,pw##k)
  #define VFR(i) (bf16x8){vlo[i][0],vlo[i][1],vlo[i][2],vlo[i][3],vhi[i][0],vhi[i][1],vhi[i][2],vhi[i][3]}
  #define PIN(x) asm volatile("":"+v"(x))
  #define MX3(a,b,c) __builtin_fmaxf(__builtin_fmaxf((a),(b)),(c))
  #define GAPA(MF,A0,A1,A2,A3,W0,W1,PW) do{ MF; sacc+=A0; sacc+=A1; sacc+=A2; sacc+=A3; PIN(sacc); W0; W1; PIN(PW); SBAR(); }while(0)
  #define EX(v) __builtin_amdgcn_exp2f(v)
  #define GAPB(MF,X,B) do{ MF; X[B]=EX(X[B]); X[B+1]=EX(X[B+1]); X[B+2]=EX(X[B+2]); X[B+3]=EX(X[B+3]); PIN(X); SBAR(); }while(0)
  #define VRD(i) do{ vlo[i]=vtr(vp_+(((i)>>2)*4096+((i)&3)*1024)); vhi[i]=vtr(vp_+(((i)>>2)*4096+((i)&3)*1024+512)); }while(0)
  #define KRD(G,j) do{ if(G){ kload2(kf,kp0+sl_next,j); SBAR(); } }while(0)
  #define STEP(C0,C1,P0,P1,t,GK,GV,GL) do{ SBAR(); \
    const lds_cptr vp_=vp0+sl_prev; \
    VRD(0); SBAR(); float sacc=(P0[0]+P0[1]); \
    GAPA(C0=__builtin_amdgcn_mfma_f32_32x32x16_bf16(kf[0],qr[0],negm,0,0,0), P0[2],P0[3],P0[4],P0[5],     pw0[0]=PKW(P0,0), pw0[1]=PKW(P0,2), pw0); \
    VRD(4); SBAR(); GAPA(C1=__builtin_amdgcn_mfma_f32_32x32x16_bf16(kf[1],qr[0],negm,0,0,0), P0[6],P0[7],P0[8],P0[9],     pw0[2]=PKW(P0,4), pw0[3]=PKW(P0,6), pw0); \
    VRD(1); SBAR(); GAPA(C0=__builtin_amdgcn_mfma_f32_32x32x16_bf16(kf[2],qr[1],C0,0,0,0),   P0[10],P0[11],P0[12],P0[13], pw1[0]=PKW(P0,8), pw1[1]=PKW(P0,10), pw1); \
    VRD(5); SBAR(); GAPA(C1=__builtin_amdgcn_mfma_f32_32x32x16_bf16(kf[3],qr[1],C1,0,0,0),   P0[14],P0[15],P1[0],P1[1],   pw1[2]=PKW(P0,12),pw1[3]=PKW(P0,14), pw1); \
    VRD(2); SBAR(); GAPA(C0=__builtin_amdgcn_mfma_f32_32x32x16_bf16(kf[4],qr[2],C0,0,0,0),   P1[2],P1[3],P1[4],P1[5],     pw2[0]=PKW(P1,0), pw2[1]=PKW(P1,2), pw2); \
    VRD(6); SBAR(); GAPA(C1=__builtin_amdgcn_mfma_f32_32x32x16_bf16(kf[5],qr[2],C1,0,0,0),   P1[6],P1[7],P1[8],P1[9],     pw2[2]=PKW(P1,4), pw2[3]=PKW(P1,6), pw2); \
    VRD(3); SBAR(); GAPA(C0=__builtin_amdgcn_mfma_f32_32x32x16_bf16(kf[6],qr[3],C0,0,0,0),   P1[10],P1[11],P1[12],P1[13], pw3[0]=PKW(P1,8), pw3[1]=PKW(P1,10), pw3); \
    VRD(7); SBAR(); GAPA(C1=__builtin_amdgcn_mfma_f32_32x32x16_bf16(kf[7],qr[3],C1,0,0,0),   P1[14],P1[15],0.f,0.f,       pw3[2]=PKW(P1,12),pw3[3]=PKW(P1,14), pw3); \
    l_reg+=sacc; \
    if(GK){DMA_K((t)+3,sl_cur);} if(GV){DMA_V((t)+1,sl_next);} \
    CMASK(C0,C1,t); \
    { float a=MX3(C0[0],C0[1],C1[0]),b=MX3(C0[2],C0[3],C1[1]); a=MX3(a,C1[2],C1[3]); \
      _Pragma("unroll") for(int r=4;r<16;r+=4){a=MX3(a,C0[r],C0[r+1]);b=MX3(b,C0[r+2],C0[r+3]);a=MX3(a,C1[r],C1[r+1]);b=MX3(b,C1[r+2],C1[r+3]);} \
      float rm=__builtin_fmaxf(a,b); { auto rr=__builtin_amdgcn_permlane32_swap(__float_as_uint(rm),__float_as_uint(rm),false,false); rm=__builtin_fmaxf(__uint_as_float(rr[0]),__uint_as_float(rr[1])); } \
      resc=false; \
      if(__builtin_expect(__any(rm>(float)THRL),0)){ const float dl=__builtin_fmaxf(rm,0.f); mhat+=dl; \
        _Pragma("unroll") for(int r=0;r<16;++r){C0[r]-=dl;C1[r]-=dl;} \
        _Pragma("unroll") for(int r=0;r<16;++r)negm[r]=-mhat; asm volatile("":"+v"(negm)); \
        const float f=__builtin_amdgcn_exp2f(-dl); l_reg*=f; if(hi==0)wsf[r32]=f; resc=true; } } \
    SBAR(); \
    GAPB(o[0]=__builtin_amdgcn_mfma_f32_32x32x16_bf16(PAF(0),VFR(0),o[0],0,0,0), C0,0); \
    GAPB(o[1]=__builtin_amdgcn_mfma_f32_32x32x16_bf16(PAF(0),VFR(4),o[1],0,0,0), C0,4); \
    KRD(GL,0); GAPB(o[0]=__builtin_amdgcn_mfma_f32_32x32x16_bf16(PAF(1),VFR(1),o[0],0,0,0), C0,8); \
    KRD(GL,1); GAPB(o[1]=__builtin_amdgcn_mfma_f32_32x32x16_bf16(PAF(1),VFR(5),o[1],0,0,0), C0,12); \
    KRD(GL,2); GAPB(o[0]=__builtin_amdgcn_mfma_f32_32x32x16_bf16(PAF(2),VFR(2),o[0],0,0,0), C1,0); \
    KRD(GL,3); GAPB(o[1]=__builtin_amdgcn_mfma_f32_32x32x16_bf16(PAF(2),VFR(6),o[1],0,0,0), C1,4); \
    GAPB(o[0]=__builtin_amdgcn_mfma_f32_32x32x16_bf16(PAF(3),VFR(3),o[0],0,0,0), C1,8); \
    GAPB(o[1]=__builtin_amdgcn_mfma_f32_32x32x16_bf16(PAF(3),VFR(7),o[1],0,0,0), C1,12); \
    }while(0)
  int t=1;
  #undef CMASK
  #define CMASK(P0,P1,t) do{}while(0)
  for(;t+5<NT;t+=2){
    STEP(pB0,pB1,pA0,pA1,t,true,true,true);     WAIT_BAR(2); RESC(); ROT();
    STEP(pA0,pA1,pB0,pB1,t+1,true,true,true);   WAIT_BAR(2); RESC(); ROT();
  }
  #undef CMASK
  #define CMASK(P0,P1,t) do{int jb_=(t)-(NT-4); if(jb_>=0)cmask(P0,P1,jb_,qrel,hi);}while(0)
  #define ENDW(tt) do{ if((tt)+3<NT){WAIT_BAR(2);} else if((tt)+2<NT){WAIT_BAR(1);} else {WAIT_BAR(0);} }while(0)
  for(;t+1<NT;t+=2){
    STEP(pB0,pB1,pA0,pA1,t,(t+3<NT),(t+1<NT),(t+1<NT));       ENDW(t);   RESC(); ROT();
    STEP(pA0,pA1,pB0,pB1,t+1,(t+4<NT),(t+2<NT),(t+2<NT));     ENDW(t+1); RESC(); ROT();
  }
  STEP(pB0,pB1,pA0,pA1,NT-1,false,false,false); RESC();
  { float sacc=pB0[0]+pB0[1]; _Pragma("unroll") for(int r=2;r<16;++r)sacc+=pB0[r]; _Pragma("unroll") for(int r=0;r<16;++r)sacc+=pB1[r]; l_reg+=sacc;
    pw0=(u32x4){PKW(pB0,0),PKW(pB0,2),PKW(pB0,4),PKW(pB0,6)};pw1=(u32x4){PKW(pB0,8),PKW(pB0,10),PKW(pB0,12),PKW(pB0,14)};pw2=(u32x4){PKW(pB1,0),PKW(pB1,2),PKW(pB1,4),PKW(pB1,6)};pw3=(u32x4){PKW(pB1,8),PKW(pB1,10),PKW(pB1,12),PKW(pB1,14)};
    SBAR(); pv(o,vb0+sl_cur,PAF(0),PAF(1),PAF(2),PAF(3)); }
  #undef PKW
  #undef PAF
  #undef VFR
  #undef PIN
  #undef MX3
  #undef GAPA
  #undef GAPB
  #undef EX
  #undef VRD
  #undef KRD
  #undef STEP
  #undef ENDW
  {auto rr=__builtin_amdgcn_permlane32_swap(__float_as_uint(l_reg),__float_as_uint(l_reg),false,false);l_reg=__uint_as_float(rr[0])+__uint_as_float(rr[1]);}
  if(hi==0)wsf[32+r32]=l_reg;asm volatile("s_waitcnt lgkmcnt(0)":::"memory");
  float rli[16];
  #pragma unroll
  for(int r=0;r<16;++r)rli[r]=__builtin_amdgcn_rcpf(wsf[32+crow(r,hi)]);
  bf16*Ow=O+(rowbase+q0+wid*QBLK)*opitch;
  { bf16*stg=(bf16*)(shm+LDS_OST)+wid*2048;
    #pragma unroll
    for(int r=0;r<16;++r){const int orow=crow(r,hi);
      #pragma unroll
      for(int d0=0;d0<2;++d0)stg[orow*64+d0*32+r32]=__float2bfloat16(o[d0][r]*rli[r]);}
    asm volatile("s_waitcnt lgkmcnt(0)":::"memory");
    #pragma unroll
    for(int i=0;i<4;++i){const int row=i*8+(lane>>3),ch=lane&7; const u32x4 v=*(const u32x4*)(stg+row*64+ch*8); ATTN_STORE16(Ow+(long)row*opitch+ch*8,v);} }
  asm volatile("s_waitcnt lgkmcnt(0)\n\ts_barrier":::"memory");
  #undef DMA_K
  #undef DMA_V
  #undef CMASK
  #undef START
  #undef RESC
  #undef ROT
}

__device__ __forceinline__ void sb_unit(int b,int qb,const bf16*Q,const bf16*__restrict__ K,const bf16*__restrict__ V,bf16*O,int opitch,char*shm){
  const int tid=opaque_tid(),lane=tid&63,r32=lane&31,hi=lane>>5; const int wid=__builtin_amdgcn_readfirstlane(tid>>6);
  const long rowbase=(long)b*SEQ; const int q0=qb*QB;
  const bf16*Qw=Q+(rowbase+q0+wid*QBLK)*DM;
  const bf16*Kh=K+rowbase*DM,*Vh=V+rowbase*DM;
  const unsigned lds0=(unsigned)(uintptr_t)shm;
  const bf16*ksrc=Kh+(long)lane*DM+wid*8;
  const bf16*vsrc=Vh+(long)(16*(wid&3)+(lane>>2))*DM+(wid>>2)*32+(lane&3)*8;
  const unsigned kdst=lds0+LDS_K+wid*1024, vdst=lds0+LDS_V+wid*1024;
  #define DMA_K(t,slot) glds16(ksrc+(long)(t)*KVBLK*DM,(unsigned)__builtin_amdgcn_readfirstlane(kdst+(slot)))
  #define DMA_V(t,slot) glds16(vsrc+(long)(t)*KVBLK*DM,(unsigned)__builtin_amdgcn_readfirstlane(vdst+(slot)))
  const int vb0=(int)(lds0+LDS_V)+((lane>>4)&1)*32+(lane&3)*8+(4*hi+((lane&15)>>2))*64;
  const char*Kbase=shm+LDS_K;
  const int NT=(q0+QB)/KVBLK;
  int j=NT-1;
  DMA_K(j,(j&1)*SLOTB);DMA_V(j,(j&1)*SLOTB);
  bf16x8 qr[4];
  #pragma unroll
  for(int d0=0;d0<4;++d0)qr[d0]=*reinterpret_cast<const bf16x8*>(&Qw[(long)r32*DM+d0*16+hi*8]);
  f32x16 o[2];o[0]=f32x16{};o[1]=f32x16{};
  float R=0.f;
  const int trow=q0+wid*QBLK+r32;
  const int wmax=q0+wid*QBLK+QBLK-1;
  const float selhi=(hi==0)?1.f:0.f;
  #pragma unroll 1
  for(;j>=0;--j){
    WAIT_BAR(0);
    if(j>0){DMA_K(j-1,((j-1)&1)*SLOTB);DMA_V(j-1,((j-1)&1)*SLOTB);}
    const int slot=(j&1)*SLOTB;
    if(64*j<wmax){
      f32x16 p0,p1; const f32x16 zero=f32x16{};
      qkt(p0,p1,Kbase+slot,qr,zero,r32,hi);
      const int thr=trow-64*j-4*hi;
      f32x16 l0,l1;
      #pragma unroll
      for(int r=0;r<16;++r){
        { const float z=p0[r]; const float lg=__builtin_amdgcn_logf(1.f+__builtin_amdgcn_exp2f(-__builtin_fabsf(z))); const float sp=__builtin_fmaxf(-z,0.f)+lg;
          const bool ok=((r&3)+8*(r>>2))<thr; l0[r]=ok?-(sp+z):0.f; p0[r]=ok?-sp:-INFINITY; }
        { const float z=p1[r]; const float lg=__builtin_amdgcn_logf(1.f+__builtin_amdgcn_exp2f(-__builtin_fabsf(z))); const float sp=__builtin_fmaxf(-z,0.f)+lg;
          const bool ok=((r&3)+8*(r>>2)+32)<thr; l1[r]=ok?-(sp+z):0.f; p1[r]=ok?-sp:-INFINITY; }
      }
      float gs[8],pt[8];
      #pragma unroll
      for(int g=0;g<4;++g){ gs[g]=(l0[4*g]+l0[4*g+1])+(l0[4*g+2]+l0[4*g+3]); gs[4+g]=(l1[4*g]+l1[4*g+1])+(l1[4*g+2]+l1[4*g+3]); }
      #pragma unroll
      for(int g=0;g<8;++g){ auto rr=__builtin_amdgcn_permlane32_swap(__float_as_uint(gs[g]),__float_as_uint(gs[g]),false,false); pt[g]=__uint_as_float(rr[0])+__uint_as_float(rr[1]); }
      float base[8]; float run=R;
      #pragma unroll
      for(int g=7;g>=0;--g){ base[g]=run+selhi*(pt[g]-gs[g]); run+=pt[g]; }
      R=run;
      #pragma unroll
      for(int g=0;g<4;++g){
        { float a=base[g]; p0[4*g+3]=__builtin_amdgcn_exp2f(p0[4*g+3]+a); a+=l0[4*g+3]; p0[4*g+2]=__builtin_amdgcn_exp2f(p0[4*g+2]+a); a+=l0[4*g+2]; p0[4*g+1]=__builtin_amdgcn_exp2f(p0[4*g+1]+a); a+=l0[4*g+1]; p0[4*g]=__builtin_amdgcn_exp2f(p0[4*g]+a); }
        { float a=base[4+g]; p1[4*g+3]=__builtin_amdgcn_exp2f(p1[4*g+3]+a); a+=l1[4*g+3]; p1[4*g+2]=__builtin_amdgcn_exp2f(p1[4*g+2]+a); a+=l1[4*g+2]; p1[4*g+1]=__builtin_amdgcn_exp2f(p1[4*g+1]+a); a+=l1[4*g+1]; p1[4*g]=__builtin_amdgcn_exp2f(p1[4*g]+a); }
      }
      u32x4 pw0,pw1,pw2,pw3;
      pw0=(u32x4){cvtpk_s(p0[0],p0[1]),cvtpk_s(p0[2],p0[3]),cvtpk_s(p0[4],p0[5]),cvtpk_s(p0[6],p0[7])};
      pw1=(u32x4){cvtpk_s(p0[8],p0[9]),cvtpk_s(p0[10],p0[11]),cvtpk_s(p0[12],p0[13]),cvtpk_s(p0[14],p0[15])};
      pw2=(u32x4){cvtpk_s(p1[0],p1[1]),cvtpk_s(p1[2],p1[3]),cvtpk_s(p1[4],p1[5]),cvtpk_s(p1[6],p1[7])};
      pw3=(u32x4){cvtpk_s(p1[8],p1[9]),cvtpk_s(p1[10],p1[11]),cvtpk_s(p1[12],p1[13]),cvtpk_s(p1[14],p1[15])};
      SBAR();
      pv(o,vb0+slot,__builtin_bit_cast(bf16x8,pw0),__builtin_bit_cast(bf16x8,pw1),__builtin_bit_cast(bf16x8,pw2),__builtin_bit_cast(bf16x8,pw3));
    }
  }
  bf16*Ow=O+(rowbase+q0+wid*QBLK)*opitch;
  { bf16*stg=(bf16*)(shm+LDS_OST)+wid*2048;
    #pragma unroll
    for(int r=0;r<16;++r){const int orow=crow(r,hi);
      #pragma unroll
      for(int d0=0;d0<2;++d0)stg[orow*64+d0*32+r32]=__float2bfloat16(o[d0][r]);}
    asm volatile("s_waitcnt lgkmcnt(0)":::"memory");
    #pragma unroll
    for(int i=0;i<4;++i){const int row=i*8+(lane>>3),ch=lane&7; const u32x4 v=*(const u32x4*)(stg+row*64+ch*8); ATTN_STORE16(Ow+(long)row*opitch+ch*8,v);} }
  asm volatile("s_waitcnt lgkmcnt(0)\n\ts_barrier":::"memory");
  #undef DMA_K
  #undef DMA_V
}
constexpr int ATTN_LDS_BYTES=LDS_BYTES;
#undef SBAR
#undef WAIT_BAR
}
namespace mk {
using nv::NB; using nv::L; using nv::D; using nv::T; using nv::DEPTH; using nv::INC; using nv::EPS;
constexpr int NWAVES = 8;
constexpr size_t MiB = 1u << 20;
constexpr size_t WS_CTL = 0, CTL_ZERO_BYTES = 1 * MiB;
constexpr size_t WS_WIN = 1 * MiB;
constexpr size_t WS_WOUT = WS_WIN + 40 * MiB;
constexpr size_t WS_XN = WS_WOUT + 16 * MiB;
constexpr size_t WS_PROJ = WS_XN + 32 * MiB;
constexpr size_t WS_SBO = WS_PROJ + 80 * MiB;
constexpr size_t WS_O1 = WS_SBO + 8 * MiB;
constexpr size_t WS_O2 = WS_O1 + 16 * MiB;
constexpr size_t WS_Y = WS_O2 + 16 * MiB;
constexpr size_t WS_H = WS_Y + 32 * MiB;
constexpr size_t WS_YS = WS_H + 64 * MiB;
constexpr size_t WS_HB = WS_YS + 64 * MiB;
constexpr size_t WS_ROUTE = WS_HB + 24 * MiB;
constexpr size_t WS_S5 = WS_ROUTE + 2 * MiB;
constexpr size_t WS_W13 = WS_S5 + 160 * MiB;
constexpr size_t WS_W2 = WS_W13 + 256 * MiB;
constexpr size_t WS_END = WS_W2 + 128 * MiB;
static_assert(WS_END <= 1024 * MiB, "d_ws map must fit 1 GiB");
constexpr int CW_TMO = 0, CW_CODE = 1;
constexpr int CW_BAR = 4096;
constexpr int MAX_BAR_REGIONS = 40;
constexpr int CW_CNT = 2048;
constexpr int RING_OFF = 0, RING_BYTES = 131072;
constexpr int LDSCTL_OFF = 143360, MISC_OFF = LDSCTL_OFF + 320;
constexpr int LDS_BYTES = 147456;

#define GAS __attribute__((address_space(1)))
#define LAS __attribute__((address_space(3)))
typedef unsigned short bf16;
typedef unsigned v4u __attribute__((ext_vector_type(4)));
typedef float f32x4 __attribute__((ext_vector_type(4)));
typedef short bf16x8 __attribute__((ext_vector_type(8)));
typedef GAS unsigned gu32;
typedef GAS unsigned long long gu64;
#define RLX_AGENT __ATOMIC_RELAXED, __HIP_MEMORY_SCOPE_AGENT
#define LDS_WAIT() asm volatile("s_waitcnt lgkmcnt(0)" ::: "memory")
#define VM_WAIT() asm volatile("s_waitcnt vmcnt(0)" ::: "memory")
__device__ __forceinline__ unsigned long long rt() { return __builtin_amdgcn_s_memrealtime(); }
__device__ __forceinline__ unsigned f2bf(float f) { unsigned u = __builtin_bit_cast(unsigned, f); return (u + 0x7fffu + ((u >> 16) & 1u)) >> 16; }
__device__ __forceinline__ unsigned pk2(float lo, float hi) { return f2bf(lo) | (f2bf(hi) << 16); }

#define XB_TMO      128
#define XB_XCNT(j)  (256  + 64 * (j))
#define XB_XSUB(j)  (1280 + 64 * (j))
#define XB_XGEN(j)  (2304 + 64 * (j))
#define XB_TOP      3328
#define XB_TOPGEN   3392
#define XCD_BAR_WORDS 3456
#define XB_SPIN_CAP (1u << 18)

__device__ __forceinline__ unsigned xb_ld(unsigned* p)              { return __hip_atomic_load(p, __ATOMIC_RELAXED, __HIP_MEMORY_SCOPE_AGENT); }
__device__ __forceinline__ unsigned xb_add(unsigned* p, unsigned v) { return __hip_atomic_fetch_add(p, v, __ATOMIC_RELAXED, __HIP_MEMORY_SCOPE_AGENT); }
__device__ __forceinline__ unsigned xb_xcc_id() { return (unsigned)__builtin_amdgcn_s_getreg((3 << 11) | 20) & 0xFu; }
#define XB_SPIN(cond, bar) do { unsigned _sp = 0; while (cond) { __builtin_amdgcn_s_sleep(1); \
    if ((++_sp & 255u) == 0u) { if (xb_ld(&(bar)[XB_TMO])) break; if (_sp > XB_SPIN_CAP) { atomicAdd(&(bar)[XB_TMO], 1u); break; } } } } while (0)

struct XcdBarrier {
    unsigned* bar; unsigned x;
    volatile LAS unsigned* st;
};

__device__ __forceinline__ XcdBarrier xcd_barrier_post(unsigned* bar, volatile LAS unsigned* st) {
    XcdBarrier b; b.bar = bar; b.x = xb_xcc_id(); b.st = st;
    if (threadIdx.x == 0) (void)xb_add(&bar[XB_XCNT(b.x)], 1u);
    return b;
}
__device__ __forceinline__ void xcd_barrier_complete(unsigned* bar, unsigned x, unsigned& nloc, unsigned& nx) {
    const unsigned G = gridDim.x * gridDim.y * gridDim.z;
    unsigned sum, cnt, mine, sp = 0u;
    for (;;) {
        sum = 0u; cnt = 0u; mine = 0u;
#pragma unroll
        for (unsigned j = 0; j < 16; ++j) { const unsigned c = xb_ld(&bar[XB_XCNT(j)]); sum += c; cnt += (c > 0u) ? 1u : 0u; mine = (j == x) ? c : mine; }
        if (sum == G) break;
        __builtin_amdgcn_s_sleep(1);
        if ((++sp & 255u) == 0u) { if (xb_ld(&bar[XB_TMO])) break; if (sp > XB_SPIN_CAP) { atomicAdd(&bar[XB_TMO], 1u); break; } }
    }
    nloc = mine > 0u ? mine : 1u; nx = cnt > 0u ? cnt : 1u;
}

__device__ __forceinline__ void xcd_barrier(const XcdBarrier& b) {
    asm volatile("s_waitcnt vmcnt(0)" ::: "memory");
    __syncthreads();
    if (threadIdx.x == 0) {
        unsigned* bar = b.bar;
        __builtin_amdgcn_s_waitcnt(0);
        unsigned nloc = b.st[0], nx = b.st[1];
        if (nloc == 0u) { xcd_barrier_complete(bar, b.x, nloc, nx); b.st[0] = nloc; b.st[1] = nx; }
        const unsigned old = xb_add(&bar[XB_XSUB(b.x)], 1u);
        const unsigned gen = old / nloc;
        if (old + 1u == (gen + 1u) * nloc) {
            __builtin_amdgcn_fence(__ATOMIC_RELEASE, "agent");
            asm volatile("s_waitcnt vmcnt(0)" ::: "memory");
            const unsigned og = xb_add(&bar[XB_TOP], 1u);
            const unsigned tg = og / nx;
            if (og + 1u == (tg + 1u) * nx) xb_add(&bar[XB_TOPGEN], 1u);
            else XB_SPIN(xb_ld(&bar[XB_TOPGEN]) == tg, bar);
            __builtin_amdgcn_fence(__ATOMIC_ACQUIRE, "agent");
            xb_add(&bar[XB_XGEN(b.x)], 1u);
            asm volatile("s_waitcnt vmcnt(0)" ::: "memory");
        } else {
            XB_SPIN(xb_ld(&bar[XB_XGEN(b.x)]) == gen, bar);
            __builtin_amdgcn_fence(__ATOMIC_ACQUIRE, "agent");
            asm volatile("s_waitcnt vmcnt(0)" ::: "memory");
        }
    }
    __syncthreads();
}
static_assert((CW_BAR + MAX_BAR_REGIONS * XCD_BAR_WORDS) * 4 <= (int)CTL_ZERO_BYTES, "barrier regions inside the memset region");

__device__ __forceinline__ float wave_sum(float v) {
#pragma unroll
    for (int o = 1; o < 64; o <<= 1) v += __shfl_xor(v, o);
    return v;
}
__device__ __forceinline__ void transpose_tile(const float* __restrict__ W, int N, int k0, int n0, bf16* __restrict__ dst, int Kd, LAS float* scr, int lane) {
    const int kr = lane >> 4, n4 = (lane & 15) * 4;
    f32x4 v[16];
#pragma unroll
    for (int i = 0; i < 16; ++i) v[i] = *(const GAS f32x4*)(W + (size_t)(k0 + i * 4 + kr) * N + n0 + n4);
#pragma unroll
    for (int i = 0; i < 16; ++i) { LAS float* s = scr + (i * 4 + kr) * 65 + n4; s[0] = v[i].x; s[1] = v[i].y; s[2] = v[i].z; s[3] = v[i].w; }
    LDS_WAIT(); asm volatile("" ::: "memory");
    const int c = lane & 7;
#pragma unroll
    for (int j = 0; j < 8; ++j) { const int n = (lane >> 3) + 8 * j; const LAS float* s = scr + (8 * c) * 65 + n;
        v4u o; o.x = pk2(s[0 * 65], s[1 * 65]); o.y = pk2(s[2 * 65], s[3 * 65]); o.z = pk2(s[4 * 65], s[5 * 65]); o.w = pk2(s[6 * 65], s[7 * 65]);
        *(GAS v4u*)(dst + (size_t)n * Kd + k0 + 8 * c) = o; }
    LDS_WAIT(); asm volatile("" ::: "memory");
}
__device__ __forceinline__ void rms_row_to_bf16(const float* xrow, const float* g, bf16* orow, int lane) {
    const GAS f32x4* xr = (const GAS f32x4*)xrow + lane; const GAS f32x4* gr = (const GAS f32x4*)g + lane;
    f32x4 v[8]; float s = 0.f;
#pragma unroll
    for (int j = 0; j < 8; ++j) { v[j] = xr[64 * j]; s += (v[j].x * v[j].x + v[j].y * v[j].y) + (v[j].z * v[j].z + v[j].w * v[j].w); }
    const float r = rsqrtf(wave_sum(s) * (1.f / D) + EPS);
    GAS unsigned long long* o8 = (GAS unsigned long long*)orow + lane;
#pragma unroll
    for (int j = 0; j < 8; ++j) { const f32x4 gg = gr[64 * j]; o8[64 * j] = (unsigned long long)pk2(v[j].x * r * gg.x, v[j].y * r * gg.y) | ((unsigned long long)pk2(v[j].z * r * gg.z, v[j].w * r * gg.w) << 32); }
}
}

namespace pg8 {
struct EpiProj {
    static constexpr bool PERM = true, AFTER_DRAIN = false;
    bf16_t* O; int ldc;
    __device__ __forceinline__ void operator()(const f32x4 (&acc)[2][2][4][2], const Unit& u, int wr, int wc, int fr, int fq) const {
        const int row0 = u.pm * BM + wr * 64 + fr; const int colt = u.pn * BM;
        const float sc = (u.pn < 2) ? nv::QS_SB : ((u.pn >= 8 && u.pn < 12) ? nv::QS_DF : 1.f);
        const int col0 = colt + wc * 32 + 8 * fq;
#pragma unroll
        for (int ai = 0; ai < 2; ++ai)
#pragma unroll
            for (int m = 0; m < 4; ++m) { bf16_t* rowp = O + (size_t)(row0 + ai * HALF + m * 16) * ldc + col0;
#pragma unroll
                for (int bj = 0; bj < 2; ++bj) { const f32x4 v0 = acc[ai][bj][m][0] * sc, v1 = acc[ai][bj][m][1] * sc;
                    u32x4 w; w.x = cvt_pk_bf16(v0[0], v0[1]); w.y = cvt_pk_bf16(v0[2], v0[3]); w.z = cvt_pk_bf16(v1[0], v1[1]); w.w = cvt_pk_bf16(v1[2], v1[3]);
                    *(u32x4*)(rowp + bj * HALF) = w; } }
    }
};
struct EpiResF32 {
    static constexpr bool PERM = false, AFTER_DRAIN = false;
    const float* R; float* out; int ldc;
    __device__ __forceinline__ void operator()(const f32x4 (&acc)[2][2][4][2], const Unit& u, int wr, int wc, int fr, int fq) const {
        const int col0 = u.pn * BM + wc * 32 + 4 * fq;
#pragma unroll
        for (int ai = 0; ai < 2; ++ai)
#pragma unroll
            for (int m = 0; m < 4; ++m) { const size_t off = (size_t)(u.pm * BM + ai * HALF + wr * 64 + m * 16 + fr) * ldc + col0;
#pragma unroll
                for (int bj = 0; bj < 2; ++bj)
#pragma unroll
                    for (int n = 0; n < 2; ++n) { const f32x4 r = *(const f32x4*)(R + off + bj * HALF + n * 16); *(f32x4*)(out + off + bj * HALF + n * 16) = acc[ai][bj][m][n] + r; }
                asm volatile("" ::: "memory"); }
    }
};
}

namespace s5 {
using mk::bf16; using mk::f32x4; using mk::bf16x8; using mk::v4u;
typedef float f32x16 __attribute__((ext_vector_type(16)));
typedef float f32x2 __attribute__((ext_vector_type(2)));
constexpr int LC_ = 32, NCH = 64, SG = 32, SN = 64, SC = 16;
constexpr size_t OFF_KT = 0;
constexpr size_t OFF_PT = 1u << 20;
constexpr size_t OFF_LP = 9u << 20;
constexpr size_t OFF_LC = 10u << 20;
constexpr size_t OFF_WG = 12u << 20;
constexpr size_t OFF_YI = 13u << 20;
constexpr size_t OFF_SE = 29u << 20;

__device__ __forceinline__ void cpow(float lr, float li, float dt, float tau, float& pr, float& pi) {
    const float mag = __builtin_amdgcn_exp2f(tau * lr * dt * 1.4426950408889634f);
    double rev = (double)tau * (double)li * (double)dt * 0.15915494309189535; rev -= __builtin_rint(rev);
    const float rv = (float)rev; pr = mag * __builtin_amdgcn_cosf(rv); pi = mag * __builtin_amdgcn_sinf(rv);
}
__device__ __forceinline__ void zoh_f(float lr, float li, float dt, float& fr, float& fi) {
    float br, bi; cpow(lr, li, dt, 1.f, br, bi);
    const float nr = br - 1.f, ni = bi, den = lr * lr + li * li;
    fr = (nr * lr + ni * li) / den; fi = (ni * lr - nr * li) / den;
}
__device__ __forceinline__ void build_tables(const float* const* in, unsigned char* s5ws, int gt, int NTH) {
    const float* lam_re = in[4]; const float* lam_im = in[5]; const float* b_re = in[6]; const float* b_im = in[7]; const float* c_re = in[8]; const float* c_im = in[9]; const float* log_dt = in[11];
    bf16* KT = (bf16*)(s5ws + OFF_KT); bf16* PT = (bf16*)(s5ws + OFF_PT); f32x2* LP = (f32x2*)(s5ws + OFF_LP); f32x2* LC = (f32x2*)(s5ws + OFF_LC);
#pragma unroll 1
    for (int it = gt; it < 2 * SG * LC_ * SC; it += NTH) { const int c = it & 15, tau = (it >> 4) & 31, lg = it >> 9;
        const float dt = __expf(log_dt[lg]); float acc[16];
#pragma unroll
        for (int q = 0; q < 16; ++q) acc[q] = 0.f;
#pragma unroll 1
        for (int n = 0; n < SN; ++n) { const float lr = lam_re[lg * SN + n], li = lam_im[lg * SN + n];
            float pr, pi, fr, fi; cpow(lr, li, dt, (float)tau, pr, pi); zoh_f(lr, li, dt, fr, fi);
            const float cr = c_re[(lg * SC + c) * SN + n], ci = c_im[(lg * SC + c) * SN + n];
            const float xr = pr * fr - pi * fi, xi = pr * fi + pi * fr;
            const float wr = cr * xr - ci * xi, wi = cr * xi + ci * xr;
            const f32x4* br4 = (const f32x4*)(b_re + (size_t)(lg * SN + n) * SC); const f32x4* bi4 = (const f32x4*)(b_im + (size_t)(lg * SN + n) * SC);
#pragma unroll
            for (int q = 0; q < 4; ++q) { const f32x4 br = br4[q], bi = bi4[q];
                acc[4 * q] += wr * br.x - wi * bi.x; acc[4 * q + 1] += wr * br.y - wi * bi.y; acc[4 * q + 2] += wr * br.z - wi * bi.z; acc[4 * q + 3] += wr * br.w - wi * bi.w; } }
        v4u o0, o1; o0.x = mk::pk2(acc[0], acc[1]); o0.y = mk::pk2(acc[2], acc[3]); o0.z = mk::pk2(acc[4], acc[5]); o0.w = mk::pk2(acc[6], acc[7]);
        o1.x = mk::pk2(acc[8], acc[9]); o1.y = mk::pk2(acc[10], acc[11]); o1.z = mk::pk2(acc[12], acc[13]); o1.w = mk::pk2(acc[14], acc[15]);
        v4u* dst = (v4u*)(KT + (size_t)it * 16); dst[0] = o0; dst[1] = o1; }
#pragma unroll 1
    for (int it = gt; it < 2 * SG * LC_ * SN; it += NTH) { const int n = it & 63, s = (it >> 6) & 31, lg = it >> 11;
        const float dt = __expf(log_dt[lg]); const float lr = lam_re[lg * SN + n], li = lam_im[lg * SN + n];
        float pr, pi, fr, fi; cpow(lr, li, dt, (float)(31 - s), pr, pi); zoh_f(lr, li, dt, fr, fi);
        const float xr = pr * fr - pi * fi, xi = pr * fi + pi * fr;
        float vr[16], vi[16];
        const f32x4* br4 = (const f32x4*)(b_re + (size_t)(lg * SN + n) * SC); const f32x4* bi4 = (const f32x4*)(b_im + (size_t)(lg * SN + n) * SC);
#pragma unroll
        for (int q = 0; q < 4; ++q) { const f32x4 br = br4[q], bi = bi4[q];
            vr[4 * q] = xr * br.x - xi * bi.x; vr[4 * q + 1] = xr * br.y - xi * bi.y; vr[4 * q + 2] = xr * br.z - xi * bi.z; vr[4 * q + 3] = xr * br.w - xi * bi.w;
            vi[4 * q] = xr * bi.x + xi * br.x; vi[4 * q + 1] = xr * bi.y + xi * br.y; vi[4 * q + 2] = xr * bi.z + xi * br.z; vi[4 * q + 3] = xr * bi.w + xi * br.w; }
        bf16* base = PT + ((size_t)(lg * LC_ + s) * 128) * 16;
        v4u o; v4u* d0 = (v4u*)(base + (size_t)n * 16); v4u* d1 = (v4u*)(base + (size_t)(64 + n) * 16);
        o.x = mk::pk2(vr[0], vr[1]); o.y = mk::pk2(vr[2], vr[3]); o.z = mk::pk2(vr[4], vr[5]); o.w = mk::pk2(vr[6], vr[7]); d0[0] = o;
        o.x = mk::pk2(vr[8], vr[9]); o.y = mk::pk2(vr[10], vr[11]); o.z = mk::pk2(vr[12], vr[13]); o.w = mk::pk2(vr[14], vr[15]); d0[1] = o;
        o.x = mk::pk2(vi[0], vi[1]); o.y = mk::pk2(vi[2], vi[3]); o.z = mk::pk2(vi[4], vi[5]); o.w = mk::pk2(vi[6], vi[7]); d1[0] = o;
        o.x = mk::pk2(vi[8], vi[9]); o.y = mk::pk2(vi[10], vi[11]); o.z = mk::pk2(vi[12], vi[13]); o.w = mk::pk2(vi[14], vi[15]); d1[1] = o; }
#pragma unroll 1
    for (int it = gt; it < 2 * SG * 32 * SN; it += NTH) { const int n = it & 63, t = (it >> 6) & 31, lg = it >> 11;
        const float dt = __expf(log_dt[lg]); float pr, pi; cpow(lam_re[lg * SN + n], lam_im[lg * SN + n], dt, (float)(t + 1), pr, pi); LP[it] = (f32x2){pr, pi}; }
#pragma unroll 1
    for (int it = gt; it < 2 * SG * 64 * SN; it += NTH) { const int n = it & 63, m = (it >> 6) & 63, lg = it >> 12;
        const float dt = __expf(log_dt[lg]); float pr, pi; cpow(lam_re[lg * SN + n], lam_im[lg * SN + n], dt, (float)(32 * m), pr, pi); LC[it] = (f32x2){pr, pi}; }
}

__device__ __forceinline__ void s5a_unit(int l, int g, int b, const bf16* PROJ, const unsigned char* s5ws, LAS unsigned char* lds) {
    const int tid = opaque_tid(), lane = tid & 63, wave = __builtin_amdgcn_readfirstlane(tid >> 6), r = lane & 31, h = lane >> 5;
    const bf16* KTg = (const bf16*)(s5ws + OFF_KT) + (size_t)(l * SG + g) * 32 * 256;
    const bf16* PTg = (const bf16*)(s5ws + OFF_PT) + (size_t)(l * SG + g) * 32 * 128 * 16;
    float* YI = (float*)(s5ws + OFF_YI); float* SE = (float*)(s5ws + OFF_SE);
#pragma unroll
    for (int i = 0; i < 8; ++i) { const int p = tid + 512 * i, tok = p >> 1, half = p & 1, chunk = tok >> 5, s = tok & 31;
        const v4u v = *(const GAS v4u*)(PROJ + (size_t)(b * 2048 + tok) * 5120 + nv::C_U + g * 16 + 8 * half);
        *(LAS v4u*)(lds + ((s * 64 + chunk) * 32 + 16 * half)) = v; }
#pragma unroll
    for (int i = 0; i < 2; ++i) { const int p = tid + 512 * i; const v4u v = *(const GAS v4u*)(KTg + (size_t)p * 8); *(LAS v4u*)(lds + 65536 + 512 + p * 16) = v; }
    if (tid < 32) *(LAS v4u*)(lds + 65536 + tid * 16) = (v4u){0u, 0u, 0u, 0u};
    asm volatile("s_waitcnt vmcnt(0) lgkmcnt(0)" ::: "memory"); __syncthreads();
    const int tl = r >> 4, c = r & 15;
#pragma unroll 1
    for (int nb = 0; nb < 2; ++nb)
#pragma unroll 1
        for (int half = 0; half < 2; ++half) { const int tb = half ? 15 - wave : wave;
            f32x16 acc = {};
            const LAS unsigned char* ap = lds + 65536 + (2 * tb + tl + 1) * 512 + c * 32 + h * 16;
            const LAS unsigned char* bp = lds + (nb * 32 + r) * 32 + 16 * h;
#pragma unroll 2
            for (int s = 0; s <= 2 * tb + 1; ++s) { const bf16x8 a = *(const LAS bf16x8*)(ap - s * 512); const bf16x8 bb = *(const LAS bf16x8*)(bp + s * 2048);
                acc = __builtin_amdgcn_mfma_f32_32x32x16_bf16(a, bb, acc, 0, 0, 0); }
            const int chunk = nb * 32 + r;
#pragma unroll
            for (int q = 0; q < 4; ++q) { const int tq = q >> 1, c0 = 8 * (q & 1) + 4 * h; const int t = chunk * 32 + 2 * tb + tq;
                *(GAS f32x4*)(YI + (size_t)(b * 2048 + t) * 512 + g * 16 + c0) = (f32x4){acc[4 * q], acc[4 * q + 1], acc[4 * q + 2], acc[4 * q + 3]}; } }
    { const int mb = wave >> 1, nb = wave & 1; f32x16 acc = {};
        const bf16* ap = PTg + (size_t)(mb * 32 + r) * 16 + 8 * h; const LAS unsigned char* bp = lds + (nb * 32 + r) * 32 + 16 * h;
#pragma unroll 4
        for (int s = 0; s < 32; ++s) { const bf16x8 a = *(const GAS bf16x8*)(ap + (size_t)s * 128 * 16); const bf16x8 bb = *(const LAS bf16x8*)(bp + s * 2048);
            acc = __builtin_amdgcn_mfma_f32_32x32x16_bf16(a, bb, acc, 0, 0, 0); }
        const int chunk = nb * 32 + r;
#pragma unroll
        for (int q = 0; q < 4; ++q) { const int rho = mb * 32 + 8 * q + 4 * h;
            *(GAS f32x4*)(SE + ((size_t)((b * 64 + chunk) * 32 + g)) * 128 + rho) = (f32x4){acc[4 * q], acc[4 * q + 1], acc[4 * q + 2], acc[4 * q + 3]}; } }
    asm volatile("s_waitcnt lgkmcnt(0)" ::: "memory"); __syncthreads();
}

__device__ __forceinline__ float gelu_tanh(float x) { const float u = 0.7978845608028654f * (x + 0.044715f * x * x * x); const float e = __builtin_amdgcn_exp2f(2.885390081777927f * u);
    const float th = 1.f - 2.f * __builtin_amdgcn_rcpf(e + 1.f); return 0.5f * x * (1.f + th); }
__device__ __forceinline__ bf16x8 pack8(const float (&v)[8]) { v4u o; o.x = mk::pk2(v[0], v[1]); o.y = mk::pk2(v[2], v[3]); o.z = mk::pk2(v[4], v[5]); o.w = mk::pk2(v[6], v[7]); return __builtin_bit_cast(bf16x8, o); }
__device__ __forceinline__ float bflo(unsigned u) { return __uint_as_float(u << 16); }
__device__ __forceinline__ float bfhi(unsigned u) { return __uint_as_float(u & 0xffff0000u); }

__device__ __forceinline__ void post_unit(int l, int b, int k, const float* const* in, const bf16* PROJ, const bf16* SBO, const bf16* O1, const bf16* O2, bf16* Y,
                                          const unsigned char* s5ws, LAS unsigned char* lds) {
    const int tid = opaque_tid(), lane = tid & 63, wave = __builtin_amdgcn_readfirstlane(tid >> 6);
    const f32x2* LP = (const f32x2*)(s5ws + OFF_LP) + (size_t)l * SG * 32 * SN; const f32x2* LC = (const f32x2*)(s5ws + OFF_LC) + (size_t)l * SG * 64 * SN;
    const bf16* WG = (const bf16*)(s5ws + OFF_WG) + (size_t)l * 512 * 512;
    const float* YI = (const float*)(s5ws + OFF_YI); const float* SE = (const float*)(s5ws + OFF_SE);
    const float* c_re = in[8] + (size_t)l * SG * SC * SN; const float* c_im = in[9] + (size_t)l * SG * SC * SN; const float* dsk = in[10] + l * 512;
    const float* b_glu = in[13] + l * 512; const float* ssm_g = in[14] + l * 512; const float* sb_g = in[3] + l * 512; const float* df_g = in[19] + l * 128;
    LAS float* SIN = (LAS float*)lds; LAS unsigned short* G1 = (LAS unsigned short*)(lds + 16384); LAS unsigned short* OUTT = (LAS unsigned short*)(lds + 49664); LAS float* RS = (LAS float*)(lds + 82944);
    const size_t tok0 = (size_t)b * 2048 + (size_t)k * 32;
#pragma unroll 1
    for (int q = 0; q < 8; ++q) { const int item = tid + 512 * q, g = item >> 6, n = item & 63; float sr = 0.f, si = 0.f;
        const float* se = SE + ((size_t)(b * 64) * 32 + g) * 128 + n; const f32x2* lc = LC + (size_t)g * 64 * SN + n;
#pragma unroll 4
        for (int j = 0; j < k; ++j) { const float er = se[(size_t)j * 32 * 128], ei = se[(size_t)j * 32 * 128 + 64]; const f32x2 cc = lc[(size_t)(k - 1 - j) * SN];
            sr += cc.x * er - cc.y * ei; si += cc.x * ei + cc.y * er; }
        SIN[g * 128 + n] = sr; SIN[g * 128 + 64 + n] = si; }
    asm volatile("s_waitcnt lgkmcnt(0)" ::: "memory"); __syncthreads();
    { const int row = lane & 15, kg = lane >> 4;
#pragma unroll 1
      for (int gi = 0; gi < 4; ++gi) { const int g = wave * 4 + gi;
#pragma unroll
        for (int mb = 0; mb < 2; ++mb) { f32x4 acc = {0.f, 0.f, 0.f, 0.f}; const int t = 16 * mb + row;
#pragma unroll
            for (int ks = 0; ks < 4; ++ks) { const int ri = ks >> 1, n0 = 32 * (ks & 1) + 8 * kg;
                const GAS f32x4* lp = (const GAS f32x4*)(LP + ((size_t)g * 32 + t) * SN + n0);
                const f32x4 p0 = lp[0], p1 = lp[1], p2 = lp[2], p3 = lp[3];
                const f32x4 sr0 = *(const LAS f32x4*)(SIN + g * 128 + n0), sr1 = *(const LAS f32x4*)(SIN + g * 128 + n0 + 4);
                const f32x4 si0 = *(const LAS f32x4*)(SIN + g * 128 + 64 + n0), si1 = *(const LAS f32x4*)(SIN + g * 128 + 64 + n0 + 4);
                const float lr[8] = {p0.x, p0.z, p1.x, p1.z, p2.x, p2.z, p3.x, p3.z}, li[8] = {p0.y, p0.w, p1.y, p1.w, p2.y, p2.w, p3.y, p3.w};
                const float sr[8] = {sr0.x, sr0.y, sr0.z, sr0.w, sr1.x, sr1.y, sr1.z, sr1.w}, si[8] = {si0.x, si0.y, si0.z, si0.w, si1.x, si1.y, si1.z, si1.w};
                float w[8], cb[8];
                const GAS f32x4* cp = (const GAS f32x4*)((ri ? c_im : c_re) + (size_t)(g * SC + row) * SN + n0); const f32x4 c0 = cp[0], c1 = cp[1];
                const float sg = ri ? -1.f : 1.f;
                cb[0] = sg * c0.x; cb[1] = sg * c0.y; cb[2] = sg * c0.z; cb[3] = sg * c0.w; cb[4] = sg * c1.x; cb[5] = sg * c1.y; cb[6] = sg * c1.z; cb[7] = sg * c1.w;
#pragma unroll
                for (int j = 0; j < 8; ++j) w[j] = ri ? (lr[j] * si[j] + li[j] * sr[j]) : (lr[j] * sr[j] - li[j] * si[j]);
                acc = __builtin_amdgcn_mfma_f32_16x16x32_bf16(pack8(w), pack8(cb), acc, 0, 0, 0); }
            const int ch = g * SC + row;
            const float dk = dsk[ch];
#pragma unroll
            for (int rg = 0; rg < 4; ++rg) { const int tt = 16 * mb + 4 * kg + rg; const size_t tok = tok0 + tt;
                const float u = bflo((unsigned)PROJ[tok * 5120 + nv::C_U + ch]);
                const float y = acc[rg] + YI[tok * 512 + ch] + dk * u;
                G1[tt * 520 + ch] = (unsigned short)mk::f2bf(gelu_tanh(y)); } } } }
    asm volatile("s_waitcnt lgkmcnt(0)" ::: "memory"); __syncthreads();
    { const int row = lane & 15, kg = lane >> 4; f32x4 acc[2][4];
#pragma unroll
      for (int mb = 0; mb < 2; ++mb)
#pragma unroll
          for (int nb = 0; nb < 4; ++nb) acc[mb][nb] = (f32x4){0.f, 0.f, 0.f, 0.f};
#pragma unroll 2
      for (int ks = 0; ks < 16; ++ks) { bf16x8 a[2], bb[4];
#pragma unroll
          for (int mb = 0; mb < 2; ++mb) a[mb] = *(const LAS bf16x8*)(G1 + (16 * mb + row) * 520 + 32 * ks + 8 * kg);
#pragma unroll
          for (int nb = 0; nb < 4; ++nb) bb[nb] = *(const GAS bf16x8*)(WG + (size_t)(64 * wave + 16 * nb + row) * 512 + 32 * ks + 8 * kg);
#pragma unroll
          for (int mb = 0; mb < 2; ++mb)
#pragma unroll
              for (int nb = 0; nb < 4; ++nb) acc[mb][nb] = __builtin_amdgcn_mfma_f32_16x16x32_bf16(a[mb], bb[nb], acc[mb][nb], 0, 0, 0); }
      float ss[2][4];
#pragma unroll
      for (int mb = 0; mb < 2; ++mb)
#pragma unroll
          for (int rg = 0; rg < 4; ++rg) ss[mb][rg] = 0.f;
#pragma unroll
      for (int nb = 0; nb < 4; ++nb) { const int j = 64 * wave + 16 * nb + row; const float bz = b_glu[j];
#pragma unroll
          for (int mb = 0; mb < 2; ++mb)
#pragma unroll
              for (int rg = 0; rg < 4; ++rg) { const int tt = 16 * mb + 4 * kg + rg; const float z = acc[mb][nb][rg] + bz; const float g1 = bflo((unsigned)G1[tt * 520 + j]);
                  const float o = g1 * __builtin_amdgcn_rcpf(1.f + __builtin_amdgcn_exp2f(-1.4426950408889634f * z)); acc[mb][nb][rg] = o; ss[mb][rg] += o * o; } }
#pragma unroll
      for (int mb = 0; mb < 2; ++mb)
#pragma unroll
          for (int rg = 0; rg < 4; ++rg) { float v = ss[mb][rg]; v += __shfl_xor(v, 1); v += __shfl_xor(v, 2); v += __shfl_xor(v, 4); v += __shfl_xor(v, 8);
              if (row == 0) RS[wave * 32 + 16 * mb + 4 * kg + rg] = v; }
      asm volatile("s_waitcnt lgkmcnt(0)" ::: "memory"); __syncthreads();
#pragma unroll
      for (int mb = 0; mb < 2; ++mb)
#pragma unroll
          for (int rg = 0; rg < 4; ++rg) { const int tt = 16 * mb + 4 * kg + rg; float tot = 0.f;
#pragma unroll
              for (int w8 = 0; w8 < 8; ++w8) tot += RS[w8 * 32 + tt];
              const float rinv = rsqrtf(tot * (1.f / 512.f) + nv::EPS);
#pragma unroll
              for (int nb = 0; nb < 4; ++nb) { const int j = 64 * wave + 16 * nb + row; OUTT[tt * 520 + j] = (unsigned short)mk::f2bf(acc[mb][nb][rg] * rinv * ssm_g[j]); } }
      asm volatile("s_waitcnt lgkmcnt(0)" ::: "memory"); __syncthreads();
#pragma unroll
      for (int i = 0; i < 4; ++i) { const int p = tid + 512 * i, rw = p >> 6, c16 = p & 63; const v4u v = *(const LAS v4u*)(OUTT + rw * 520 + c16 * 8);
          *(GAS v4u*)(Y + (tok0 + rw) * 2048 + 512 + c16 * 8) = v; } }
    { float a_ = in[15][l * 64 + lane] * in[16][l * 64 + lane], c_ = in[17][l * 64 + lane] * in[18][l * 64 + lane];
      a_ = mk::wave_sum(a_); c_ = mk::wave_sum(c_);
      const float lam_init = 0.8f - 0.6f * __expf(-0.3f * (float)l); const float lam = __expf(a_) - __expf(c_) + lam_init;
#pragma unroll 1
      for (int i = 0; i < 4; ++i) { const size_t tok = tok0 + 4 * wave + i;
          { const v4u v = *(const GAS v4u*)(SBO + tok * 512 + lane * 8); const f32x4 g0 = *(const GAS f32x4*)(sb_g + lane * 8), g1 = *(const GAS f32x4*)(sb_g + lane * 8 + 4);
            float x[8] = {bflo(v.x), bfhi(v.x), bflo(v.y), bfhi(v.y), bflo(v.z), bfhi(v.z), bflo(v.w), bfhi(v.w)}; float s = 0.f;
#pragma unroll
            for (int j = 0; j < 8; ++j) s += x[j] * x[j];
            const float rinv = rsqrtf(mk::wave_sum(s) * (1.f / 512.f) + nv::EPS);
            v4u o; o.x = mk::pk2(x[0] * rinv * g0.x, x[1] * rinv * g0.y); o.y = mk::pk2(x[2] * rinv * g0.z, x[3] * rinv * g0.w); o.z = mk::pk2(x[4] * rinv * g1.x, x[5] * rinv * g1.y); o.w = mk::pk2(x[6] * rinv * g1.z, x[7] * rinv * g1.w);
            *(GAS v4u*)(Y + tok * 2048 + lane * 8) = o; }
          { const GAS v4u* p1 = (const GAS v4u*)(O1 + tok * 1024 + lane * 16); const GAS v4u* p2 = (const GAS v4u*)(O2 + tok * 1024 + lane * 16);
            const v4u a0 = p1[0], a1 = p1[1], b0 = p2[0], b1 = p2[1];
            float x[16] = {bflo(a0.x) - lam * bflo(b0.x), bfhi(a0.x) - lam * bfhi(b0.x), bflo(a0.y) - lam * bflo(b0.y), bfhi(a0.y) - lam * bfhi(b0.y),
                           bflo(a0.z) - lam * bflo(b0.z), bfhi(a0.z) - lam * bfhi(b0.z), bflo(a0.w) - lam * bflo(b0.w), bfhi(a0.w) - lam * bfhi(b0.w),
                           bflo(a1.x) - lam * bflo(b1.x), bfhi(a1.x) - lam * bfhi(b1.x), bflo(a1.y) - lam * bflo(b1.y), bfhi(a1.y) - lam * bfhi(b1.y),
                           bflo(a1.z) - lam * bflo(b1.z), bfhi(a1.z) - lam * bfhi(b1.z), bflo(a1.w) - lam * bflo(b1.w), bfhi(a1.w) - lam * bfhi(b1.w)};
            float s = 0.f;
#pragma unroll
            for (int j = 0; j < 16; ++j) s += x[j] * x[j];
            s += __shfl_xor(s, 1); s += __shfl_xor(s, 2); s += __shfl_xor(s, 4);
            const float rinv = rsqrtf(s * (1.f / 128.f) + nv::EPS) * (1.f - lam_init);
            const GAS f32x4* gp = (const GAS f32x4*)(df_g + (lane & 7) * 16); const f32x4 g0 = gp[0], g1 = gp[1], g2 = gp[2], g3 = gp[3];
            v4u o0, o1; o0.x = mk::pk2(x[0] * rinv * g0.x, x[1] * rinv * g0.y); o0.y = mk::pk2(x[2] * rinv * g0.z, x[3] * rinv * g0.w); o0.z = mk::pk2(x[4] * rinv * g1.x, x[5] * rinv * g1.y); o0.w = mk::pk2(x[6] * rinv * g1.z, x[7] * rinv * g1.w);
            o1.x = mk::pk2(x[8] * rinv * g2.x, x[9] * rinv * g2.y); o1.y = mk::pk2(x[10] * rinv * g2.z, x[11] * rinv * g2.w); o1.z = mk::pk2(x[12] * rinv * g3.x, x[13] * rinv * g3.y); o1.w = mk::pk2(x[14] * rinv * g3.z, x[15] * rinv * g3.w);
            GAS v4u* yo = (GAS v4u*)(Y + tok * 2048 + 1024 + lane * 16); yo[0] = o0; yo[1] = o1; } } }
    asm volatile("s_waitcnt lgkmcnt(0)" ::: "memory"); __syncthreads();
}
}

namespace mk {
struct MArgs { const float* in[30]; float* out; unsigned char* ws; int ph_lo, ph_hi, li, pad; };
constexpr int NPHASE = 1 + 8 * DEPTH;

__global__ void __launch_bounds__(NWAVES * 64, 2) mk_fwd(MArgs args) {
    extern __shared__ __attribute__((aligned(16))) unsigned char lds[];
    LAS unsigned char* ldsl = (LAS unsigned char*)lds;
    volatile LAS unsigned* MISC = (volatile LAS unsigned*)(ldsl + MISC_OFF);
    const int tid = threadIdx.x, wave = __builtin_amdgcn_readfirstlane(tid >> 6);
    const int G = gridDim.x; const int bx = blockIdx.x; const int vcu = (G % 8 == 0) ? (bx % 8) * (G / 8) + bx / 8 : bx;
    unsigned char* ws = args.ws;
    gu32* ctl = (gu32*)(ws + WS_CTL);
    for (int u = tid; u < (LDS_BYTES - LDSCTL_OFF) / 4; u += NWAVES * 64) ((LAS unsigned*)(ldsl + LDSCTL_OFF))[u] = 0u;
    __syncthreads();
    XcdBarrier bar = xcd_barrier_post((unsigned*)(ctl + CW_BAR) + args.li * XCD_BAR_WORDS, MISC + 8);
    const int lo = args.ph_lo, hi = args.ph_hi;
#define IN(k) (lo <= (k) && (k) < hi)
#define SEAM(k) do { if (IN(k) && IN((k) + 1)) xcd_barrier(bar); } while (0)
    bf16* WinT = (bf16*)(ws + WS_WIN); bf16* WoutT = (bf16*)(ws + WS_WOUT); bf16* XN = (bf16*)(ws + WS_XN); bf16* PROJ = (bf16*)(ws + WS_PROJ);
    bf16* Y = (bf16*)(ws + WS_Y); float* H = (float*)(ws + WS_H); bf16* YS = (bf16*)(ws + WS_YS); bf16* HB = (bf16*)(ws + WS_HB);
    bf16* W13T = (bf16*)(ws + WS_W13); bf16* W2T = (bf16*)(ws + WS_W2); int* LIST = (int*)(ws + WS_ROUTE); float* GATEW = (float*)(ws + WS_ROUTE + MiB);
    int* EI = (int*)(ws + WS_ROUTE + MiB + 256 * 1024); float* EW = (float*)(ws + WS_ROUTE + MiB + 512 * 1024);
    LAS int* tab = (LAS int*)(ldsl + LDSCTL_OFF + 1024);
    const int NGW = G * NWAVES;
#define PHASE_IDS() const int tid_ = opaque_tid(); const int lane = tid_ & 63; const int gw = vcu * NWAVES + wave; (void)gw; (void)lane

    if (IN(0)) { PHASE_IDS();
        LAS float* scr = (LAS float*)(ldsl + RING_OFF + wave * 16640);
        constexpr int I_IN = (D / 64) * (INC / 64), I_OUT = (D / 64) * (D / 64);
        constexpr int NIT = DEPTH * (I_IN + I_OUT);
        for (int it = gw; it < NIT; it += NGW) {
            int r = it; const int l = r / (I_IN + I_OUT); r -= l * (I_IN + I_OUT);
            if (r < I_IN) { const int nb = r % (INC / 64), kb = r / (INC / 64);
                transpose_tile(args.in[2] + (size_t)l * D * INC, INC, kb * 64, nb * 64, WinT + ((size_t)l * INC + nb * 64) * D, D, scr, lane); }
            else { r -= I_IN; const int nb = r % (D / 64), kb = r / (D / 64);
                transpose_tile(args.in[20] + (size_t)l * D * D, D, kb * 64, nb * 64, WoutT + ((size_t)l * D + nb * 64) * D, D, scr, lane); }
        }
        for (int m = gw; m < T; m += NGW) rms_row_to_bf16(args.in[0] + (size_t)m * D, args.in[1], XN + (size_t)m * D, lane);
        s5::build_tables(args.in, ws + WS_S5, vcu * (NWAVES * 64) + tid_, G * NWAVES * 64);
        for (int it = gw; it < DEPTH * 64; it += NGW) { const int l = it >> 6, r = it & 63, nb = r & 7, kb = r >> 3;
            transpose_tile(args.in[12] + (size_t)l * 512 * 512, 512, kb * 64, nb * 64, (bf16*)(ws + WS_S5 + s5::OFF_WG) + ((size_t)l * 512 + nb * 64) * 512, 512, scr, lane); }
        constexpr int NEX = DEPTH * nv::NEXP * 768;
        for (int it = gw; it < NEX; it += NGW) {
            const int le = it / 768; int r = it - le * 768;
            if (r < 512) { const int w3 = r >> 8; r &= 255; const int nb = r & 7, kb = r >> 3; const int n0 = nb * 64;
                const float* W = args.in[w3 ? 27 : 26] + (size_t)le * D * nv::DE;
                transpose_tile(W, nv::DE, kb * 64, n0, W13T + ((size_t)le * 1024 + (n0 >> 7) * 256 + w3 * 128 + (n0 & 127)) * D, D, scr, lane); }
            else { r -= 512; const int nb = r & 31, kb = r >> 5;
                transpose_tile(args.in[28] + (size_t)le * nv::DE * D, D, kb * 64, nb * 64, W2T + ((size_t)le * D + nb * 64) * nv::DE, nv::DE, scr, lane); }
        }
    }
    SEAM(0);
    for (int l = 0; l < DEPTH; ++l) {
        const int pb = 1 + 8 * l;
        if (IN(pb + 0)) {
            pg8::Gemm g{XN, WinT + (size_t)l * INC * D, T, INC, D}; pg8::StaticOrder S; S.init(T, INC, G, bx);
            pg8::EpiProj E{PROJ, INC};
            pg8::gemm_phase<pg8::EpiProj, pg8::StaticOrder, PG8_ALIGN, PG8_SP2>(ldsl + RING_OFF, g, S, E);
        }
        SEAM(pb + 0);
        if (IN(pb + 1)) {
#pragma unroll 1
            for (int u = vcu; u < 128; u += G) s5::s5a_unit(l, u & 31, u >> 5, PROJ, ws + WS_S5, ldsl + RING_OFF);
        }
        if (IN(pb + 1)) {
            bf16* O1 = (bf16*)(ws + WS_O1); bf16* O2 = (bf16*)(ws + WS_O2);
#pragma unroll 1
            for (int u = vcu; u < 1024; u += G) { const int i = u >> 8, v = u & 255, combo = v >> 1, sub = v & 1;
                const int qb = ((sub ? 0x4352 : 0x6170) >> (4 * i)) & 7;
                const int b = combo >> 5, rem = combo & 31, h = rem >> 2, mp = (rem >> 1) & 1, vh = rem & 1;
                attn_body::attn_unit<8>(b, qb, (const attn_body::bf16*)(PROJ + nv::C_DQ + h * 128 + mp * 64), (const attn_body::bf16*)(PROJ + nv::C_DK + h * 128 + mp * 64),
                                        (const attn_body::bf16*)(PROJ + nv::C_DV + h * 128 + vh * 64), (attn_body::bf16*)((mp ? O2 : O1) + h * 128 + vh * 64), 1024, (char*)lds + RING_OFF); }
        }
#if !defined(NO_MK_SB)
        if (IN(pb + 1)) {
            bf16* SBO = (bf16*)(ws + WS_SBO);
#pragma unroll 1
            for (int u = vcu; u < 256; u += G) { const int bh = u >> 3, qb = u & 7, b = bh >> 3, h = bh & 7;
                attn_body::sb_unit(b, qb, (const attn_body::bf16*)(PROJ + nv::C_SBQ + h * 64), (const attn_body::bf16*)(PROJ + nv::C_SBK + h * 64),
                                   (const attn_body::bf16*)(PROJ + nv::C_SBV + h * 64), (attn_body::bf16*)(SBO + h * 64), 512, (char*)lds + RING_OFF); }
        }
#endif
        SEAM(pb + 1);
        if (IN(pb + 2)) {
#pragma unroll 1
            for (int u = vcu; u < 256; u += G) s5::post_unit(l, u >> 6, u & 63, args.in, PROJ, (const bf16*)(ws + WS_SBO), (const bf16*)(ws + WS_O1), (const bf16*)(ws + WS_O2), Y, ws + WS_S5, ldsl + RING_OFF);
        }
        SEAM(pb + 2);
        if (IN(pb + 3)) {
            pg8::Gemm g{Y, WoutT + (size_t)l * D * D, T, D, D}; pg8::StaticOrder S; S.init(T, D, G, bx);
            pg8::EpiResF32 E{l == 0 ? args.in[0] : (const float*)H, H, D};
            pg8::gemm_phase<pg8::EpiResF32, pg8::StaticOrder, PG8_ALIGN, PG8_SP2>(ldsl + RING_OFF, g, S, E);
        }
        SEAM(pb + 3);
        gu32* cnt = ctl + CW_CNT + 64 * l;
        if (IN(pb + 4)) { PHASE_IDS();
            const float* gF = args.in[21] + (size_t)l * D; const float* rgw = args.in[22] + (size_t)l * D * 4; const float* rgb = args.in[23] + l * 4;
            const float* rew = args.in[24] + (size_t)l * 4 * D * 8; const float* reb = args.in[25] + l * 32;
            LAS float* hrow = (LAS float*)(ldsl + RING_OFF + wave * 8192);
#pragma unroll 1
            for (int m = gw; m < T; m += NGW) {
                float r;
                { const GAS f32x4* hr = (const GAS f32x4*)(H + (size_t)m * D) + lane; const GAS f32x4* gr = (const GAS f32x4*)gF + lane;
                  f32x4 v[8]; float s = 0.f;
#pragma unroll
                  for (int j = 0; j < 8; ++j) { v[j] = hr[64 * j]; s += (v[j].x * v[j].x + v[j].y * v[j].y) + (v[j].z * v[j].z + v[j].w * v[j].w); }
                  r = rsqrtf(wave_sum(s) * (1.f / D) + EPS);
                  GAS unsigned long long* o8 = (GAS unsigned long long*)(XN + (size_t)m * D) + lane;
#pragma unroll
                  for (int j = 0; j < 8; ++j) { const f32x4 gg = gr[64 * j]; const f32x4 o = v[j] * r * gg;
                      o8[64 * j] = (unsigned long long)pk2(o.x, o.y) | ((unsigned long long)pk2(o.z, o.w) << 32);
                      *(LAS f32x4*)(hrow + 256 * j + 4 * lane) = o; } }
                LDS_WAIT(); asm volatile("" ::: "memory");
                float gl0 = 0.f, gl1 = 0.f, gl2 = 0.f, gl3 = 0.f;
#pragma unroll 4
                for (int jj = 0; jj < 32; ++jj) { const int d = jj * 64 + lane; const float hv = hrow[d]; const f32x4 w = *(const GAS f32x4*)(rgw + (size_t)d * 4);
                    gl0 += hv * w.x; gl1 += hv * w.y; gl2 += hv * w.z; gl3 += hv * w.w; }
                gl0 = wave_sum(gl0) + rgb[0]; gl1 = wave_sum(gl1) + rgb[1]; gl2 = wave_sum(gl2) + rgb[2]; gl3 = wave_sum(gl3) + rgb[3];
                int gi = 0; float gm = gl0;
                if (gl1 > gm) { gm = gl1; gi = 1; } if (gl2 > gm) { gm = gl2; gi = 2; } if (gl3 > gm) { gm = gl3; gi = 3; }
                const float gtop = 1.f / (expf(gl0 - gm) + expf(gl1 - gm) + expf(gl2 - gm) + expf(gl3 - gm));
                gi = __builtin_amdgcn_readfirstlane(gi);
                const float* rw = rew + (size_t)gi * D * 8;
                float e0 = 0.f, e1 = 0.f, e2 = 0.f, e3 = 0.f, e4 = 0.f, e5 = 0.f, e6 = 0.f, e7 = 0.f;
#pragma unroll 4
                for (int jj = 0; jj < 32; ++jj) { const int d = jj * 64 + lane; const float hv = hrow[d]; const GAS f32x4* wp = (const GAS f32x4*)(rw + (size_t)d * 8); const f32x4 w0 = wp[0], w1 = wp[1];
                    e0 += hv * w0.x; e1 += hv * w0.y; e2 += hv * w0.z; e3 += hv * w0.w; e4 += hv * w1.x; e5 += hv * w1.y; e6 += hv * w1.z; e7 += hv * w1.w; }
                float m0 = -INFINITY, m1 = -INFINITY; int i0 = 0, i1 = 0;
#define TOP2(ev, q) do { const float lv = wave_sum(ev) + reb[gi * 8 + (q)]; if (lv > m0) { m1 = m0; i1 = i0; m0 = lv; i0 = (q); } else if (lv > m1) { m1 = lv; i1 = (q); } } while (0)
                TOP2(e0, 0); TOP2(e1, 1); TOP2(e2, 2); TOP2(e3, 3); TOP2(e4, 4); TOP2(e5, 5); TOP2(e6, 6); TOP2(e7, 7);
#undef TOP2
                const float p1 = expf(m1 - m0); const float w0 = 1.f / (1.f + p1) * gtop, w1 = p1 / (1.f + p1) * gtop;
                if (lane == 0) { const int x0 = gi * 8 + i0, x1 = gi * 8 + i1;
                    const unsigned q0 = __hip_atomic_fetch_add(cnt + x0, 1u, RLX_AGENT), q1 = __hip_atomic_fetch_add(cnt + x1, 1u, RLX_AGENT);
                    LIST[x0 * 8192 + q0] = 2 * m; LIST[x1 * 8192 + q1] = 2 * m + 1; GATEW[2 * m] = w0; GATEW[2 * m + 1] = w1;
                    EI[2 * m] = x0; EI[2 * m + 1] = x1; EW[2 * m] = w0; EW[2 * m + 1] = w1; }
                asm volatile("" ::: "memory");
            }
        }
        SEAM(pb + 4);
#define BUILD_TAB() do { PHASE_IDS(); if (wave == 0) { const int c_ = (lane < 32) ? (int)__hip_atomic_load(cnt + (lane & 31), RLX_AGENT) : 0; int incl = (c_ + 255) >> 8; \
            _Pragma("unroll") for (int o = 1; o < 32; o <<= 1) { const int t_ = __shfl_up(incl, o); if (lane >= o) incl += t_; } \
            if (lane < 32) { tab[lane] = c_; tab[33 + lane] = incl; } if (lane == 0) tab[32] = 0; } LDS_WAIT(); __syncthreads(); } while (0)
        if (IN(pb + 5)) {
            BUILD_TAB();
            pg8::GroupedOrder S{(const LAS int*)tab, 4, G, bx, 1024u * 2048u * 2u};
            pg8::Gemm g{XN, W13T + (size_t)l * nv::NEXP * 1024 * D, 0, 0, D};
            pg8::EpiMoe1 E{HB, LIST, GATEW};
            pg8::gemm_phase_g<pg8::EpiMoe1, true>(ldsl + RING_OFF, g, S, E, LIST);
        }
        SEAM(pb + 5);
        if (IN(pb + 6)) {
            BUILD_TAB();
            pg8::GroupedOrder S{(const LAS int*)tab, 8, G, bx, 2048u * 512u * 2u};
            pg8::Gemm g{HB, W2T + (size_t)l * nv::NEXP * D * nv::DE, 0, 0, nv::DE};
            pg8::EpiMoe2 E{YS, LIST};
            pg8::gemm_phase_g<pg8::EpiMoe2, false>(ldsl + RING_OFF, g, S, E, LIST);
        }
        SEAM(pb + 6);
        if (IN(pb + 7)) { PHASE_IDS();
            const bool fin = (l + 1 == DEPTH); const float* gN = fin ? args.in[29] : args.in[1] + (size_t)(l + 1) * D;
            for (int m = gw; m < T; m += NGW) {
                GAS f32x4* hr = (GAS f32x4*)(H + (size_t)m * D) + lane; const GAS f32x4* gr = (const GAS f32x4*)gN + lane;
                typedef unsigned u32x2_t __attribute__((ext_vector_type(2))); const GAS u32x2_t* y0 = (const GAS u32x2_t*)(YS + (size_t)(2 * m) * D) + lane; const GAS u32x2_t* y1 = (const GAS u32x2_t*)(YS + (size_t)(2 * m + 1) * D) + lane;
                f32x4 v[8]; float s = 0.f;
#pragma unroll
                for (int j = 0; j < 8; ++j) { const f32x4 h4 = hr[64 * j]; const u32x2_t a = y0[64 * j], b = y1[64 * j];
                    v[j].x = h4.x + __uint_as_float(a.x << 16) + __uint_as_float(b.x << 16); v[j].y = h4.y + __uint_as_float(a.x & 0xffff0000u) + __uint_as_float(b.x & 0xffff0000u);
                    v[j].z = h4.z + __uint_as_float(a.y << 16) + __uint_as_float(b.y << 16); v[j].w = h4.w + __uint_as_float(a.y & 0xffff0000u) + __uint_as_float(b.y & 0xffff0000u);
                    s += (v[j].x * v[j].x + v[j].y * v[j].y) + (v[j].z * v[j].z + v[j].w * v[j].w); }
                const float r = rsqrtf(wave_sum(s) * (1.f / D) + EPS);
                if (fin) { GAS f32x4* orow = (GAS f32x4*)(args.out + (size_t)m * D) + lane;
#pragma unroll
                    for (int j = 0; j < 8; ++j) orow[64 * j] = v[j] * r * gr[64 * j]; }
                else { GAS unsigned long long* o8 = (GAS unsigned long long*)(XN + (size_t)m * D) + lane;
#pragma unroll
                    for (int j = 0; j < 8; ++j) { hr[64 * j] = v[j]; const f32x4 o = v[j] * r * gr[64 * j]; o8[64 * j] = (unsigned long long)pk2(o.x, o.y) | ((unsigned long long)pk2(o.z, o.w) << 32); } }
            }
        }
        SEAM(pb + 7);
    }
#undef IN
#undef SEAM
}

static int g_grid = 0;
static bool mk_setup() {
    if (g_grid != 0) return g_grid > 0;
    int dev = 0, cus = 0, per_cu = 0;
    if (hipGetDevice(&dev) != hipSuccess || hipDeviceGetAttribute(&cus, hipDeviceAttributeMultiprocessorCount, dev) != hipSuccess) { g_grid = -1; return false; }
    if (hipFuncSetAttribute((const void*)mk_fwd, hipFuncAttributeMaxDynamicSharedMemorySize, LDS_BYTES) != hipSuccess) { fprintf(stderr, "mk: hipFuncSetAttribute failed\n"); g_grid = -1; return false; }
    if (hipOccupancyMaxActiveBlocksPerMultiprocessor(&per_cu, (const void*)mk_fwd, NWAVES * 64, LDS_BYTES) != hipSuccess || per_cu < 1) { fprintf(stderr, "mk: occupancy query says %d\n", per_cu); }
    (void)hipGetLastError();
    g_grid = cus;
    return true;
}
static void mk_launch(const MArgs& base, int lo, int hi, int& li, hipStream_t stream) {
    MArgs a = base; a.ph_lo = lo; a.ph_hi = hi; a.li = li++; a.pad = 0;
    hipLaunchKernelGGL(mk_fwd, dim3(g_grid), dim3(NWAVES * 64), LDS_BYTES, stream, a);
}
}
extern "C" void kernel_launch(void* const* d_in, const int* in_sizes, int n_in, void* d_out, int out_size, void* d_ws, size_t ws_size, hipStream_t stream) {
    using namespace nv;
    if (n_in != 30 || ws_size < mk::WS_END) { fprintf(stderr, "kernel_launch: unexpected n_in %d / ws %zu\n", n_in, ws_size); return; }
    if (!mk::mk_setup()) return;
    const float* x = (const float*)d_in[0];
    const float* norm_mix_g = (const float*)d_in[1]; const float* sb_norm_g = (const float*)d_in[3];
    const float* lam_re = (const float*)d_in[4]; const float* lam_im = (const float*)d_in[5]; const float* b_re = (const float*)d_in[6]; const float* b_im = (const float*)d_in[7];
    const float* c_re = (const float*)d_in[8]; const float* c_im = (const float*)d_in[9]; const float* ssm_d = (const float*)d_in[10]; const float* log_dt = (const float*)d_in[11];
    const float* w_glu = (const float*)d_in[12]; const float* b_glu = (const float*)d_in[13]; const float* ssm_norm_g = (const float*)d_in[14];
    const float* lq1 = (const float*)d_in[15]; const float* lk1 = (const float*)d_in[16]; const float* lq2 = (const float*)d_in[17]; const float* lk2 = (const float*)d_in[18];
    const float* subln = (const float*)d_in[19]; const float* norm_ffn_g = (const float*)d_in[21];
    const float* rgw = (const float*)d_in[22]; const float* rgb = (const float*)d_in[23]; const float* rew = (const float*)d_in[24]; const float* reb = (const float*)d_in[25];
    const float* ew1 = (const float*)d_in[26]; const float* ew3 = (const float*)d_in[27]; const float* ew2 = (const float*)d_in[28]; const float* final_g = (const float*)d_in[29];
    char* ws = (char*)d_ws;
    bf16_t* XN = (bf16_t*)(ws + mk::WS_XN); bf16_t* PROJ = (bf16_t*)(ws + mk::WS_PROJ); bf16_t* SBO = (bf16_t*)(ws + mk::WS_SBO);
    bf16_t* O1 = (bf16_t*)(ws + mk::WS_O1); bf16_t* O2 = (bf16_t*)(ws + mk::WS_O2); bf16_t* Y = (bf16_t*)(ws + mk::WS_Y); float* H = (float*)(ws + mk::WS_H);
    bf16_t* YS = (bf16_t*)(ws + mk::WS_YS);
    float2* ST = (float2*)(ws + mk::WS_S5); float* G1 = (float*)(ws + mk::WS_S5 + 128 * mk::MiB); float* SY = (float*)(ws + mk::WS_S5 + 144 * mk::MiB);
    (void)hipMemsetAsync(ws + mk::WS_CTL, 0, mk::CTL_ZERO_BYTES, stream);
    mk::MArgs a{};
    for (int i = 0; i < 30; ++i) a.in[i] = (const float*)d_in[i];
    a.out = (float*)d_out; a.ws = (unsigned char*)d_ws;
    int li = 0;
    mk::mk_launch(a, 0, mk::NPHASE, li, stream);
}
```

```cpp
#include <hip/hip_runtime.h>
#include <hip/hip_bf16.h>
#include <cstdint>
#include <cstdio>
#include <cmath>
__device__ __forceinline__ int opaque_tid() { int t = threadIdx.x; asm volatile("" : "+v"(t)); return t; }
namespace nv {
constexpr int NB = 4, L = 2048, D = 2048, T = NB * L, DEPTH = 2;
constexpr int SBW = 512, SBH = 8, SSMW = 512, SG = 32, SN = 64, SC = 16, DFW = 1024, DFH = 8, DFV = 128;
constexpr int INC = 5120, NEXP = 32, EPG = 8, NGRP = 4, DE = 512;
constexpr int C_SBQ = 0, C_SBK = 512, C_SBV = 1024, C_U = 1536, C_DQ = 2048, C_DK = 3072, C_DV = 4096;
constexpr float EPS = 1e-6f;
constexpr float LOG2E = 1.4426950408889634f;
constexpr float QS_SB = 0.125f * LOG2E, QS_DF = 0.125f * LOG2E;

typedef unsigned short bf16_t;
__device__ __forceinline__ float bf2f(bf16_t v) { return __uint_as_float(((unsigned)v) << 16); }
__device__ __forceinline__ bf16_t f2bf(float f) { unsigned u = __float_as_uint(f); return (bf16_t)((u + 0x7fffu + ((u >> 16) & 1u)) >> 16); }

__device__ __forceinline__ float block_sum(float v, float* red) {
    for (int o = 32; o > 0; o >>= 1) v += __shfl_xor(v, o);
    const int w = threadIdx.x >> 6, nw = blockDim.x >> 6;
    __syncthreads();
    if ((threadIdx.x & 63) == 0) red[w] = v;
    __syncthreads();
    float s = 0.f;
    for (int i = 0; i < nw; ++i) s += red[i];
    return s;
}
__device__ __forceinline__ float block_max(float v, float* red) {
    for (int o = 32; o > 0; o >>= 1) v = fmaxf(v, __shfl_xor(v, o));
    const int w = threadIdx.x >> 6, nw = blockDim.x >> 6;
    __syncthreads();
    if ((threadIdx.x & 63) == 0) red[w] = v;
    __syncthreads();
    float s = -INFINITY;
    for (int i = 0; i < nw; ++i) s = fmaxf(s, red[i]);
    return s;
}

__global__ void __launch_bounds__(256) k_rmsnorm(const float* __restrict__ x, const float* __restrict__ g, bf16_t* __restrict__ out) {
    __shared__ float red[16];
    const int t = blockIdx.x; const float* xr = x + (size_t)t * D;
    float v[8]; float s = 0.f;
    for (int i = 0; i < 8; ++i) { v[i] = xr[threadIdx.x + 256 * i]; s += v[i] * v[i]; }
    s = block_sum(s, red);
    const float r = rsqrtf(s / D + EPS);
    for (int i = 0; i < 8; ++i) out[(size_t)t * D + threadIdx.x + 256 * i] = f2bf(v[i] * r * g[threadIdx.x + 256 * i]);
}

template <int EPI>
__global__ void __launch_bounds__(256) k_gemm(const bf16_t* __restrict__ A, int lda, const float* __restrict__ Bm, int ldb, int K,
                                             void* __restrict__ Cout, int ldc, const float* __restrict__ R) {
    __shared__ float As[16][68];
    __shared__ float Bs[16][68];
    const int tx = threadIdx.x & 15, ty = threadIdx.x >> 4;
    const int m0 = blockIdx.y * 64, n0 = blockIdx.x * 64;
    float acc[4][4];
    for (int i = 0; i < 4; ++i) for (int j = 0; j < 4; ++j) acc[i][j] = 0.f;
    for (int k0 = 0; k0 < K; k0 += 16) {
        for (int e = threadIdx.x; e < 64 * 16; e += 256) { const int r = e >> 4, c = e & 15; As[c][r] = bf2f(A[(size_t)(m0 + r) * lda + k0 + c]); }
        for (int e = threadIdx.x; e < 64 * 16; e += 256) { const int r = e >> 6, c = e & 63; Bs[r][c] = Bm[(size_t)(k0 + r) * ldb + n0 + c]; }
        __syncthreads();
#pragma unroll
        for (int k = 0; k < 16; ++k) {
            float a[4], b[4];
            for (int i = 0; i < 4; ++i) a[i] = As[k][ty * 4 + i];
            for (int j = 0; j < 4; ++j) b[j] = Bs[k][tx * 4 + j];
            for (int i = 0; i < 4; ++i) for (int j = 0; j < 4; ++j) acc[i][j] += a[i] * b[j];
        }
        __syncthreads();
    }
    for (int i = 0; i < 4; ++i) for (int j = 0; j < 4; ++j) {
        const int m = m0 + ty * 4 + i, n = n0 + tx * 4 + j;
        if (EPI == 0) {
            float sc = 1.f; if (n < C_SBK) sc = QS_SB; else if (n >= C_DQ && n < C_DK) sc = QS_DF;
            ((bf16_t*)Cout)[(size_t)m * ldc + n] = f2bf(acc[i][j] * sc);
        } else {
            ((float*)Cout)[(size_t)m * ldc + n] = acc[i][j] + R[(size_t)m * ldc + n];
        }
    }
}

__global__ void __launch_bounds__(256) k_sb_attn(const bf16_t* __restrict__ P, bf16_t* __restrict__ O) {
    __shared__ float zs[L];
    __shared__ float qv[64];
    __shared__ float part[4][64];
    const int t = blockIdx.x, h = blockIdx.y, b = blockIdx.z, tid = threadIdx.x;
    const size_t rowb = (size_t)b * L;
    if (tid < 64) qv[tid] = bf2f(P[(rowb + t) * INC + C_SBQ + h * 64 + tid]);
    __syncthreads();
    for (int s = tid; s < t; s += 256) {
        const bf16_t* kr = P + (rowb + s) * INC + C_SBK + h * 64;
        float z = 0.f;
        for (int d = 0; d < 64; ++d) z += qv[d] * bf2f(kr[d]);
        zs[s] = z;
    }
    __syncthreads();
    if (tid == 0) {
        float Racc = 0.f;
        for (int s = t - 1; s >= 0; --s) {
            const float z = zs[s];
            const float sp = fmaxf(-z, 0.f) + log1pf(expf(-fabsf(z)));
            zs[s] = expf(-sp + Racc);
            Racc += -(sp + z);
        }
    }
    __syncthreads();
    const int d = tid & 63, gq = tid >> 6;
    float o = 0.f;
    for (int s = gq; s < t; s += 4) o += zs[s] * bf2f(P[(rowb + s) * INC + C_SBV + h * 64 + d]);
    part[gq][d] = o;
    __syncthreads();
    if (tid < 64) O[(rowb + t) * SBW + h * 64 + tid] = f2bf(part[0][tid] + part[1][tid] + part[2][tid] + part[3][tid]);
}

__global__ void __launch_bounds__(256) k_diff_attn(const bf16_t* __restrict__ P, bf16_t* __restrict__ O1, bf16_t* __restrict__ O2) {
    __shared__ float ps[L];
    __shared__ float qv[64];
    __shared__ float part[2][128];
    __shared__ float red[16];
    const int t = blockIdx.x, h = blockIdx.y >> 1, mp = blockIdx.y & 1, b = blockIdx.z, tid = threadIdx.x;
    const size_t rowb = (size_t)b * L;
    if (tid < 64) qv[tid] = bf2f(P[(rowb + t) * INC + C_DQ + h * 128 + mp * 64 + tid]);
    __syncthreads();
    float mx = -INFINITY;
    for (int s = tid; s <= t; s += 256) {
        const bf16_t* kr = P + (rowb + s) * INC + C_DK + h * 128 + mp * 64;
        float z = 0.f;
        for (int d = 0; d < 64; ++d) z += qv[d] * bf2f(kr[d]);
        ps[s] = z; mx = fmaxf(mx, z);
    }
    mx = block_max(mx, red);
    float sum = 0.f;
    for (int s = tid; s <= t; s += 256) { const float p = exp2f(ps[s] - mx); ps[s] = p; sum += p; }
    sum = block_sum(sum, red);
    __syncthreads();
    const int d = tid & 127, gq = tid >> 7;
    float o = 0.f;
    for (int s = gq; s <= t; s += 2) o += ps[s] * bf2f(P[(rowb + s) * INC + C_DV + h * 128 + d]);
    part[gq][d] = o;
    __syncthreads();
    if (tid < 128) { bf16_t* O = mp ? O2 : O1; O[(rowb + t) * DFW + h * 128 + tid] = f2bf((part[0][tid] + part[1][tid]) / sum); }
}

__global__ void __launch_bounds__(64) k_s5_scan(const bf16_t* __restrict__ P, const float* lam_re, const float* lam_im, const float* b_re, const float* b_im,
                                                const float* log_dt, float2* __restrict__ ST) {
    const int b = blockIdx.x / SG, g = blockIdx.x % SG, n = threadIdx.x;
    const double dt = exp((double)log_dt[g]);
    const double lr = lam_re[g * SN + n], li = lam_im[g * SN + n];
    const double er = exp(lr * dt), lbr = er * cos(li * dt), lbi = er * sin(li * dt);
    const double nr = lbr - 1.0, ni = lbi, den = lr * lr + li * li;
    const double fr = (nr * lr + ni * li) / den, fi = (ni * lr - nr * li) / den;
    float bbr[SC], bbi[SC];
#pragma unroll
    for (int c = 0; c < SC; ++c) { const double br = b_re[(g * SN + n) * SC + c], bi = b_im[(g * SN + n) * SC + c]; bbr[c] = (float)(fr * br - fi * bi); bbi[c] = (float)(fr * bi + fi * br); }
    const float ar = (float)lbr, ai = (float)lbi;
    float sr = 0.f, si = 0.f;
    for (int t = 0; t < L; ++t) {
        const bf16_t* ur = P + ((size_t)b * L + t) * INC + C_U + g * SC;
        float bur = 0.f, bui = 0.f;
#pragma unroll
        for (int c = 0; c < SC; ++c) { const float u = bf2f(ur[c]); bur += bbr[c] * u; bui += bbi[c] * u; }
        const float nsr = ar * sr - ai * si + bur, nsi = ar * si + ai * sr + bui;
        sr = nsr; si = nsi;
        ST[(((size_t)b * L + t) * SG + g) * SN + n] = make_float2(sr, si);
    }
}
__device__ __forceinline__ float gelu_tanh(float x) { const float u = 0.7978845608028654f * (x + 0.044715f * x * x * x); return 0.5f * x * (1.f + tanhf(u)); }
__global__ void __launch_bounds__(256) k_s5_out(const bf16_t* __restrict__ P, const float2* __restrict__ ST, const float* c_re, const float* c_im, const float* dsk, float* __restrict__ G1) {
    const size_t idx = (size_t)blockIdx.x * 256 + threadIdx.x;
    const int ch = (int)(idx % SSMW); const size_t t = idx / SSMW; const int g = ch / SC, c = ch % SC;
    const float2* st = ST + (t * SG + g) * SN;
    float y = 0.f;
    for (int n = 0; n < SN; ++n) { const float2 s = st[n]; y += c_re[(g * SC + c) * SN + n] * s.x - c_im[(g * SC + c) * SN + n] * s.y; }
    y += dsk[g * SC + c] * bf2f(P[t * INC + C_U + ch]);
    G1[idx] = gelu_tanh(y);
}
__global__ void __launch_bounds__(512) k_glu(const float* __restrict__ G1, const float* __restrict__ w, const float* __restrict__ bg, float* __restrict__ SY) {
    __shared__ float row[SSMW];
    const int t = blockIdx.x, j = threadIdx.x;
    row[j] = G1[(size_t)t * SSMW + j];
    __syncthreads();
    float z = bg[j];
    for (int k = 0; k < SSMW; ++k) z += row[k] * w[(size_t)k * SSMW + j];
    SY[(size_t)t * SSMW + j] = row[j] / (1.f + expf(-z));
}
__global__ void __launch_bounds__(256) k_post(const bf16_t* __restrict__ SBO, const float* __restrict__ SY, const bf16_t* __restrict__ O1, const bf16_t* __restrict__ O2,
                                             const float* sbg, const float* ssmg, const float* dfg, const float* lq1, const float* lk1, const float* lq2, const float* lk2,
                                             float lam_init, bf16_t* __restrict__ Y) {
    __shared__ float red[16];
    const int t = blockIdx.x, tid = threadIdx.x;
    float a = 0.f, c = 0.f;
    if (tid < 64) { a = lq1[tid] * lk1[tid]; c = lq2[tid] * lk2[tid]; }
    a = block_sum(a, red); c = block_sum(c, red);
    const float lam = expf(a) - expf(c) + lam_init;
    { float v0 = bf2f(SBO[(size_t)t * SBW + tid]), v1 = bf2f(SBO[(size_t)t * SBW + 256 + tid]);
      const float s = block_sum(v0 * v0 + v1 * v1, red); const float r = rsqrtf(s / SBW + EPS);
      Y[(size_t)t * D + tid] = f2bf(v0 * r * sbg[tid]); Y[(size_t)t * D + 256 + tid] = f2bf(v1 * r * sbg[256 + tid]); }
    { float v0 = SY[(size_t)t * SSMW + tid], v1 = SY[(size_t)t * SSMW + 256 + tid];
      const float s = block_sum(v0 * v0 + v1 * v1, red); const float r = rsqrtf(s / SSMW + EPS);
      Y[(size_t)t * D + 512 + tid] = f2bf(v0 * r * ssmg[tid]); Y[(size_t)t * D + 768 + tid] = f2bf(v1 * r * ssmg[256 + tid]); }
    for (int i = 0; i < 4; ++i) {
        const int e = tid + 256 * i; const int dv = e & 127;
        const float v = bf2f(O1[(size_t)t * DFW + e]) - lam * bf2f(O2[(size_t)t * DFW + e]);
        float s = v * v;
        for (int o = 32; o > 0; o >>= 1) s += __shfl_xor(s, o);
        __syncthreads();
        if ((tid & 63) == 0) red[tid >> 6] = s;
        __syncthreads();
        const int w = tid >> 6; const float tot = red[w & ~1] + red[(w & ~1) + 1];
        const float r = rsqrtf(tot / DFV + EPS);
        Y[(size_t)t * D + 1024 + e] = f2bf(v * r * dfg[dv] * (1.f - lam_init));
    }
}
__global__ void __launch_bounds__(256) k_route(const float* __restrict__ H, const float* __restrict__ g, const float* __restrict__ rgw, const float* __restrict__ rgb,
                                              const float* __restrict__ rew, const float* __restrict__ reb, bf16_t* __restrict__ HN, int* __restrict__ EI, float* __restrict__ EW) {
    __shared__ float red[16];
    __shared__ float hn[D];
    const int t = blockIdx.x, tid = threadIdx.x;
    float s = 0.f;
    for (int i = 0; i < 8; ++i) { const float v = H[(size_t)t * D + tid + 256 * i]; hn[tid + 256 * i] = v; s += v * v; }
    s = block_sum(s, red);
    const float r = rsqrtf(s / D + EPS);
    for (int i = 0; i < 8; ++i) { const int d = tid + 256 * i; const float v = hn[d] * r * g[d]; hn[d] = v; HN[(size_t)t * D + d] = f2bf(v); }
    __syncthreads();
    float gl[NGRP];
#pragma unroll
    for (int j = 0; j < NGRP; ++j) { float p = 0.f; for (int i = 0; i < 8; ++i) { const int d = tid + 256 * i; p += hn[d] * rgw[(size_t)d * NGRP + j]; } gl[j] = block_sum(p, red) + rgb[j]; }
    int gi = 0; float gm = gl[0];
#pragma unroll
    for (int j = 1; j < NGRP; ++j) if (gl[j] > gm) { gm = gl[j]; gi = j; }
    float gs = 0.f;
#pragma unroll
    for (int j = 0; j < NGRP; ++j) gs += expf(gl[j] - gm);
    const float gtop = 1.f / gs;
    float m0 = -INFINITY, m1 = -INFINITY; int i0 = 0, i1 = 0;
#pragma unroll
    for (int e = 0; e < EPG; ++e) { float p = 0.f; for (int i = 0; i < 8; ++i) { const int d = tid + 256 * i; p += hn[d] * rew[((size_t)gi * D + d) * EPG + e]; }
        const float v = block_sum(p, red) + reb[gi * EPG + e];
        if (v > m0) { m1 = m0; i1 = i0; m0 = v; i0 = e; } else if (v > m1) { m1 = v; i1 = e; } }
    const float p1 = expf(m1 - m0);
    const float w0 = 1.f / (1.f + p1) * gtop, w1 = p1 / (1.f + p1) * gtop;
    if (tid == 0) { EI[t * 2] = gi * EPG + i0; EI[t * 2 + 1] = gi * EPG + i1; EW[t * 2] = w0; EW[t * 2 + 1] = w1; }
}
__global__ void __launch_bounds__(512) k_moe_h(const bf16_t* __restrict__ HN, const int* __restrict__ EI, const float* __restrict__ EW, const float* __restrict__ w1, const float* __restrict__ w3, float* __restrict__ HB) {
    __shared__ float xr[D];
    const int ts = blockIdx.x, t = ts >> 1, f = threadIdx.x;
    for (int i = 0; i < 4; ++i) xr[f + 512 * i] = bf2f(HN[(size_t)t * D + f + 512 * i]);
    __syncthreads();
    const int e = EI[ts]; const float gw = EW[ts];
    const float* a1 = w1 + (size_t)e * D * DE + f; const float* a3 = w3 + (size_t)e * D * DE + f;
    float a = 0.f, b = 0.f;
    for (int d = 0; d < D; ++d) { a += xr[d] * a1[(size_t)d * DE]; b += xr[d] * a3[(size_t)d * DE]; }
    HB[(size_t)ts * DE + f] = a / (1.f + expf(-a)) * b * gw;
}
__global__ void __launch_bounds__(512) k_moe_y(const float* __restrict__ HB, const int* __restrict__ EI, const float* __restrict__ w2, bf16_t* __restrict__ YS) {
    __shared__ float hr[DE];
    const int ts = blockIdx.x, j = threadIdx.x;
    hr[j] = HB[(size_t)ts * DE + j];
    __syncthreads();
    const int e = EI[ts];
    const float* w = w2 + (size_t)e * DE * D;
    float acc[4] = {0.f, 0.f, 0.f, 0.f};
    for (int f = 0; f < DE; ++f) { const float hv = hr[f]; for (int i = 0; i < 4; ++i) acc[i] += hv * w[(size_t)f * D + j + 512 * i]; }
    for (int i = 0; i < 4; ++i) YS[(size_t)ts * D + j + 512 * i] = f2bf(acc[i]);
}
__global__ void __launch_bounds__(256) k_combine(float* __restrict__ H, const bf16_t* __restrict__ YS, const float* __restrict__ g, bf16_t* __restrict__ XN, float* __restrict__ out) {
    __shared__ float red[16];
    const int t = blockIdx.x, tid = threadIdx.x;
    float v[8]; float s = 0.f;
    for (int i = 0; i < 8; ++i) { const int d = tid + 256 * i; v[i] = H[(size_t)t * D + d] + bf2f(YS[((size_t)t * 2) * D + d]) + bf2f(YS[((size_t)t * 2 + 1) * D + d]); s += v[i] * v[i]; }
    s = block_sum(s, red);
    const float r = rsqrtf(s / D + EPS);
    for (int i = 0; i < 8; ++i) { const int d = tid + 256 * i;
        if (out) out[(size_t)t * D + d] = v[i] * r * g[d];
        else { H[(size_t)t * D + d] = v[i]; XN[(size_t)t * D + d] = f2bf(v[i] * r * g[d]); } }
}
}

namespace pg8 {
#define PG8_LAS __attribute__((address_space(3)))
typedef unsigned short bf16_t;
typedef short bf16x8 __attribute__((ext_vector_type(8)));
typedef float f32x4 __attribute__((ext_vector_type(4)));
typedef unsigned u32x4 __attribute__((ext_vector_type(4)));
constexpr int BM = 256, BK = 64, HALF = 128, HTB = HALF * BK * 2  , STAGE_BYTES = 8 * HTB, NXCD = 8, WGM = 8;

__host__ __device__ __forceinline__ int lds_byte(int r, int c) { const int st = (r >> 4) * 2 + (c >> 5), rr = r & 15, cc = c & 31, ob = rr * 64 + cc * 2; return st * 1024 + (ob ^ (((ob >> 9) & 1) << 5)); }
__host__ __device__ __forceinline__ void stage_rc(int b, int& R, int& C) { const int st = b / 1024, sb = b % 1024, swz = sb ^ (((sb >> 9) & 1) << 5); R = (st >> 1) * 16 + swz / 64; C = (st & 1) * 32 + (swz % 64) / 2; }
__host__ __device__ __forceinline__ int perm32(int rho) { const int n = rho >> 4, i = rho & 15; return 8 * (i >> 2) + 4 * n + (i & 3); }

struct Unit { int pm, pn; };
struct Gemm { const bf16_t* A; const bf16_t* Bt; int M, N, K; };

struct StaticOrder {
    int nM, nN, nwg, G, c;
    __host__ __device__ void init(int M, int N, int G_, int c_) { nM = M / BM; nN = N / BM; nwg = nM * nN; G = G_; c = c_; }
    __host__ __device__ bool next(int i, Unit& u) const {
        const long L = (long)i * G + c; if (L >= nwg) return false;
        int wgid = (int)L; { const int q = nwg / NXCD, r = nwg % NXCD, xcd = wgid % NXCD, off = wgid / NXCD; wgid = (xcd < r ? xcd * (q + 1) : r * (q + 1) + (xcd - r) * q) + off; }
        const int nig = WGM * nN, gid = wgid / nig, fm = gid * WGM, gsz = (nM - fm) < WGM ? (nM - fm) : WGM;
        u.pm = fm + ((wgid % nig) % gsz); u.pn = (wgid % nig) / gsz; return true;
    }
    __device__ __forceinline__ void a_ready(const Unit&) const {}
    __device__ __forceinline__ void done(const Unit&) const {}
};

__device__ __forceinline__ unsigned cvt_pk_bf16(float lo, float hi) { unsigned r; asm volatile("v_cvt_pk_bf16_f32 %0, %1, %2" : "=v"(r) : "v"(lo), "v"(hi)); return r; }
typedef float f32x2 __attribute__((ext_vector_type(2)));
__device__ __forceinline__ f32x2 gelu_pk(f32x2 v) {
    const f32x2 av = __builtin_elementwise_abs(v), d = av * 0.2316418882f + 1.0f;
    f32x2 t; t.x = __builtin_amdgcn_rcpf(d.x); t.y = __builtin_amdgcn_rcpf(d.y);
    f32x2 q = t * 0.5307027145f + (-0.7265760135f); q = q * t + 0.7107068705f; q = q * t + (-0.142248368f); q = q * t + 0.127414796f; q = q * t;
    const f32x2 s = (v * v) * (-0.72134752044f);
    f32x2 e; e.x = __builtin_amdgcn_exp2f(s.x); e.y = __builtin_amdgcn_exp2f(s.y);
    const f32x2 m = v * (q * e), r = v - m;
    f32x2 o; o.x = v.x < 0.f ? m.x : r.x; o.y = v.y < 0.f ? m.y : r.y; return o;
}

template <int ACT  > struct EpiBf16 {
    static constexpr bool PERM = true, AFTER_DRAIN = false; static_assert(ACT == 0 || ACT == 1, "EpiBf16: ACT is 0 (none) or 1 (gelu_pk)");
    bf16_t* O; int ldc; const float* bias; int split_cols; size_t split_stride; float scale0;
    __device__ __forceinline__ void operator()(const f32x4 (&acc)[2][2][4][2], const Unit& u, int wr, int wc, int fr, int fq) const {
        const int row0 = u.pm * BM + wr * 64 + fr; int colt = u.pn * BM; bf16_t* base = O;
        float sc = 1.f; if (split_cols) { const int t = colt / split_cols; base += (size_t)t * split_stride; colt -= t * split_cols; if (t == 0) sc = scale0; }
        const int col0 = colt + wc * 32 + 8 * fq, bcol0 = u.pn * BM + wc * 32 + 8 * fq;
        f32x4 bv[2][2];
#pragma unroll
        for (int bj = 0; bj < 2; ++bj)
#pragma unroll
            for (int n = 0; n < 2; ++n) bv[bj][n] = bias ? *(const f32x4*)(bias + bcol0 + bj * HALF + 4 * n) : (f32x4){0.f, 0.f, 0.f, 0.f};
#pragma unroll
        for (int ai = 0; ai < 2; ++ai)
#pragma unroll
            for (int m = 0; m < 4; ++m) { bf16_t* rowp = base + (size_t)(row0 + ai * HALF + m * 16) * ldc + col0;
#pragma unroll
                for (int bj = 0; bj < 2; ++bj) { f32x4 v0 = acc[ai][bj][m][0] + bv[bj][0], v1 = acc[ai][bj][m][1] + bv[bj][1];
                    if (ACT == 1) { f32x2 a = gelu_pk((f32x2){v0[0], v0[1]}), b = gelu_pk((f32x2){v0[2], v0[3]}), c = gelu_pk((f32x2){v1[0], v1[1]}), d = gelu_pk((f32x2){v1[2], v1[3]});
                        v0 = (f32x4){a.x, a.y, b.x, b.y}; v1 = (f32x4){c.x, c.y, d.x, d.y}; }
                    v0 = v0 * sc; v1 = v1 * sc; u32x4 w; w.x = cvt_pk_bf16(v0[0], v0[1]); w.y = cvt_pk_bf16(v0[2], v0[3]); w.z = cvt_pk_bf16(v1[0], v1[1]); w.w = cvt_pk_bf16(v1[2], v1[3]);
                    *(u32x4*)(rowp + bj * HALF) = w; } }
    }
};
template <class Epi, class Sched, bool ALIGN_EPI = false, bool SP2 = false>
__device__ __forceinline__ void gemm_phase(PG8_LAS unsigned char* lds, const Gemm g, const Sched& S, const Epi& E) {
    const int tid = opaque_tid(), wid = __builtin_amdgcn_readfirstlane(tid >> 6), lane = tid & 63, wr = wid >> 2, wc = wid & 3, fr = lane & 15, fq = lane >> 4;
    const int K = g.K, nt = K / BK;
    unsigned voffA[2], voffB[2];
#pragma unroll
    for (int i = 0; i < 2; ++i) { int R, C; stage_rc(tid * 16 + i * 8192, R, C); const int Rb = Epi::PERM ? ((R & ~31) + perm32(R & 31)) : R;
        voffA[i] = (unsigned)(R * K + C) * 2u; voffB[i] = (unsigned)(Rb * K + C) * 2u; }
    const size_t kstep = (size_t)(BK * 2);
    const size_t hstep = (size_t)HALF * K * 2;
    const size_t tstep = 2 * hstep;
    const unsigned ldsw = (unsigned)wid * 1024u;
    const int aoff = lds_byte(wr * 64 + fr, fq * 8), boff = lds_byte(wc * 32 + fr, fq * 8);
#define PG8_SA(b, h) (((b) * 2 + (h)) * HTB)
#define PG8_SB(b, h) ((4 + (b) * 2 + (h)) * HTB)
#define PG8_STAGE(bufoff, gbase, voff) do { _Pragma("unroll") for (int _i = 0; _i < 2; ++_i) \
        __builtin_amdgcn_global_load_lds((const unsigned*)((const char*)(gbase) + (voff)[_i]), (PG8_LAS unsigned*)(lds + (bufoff) + ldsw + _i * 8192), 16, 0, 0); } while (0)
#define PG8_LDA(dst, b, h) do { _Pragma("unroll") for (int m = 0; m < 4; ++m) _Pragma("unroll") for (int k = 0; k < 2; ++k) dst[m][k] = *(const PG8_LAS bf16x8*)(lds + PG8_SA(b, h) + aoff + m * 2048 + k * 1024); } while (0)
#define PG8_LDB(dst, b, h) do { _Pragma("unroll") for (int n = 0; n < 2; ++n) _Pragma("unroll") for (int k = 0; k < 2; ++k) dst[n][k] = *(const PG8_LAS bf16x8*)(lds + PG8_SB(b, h) + boff + n * 2048 + k * 1024); } while (0)
#define PG8_MMA(ai, bj, At, Bt) do { __builtin_amdgcn_s_setprio(1); _Pragma("unroll") for (int m = 0; m < 4; ++m) _Pragma("unroll") for (int n = 0; n < 2; ++n) _Pragma("unroll") for (int k = 0; k < 2; ++k) \
        acc[ai][bj][m][n] = __builtin_amdgcn_mfma_f32_16x16x32_bf16(Bt[n][k], At[m][k], acc[ai][bj][m][n], 0, 0, 0); __builtin_amdgcn_s_setprio(0); } while (0)
#define PG8_WAIT_V(n) asm volatile("s_waitcnt vmcnt(" #n ")" ::: "memory")
#define PG8_WAIT_L(n) asm volatile("s_waitcnt lgkmcnt(" #n ")" ::: "memory")
#define PG8_BAR __builtin_amdgcn_s_barrier()
#define PG8_SCHED __builtin_amdgcn_sched_barrier(0)
    Unit cur, nxt; int ui = 0;
    if (!S.next(0, cur)) return;
    f32x4 acc[2][2][4][2];
#pragma unroll
    for (int a = 0; a < 2; ++a)
#pragma unroll
        for (int b = 0; b < 2; ++b)
#pragma unroll
            for (int m = 0; m < 4; ++m)
#pragma unroll
                for (int n = 0; n < 2; ++n) acc[a][b][m][n] = (f32x4){0.f, 0.f, 0.f, 0.f};
    bf16x8 At[4][2], B0[2][2], B1[2][2];
    const char* cA = (const char*)g.A + (size_t)cur.pm * tstep; const char* cB = (const char*)g.Bt + (size_t)cur.pn * tstep;
    S.a_ready(cur);
    if constexpr (SP2) {
        PG8_STAGE(PG8_SB(0, 0), cB, voffB); PG8_STAGE(PG8_SB(0, 1), cB + hstep, voffB); PG8_STAGE(PG8_SA(0, 0), cA, voffA); PG8_STAGE(PG8_SA(0, 1), cA + hstep, voffA);
        if (wr == 1) PG8_BAR;
        PG8_WAIT_V(2); PG8_BAR;
        PG8_STAGE(PG8_SB(1, 0), cB + kstep, voffB); PG8_STAGE(PG8_SA(1, 0), cA + kstep, voffA); PG8_STAGE(PG8_SB(1, 1), cB + hstep + kstep, voffB);
        PG8_WAIT_V(6); PG8_BAR;
    } else {
        PG8_STAGE(PG8_SB(0, 0), cB, voffB); PG8_STAGE(PG8_SA(0, 0), cA, voffA); PG8_STAGE(PG8_SB(0, 1), cB + hstep, voffB); PG8_STAGE(PG8_SA(0, 1), cA + hstep, voffA);
        if (wr == 1) PG8_BAR;
        PG8_WAIT_V(4); PG8_BAR;
        PG8_STAGE(PG8_SB(1, 0), cB + kstep, voffB); PG8_STAGE(PG8_SA(1, 0), cA + kstep, voffA); PG8_STAGE(PG8_SB(1, 1), cB + hstep + kstep, voffB);
        PG8_WAIT_V(6); PG8_BAR;
    }
    for (;;) {
        const bool has_next = S.next(ui + 1, nxt);
        const char* nA = has_next ? (const char*)g.A + (size_t)nxt.pm * tstep : cA; const char* nB = has_next ? (const char*)g.Bt + (size_t)nxt.pn * tstep : cB;
        for (int t = 0; t < nt; t += 2) {
            const bool last = (t == nt - 2);
            const char* a1 = cA + (size_t)(t + 1) * kstep;
            const char* a2 = last ? nA : cA + (size_t)(t + 2) * kstep; const char* b2 = last ? nB : cB + (size_t)(t + 2) * kstep;
            const char* a3 = a2 + kstep; const char* b3 = b2 + kstep;
            if (last && has_next) S.a_ready(nxt);
            if constexpr (SP2) {
            PG8_LDB(B0, 0, 0); PG8_LDB(B1, 0, 1); PG8_SCHED; PG8_LDA(At, 0, 0); PG8_STAGE(PG8_SA(1, 1), a1 + hstep, voffA);
            PG8_WAIT_V(8); PG8_WAIT_L(0); PG8_BAR; PG8_MMA(0, 0, At, B0); PG8_MMA(0, 1, At, B1); PG8_BAR; PG8_SCHED;
            PG8_LDA(At, 0, 1); PG8_STAGE(PG8_SB(0, 0), b2, voffB); PG8_STAGE(PG8_SB(0, 1), b2 + hstep, voffB); PG8_STAGE(PG8_SA(0, 0), a2, voffA);
            PG8_WAIT_V(8); PG8_WAIT_L(0); PG8_BAR; PG8_MMA(1, 0, At, B0); PG8_MMA(1, 1, At, B1); PG8_BAR; PG8_SCHED;
            PG8_LDB(B0, 1, 0); PG8_LDB(B1, 1, 1); PG8_SCHED; PG8_LDA(At, 1, 0); PG8_STAGE(PG8_SA(0, 1), a2 + hstep, voffA);
            PG8_WAIT_V(8); PG8_WAIT_L(0); PG8_BAR; PG8_MMA(0, 0, At, B0); PG8_MMA(0, 1, At, B1); PG8_BAR; PG8_SCHED;
            PG8_LDA(At, 1, 1); PG8_STAGE(PG8_SB(1, 0), b3, voffB); PG8_STAGE(PG8_SB(1, 1), b3 + hstep, voffB); PG8_STAGE(PG8_SA(1, 0), a3, voffA);
            PG8_WAIT_V(8); PG8_WAIT_L(0); PG8_BAR; PG8_MMA(1, 0, At, B0); PG8_MMA(1, 1, At, B1); PG8_BAR; PG8_SCHED;
            } else {
            PG8_LDB(B0, 0, 0); PG8_SCHED; PG8_LDA(At, 0, 0); PG8_STAGE(PG8_SA(1, 1), a1 + hstep, voffA);
            PG8_WAIT_L(8); PG8_BAR; PG8_WAIT_L(0); PG8_MMA(0, 0, At, B0); PG8_BAR; PG8_SCHED;
            PG8_LDB(B1, 0, 1); PG8_STAGE(PG8_SB(0, 0), b2, voffB);
            PG8_BAR; PG8_WAIT_L(0); PG8_MMA(0, 1, At, B1); PG8_BAR;
            PG8_LDA(At, 0, 1); PG8_STAGE(PG8_SA(0, 0), a2, voffA);
            PG8_BAR; PG8_WAIT_L(0); PG8_MMA(1, 0, At, B0); PG8_BAR; PG8_SCHED;
            PG8_STAGE(PG8_SB(0, 1), b2 + hstep, voffB);
            PG8_WAIT_V(6); PG8_BAR; PG8_MMA(1, 1, At, B1); PG8_BAR;
            PG8_LDB(B0, 1, 0); PG8_SCHED; PG8_LDA(At, 1, 0); PG8_STAGE(PG8_SA(0, 1), a2 + hstep, voffA);
            PG8_WAIT_L(8); PG8_BAR; PG8_WAIT_L(0); PG8_MMA(0, 0, At, B0); PG8_BAR; PG8_SCHED;
            PG8_LDB(B1, 1, 1); PG8_STAGE(PG8_SB(1, 0), b3, voffB);
            PG8_BAR; PG8_WAIT_L(0); PG8_MMA(0, 1, At, B1); PG8_BAR;
            PG8_LDA(At, 1, 1); PG8_STAGE(PG8_SA(1, 0), a3, voffA);
            PG8_BAR; PG8_WAIT_L(0); PG8_MMA(1, 0, At, B0); PG8_BAR; PG8_SCHED;
            PG8_STAGE(PG8_SB(1, 1), b3 + hstep, voffB);
            PG8_WAIT_V(6); PG8_BAR; PG8_MMA(1, 1, At, B1); PG8_BAR;
            }
        }
        if constexpr (ALIGN_EPI) { if (wr == 0) PG8_BAR; }
        if constexpr (!Epi::AFTER_DRAIN) { E(acc, cur, wr, wc, fr, fq); S.done(cur); }
        if (!has_next) break;
#pragma unroll
        for (int a = 0; a < 2; ++a)
#pragma unroll
            for (int b = 0; b < 2; ++b)
#pragma unroll
                for (int m = 0; m < 4; ++m)
#pragma unroll
                    for (int n = 0; n < 2; ++n) acc[a][b][m][n] = (f32x4){0.f, 0.f, 0.f, 0.f};
        cur = nxt; cA = nA; cB = nB; ++ui;
        if constexpr (ALIGN_EPI) { if (wr == 1) PG8_BAR; }
    }
    PG8_WAIT_V(0);
    if constexpr (!ALIGN_EPI) { if (wr == 0) PG8_BAR; }
    PG8_BAR;
    if constexpr (Epi::AFTER_DRAIN) { E.fused(acc, cur, wr, wc, fr, fq, lds, wid, lane); S.done(cur); }
#undef PG8_SA
#undef PG8_SB
#undef PG8_STAGE
#undef PG8_LDA
#undef PG8_LDB
#undef PG8_MMA
#undef PG8_WAIT_V
#undef PG8_WAIT_L
#undef PG8_BAR
#undef PG8_SCHED
}
}

#ifndef PG8_SP2
#define PG8_SP2 true
#endif
#ifndef PG8_ALIGN
#define PG8_ALIGN true
#endif
namespace pg8 {
struct UnitG { int pm, pn, e, r0, nvalid; unsigned boff; };
struct GroupedOrder {
    const PG8_LAS int* tab; int nN, G, c; unsigned bstride;
    __device__ __forceinline__ bool next(int i, UnitG& u) const {
        const int Lx = i * G + c; const int total = __builtin_amdgcn_readfirstlane(tab[64]) * nN; if (Lx >= total) return false;
        int e = 0;
#pragma unroll 4
        for (int k = 1; k < 32; ++k) { const int s = __builtin_amdgcn_readfirstlane(tab[32 + k]) * nN; if (Lx >= s) e = k; }
        const int m0 = __builtin_amdgcn_readfirstlane(tab[32 + e]), m1 = __builtin_amdgcn_readfirstlane(tab[33 + e]), ce = __builtin_amdgcn_readfirstlane(tab[e]);
        const int idx = Lx - m0 * nN, mte = m1 - m0; const int pn = idx / mte, mtl = idx - pn * mte;
        u.pm = m0 + mtl; u.pn = pn; u.e = e; u.r0 = mtl * 256; u.nvalid = ce - mtl * 256; u.boff = (unsigned)e * bstride; return true;
    }
};
template <class Epi, bool GATHER>
__device__ __forceinline__ void gemm_phase_g(PG8_LAS unsigned char* lds, const Gemm g, const GroupedOrder& S, const Epi& E, const int* __restrict__ LIST) {
    const int tid = opaque_tid(), wid = __builtin_amdgcn_readfirstlane(tid >> 6), lane = tid & 63, wr = wid >> 2, wc = wid & 3, fr = lane & 15, fq = lane >> 4;
    const int K = g.K, nt = K / BK;
    unsigned voffB[2]; int RA[2], CA[2];
#pragma unroll
    for (int i = 0; i < 2; ++i) { int R, C; stage_rc(tid * 16 + i * 8192, R, C); const int Rb = Epi::PERM ? ((R & ~31) + perm32(R & 31)) : R;
        RA[i] = R; CA[i] = C; voffB[i] = (unsigned)(Rb * K + C) * 2u; }
    const size_t kstep = (size_t)(BK * 2);
    const size_t hstepB = (size_t)HALF * K * 2;
    const size_t tstepB = 2 * hstepB;
    const unsigned ldsw = (unsigned)wid * 1024u;
    const int aoff = lds_byte(wr * 64 + fr, fq * 8), boff = lds_byte(wc * 32 + fr, fq * 8);
#define PG8_SA(b, h) (((b) * 2 + (h)) * HTB)
#define PG8_SB(b, h) ((4 + (b) * 2 + (h)) * HTB)
#define PG8_STAGE(bufoff, gbase, voff) do { _Pragma("unroll") for (int _i = 0; _i < 2; ++_i) \
        __builtin_amdgcn_global_load_lds((const unsigned*)((const char*)(gbase) + (voff)[_i]), (PG8_LAS unsigned*)(lds + (bufoff) + ldsw + _i * 8192), 16, 0, 0); } while (0)
#define PG8_LDA(dst, b, h) do { _Pragma("unroll") for (int m = 0; m < 4; ++m) _Pragma("unroll") for (int k = 0; k < 2; ++k) dst[m][k] = *(const PG8_LAS bf16x8*)(lds + PG8_SA(b, h) + aoff + m * 2048 + k * 1024); } while (0)
#define PG8_LDB(dst, b, h) do { _Pragma("unroll") for (int n = 0; n < 2; ++n) _Pragma("unroll") for (int k = 0; k < 2; ++k) dst[n][k] = *(const PG8_LAS bf16x8*)(lds + PG8_SB(b, h) + boff + n * 2048 + k * 1024); } while (0)
#define PG8_MMA(ai, bj, At, Bt) do { __builtin_amdgcn_s_setprio(1); _Pragma("unroll") for (int m = 0; m < 4; ++m) _Pragma("unroll") for (int n = 0; n < 2; ++n) _Pragma("unroll") for (int k = 0; k < 2; ++k) \
        acc[ai][bj][m][n] = __builtin_amdgcn_mfma_f32_16x16x32_bf16(Bt[n][k], At[m][k], acc[ai][bj][m][n], 0, 0, 0); __builtin_amdgcn_s_setprio(0); } while (0)
#define PG8_WAIT_V(n) asm volatile("s_waitcnt vmcnt(" #n ")" ::: "memory")
#define PG8_WAIT_L(n) asm volatile("s_waitcnt lgkmcnt(" #n ")" ::: "memory")
#define PG8_BAR __builtin_amdgcn_s_barrier()
#define PG8_SCHED __builtin_amdgcn_sched_barrier(0)
#define PG8_AOFF(u, vo) do { _Pragma("unroll") for (int _h = 0; _h < 2; ++_h) _Pragma("unroll") for (int _i = 0; _i < 2; ++_i) { const int _r = _h * HALF + RA[_i]; int _row; \
        if (GATHER) { _row = 0; if (_r < (u).nvalid) _row = LIST[(u).e * 8192 + (u).r0 + _r] >> 1; } else _row = (u).pm * BM + _r; \
        (vo)[_h][_i] = (unsigned)(_row * K + CA[_i]) * 2u; } } while (0)
    UnitG cur, nxt; int ui = 0;
    if (!S.next(0, cur)) return;
    f32x4 acc[2][2][4][2];
#pragma unroll
    for (int a = 0; a < 2; ++a)
#pragma unroll
        for (int b = 0; b < 2; ++b)
#pragma unroll
            for (int m = 0; m < 4; ++m)
#pragma unroll
                for (int n = 0; n < 2; ++n) acc[a][b][m][n] = (f32x4){0.f, 0.f, 0.f, 0.f};
    bf16x8 At[4][2], B0[2][2], B1[2][2];
    unsigned vA[2][2], vN[2][2];
    PG8_AOFF(cur, vA);
    const char* gA = (const char*)g.A;
    const char* cB = (const char*)g.Bt + cur.boff + (size_t)cur.pn * tstepB;
    PG8_STAGE(PG8_SB(0, 0), cB, voffB); PG8_STAGE(PG8_SB(0, 1), cB + hstepB, voffB); PG8_STAGE(PG8_SA(0, 0), gA, vA[0]); PG8_STAGE(PG8_SA(0, 1), gA, vA[1]);
    if (wr == 1) PG8_BAR;
    PG8_WAIT_V(2); PG8_BAR;
    PG8_STAGE(PG8_SB(1, 0), cB + kstep, voffB); PG8_STAGE(PG8_SA(1, 0), gA + kstep, vA[0]); PG8_STAGE(PG8_SB(1, 1), cB + hstepB + kstep, voffB);
    PG8_WAIT_V(6); PG8_BAR;
    for (;;) {
        const bool has_next = S.next(ui + 1, nxt);
        if (has_next) { PG8_AOFF(nxt, vN); } else {
#pragma unroll
            for (int _h = 0; _h < 2; ++_h)
#pragma unroll
                for (int _i = 0; _i < 2; ++_i) vN[_h][_i] = vA[_h][_i]; }
        const char* nB = has_next ? (const char*)g.Bt + nxt.boff + (size_t)nxt.pn * tstepB : cB;
        for (int t = 0; t < nt; t += 2) {
            const bool last = (t == nt - 2);
            const char* a1 = gA + (size_t)(t + 1) * kstep;
            const char* a2 = last ? gA : gA + (size_t)(t + 2) * kstep; const char* b2 = last ? nB : cB + (size_t)(t + 2) * kstep;
            const char* a3 = a2 + kstep; const char* b3 = b2 + kstep;
            unsigned v2a[2], v2b[2];
#pragma unroll
            for (int _i = 0; _i < 2; ++_i) { v2a[_i] = last ? vN[0][_i] : vA[0][_i]; v2b[_i] = last ? vN[1][_i] : vA[1][_i]; }
            PG8_LDB(B0, 0, 0); PG8_LDB(B1, 0, 1); PG8_SCHED; PG8_LDA(At, 0, 0); PG8_STAGE(PG8_SA(1, 1), a1, vA[1]);
            PG8_WAIT_V(8); PG8_WAIT_L(0); PG8_BAR; PG8_MMA(0, 0, At, B0); PG8_MMA(0, 1, At, B1); PG8_BAR; PG8_SCHED;
            PG8_LDA(At, 0, 1); PG8_STAGE(PG8_SB(0, 0), b2, voffB); PG8_STAGE(PG8_SB(0, 1), b2 + hstepB, voffB); PG8_STAGE(PG8_SA(0, 0), a2, v2a);
            PG8_WAIT_V(8); PG8_WAIT_L(0); PG8_BAR; PG8_MMA(1, 0, At, B0); PG8_MMA(1, 1, At, B1); PG8_BAR; PG8_SCHED;
            PG8_LDB(B0, 1, 0); PG8_LDB(B1, 1, 1); PG8_SCHED; PG8_LDA(At, 1, 0); PG8_STAGE(PG8_SA(0, 1), a2, v2b);
            PG8_WAIT_V(8); PG8_WAIT_L(0); PG8_BAR; PG8_MMA(0, 0, At, B0); PG8_MMA(0, 1, At, B1); PG8_BAR; PG8_SCHED;
            PG8_LDA(At, 1, 1); PG8_STAGE(PG8_SB(1, 0), b3, voffB); PG8_STAGE(PG8_SB(1, 1), b3 + hstepB, voffB); PG8_STAGE(PG8_SA(1, 0), a3, v2a);
            PG8_WAIT_V(8); PG8_WAIT_L(0); PG8_BAR; PG8_MMA(1, 0, At, B0); PG8_MMA(1, 1, At, B1); PG8_BAR; PG8_SCHED;
        }
        if (wr == 0) PG8_BAR;
        E(acc, cur, wr, wc, fr, fq);
        if (!has_next) break;
#pragma unroll
        for (int a = 0; a < 2; ++a)
#pragma unroll
            for (int b = 0; b < 2; ++b)
#pragma unroll
                for (int m = 0; m < 4; ++m)
#pragma unroll
                    for (int n = 0; n < 2; ++n) acc[a][b][m][n] = (f32x4){0.f, 0.f, 0.f, 0.f};
        cur = nxt; cB = nB; ++ui;
#pragma unroll
        for (int _h = 0; _h < 2; ++_h)
#pragma unroll
            for (int _i = 0; _i < 2; ++_i) vA[_h][_i] = vN[_h][_i];
        if (wr == 1) PG8_BAR;
    }
    PG8_WAIT_V(0);
    PG8_BAR;
#undef PG8_AOFF
#undef PG8_SA
#undef PG8_SB
#undef PG8_STAGE
#undef PG8_LDA
#undef PG8_LDB
#undef PG8_MMA
#undef PG8_WAIT_V
#undef PG8_WAIT_L
#undef PG8_BAR
#undef PG8_SCHED
}
__device__ __forceinline__ float silu_f(float a) { return a * __builtin_amdgcn_rcpf(1.f + __builtin_amdgcn_exp2f(-1.4426950408889634f * a)); }
struct EpiMoe1 {
    static constexpr bool PERM = true, AFTER_DRAIN = false;
    bf16_t* HB; const int* LIST; const float* GATEW;
    __device__ __forceinline__ void operator()(const f32x4 (&acc)[2][2][4][2], const UnitG& u, int wr, int wc, int fr, int fq) const {
#pragma unroll
        for (int ai = 0; ai < 2; ++ai)
#pragma unroll
            for (int m = 0; m < 4; ++m) { const int r = ai * HALF + wr * 64 + m * 16 + fr;
                float gate = 0.f; if (r < u.nvalid) gate = GATEW[LIST[u.e * 8192 + u.r0 + r]];
                bf16_t* rowp = HB + (size_t)(u.pm * BM + r) * 512 + u.pn * 128 + wc * 32 + 8 * fq;
                const f32x4 a0 = acc[ai][0][m][0], a1 = acc[ai][0][m][1], b0 = acc[ai][1][m][0], b1 = acc[ai][1][m][1];
                f32x4 h0, h1;
#pragma unroll
                for (int j = 0; j < 4; ++j) { h0[j] = silu_f(a0[j]) * b0[j] * gate; h1[j] = silu_f(a1[j]) * b1[j] * gate; }
                u32x4 w; w.x = cvt_pk_bf16(h0[0], h0[1]); w.y = cvt_pk_bf16(h0[2], h0[3]); w.z = cvt_pk_bf16(h1[0], h1[1]); w.w = cvt_pk_bf16(h1[2], h1[3]);
                *(u32x4*)rowp = w; }
    }
};
struct EpiMoe2 {
    static constexpr bool PERM = true, AFTER_DRAIN = false;
    bf16_t* YS; const int* LIST;
    __device__ __forceinline__ void operator()(const f32x4 (&acc)[2][2][4][2], const UnitG& u, int wr, int wc, int fr, int fq) const {
#pragma unroll
        for (int ai = 0; ai < 2; ++ai)
#pragma unroll
            for (int m = 0; m < 4; ++m) { const int r = ai * HALF + wr * 64 + m * 16 + fr;
                if (r < u.nvalid) { const int idx = LIST[u.e * 8192 + u.r0 + r];
                    bf16_t* rowp = YS + (size_t)idx * 2048 + u.pn * BM + wc * 32 + 8 * fq;
#pragma unroll
                    for (int bj = 0; bj < 2; ++bj) { const f32x4 v0 = acc[ai][bj][m][0], v1 = acc[ai][bj][m][1];
                        u32x4 w; w.x = cvt_pk_bf16(v0[0], v0[1]); w.y = cvt_pk_bf16(v0[2], v0[3]); w.z = cvt_pk_bf16(v1[0], v1[1]); w.w = cvt_pk_bf16(v1[2], v1[3]);
                        *(u32x4*)(rowp + bj * HALF) = w; } } }
    }
};
}
#include <hip/hip_bf16.h>
#include <cmath>
namespace attn_body {
using bf16=__hip_bfloat16;
using bf16x8=__attribute__((ext_vector_type(8)))short;
using s16x4=__attribute__((ext_vector_type(4)))short;
using f32x16=__attribute__((ext_vector_type(16)))float;
using u32x4=__attribute__((ext_vector_type(4)))unsigned;
constexpr int SEQ=2048,D=64,DM=5120;
constexpr int NW=8,QBLK=32,QB=QBLK*NW,KVBLK=64,NQB=SEQ/QB;
constexpr int ATTN_UNIT_ROWS=QB;
__device__ __forceinline__ int crow(int r,int hi){return (r&3)+8*(r>>2)+4*hi;}
#define SBAR() __builtin_amdgcn_sched_barrier(0)
__device__ __forceinline__ void cmask(f32x16&p0,f32x16&p1,int jb,int qrel,int hi){
  const float NEG=-INFINITY; int kb=64*jb+4*hi;
  #pragma unroll
  for(int r=0;r<16;++r){int kv=kb+(r&3)+8*(r>>2); if(kv>qrel)p0[r]=NEG; if(kv+32>qrel)p1[r]=NEG;}
}

constexpr int NSLOT=3, SLOTB=8192;
constexpr int LDS_K=0, LDS_V=NSLOT*SLOTB, LDS_WS=2*NSLOT*SLOTB, LDS_OST=LDS_WS+NW*64*4, LDS_BYTES=LDS_OST+NW*4096;
constexpr float C2=0.125f*1.4426950408889634f;
__device__ __forceinline__ void glds16(const void*gsrc,unsigned lds_dst){unsigned keep;
  asm volatile("s_mov_b32 %0, m0\n\ts_mov_b32 m0, %2\n\ts_nop 0\n\tglobal_load_lds_dwordx4 %1, off\n\ts_mov_b32 m0, %0":"=&s"(keep):"v"(gsrc),"s"(lds_dst):"memory");}
__device__ __forceinline__ float max3f(float a,float b,float c){float r;asm("v_max3_f32 %0, %1, %2, %3":"=v"(r):"v"(a),"v"(b),"v"(c));return r;}
__device__ __forceinline__ float max2f(float a,float b){float r;asm("v_max_f32_e32 %0, %1, %2":"=v"(r):"v"(a),"v"(b));return r;}
__device__ __forceinline__ float fadd_s(float a,float b){float r;asm("v_add_f32_e32 %0, %1, %2":"=v"(r):"v"(a),"v"(b));return r;}
__device__ __forceinline__ float fsub_s(float a,float b){float r;asm("v_sub_f32_e32 %0, %1, %2":"=v"(r):"v"(a),"v"(b));return r;}
typedef float f32x2_t __attribute__((ext_vector_type(2))); typedef __bf16 bf16x2_t __attribute__((ext_vector_type(2)));
__device__ __forceinline__ unsigned cvtpk_s(float lo,float hi){f32x2_t v={lo,hi};bf16x2_t b=__builtin_convertvector(v,bf16x2_t);return __builtin_bit_cast(unsigned,b);}
#define WAIT_BAR(N) asm volatile("s_waitcnt vmcnt(" #N ") lgkmcnt(0)\n\ts_barrier":::"memory")

__device__ __forceinline__ void qkt(f32x16&p0,f32x16&p1,const char*Kslot,const bf16x8*qr,const f32x16&negm,int r32,int hi){
  const char*kb=Kslot+hi*1024+r32*16;
  #pragma unroll
  for(int d0=0;d0<4;++d0){
    const bf16x8 b0=*reinterpret_cast<const bf16x8*>(kb+d0*2048);
    const bf16x8 b1=*reinterpret_cast<const bf16x8*>(kb+d0*2048+512);
    if(d0==0){p0=__builtin_amdgcn_mfma_f32_32x32x16_bf16(b0,qr[0],negm,0,0,0);p1=__builtin_amdgcn_mfma_f32_32x32x16_bf16(b1,qr[0],negm,0,0,0);}
    else{p0=__builtin_amdgcn_mfma_f32_32x32x16_bf16(b0,qr[d0],p0,0,0,0);p1=__builtin_amdgcn_mfma_f32_32x32x16_bf16(b1,qr[d0],p1,0,0,0);}}
}
typedef __attribute__((address_space(3))) const char* lds_cptr;
typedef short v4i16_t __attribute__((ext_vector_type(4)));
__device__ __forceinline__ void kload8(bf16x8*kf,lds_cptr kp){
  kf[0]=*(const __attribute__((address_space(3))) bf16x8*)(kp);      kf[1]=*(const __attribute__((address_space(3))) bf16x8*)(kp+512);
  kf[2]=*(const __attribute__((address_space(3))) bf16x8*)(kp+2048); kf[3]=*(const __attribute__((address_space(3))) bf16x8*)(kp+2560);
  kf[4]=*(const __attribute__((address_space(3))) bf16x8*)(kp+4096); kf[5]=*(const __attribute__((address_space(3))) bf16x8*)(kp+4608);
  kf[6]=*(const __attribute__((address_space(3))) bf16x8*)(kp+6144); kf[7]=*(const __attribute__((address_space(3))) bf16x8*)(kp+6656);
}
__device__ __forceinline__ void kload2(bf16x8*kf,lds_cptr kp,int j){ kf[2*j]=*(const __attribute__((address_space(3))) bf16x8*)(kp+j*2048); kf[2*j+1]=*(const __attribute__((address_space(3))) bf16x8*)(kp+j*2048+512); }
__device__ __forceinline__ s16x4 vtr(lds_cptr p){ return __builtin_bit_cast(s16x4,__builtin_amdgcn_ds_read_tr16_b64_v4i16((__attribute__((address_space(3))) v4i16_t*)p)); }
__device__ __forceinline__ float rowmax(const f32x16&p0,const f32x16&p1){
  float a=max3f(p0[0],p0[1],p1[0]),b=max3f(p0[2],p0[3],p1[1]);a=max3f(a,p1[2],p1[3]);
  #pragma unroll
  for(int r=4;r<16;r+=4){a=max3f(a,p0[r],p0[r+1]);b=max3f(b,p0[r+2],p0[r+3]);a=max3f(a,p1[r],p1[r+1]);b=max3f(b,p1[r+2],p1[r+3]);}
  const float m=max2f(a,b);
  auto rr=__builtin_amdgcn_permlane32_swap(__float_as_uint(m),__float_as_uint(m),false,false);
  return max2f(__uint_as_float(rr[0]),__uint_as_float(rr[1]));
}
__device__ __forceinline__ void pv(f32x16*o,int vb,bf16x8 pa0,bf16x8 pa1,bf16x8 pa2,bf16x8 pa3){
  #pragma unroll
  for(int d0=0;d0<2;++d0){s16x4 lo[4],hi[4];
    #pragma unroll
    for(int ks=0;ks<4;++ks){
      asm volatile("ds_read_b64_tr_b16 %0,%1 offset:%c2":"=&v"(lo[ks]):"v"(vb),"i"(d0*4096+ks*1024):"memory");
      asm volatile("ds_read_b64_tr_b16 %0,%1 offset:%c2":"=&v"(hi[ks]):"v"(vb),"i"(d0*4096+ks*1024+512):"memory");}
    asm volatile("s_waitcnt lgkmcnt(0)":::"memory");SBAR();
    #define PK(k) (bf16x8){lo[k][0],lo[k][1],lo[k][2],lo[k][3],hi[k][0],hi[k][1],hi[k][2],hi[k][3]}
    o[d0]=__builtin_amdgcn_mfma_f32_32x32x16_bf16(pa0,PK(0),o[d0],0,0,0);
    o[d0]=__builtin_amdgcn_mfma_f32_32x32x16_bf16(pa1,PK(1),o[d0],0,0,0);
    o[d0]=__builtin_amdgcn_mfma_f32_32x32x16_bf16(pa2,PK(2),o[d0],0,0,0);
    o[d0]=__builtin_amdgcn_mfma_f32_32x32x16_bf16(pa3,PK(3),o[d0],0,0,0);
    #undef PK
  }
}

#ifndef ATTN_STORE16
#define ATTN_STORE16(p,v) (*(u32x4*)(p)=(v))
#endif
template<int THRL> __device__ __forceinline__ void attn_unit(int b,int qb,const bf16*Q,const bf16*__restrict__ K,const bf16*__restrict__ V,bf16*O,int opitch,char*shm){
  const int tid=opaque_tid(),lane=tid&63,r32=lane&31,hi=lane>>5; const int wid=__builtin_amdgcn_readfirstlane(tid>>6);
  const long rowbase=(long)b*SEQ; const int q0=qb*QB;
  const bf16*Qw=Q+(rowbase+q0+wid*QBLK)*DM;
  const bf16*Kh=K+rowbase*DM,*Vh=V+rowbase*DM;
  const unsigned lds0=(unsigned)(uintptr_t)shm;
  float*wsf=(float*)(shm+LDS_WS)+wid*64;
  const bf16*ksrc=Kh+(long)lane*DM+wid*8;
  const bf16*vsrc=Vh+(long)(16*(wid&3)+(lane>>2))*DM+(wid>>2)*32+(lane&3)*8;
  const unsigned kdst=lds0+LDS_K+wid*1024, vdst=lds0+LDS_V+wid*1024;
  #define DMA_K(t,slot) glds16(ksrc+(long)(t)*KVBLK*DM,(unsigned)__builtin_amdgcn_readfirstlane(kdst+(slot)))
  #define DMA_V(t,slot) glds16(vsrc+(long)(t)*KVBLK*DM,(unsigned)__builtin_amdgcn_readfirstlane(vdst+(slot)))
  const int vb0=(int)(lds0+LDS_V)+((lane>>4)&1)*32+(lane&3)*8+(4*hi+((lane&15)>>2))*64;
  const char*Kbase=shm+LDS_K; bf16x8 kf[8];
  const lds_cptr shm3=(lds_cptr)shm; const lds_cptr kp0=shm3+LDS_K+hi*1024+r32*16; const lds_cptr vp0=shm3+LDS_V+((lane>>4)&1)*32+(lane&3)*8+(4*hi+((lane&15)>>2))*64;
  const int NT=(q0+QB)/KVBLK;
  DMA_K(0,0);DMA_V(0,0);DMA_K(1,SLOTB);
  bf16x8 qr[4];
  #pragma unroll
  for(int d0=0;d0<4;++d0)qr[d0]=*reinterpret_cast<const bf16x8*>(&Qw[(long)r32*DM+d0*16+hi*8]);
  float mhat=0.f,l_reg=0.f;f32x16 o[2];o[0]=f32x16{};o[1]=f32x16{};f32x16 negm=f32x16{};asm volatile("":"+v"(negm));
  const int qrel=wid*QBLK+r32;
  #define CMASK(P0,P1,t) do{int jb_=(t)-(NT-4); if(jb_>=0)cmask(P0,P1,jb_,qrel,hi);}while(0)
  bool resc=false;
  #define START(P0,P1) do{ const float rm=rowmax(P0,P1); resc=false; \
    { const float dl=rm; mhat=fadd_s(mhat,dl); \
      _Pragma("unroll") for(int r=0;r<16;++r){P0[r]=fsub_s(P0[r],dl);P1[r]=fsub_s(P1[r],dl);} \
      _Pragma("unroll") for(int r=0;r<16;++r)negm[r]=-mhat; asm volatile("":"+v"(negm)); } \
    _Pragma("unroll") for(int r=0;r<16;++r)P0[r]=__builtin_amdgcn_exp2f(P0[r]); }while(0)
  #define RESC() do{ if(resc){ asm volatile("s_waitcnt lgkmcnt(0)":::"memory"); \
      _Pragma("unroll") for(int d_=0;d_<2;++d_) _Pragma("unroll") for(int r=0;r<16;++r)o[d_][r]*=wsf[crow(r,hi)]; } }while(0)
  f32x16 pA0,pA1,pB0,pB1;
  int sl_prev=0,sl_cur=0,sl_next=SLOTB;
  #define ROT() do{sl_prev=sl_cur;sl_cur=sl_next;sl_next=(sl_next==(NSLOT-1)*SLOTB)?0:sl_next+SLOTB;}while(0)
  DMA_K(2,2*SLOTB);
  WAIT_BAR(3);
  qkt(pA0,pA1,Kbase,qr,negm,r32,hi);asm volatile("s_nop 15\n\ts_nop 7":"+v"(pA0),"+v"(pA1));CMASK(pA0,pA1,0);
  START(pA0,pA1);
  _Pragma("unroll") for(int r=0;r<16;++r)pA1[r]=__builtin_amdgcn_exp2f(pA1[r]);
  WAIT_BAR(0);
  DMA_K(3,0);DMA_V(1,SLOTB);
  ROT();
  kload8(kf,kp0+sl_cur);
  WAIT_BAR(2);
  s16x4 vlo[8],vhi[8]; u32x4 pw0,pw1,pw2,pw3;
  #define PKW(P,B) cvtpk_s(P[B],P[B+1])
  #define PAF(k) __builtin_bit_cast(bf16x8,pw##k)
  #define VFR(i) (bf16x8){vlo[i][0],vlo[i][1],vlo[i][2],vlo[i][3],vhi[i][0],vhi[i][1],vhi[i][2],vhi[i][3]}
  #define PIN(x) asm volatile("":"+v"(x))
  #define MX3(a,b,c) __builtin_fmaxf(__builtin_fmaxf((a),(b)),(c))
  #define GAPA(MF,A0,A1,A2,A3,W0,W1,PW) do{ MF; sacc+=A0; sacc+=A1; sacc+=A2; sacc+=A3; PIN(sacc); W0; W1; PIN(PW); SBAR(); }while(0)
  #define EX(v) __builtin_amdgcn_exp2f(v)
  #define GAPB(MF,X,B) do{ MF; X[B]=EX(X[B]); X[B+1]=EX(X[B+1]); X[B+2]=EX(X[B+2]); X[B+3]=EX(X[B+3]); PIN(X); SBAR(); }while(0)
  #define VRD(i) do{ vlo[i]=vtr(vp_+(((i)>>2)*4096+((i)&3)*1024)); vhi[i]=vtr(vp_+(((i)>>2)*4096+((i)&3)*1024+512)); }while(0)
  #define KRD(G,j) do{ if(G){ kload2(kf,kp0+sl_next,j); SBAR(); } }while(0)
  #define STEP(C0,C1,P0,P1,t,GK,GV,GL) do{ SBAR(); \
    const lds_cptr vp_=vp0+sl_prev; \
    VRD(0); SBAR(); float sacc=(P0[0]+P0[1]); \
    GAPA(C0=__builtin_amdgcn_mfma_f32_32x32x16_bf16(kf[0],qr[0],negm,0,0,0), P0[2],P0[3],P0[4],P0[5],     pw0[0]=PKW(P0,0), pw0[1]=PKW(P0,2), pw0); \
    VRD(4); SBAR(); GAPA(C1=__builtin_amdgcn_mfma_f32_32x32x16_bf16(kf[1],qr[0],negm,0,0,0), P0[6],P0[7],P0[8],P0[9],     pw0[2]=PKW(P0,4), pw0[3]=PKW(P0,6), pw0); \
    VRD(1); SBAR(); GAPA(C0=__builtin_amdgcn_mfma_f32_32x32x16_bf16(kf[2],qr[1],C0,0,0,0),   P0[10],P0[11],P0[12],P0[13], pw1[0]=PKW(P0,8), pw1[1]=PKW(P0,10), pw1); \
    VRD(5); SBAR(); GAPA(C1=__builtin_amdgcn_mfma_f32_32x32x16_bf16(kf[3],qr[1],C1,0,0,0),   P0[14],P0[15],P1[0],P1[1],   pw1[2]=PKW(P0,12),pw1[3]=PKW(P0,14), pw1); \
    VRD(2); SBAR(); GAPA(C0=__builtin_amdgcn_mfma_f32_32x32x16_bf16(kf[4],qr[2],C0,0,0,0),   P1[2],P1[3],P1[4],P1[5],     pw2[0]=PKW(P1,0), pw2[1]=PKW(P1,2), pw2); \
    VRD(6); SBAR(); GAPA(C1=__builtin_amdgcn_mfma_f32_32x32x16_bf16(kf[5],qr[2],C1,0,0,0),   P1[6],P1[7],P1[8],P1[9],     pw2[2]=PKW(P1,4), pw2[3]=PKW(P1,6), pw2); \
    VRD(3); SBAR(); GAPA(C0=__builtin_amdgcn_mfma_f32_32x32x16_bf16(kf[6],qr[3],C0,0,0,0),   P1[10],P1[11],P1[12],P1[13], pw3[0]=PKW(P1,8), pw3[1]=PKW(P1,10), pw3); \
    VRD(7); SBAR(); GAPA(C1=__builtin_amdgcn_mfma_f32_32x32x16_bf16(kf[7],qr[3],C1,0,0,0),   P1[14],P1[15],0.f,0.f,       pw3[2]=PKW(P1,12),pw3[3]=PKW(P1,14), pw3); \
    l_reg+=sacc; \
    if(GK){DMA_K((t)+3,sl_cur);} if(GV){DMA_V((t)+1,sl_next);} \
    CMASK(C0,C1,t); \
    { float a=MX3(C0[0],C0[1],C1[0]),b=MX3(C0[2],C0[3],C1[1]); a=MX3(a,C1[2],C1[3]); \
      _Pragma("unroll") for(int r=4;r<16;r+=4){a=MX3(a,C0[r],C0[r+1]);b=MX3(b,C0[r+2],C0[r+3]);a=MX3(a,C1[r],C1[r+1]);b=MX3(b,C1[r+2],C1[r+3]);} \
      float rm=__builtin_fmaxf(a,b); { auto rr=__builtin_amdgcn_permlane32_swap(__float_as_uint(rm),__float_as_uint(rm),false,false); rm=__builtin_fmaxf(__uint_as_float(rr[0]),__uint_as_float(rr[1])); } \
      resc=false; \
      if(__builtin_expect(__any(rm>(float)THRL),0)){ const float dl=__builtin_fmaxf(rm,0.f); mhat+=dl; \
        _Pragma("unroll") for(int r=0;r<16;++r){C0[r]-=dl;C1[r]-=dl;} \
        _Pragma("unroll") for(int r=0;r<16;++r)negm[r]=-mhat; asm volatile("":"+v"(negm)); \
        const float f=__builtin_amdgcn_exp2f(-dl); l_reg*=f; if(hi==0)wsf[r32]=f; resc=true; } } \
    SBAR(); \
    GAPB(o[0]=__builtin_amdgcn_mfma_f32_32x32x16_bf16(PAF(0),VFR(0),o[0],0,0,0), C0,0); \
    GAPB(o[1]=__builtin_amdgcn_mfma_f32_32x32x16_bf16(PAF(0),VFR(4),o[1],0,0,0), C0,4); \
    KRD(GL,0); GAPB(o[0]=__builtin_amdgcn_mfma_f32_32x32x16_bf16(PAF(1),VFR(1),o[0],0,0,0), C0,8); \
    KRD(GL,1); GAPB(o[1]=__builtin_amdgcn_mfma_f32_32x32x16_bf16(PAF(1),VFR(5),o[1],0,0,0), C0,12); \
    KRD(GL,2); GAPB(o[0]=__builtin_amdgcn_mfma_f32_32x32x16_bf16(PAF(2),VFR(2),o[0],0,0,0), C1,0); \
    KRD(GL,3); GAPB(o[1]=__builtin_amdgcn_mfma_f32_32x32x16_bf16(PAF(2),VFR(6),o[1],0,0,0), C1,4); \
    GAPB(o[0]=__builtin_amdgcn_mfma_f32_32x32x16_bf16(PAF(3),VFR(3),o[0],0,0,0), C1,8); \
    GAPB(o[1]=__builtin_amdgcn_mfma_f32_32x32x16_bf16(PAF(3),VFR(7),o[1],0,0,0), C1,12); \
    }while(0)
  int t=1;
  #undef CMASK
  #define CMASK(P0,P1,t) do{}while(0)
  for(;t+5<NT;t+=2){
    STEP(pB0,pB1,pA0,pA1,t,true,true,true);     WAIT_BAR(2); RESC(); ROT();
    STEP(pA0,pA1,pB0,pB1,t+1,true,true,true);   WAIT_BAR(2); RESC(); ROT();
  }
  #undef CMASK
  #define CMASK(P0,P1,t) do{int jb_=(t)-(NT-4); if(jb_>=0)cmask(P0,P1,jb_,qrel,hi);}while(0)
  #define ENDW(tt) do{ if((tt)+3<NT){WAIT_BAR(2);} else if((tt)+2<NT){WAIT_BAR(1);} else {WAIT_BAR(0);} }while(0)
  for(;t+1<NT;t+=2){
    STEP(pB0,pB1,pA0,pA1,t,(t+3<NT),(t+1<NT),(t+1<NT));       ENDW(t);   RESC(); ROT();
    STEP(pA0,pA1,pB0,pB1,t+1,(t+4<NT),(t+2<NT),(t+2<NT));     ENDW(t+1); RESC(); ROT();
  }
  STEP(pB0,pB1,pA0,pA1,NT-1,false,false,false); RESC();
  { float sacc=pB0[0]+pB0[1]; _Pragma("unroll") for(int r=2;r<16;++r)sacc+=pB0[r]; _Pragma("unroll") for(int r=0;r<16;++r)sacc+=pB1[r]; l_reg+=sacc;
    pw0=(u32x4){PKW(pB0,0),PKW(pB0,2),PKW(pB0,4),PKW(pB0,6)};pw1=(u32x4){PKW(pB0,8),PKW(pB0,10),PKW(pB0,12),PKW(pB0,14)};pw2=(u32x4){PKW(pB1,0),PKW(pB1,2),PKW(pB1,4),PKW(pB1,6)};pw3=(u32x4){PKW(pB1,8),PKW(pB1,10),PKW(pB1,12),PKW(pB1,14)};
    SBAR(); pv(o,vb0+sl_cur,PAF(0),PAF(1),PAF(2),PAF(3)); }
  #undef PKW
  #undef PAF
  #undef VFR
  #undef PIN
  #undef MX3
  #undef GAPA
  #undef GAPB
  #undef EX
  #undef VRD
  #undef KRD
  #undef STEP
  #undef ENDW
  {auto rr=__builtin_amdgcn_permlane32_swap(__float_as_uint(l_reg),__float_as_uint(l_reg),false,false);l_reg=__uint_as_float(rr[0])+__uint_as_float(rr[1]);}
  if(hi==0)wsf[32+r32]=l_reg;asm volatile("s_waitcnt lgkmcnt(0)":::"memory");
  float rli[16];
  #pragma unroll
  for(int r=0;r<16;++r)rli[r]=__builtin_amdgcn_rcpf(wsf[32+crow(r,hi)]);
  bf16*Ow=O+(rowbase+q0+wid*QBLK)*opitch;
  { bf16*stg=(bf16*)(shm+LDS_OST)+wid*2048;
    #pragma unroll
    for(int r=0;r<16;++r){const int orow=crow(r,hi);
      #pragma unroll
      for(int d0=0;d0<2;++d0)stg[orow*64+d0*32+r32]=__float2bfloat16(o[d0][r]*rli[r]);}
    asm volatile("s_waitcnt lgkmcnt(0)":::"memory");
    #pragma unroll
    for(int i=0;i<4;++i){const int row=i*8+(lane>>3),ch=lane&7; const u32x4 v=*(const u32x4*)(stg+row*64+ch*8); ATTN_STORE16(Ow+(long)row*opitch+ch*8,v);} }
  asm volatile("s_waitcnt lgkmcnt(0)\n\ts_barrier":::"memory");
  #undef DMA_K
  #undef DMA_V
  #undef CMASK
  #undef START
  #undef RESC
  #undef ROT
}

__device__ __forceinline__ void sb_unit(int b,int qb,const bf16*Q,const bf16*__restrict__ K,const bf16*__restrict__ V,bf16*O,int opitch,char*shm){
  const int tid=opaque_tid(),lane=tid&63,r32=lane&31,hi=lane>>5; const int wid=__builtin_amdgcn_readfirstlane(tid>>6);
  const long rowbase=(long)b*SEQ; const int q0=qb*QB;
  const bf16*Qw=Q+(rowbase+q0+wid*QBLK)*DM;
  const bf16*Kh=K+rowbase*DM,*Vh=V+rowbase*DM;
  const unsigned lds0=(unsigned)(uintptr_t)shm;
  const bf16*ksrc=Kh+(long)lane*DM+wid*8;
  const bf16*vsrc=Vh+(long)(16*(wid&3)+(lane>>2))*DM+(wid>>2)*32+(lane&3)*8;
  const unsigned kdst=lds0+LDS_K+wid*1024, vdst=lds0+LDS_V+wid*1024;
  #define DMA_K(t,slot) glds16(ksrc+(long)(t)*KVBLK*DM,(unsigned)__builtin_amdgcn_readfirstlane(kdst+(slot)))
  #define DMA_V(t,slot) glds16(vsrc+(long)(t)*KVBLK*DM,(unsigned)__builtin_amdgcn_readfirstlane(vdst+(slot)))
  const int vb0=(int)(lds0+LDS_V)+((lane>>4)&1)*32+(lane&3)*8+(4*hi+((lane&15)>>2))*64;
  const char*Kbase=shm+LDS_K;
  const int NT=(q0+QB)/KVBLK;
  int j=NT-1;
  DMA_K(j,(j&1)*SLOTB);DMA_V(j,(j&1)*SLOTB);
  bf16x8 qr[4];
  #pragma unroll
  for(int d0=0;d0<4;++d0)qr[d0]=*reinterpret_cast<const bf16x8*>(&Qw[(long)r32*DM+d0*16+hi*8]);
  f32x16 o[2];o[0]=f32x16{};o[1]=f32x16{};
  float R=0.f;
  const int trow=q0+wid*QBLK+r32;
  const int wmax=q0+wid*QBLK+QBLK-1;
  const float selhi=(hi==0)?1.f:0.f;
  #pragma unroll 1
  for(;j>=0;--j){
    WAIT_BAR(0);
    if(j>0){DMA_K(j-1,((j-1)&1)*SLOTB);DMA_V(j-1,((j-1)&1)*SLOTB);}
    const int slot=(j&1)*SLOTB;
    if(64*j<wmax){
      f32x16 p0,p1; const f32x16 zero=f32x16{};
      qkt(p0,p1,Kbase+slot,qr,zero,r32,hi);
      const int thr=trow-64*j-4*hi;
      f32x16 l0,l1;
      #pragma unroll
      for(int r=0;r<16;++r){
        { const float z=p0[r]; const float lg=__builtin_amdgcn_logf(1.f+__builtin_amdgcn_exp2f(-__builtin_fabsf(z))); const float sp=__builtin_fmaxf(-z,0.f)+lg;
          const bool ok=((r&3)+8*(r>>2))<thr; l0[r]=ok?-(sp+z):0.f; p0[r]=ok?-sp:-INFINITY; }
        { const float z=p1[r]; const float lg=__builtin_amdgcn_logf(1.f+__builtin_amdgcn_exp2f(-__builtin_fabsf(z))); const float sp=__builtin_fmaxf(-z,0.f)+lg;
          const bool ok=((r&3)+8*(r>>2)+32)<thr; l1[r]=ok?-(sp+z):0.f; p1[r]=ok?-sp:-INFINITY; }
      }
      float gs[8],pt[8];
      #pragma unroll
      for(int g=0;g<4;++g){ gs[g]=(l0[4*g]+l0[4*g+1])+(l0[4*g+2]+l0[4*g+3]); gs[4+g]=(l1[4*g]+l1[4*g+1])+(l1[4*g+2]+l1[4*g+3]); }
      #pragma unroll
      for(int g=0;g<8;++g){ auto rr=__builtin_amdgcn_permlane32_swap(__float_as_uint(gs[g]),__float_as_uint(gs[g]),false,false); pt[g]=__uint_as_float(rr[0])+__uint_as_float(rr[1]); }
      float base[8]; float run=R;
      #pragma unroll
      for(int g=7;g>=0;--g){ base[g]=run+selhi*(pt[g]-gs[g]); run+=pt[g]; }
      R=run;
      #pragma unroll
      for(int g=0;g<4;++g){
        { float a=base[g]; p0[4*g+3]=__builtin_amdgcn_exp2f(p0[4*g+3]+a); a+=l0[4*g+3]; p0[4*g+2]=__builtin_amdgcn_exp2f(p0[4*g+2]+a); a+=l0[4*g+2]; p0[4*g+1]=__builtin_amdgcn_exp2f(p0[4*g+1]+a); a+=l0[4*g+1]; p0[4*g]=__builtin_amdgcn_exp2f(p0[4*g]+a); }
        { float a=base[4+g]; p1[4*g+3]=__builtin_amdgcn_exp2f(p1[4*g+3]+a); a+=l1[4*g+3]; p1[4*g+2]=__builtin_amdgcn_exp2f(p1[4*g+2]+a); a+=l1[4*g+2]; p1[4*g+1]=__builtin_amdgcn_exp2f(p1[4*g+1]+a); a+=l1[4*g+1]; p1[4*g]=__builtin_amdgcn_exp2f(p1[4*g]+a); }
      }
      u32x4 pw0,pw1,pw2,pw3;
      pw0=(u32x4){cvtpk_s(p0[0],p0[1]),cvtpk_s(p0[2],p0[3]),cvtpk_s(p0[4],p0[5]),cvtpk_s(p0[6],p0[7])};
      pw1=(u32x4){cvtpk_s(p0[8],p0[9]),cvtpk_s(p0[10],p0[11]),cvtpk_s(p0[12],p0[13]),cvtpk_s(p0[14],p0[15])};
      pw2=(u32x4){cvtpk_s(p1[0],p1[1]),cvtpk_s(p1[2],p1[3]),cvtpk_s(p1[4],p1[5]),cvtpk_s(p1[6],p1[7])};
      pw3=(u32x4){cvtpk_s(p1[8],p1[9]),cvtpk_s(p1[10],p1[11]),cvtpk_s(p1[12],p1[13]),cvtpk_s(p1[14],p1[15])};
      SBAR();
      pv(o,vb0+slot,__builtin_bit_cast(bf16x8,pw0),__builtin_bit_cast(bf16x8,pw1),__builtin_bit_cast(bf16x8,pw2),__builtin_bit_cast(bf16x8,pw3));
    }
  }
  bf16*Ow=O+(rowbase+q0+wid*QBLK)*opitch;
  { bf16*stg=(bf16*)(shm+LDS_OST)+wid*2048;
    #pragma unroll
    for(int r=0;r<16;++r){const int orow=crow(r,hi);
      #pragma unroll
      for(int d0=0;d0<2;++d0)stg[orow*64+d0*32+r32]=__float2bfloat16(o[d0][r]);}
    asm volatile("s_waitcnt lgkmcnt(0)":::"memory");
    #pragma unroll
    for(int i=0;i<4;++i){const int row=i*8+(lane>>3),ch=lane&7; const u32x4 v=*(const u32x4*)(stg+row*64+ch*8); ATTN_STORE16(Ow+(long)row*opitch+ch*8,v);} }
  asm volatile("s_waitcnt lgkmcnt(0)\n\ts_barrier":::"memory");
  #undef DMA_K
  #undef DMA_V
}
constexpr int ATTN_LDS_BYTES=LDS_BYTES;
#undef SBAR
#undef WAIT_BAR
}
namespace mk {
using nv::NB; using nv::L; using nv::D; using nv::T; using nv::DEPTH; using nv::INC; using nv::EPS;
constexpr int NWAVES = 8;
constexpr size_t MiB = 1u << 20;
constexpr size_t WS_CTL = 0, CTL_ZERO_BYTES = 1 * MiB;
constexpr size_t WS_WIN = 1 * MiB;
constexpr size_t WS_WOUT = WS_WIN + 40 * MiB;
constexpr size_t WS_XN = WS_WOUT + 16 * MiB;
constexpr size_t WS_PROJ = WS_XN + 32 * MiB;
constexpr size_t WS_SBO = WS_PROJ + 80 * MiB;
constexpr size_t WS_O1 = WS_SBO + 8 * MiB;
constexpr size_t WS_O2 = WS_O1 + 16 * MiB;
constexpr size_t WS_Y = WS_O2 + 16 * MiB;
constexpr size_t WS_H = WS_Y + 32 * MiB;
constexpr size_t WS_YS = WS_H + 64 * MiB;
constexpr size_t WS_HB = WS_YS + 64 * MiB;
constexpr size_t WS_ROUTE = WS_HB + 24 * MiB;
constexpr size_t WS_S5 = WS_ROUTE + 2 * MiB;
constexpr size_t WS_W13 = WS_S5 + 160 * MiB;
constexpr size_t WS_W2 = WS_W13 + 256 * MiB;
constexpr size_t WS_END = WS_W2 + 128 * MiB;
static_assert(WS_END <= 1024 * MiB, "d_ws map must fit 1 GiB");
constexpr int CW_TMO = 0, CW_CODE = 1;
constexpr int CW_BAR = 4096;
constexpr int MAX_BAR_REGIONS = 40;
constexpr int CW_CNT = 143360;
constexpr int RING_OFF = 0, RING_BYTES = 131072;
constexpr int LDSCTL_OFF = 143360, MISC_OFF = LDSCTL_OFF + 320;
constexpr int LDS_BYTES = 147456;

#define GAS __attribute__((address_space(1)))
#define LAS __attribute__((address_space(3)))
typedef unsigned short bf16;
typedef unsigned v4u __attribute__((ext_vector_type(4)));
typedef float f32x4 __attribute__((ext_vector_type(4)));
typedef short bf16x8 __attribute__((ext_vector_type(8)));
typedef GAS unsigned gu32;
typedef GAS unsigned long long gu64;
#define RLX_AGENT __ATOMIC_RELAXED, __HIP_MEMORY_SCOPE_AGENT
#define LDS_WAIT() asm volatile("s_waitcnt lgkmcnt(0)" ::: "memory")
#define VM_WAIT() asm volatile("s_waitcnt vmcnt(0)" ::: "memory")
__device__ __forceinline__ unsigned long long rt() { return __builtin_amdgcn_s_memrealtime(); }
__device__ __forceinline__ unsigned f2bf(float f) { unsigned u = __builtin_bit_cast(unsigned, f); return (u + 0x7fffu + ((u >> 16) & 1u)) >> 16; }
__device__ __forceinline__ unsigned pk2(float lo, float hi) { return f2bf(lo) | (f2bf(hi) << 16); }

#define XB_TMO      128
#define XB_XCNT(j)  (256  + 64 * (j))
#define XB_XSUB(j)  (1280 + 64 * (j))
#define XB_XGEN(j)  (2304 + 64 * (j))
#define XB_TOP      3328
#define XB_TOPGEN   3392
#define XCD_BAR_WORDS 3456
#define XB_SPIN_CAP (1u << 18)

__device__ __forceinline__ unsigned xb_ld(unsigned* p)              { return __hip_atomic_load(p, __ATOMIC_RELAXED, __HIP_MEMORY_SCOPE_AGENT); }
__device__ __forceinline__ unsigned xb_add(unsigned* p, unsigned v) { return __hip_atomic_fetch_add(p, v, __ATOMIC_RELAXED, __HIP_MEMORY_SCOPE_AGENT); }
__device__ __forceinline__ unsigned xb_xcc_id() { return (unsigned)__builtin_amdgcn_s_getreg((3 << 11) | 20) & 0xFu; }
#define XB_SPIN(cond, bar) do { unsigned _sp = 0; while (cond) { __builtin_amdgcn_s_sleep(1); \
    if ((++_sp & 255u) == 0u) { if (xb_ld(&(bar)[XB_TMO])) break; if (_sp > XB_SPIN_CAP) { atomicAdd(&(bar)[XB_TMO], 1u); break; } } } } while (0)

struct XcdBarrier {
    unsigned* bar; unsigned x;
    volatile LAS unsigned* st;
};

__device__ __forceinline__ XcdBarrier xcd_barrier_post(unsigned* bar, volatile LAS unsigned* st) {
    XcdBarrier b; b.bar = bar; b.x = xb_xcc_id(); b.st = st;
    if (threadIdx.x == 0) (void)xb_add(&bar[XB_XCNT(b.x)], 1u);
    return b;
}
__device__ __forceinline__ void xcd_barrier_complete(unsigned* bar, unsigned x, unsigned& nloc, unsigned& nx) {
    const unsigned G = gridDim.x * gridDim.y * gridDim.z;
    unsigned sum, cnt, mine, sp = 0u;
    for (;;) {
        sum = 0u; cnt = 0u; mine = 0u;
#pragma unroll
        for (unsigned j = 0; j < 16; ++j) { const unsigned c = xb_ld(&bar[XB_XCNT(j)]); sum += c; cnt += (c > 0u) ? 1u : 0u; mine = (j == x) ? c : mine; }
        if (sum == G) break;
        __builtin_amdgcn_s_sleep(1);
        if ((++sp & 255u) == 0u) { if (xb_ld(&bar[XB_TMO])) break; if (sp > XB_SPIN_CAP) { atomicAdd(&bar[XB_TMO], 1u); break; } }
    }
    nloc = mine > 0u ? mine : 1u; nx = cnt > 0u ? cnt : 1u;
}

__device__ __forceinline__ void xcd_barrier(const XcdBarrier& b) {
    asm volatile("s_waitcnt vmcnt(0)" ::: "memory");
    __syncthreads();
    if (threadIdx.x == 0) {
        unsigned* bar = b.bar;
        __builtin_amdgcn_s_waitcnt(0);
        unsigned nloc = b.st[0], nx = b.st[1];
        if (nloc == 0u) { xcd_barrier_complete(bar, b.x, nloc, nx); b.st[0] = nloc; b.st[1] = nx; }
        const unsigned old = xb_add(&bar[XB_XSUB(b.x)], 1u);
        const unsigned gen = old / nloc;
        if (old + 1u == (gen + 1u) * nloc) {
            __builtin_amdgcn_fence(__ATOMIC_RELEASE, "agent");
            asm volatile("s_waitcnt vmcnt(0)" ::: "memory");
            const unsigned og = xb_add(&bar[XB_TOP], 1u);
            const unsigned tg = og / nx;
            if (og + 1u == (tg + 1u) * nx) xb_add(&bar[XB_TOPGEN], 1u);
            else XB_SPIN(xb_ld(&bar[XB_TOPGEN]) == tg, bar);
            __builtin_amdgcn_fence(__ATOMIC_ACQUIRE, "agent");
            xb_add(&bar[XB_XGEN(b.x)], 1u);
            asm volatile("s_waitcnt vmcnt(0)" ::: "memory");
        } else {
            XB_SPIN(xb_ld(&bar[XB_XGEN(b.x)]) == gen, bar);
            __builtin_amdgcn_fence(__ATOMIC_ACQUIRE, "agent");
            asm volatile("s_waitcnt vmcnt(0)" ::: "memory");
        }
    }
    __syncthreads();
}
static_assert((CW_BAR + MAX_BAR_REGIONS * XCD_BAR_WORDS) <= CW_CNT && (CW_CNT + 2 * 2048) * 4 <= (int)CTL_ZERO_BYTES, "barrier regions and expert counters inside the memset region");

__device__ __forceinline__ float wave_sum(float v) {
#pragma unroll
    for (int o = 1; o < 64; o <<= 1) v += __shfl_xor(v, o);
    return v;
}
__device__ __forceinline__ void transpose_tile(const float* __restrict__ W, int N, int k0, int n0, bf16* __restrict__ dst, int Kd, LAS float* scr, int lane) {
    const int kr = lane >> 4, n4 = (lane & 15) * 4;
    f32x4 v[16];
#pragma unroll
    for (int i = 0; i < 16; ++i) v[i] = *(const GAS f32x4*)(W + (size_t)(k0 + i * 4 + kr) * N + n0 + n4);
#pragma unroll
    for (int i = 0; i < 16; ++i) { LAS float* s = scr + (i * 4 + kr) * 65 + n4; s[0] = v[i].x; s[1] = v[i].y; s[2] = v[i].z; s[3] = v[i].w; }
    LDS_WAIT(); asm volatile("" ::: "memory");
    const int c = lane & 7;
#pragma unroll
    for (int j = 0; j < 8; ++j) { const int n = (lane >> 3) + 8 * j; const LAS float* s = scr + (8 * c) * 65 + n;
        v4u o; o.x = pk2(s[0 * 65], s[1 * 65]); o.y = pk2(s[2 * 65], s[3 * 65]); o.z = pk2(s[4 * 65], s[5 * 65]); o.w = pk2(s[6 * 65], s[7 * 65]);
        *(GAS v4u*)(dst + (size_t)n * Kd + k0 + 8 * c) = o; }
    LDS_WAIT(); asm volatile("" ::: "memory");
}
__device__ __forceinline__ void rms_row_to_bf16(const float* xrow, const float* g, bf16* orow, int lane) {
    const GAS f32x4* xr = (const GAS f32x4*)xrow + lane; const GAS f32x4* gr = (const GAS f32x4*)g + lane;
    f32x4 v[8]; float s = 0.f;
#pragma unroll
    for (int j = 0; j < 8; ++j) { v[j] = xr[64 * j]; s += (v[j].x * v[j].x + v[j].y * v[j].y) + (v[j].z * v[j].z + v[j].w * v[j].w); }
    const float r = rsqrtf(wave_sum(s) * (1.f / D) + EPS);
    GAS unsigned long long* o8 = (GAS unsigned long long*)orow + lane;
#pragma unroll
    for (int j = 0; j < 8; ++j) { const f32x4 gg = gr[64 * j]; o8[64 * j] = (unsigned long long)pk2(v[j].x * r * gg.x, v[j].y * r * gg.y) | ((unsigned long long)pk2(v[j].z * r * gg.z, v[j].w * r * gg.w) << 32); }
}
}

namespace pg8 {
struct EpiProj {
    static constexpr bool PERM = true, AFTER_DRAIN = false;
    bf16_t* O; int ldc;
    __device__ __forceinline__ void operator()(const f32x4 (&acc)[2][2][4][2], const Unit& u, int wr, int wc, int fr, int fq) const {
        const int row0 = u.pm * BM + wr * 64 + fr; const int colt = u.pn * BM;
        const float sc = (u.pn < 2) ? nv::QS_SB : ((u.pn >= 8 && u.pn < 12) ? nv::QS_DF : 1.f);
        const int col0 = colt + wc * 32 + 8 * fq;
#pragma unroll
        for (int ai = 0; ai < 2; ++ai)
#pragma unroll
            for (int m = 0; m < 4; ++m) { bf16_t* rowp = O + (size_t)(row0 + ai * HALF + m * 16) * ldc + col0;
#pragma unroll
                for (int bj = 0; bj < 2; ++bj) { const f32x4 v0 = acc[ai][bj][m][0] * sc, v1 = acc[ai][bj][m][1] * sc;
                    u32x4 w; w.x = cvt_pk_bf16(v0[0], v0[1]); w.y = cvt_pk_bf16(v0[2], v0[3]); w.z = cvt_pk_bf16(v1[0], v1[1]); w.w = cvt_pk_bf16(v1[2], v1[3]);
                    *(u32x4*)(rowp + bj * HALF) = w; } }
    }
};
struct EpiResF32 {
    static constexpr bool PERM = false, AFTER_DRAIN = false;
    const float* R; float* out; int ldc;
    __device__ __forceinline__ void operator()(const f32x4 (&acc)[2][2][4][2], const Unit& u, int wr, int wc, int fr, int fq) const {
        const int col0 = u.pn * BM + wc * 32 + 4 * fq;
#pragma unroll
        for (int ai = 0; ai < 2; ++ai)
#pragma unroll
            for (int m = 0; m < 4; ++m) { const size_t off = (size_t)(u.pm * BM + ai * HALF + wr * 64 + m * 16 + fr) * ldc + col0;
#pragma unroll
                for (int bj = 0; bj < 2; ++bj)
#pragma unroll
                    for (int n = 0; n < 2; ++n) { const f32x4 r = *(const f32x4*)(R + off + bj * HALF + n * 16); *(f32x4*)(out + off + bj * HALF + n * 16) = acc[ai][bj][m][n] + r; }
                asm volatile("" ::: "memory"); }
    }
};
}

namespace s5 {
using mk::bf16; using mk::f32x4; using mk::bf16x8; using mk::v4u;
typedef float f32x16 __attribute__((ext_vector_type(16)));
typedef float f32x2 __attribute__((ext_vector_type(2)));
constexpr int LC_ = 32, NCH = 64, SG = 32, SN = 64, SC = 16;
constexpr size_t OFF_KT = 0;
constexpr size_t OFF_PT = 1u << 20;
constexpr size_t OFF_LP = 9u << 20;
constexpr size_t OFF_LC = 10u << 20;
constexpr size_t OFF_WG = 12u << 20;
constexpr size_t OFF_YI = 13u << 20;
constexpr size_t OFF_SE = 29u << 20;

__device__ __forceinline__ void cpow(float lr, float li, float dt, float tau, float& pr, float& pi) {
    const float mag = __builtin_amdgcn_exp2f(tau * lr * dt * 1.4426950408889634f);
    double rev = (double)tau * (double)li * (double)dt * 0.15915494309189535; rev -= __builtin_rint(rev);
    const float rv = (float)rev; pr = mag * __builtin_amdgcn_cosf(rv); pi = mag * __builtin_amdgcn_sinf(rv);
}
__device__ __forceinline__ void zoh_f(float lr, float li, float dt, float& fr, float& fi) {
    float br, bi; cpow(lr, li, dt, 1.f, br, bi);
    const float nr = br - 1.f, ni = bi, den = lr * lr + li * li;
    fr = (nr * lr + ni * li) / den; fi = (ni * lr - nr * li) / den;
}
__device__ __forceinline__ void build_tables(const float* const* in, unsigned char* s5ws, int gt, int NTH) {
    const float* lam_re = in[4]; const float* lam_im = in[5]; const float* b_re = in[6]; const float* b_im = in[7]; const float* c_re = in[8]; const float* c_im = in[9]; const float* log_dt = in[11];
    bf16* KT = (bf16*)(s5ws + OFF_KT); bf16* PT = (bf16*)(s5ws + OFF_PT); f32x2* LP = (f32x2*)(s5ws + OFF_LP);
#pragma unroll 1
    for (int it = gt; it < 2 * SG * LC_ * SC; it += NTH) { const int c = it & 15, tau = (it >> 4) & 31, lg = it >> 9;
        const float dt = __expf(log_dt[lg]); float acc[16];
#pragma unroll
        for (int q = 0; q < 16; ++q) acc[q] = 0.f;
#pragma unroll 1
        for (int n = 0; n < SN; ++n) { const float lr = lam_re[lg * SN + n], li = lam_im[lg * SN + n];
            float pr, pi, fr, fi; cpow(lr, li, dt, (float)tau, pr, pi); zoh_f(lr, li, dt, fr, fi);
            const float cr = c_re[(lg * SC + c) * SN + n], ci = c_im[(lg * SC + c) * SN + n];
            const float xr = pr * fr - pi * fi, xi = pr * fi + pi * fr;
            const float wr = cr * xr - ci * xi, wi = cr * xi + ci * xr;
            const f32x4* br4 = (const f32x4*)(b_re + (size_t)(lg * SN + n) * SC); const f32x4* bi4 = (const f32x4*)(b_im + (size_t)(lg * SN + n) * SC);
#pragma unroll
            for (int q = 0; q < 4; ++q) { const f32x4 br = br4[q], bi = bi4[q];
                acc[4 * q] += wr * br.x - wi * bi.x; acc[4 * q + 1] += wr * br.y - wi * bi.y; acc[4 * q + 2] += wr * br.z - wi * bi.z; acc[4 * q + 3] += wr * br.w - wi * bi.w; } }
        v4u o0, o1; o0.x = mk::pk2(acc[0], acc[1]); o0.y = mk::pk2(acc[2], acc[3]); o0.z = mk::pk2(acc[4], acc[5]); o0.w = mk::pk2(acc[6], acc[7]);
        o1.x = mk::pk2(acc[8], acc[9]); o1.y = mk::pk2(acc[10], acc[11]); o1.z = mk::pk2(acc[12], acc[13]); o1.w = mk::pk2(acc[14], acc[15]);
        v4u* dst = (v4u*)(KT + (size_t)it * 16); dst[0] = o0; dst[1] = o1; }
#pragma unroll 1
    for (int it = gt; it < 2 * SG * LC_ * SN; it += NTH) { const int n = it & 63, s = (it >> 6) & 31, lg = it >> 11;
        const float dt = __expf(log_dt[lg]); const float lr = lam_re[lg * SN + n], li = lam_im[lg * SN + n];
        float pr, pi, fr, fi; cpow(lr, li, dt, (float)(31 - s), pr, pi); zoh_f(lr, li, dt, fr, fi);
        const float xr = pr * fr - pi * fi, xi = pr * fi + pi * fr;
        float vr[16], vi[16];
        const f32x4* br4 = (const f32x4*)(b_re + (size_t)(lg * SN + n) * SC); const f32x4* bi4 = (const f32x4*)(b_im + (size_t)(lg * SN + n) * SC);
#pragma unroll
        for (int q = 0; q < 4; ++q) { const f32x4 br = br4[q], bi = bi4[q];
            vr[4 * q] = xr * br.x - xi * bi.x; vr[4 * q + 1] = xr * br.y - xi * bi.y; vr[4 * q + 2] = xr * br.z - xi * bi.z; vr[4 * q + 3] = xr * br.w - xi * bi.w;
            vi[4 * q] = xr * bi.x + xi * br.x; vi[4 * q + 1] = xr * bi.y + xi * br.y; vi[4 * q + 2] = xr * bi.z + xi * br.z; vi[4 * q + 3] = xr * bi.w + xi * br.w; }
        bf16* base = PT + ((size_t)(lg * LC_ + s) * 128) * 16;
        v4u o; v4u* d0 = (v4u*)(base + (size_t)n * 16); v4u* d1 = (v4u*)(base + (size_t)(64 + n) * 16);
        o.x = mk::pk2(vr[0], vr[1]); o.y = mk::pk2(vr[2], vr[3]); o.z = mk::pk2(vr[4], vr[5]); o.w = mk::pk2(vr[6], vr[7]); d0[0] = o;
        o.x = mk::pk2(vr[8], vr[9]); o.y = mk::pk2(vr[10], vr[11]); o.z = mk::pk2(vr[12], vr[13]); o.w = mk::pk2(vr[14], vr[15]); d0[1] = o;
        o.x = mk::pk2(vi[0], vi[1]); o.y = mk::pk2(vi[2], vi[3]); o.z = mk::pk2(vi[4], vi[5]); o.w = mk::pk2(vi[6], vi[7]); d1[0] = o;
        o.x = mk::pk2(vi[8], vi[9]); o.y = mk::pk2(vi[10], vi[11]); o.z = mk::pk2(vi[12], vi[13]); o.w = mk::pk2(vi[14], vi[15]); d1[1] = o; }
#pragma unroll 1
    for (int it = gt; it < 2 * SG * 32 * SN; it += NTH) { const int n = it & 63, t = (it >> 6) & 31, lg = it >> 11;
        const float dt = __expf(log_dt[lg]); float pr, pi; cpow(lam_re[lg * SN + n], lam_im[lg * SN + n], dt, (float)(t + 1), pr, pi); LP[it] = (f32x2){pr, pi}; }
}

__device__ __forceinline__ void s5a_unit(int l, int g, int b, const bf16* PROJ, const unsigned char* s5ws, LAS unsigned char* lds) {
    const int tid = opaque_tid(), lane = tid & 63, wave = __builtin_amdgcn_readfirstlane(tid >> 6), r = lane & 31, h = lane >> 5;
    const bf16* KTg = (const bf16*)(s5ws + OFF_KT) + (size_t)(l * SG + g) * 32 * 256;
    const bf16* PTg = (const bf16*)(s5ws + OFF_PT) + (size_t)(l * SG + g) * 32 * 128 * 16;
    float* YI = (float*)(s5ws + OFF_YI); float* SE = (float*)(s5ws + OFF_SE);
#pragma unroll
    for (int i = 0; i < 8; ++i) { const int p = tid + 512 * i, tok = p >> 1, half = p & 1, chunk = tok >> 5, s = tok & 31;
        const v4u v = *(const GAS v4u*)(PROJ + (size_t)(b * 2048 + tok) * 5120 + nv::C_U + g * 16 + 8 * half);
        *(LAS v4u*)(lds + ((s * 64 + chunk) * 32 + 16 * half)) = v; }
#pragma unroll
    for (int i = 0; i < 2; ++i) { const int p = tid + 512 * i; const v4u v = *(const GAS v4u*)(KTg + (size_t)p * 8); *(LAS v4u*)(lds + 65536 + 512 + p * 16) = v; }
    if (tid < 32) *(LAS v4u*)(lds + 65536 + tid * 16) = (v4u){0u, 0u, 0u, 0u};
    asm volatile("s_waitcnt vmcnt(0) lgkmcnt(0)" ::: "memory"); __syncthreads();
    const int tl = r >> 4, c = r & 15;
#pragma unroll 1
    for (int nb = 0; nb < 2; ++nb)
#pragma unroll 1
        for (int half = 0; half < 2; ++half) { const int tb = half ? 15 - wave : wave;
            f32x16 acc = {};
            const LAS unsigned char* ap = lds + 65536 + (2 * tb + tl + 1) * 512 + c * 32 + h * 16;
            const LAS unsigned char* bp = lds + (nb * 32 + r) * 32 + 16 * h;
#pragma unroll 2
            for (int s = 0; s <= 2 * tb + 1; ++s) { const bf16x8 a = *(const LAS bf16x8*)(ap - s * 512); const bf16x8 bb = *(const LAS bf16x8*)(bp + s * 2048);
                acc = __builtin_amdgcn_mfma_f32_32x32x16_bf16(a, bb, acc, 0, 0, 0); }
            const int chunk = nb * 32 + r;
#pragma unroll
            for (int q = 0; q < 4; ++q) { const int tq = q >> 1, c0 = 8 * (q & 1) + 4 * h; const int t = chunk * 32 + 2 * tb + tq;
                *(GAS f32x4*)(YI + (size_t)(b * 2048 + t) * 512 + g * 16 + c0) = (f32x4){acc[4 * q], acc[4 * q + 1], acc[4 * q + 2], acc[4 * q + 3]}; } }
    { const int mb = wave >> 1, nb = wave & 1; f32x16 acc = {};
        const bf16* ap = PTg + (size_t)(mb * 32 + r) * 16 + 8 * h; const LAS unsigned char* bp = lds + (nb * 32 + r) * 32 + 16 * h;
#pragma unroll 4
        for (int s = 0; s < 32; ++s) { const bf16x8 a = *(const GAS bf16x8*)(ap + (size_t)s * 128 * 16); const bf16x8 bb = *(const LAS bf16x8*)(bp + s * 2048);
            acc = __builtin_amdgcn_mfma_f32_32x32x16_bf16(a, bb, acc, 0, 0, 0); }
        const int chunk = nb * 32 + r;
        LAS float* SEL = (LAS float*)(lds + 98304);
#pragma unroll
        for (int q = 0; q < 4; ++q) { const int rho = mb * 32 + 8 * q + 4 * h;
#pragma unroll
            for (int i = 0; i < 4; ++i) SEL[(rho + i) * 65 + chunk] = acc[4 * q + i]; } }
    asm volatile("s_waitcnt lgkmcnt(0)" ::: "memory"); __syncthreads();
    if (tid < 64) { const int n = tid; const LAS float* SEL = (const LAS float*)(lds + 98304);
        const f32x2 a32 = ((const f32x2*)(s5ws + OFF_LP))[((size_t)(l * SG + g) * 32 + 31) * SN + n];
        float sr = 0.f, si = 0.f; float* dst = SE + ((size_t)(b * 64) * 32 + g) * 128 + n;
#pragma unroll 4
        for (int k = 0; k < 64; ++k) { dst[(size_t)k * 32 * 128] = sr; dst[(size_t)k * 32 * 128 + 64] = si;
            const float er = SEL[n * 65 + k], ei = SEL[(64 + n) * 65 + k];
            const float nr = a32.x * sr - a32.y * si + er, ni = a32.x * si + a32.y * sr + ei; sr = nr; si = ni; } }
    asm volatile("s_waitcnt lgkmcnt(0)" ::: "memory"); __syncthreads();
}

__device__ __forceinline__ float gelu_tanh(float x) { const float u = 0.7978845608028654f * (x + 0.044715f * x * x * x); const float e = __builtin_amdgcn_exp2f(2.885390081777927f * u);
    const float th = 1.f - 2.f * __builtin_amdgcn_rcpf(e + 1.f); return 0.5f * x * (1.f + th); }
__device__ __forceinline__ bf16x8 pack8(const float (&v)[8]) { v4u o; o.x = mk::pk2(v[0], v[1]); o.y = mk::pk2(v[2], v[3]); o.z = mk::pk2(v[4], v[5]); o.w = mk::pk2(v[6], v[7]); return __builtin_bit_cast(bf16x8, o); }
__device__ __forceinline__ float bflo(unsigned u) { return __uint_as_float(u << 16); }
__device__ __forceinline__ float bfhi(unsigned u) { return __uint_as_float(u & 0xffff0000u); }

__device__ __forceinline__ void post_unit(int l, int b, int k, const float* const* in, const bf16* PROJ, const bf16* SBO, const bf16* O1, const bf16* O2, bf16* Y,
                                          const unsigned char* s5ws, LAS unsigned char* lds) {
    const int tid = opaque_tid(), lane = tid & 63, wave = __builtin_amdgcn_readfirstlane(tid >> 6);
    const f32x2* LP = (const f32x2*)(s5ws + OFF_LP) + (size_t)l * SG * 32 * SN;
    const bf16* WG = (const bf16*)(s5ws + OFF_WG) + (size_t)l * 512 * 512;
    const float* YI = (const float*)(s5ws + OFF_YI); const float* SE = (const float*)(s5ws + OFF_SE);
    const float* c_re = in[8] + (size_t)l * SG * SC * SN; const float* c_im = in[9] + (size_t)l * SG * SC * SN; const float* dsk = in[10] + l * 512;
    const float* b_glu = in[13] + l * 512; const float* ssm_g = in[14] + l * 512; const float* sb_g = in[3] + l * 512; const float* df_g = in[19] + l * 128;
    LAS float* SIN = (LAS float*)lds; LAS unsigned short* G1 = (LAS unsigned short*)(lds + 16384); LAS unsigned short* OUTT = (LAS unsigned short*)(lds + 49664); LAS float* RS = (LAS float*)(lds + 82944);
    const size_t tok0 = (size_t)b * 2048 + (size_t)k * 32;
#pragma unroll
    for (int q = 0; q < 2; ++q) { const int p = tid + 512 * q; *(LAS f32x4*)(SIN + 4 * p) = *(const GAS f32x4*)(SE + ((size_t)(b * 64 + k) * 32) * 128 + 4 * p); }
    asm volatile("s_waitcnt vmcnt(0) lgkmcnt(0)" ::: "memory"); __syncthreads();
    { const int row = lane & 15, kg = lane >> 4;
#pragma unroll 1
      for (int gi = 0; gi < 4; ++gi) { const int g = wave * 4 + gi;
#pragma unroll
        for (int mb = 0; mb < 2; ++mb) { f32x4 acc = {0.f, 0.f, 0.f, 0.f}; const int t = 16 * mb + row;
#pragma unroll
            for (int ks = 0; ks < 4; ++ks) { const int ri = ks >> 1, n0 = 32 * (ks & 1) + 8 * kg;
                const GAS f32x4* lp = (const GAS f32x4*)(LP + ((size_t)g * 32 + t) * SN + n0);
                const f32x4 p0 = lp[0], p1 = lp[1], p2 = lp[2], p3 = lp[3];
                const f32x4 sr0 = *(const LAS f32x4*)(SIN + g * 128 + n0), sr1 = *(const LAS f32x4*)(SIN + g * 128 + n0 + 4);
                const f32x4 si0 = *(const LAS f32x4*)(SIN + g * 128 + 64 + n0), si1 = *(const LAS f32x4*)(SIN + g * 128 + 64 + n0 + 4);
                const float lr[8] = {p0.x, p0.z, p1.x, p1.z, p2.x, p2.z, p3.x, p3.z}, li[8] = {p0.y, p0.w, p1.y, p1.w, p2.y, p2.w, p3.y, p3.w};
                const float sr[8] = {sr0.x, sr0.y, sr0.z, sr0.w, sr1.x, sr1.y, sr1.z, sr1.w}, si[8] = {si0.x, si0.y, si0.z, si0.w, si1.x, si1.y, si1.z, si1.w};
                float w[8], cb[8];
                const GAS f32x4* cp = (const GAS f32x4*)((ri ? c_im : c_re) + (size_t)(g * SC + row) * SN + n0); const f32x4 c0 = cp[0], c1 = cp[1];
                const float sg = ri ? -1.f : 1.f;
                cb[0] = sg * c0.x; cb[1] = sg * c0.y; cb[2] = sg * c0.z; cb[3] = sg * c0.w; cb[4] = sg * c1.x; cb[5] = sg * c1.y; cb[6] = sg * c1.z; cb[7] = sg * c1.w;
#pragma unroll
                for (int j = 0; j < 8; ++j) w[j] = ri ? (lr[j] * si[j] + li[j] * sr[j]) : (lr[j] * sr[j] - li[j] * si[j]);
                acc = __builtin_amdgcn_mfma_f32_16x16x32_bf16(pack8(w), pack8(cb), acc, 0, 0, 0); }
            const int ch = g * SC + row;
            const float dk = dsk[ch];
#pragma unroll
            for (int rg = 0; rg < 4; ++rg) { const int tt = 16 * mb + 4 * kg + rg; const size_t tok = tok0 + tt;
                const float u = bflo((unsigned)PROJ[tok * 5120 + nv::C_U + ch]);
                const float y = acc[rg] + YI[tok * 512 + ch] + dk * u;
                G1[tt * 520 + ch] = (unsigned short)mk::f2bf(gelu_tanh(y)); } } } }
    asm volatile("s_waitcnt lgkmcnt(0)" ::: "memory"); __syncthreads();
    { const int row = lane & 15, kg = lane >> 4; f32x4 acc[2][4];
#pragma unroll
      for (int mb = 0; mb < 2; ++mb)
#pragma unroll
          for (int nb = 0; nb < 4; ++nb) acc[mb][nb] = (f32x4){0.f, 0.f, 0.f, 0.f};
#pragma unroll 2
      for (int ks = 0; ks < 16; ++ks) { bf16x8 a[2], bb[4];
#pragma unroll
          for (int mb = 0; mb < 2; ++mb) a[mb] = *(const LAS bf16x8*)(G1 + (16 * mb + row) * 520 + 32 * ks + 8 * kg);
#pragma unroll
          for (int nb = 0; nb < 4; ++nb) bb[nb] = *(const GAS bf16x8*)(WG + (size_t)(64 * wave + 16 * nb + row) * 512 + 32 * ks + 8 * kg);
#pragma unroll
          for (int mb = 0; mb < 2; ++mb)
#pragma unroll
              for (int nb = 0; nb < 4; ++nb) acc[mb][nb] = __builtin_amdgcn_mfma_f32_16x16x32_bf16(a[mb], bb[nb], acc[mb][nb], 0, 0, 0); }
      float ss[2][4];
#pragma unroll
      for (int mb = 0; mb < 2; ++mb)
#pragma unroll
          for (int rg = 0; rg < 4; ++rg) ss[mb][rg] = 0.f;
#pragma unroll
      for (int nb = 0; nb < 4; ++nb) { const int j = 64 * wave + 16 * nb + row; const float bz = b_glu[j];
#pragma unroll
          for (int mb = 0; mb < 2; ++mb)
#pragma unroll
              for (int rg = 0; rg < 4; ++rg) { const int tt = 16 * mb + 4 * kg + rg; const float z = acc[mb][nb][rg] + bz; const float g1 = bflo((unsigned)G1[tt * 520 + j]);
                  const float o = g1 * __builtin_amdgcn_rcpf(1.f + __builtin_amdgcn_exp2f(-1.4426950408889634f * z)); acc[mb][nb][rg] = o; ss[mb][rg] += o * o; } }
#pragma unroll
      for (int mb = 0; mb < 2; ++mb)
#pragma unroll
          for (int rg = 0; rg < 4; ++rg) { float v = ss[mb][rg]; v += __shfl_xor(v, 1); v += __shfl_xor(v, 2); v += __shfl_xor(v, 4); v += __shfl_xor(v, 8);
              if (row == 0) RS[wave * 32 + 16 * mb + 4 * kg + rg] = v; }
      asm volatile("s_waitcnt lgkmcnt(0)" ::: "memory"); __syncthreads();
#pragma unroll
      for (int mb = 0; mb < 2; ++mb)
#pragma unroll
          for (int rg = 0; rg < 4; ++rg) { const int tt = 16 * mb + 4 * kg + rg; float tot = 0.f;
#pragma unroll
              for (int w8 = 0; w8 < 8; ++w8) tot += RS[w8 * 32 + tt];
              const float rinv = rsqrtf(tot * (1.f / 512.f) + nv::EPS);
#pragma unroll
              for (int nb = 0; nb < 4; ++nb) { const int j = 64 * wave + 16 * nb + row; OUTT[tt * 520 + j] = (unsigned short)mk::f2bf(acc[mb][nb][rg] * rinv * ssm_g[j]); } }
      asm volatile("s_waitcnt lgkmcnt(0)" ::: "memory"); __syncthreads();
#pragma unroll
      for (int i = 0; i < 4; ++i) { const int p = tid + 512 * i, rw = p >> 6, c16 = p & 63; const v4u v = *(const LAS v4u*)(OUTT + rw * 520 + c16 * 8);
          *(GAS v4u*)(Y + (tok0 + rw) * 2048 + 512 + c16 * 8) = v; } }
    { float a_ = in[15][l * 64 + lane] * in[16][l * 64 + lane], c_ = in[17][l * 64 + lane] * in[18][l * 64 + lane];
      a_ = mk::wave_sum(a_); c_ = mk::wave_sum(c_);
      const float lam_init = 0.8f - 0.6f * __expf(-0.3f * (float)l); const float lam = __expf(a_) - __expf(c_) + lam_init;
#pragma unroll 1
      for (int i = 0; i < 4; ++i) { const size_t tok = tok0 + 4 * wave + i;
          { const v4u v = *(const GAS v4u*)(SBO + tok * 512 + lane * 8); const f32x4 g0 = *(const GAS f32x4*)(sb_g + lane * 8), g1 = *(const GAS f32x4*)(sb_g + lane * 8 + 4);
            float x[8] = {bflo(v.x), bfhi(v.x), bflo(v.y), bfhi(v.y), bflo(v.z), bfhi(v.z), bflo(v.w), bfhi(v.w)}; float s = 0.f;
#pragma unroll
            for (int j = 0; j < 8; ++j) s += x[j] * x[j];
            const float rinv = rsqrtf(mk::wave_sum(s) * (1.f / 512.f) + nv::EPS);
            v4u o; o.x = mk::pk2(x[0] * rinv * g0.x, x[1] * rinv * g0.y); o.y = mk::pk2(x[2] * rinv * g0.z, x[3] * rinv * g0.w); o.z = mk::pk2(x[4] * rinv * g1.x, x[5] * rinv * g1.y); o.w = mk::pk2(x[6] * rinv * g1.z, x[7] * rinv * g1.w);
            *(GAS v4u*)(Y + tok * 2048 + lane * 8) = o; }
          { const GAS v4u* p1 = (const GAS v4u*)(O1 + tok * 1024 + lane * 16); const GAS v4u* p2 = (const GAS v4u*)(O2 + tok * 1024 + lane * 16);
            const v4u a0 = p1[0], a1 = p1[1], b0 = p2[0], b1 = p2[1];
            float x[16] = {bflo(a0.x) - lam * bflo(b0.x), bfhi(a0.x) - lam * bfhi(b0.x), bflo(a0.y) - lam * bflo(b0.y), bfhi(a0.y) - lam * bfhi(b0.y),
                           bflo(a0.z) - lam * bflo(b0.z), bfhi(a0.z) - lam * bfhi(b0.z), bflo(a0.w) - lam * bflo(b0.w), bfhi(a0.w) - lam * bfhi(b0.w),
                           bflo(a1.x) - lam * bflo(b1.x), bfhi(a1.x) - lam * bfhi(b1.x), bflo(a1.y) - lam * bflo(b1.y), bfhi(a1.y) - lam * bfhi(b1.y),
                           bflo(a1.z) - lam * bflo(b1.z), bfhi(a1.z) - lam * bfhi(b1.z), bflo(a1.w) - lam * bflo(b1.w), bfhi(a1.w) - lam * bfhi(b1.w)};
            float s = 0.f;
#pragma unroll
            for (int j = 0; j < 16; ++j) s += x[j] * x[j];
            s += __shfl_xor(s, 1); s += __shfl_xor(s, 2); s += __shfl_xor(s, 4);
            const float rinv = rsqrtf(s * (1.f / 128.f) + nv::EPS) * (1.f - lam_init);
            const GAS f32x4* gp = (const GAS f32x4*)(df_g + (lane & 7) * 16); const f32x4 g0 = gp[0], g1 = gp[1], g2 = gp[2], g3 = gp[3];
            v4u o0, o1; o0.x = mk::pk2(x[0] * rinv * g0.x, x[1] * rinv * g0.y); o0.y = mk::pk2(x[2] * rinv * g0.z, x[3] * rinv * g0.w); o0.z = mk::pk2(x[4] * rinv * g1.x, x[5] * rinv * g1.y); o0.w = mk::pk2(x[6] * rinv * g1.z, x[7] * rinv * g1.w);
            o1.x = mk::pk2(x[8] * rinv * g2.x, x[9] * rinv * g2.y); o1.y = mk::pk2(x[10] * rinv * g2.z, x[11] * rinv * g2.w); o1.z = mk::pk2(x[12] * rinv * g3.x, x[13] * rinv * g3.y); o1.w = mk::pk2(x[14] * rinv * g3.z, x[15] * rinv * g3.w);
            GAS v4u* yo = (GAS v4u*)(Y + tok * 2048 + 1024 + lane * 16); yo[0] = o0; yo[1] = o1; } } }
    asm volatile("s_waitcnt lgkmcnt(0)" ::: "memory"); __syncthreads();
}
}

namespace mk {
struct MArgs { const float* in[30]; float* out; unsigned char* ws; int ph_lo, ph_hi, li, pad; };
constexpr int NPHASE = 1 + 8 * DEPTH;

__global__ void __launch_bounds__(NWAVES * 64, 2) mk_fwd(MArgs args) {
    extern __shared__ __attribute__((aligned(16))) unsigned char lds[];
    LAS unsigned char* ldsl = (LAS unsigned char*)lds;
    volatile LAS unsigned* MISC = (volatile LAS unsigned*)(ldsl + MISC_OFF);
    const int tid = threadIdx.x, wave = __builtin_amdgcn_readfirstlane(tid >> 6);
    const int G = gridDim.x; const int bx = blockIdx.x; const int vcu = (G % 8 == 0) ? (bx % 8) * (G / 8) + bx / 8 : bx;
    unsigned char* ws = args.ws;
    gu32* ctl = (gu32*)(ws + WS_CTL);
    for (int u = tid; u < (LDS_BYTES - LDSCTL_OFF) / 4; u += NWAVES * 64) ((LAS unsigned*)(ldsl + LDSCTL_OFF))[u] = 0u;
    __syncthreads();
    XcdBarrier bar = xcd_barrier_post((unsigned*)(ctl + CW_BAR) + args.li * XCD_BAR_WORDS, MISC + 8);
    const int lo = args.ph_lo, hi = args.ph_hi;
#ifndef REP_P0
#define REP_P0 1
#endif
#ifndef REP_A
#define REP_A 1
#endif
#ifndef REP_B
#define REP_B 1
#endif
#ifndef REP_C
#define REP_C 1
#endif
#ifndef REP_D0
#define REP_D0 1
#endif
#ifndef REP_F
#define REP_F 1
#endif
#ifndef REP_G
#define REP_G 1
#endif
#ifndef REP_BARX
#define REP_BARX 0
#endif
#ifndef REP_E
#define REP_E 1
#endif
#ifndef REP_H1
#define REP_H1 1
#endif
#define IN(k) (lo <= (k) && (k) < hi)
#define REPEAT(n) for (int rep_ = 0; rep_ < (n); ++rep_, ((rep_ < (n)) ? xcd_barrier(bar) : (void)0))
#define SEAM(k) do { if (IN(k) && IN((k) + 1)) xcd_barrier(bar); } while (0)
    bf16* WinT = (bf16*)(ws + WS_WIN); bf16* WoutT = (bf16*)(ws + WS_WOUT); bf16* XN = (bf16*)(ws + WS_XN); bf16* PROJ = (bf16*)(ws + WS_PROJ);
    bf16* Y = (bf16*)(ws + WS_Y); float* H = (float*)(ws + WS_H); bf16* YS = (bf16*)(ws + WS_YS); bf16* HB = (bf16*)(ws + WS_HB);
    bf16* W13T = (bf16*)(ws + WS_W13); bf16* W2T = (bf16*)(ws + WS_W2); int* LIST = (int*)(ws + WS_ROUTE); float* GATEW = (float*)(ws + WS_ROUTE + MiB);
    float* WRT = (float*)(ws + WS_ROUTE + MiB + 256 * 1024);
    LAS int* tab = (LAS int*)(ldsl + LDSCTL_OFF + 1024);
    const int NGW = G * NWAVES;
#define PHASE_IDS() const int tid_ = opaque_tid(); const int lane = tid_ & 63; const int gw = vcu * NWAVES + wave; (void)gw; (void)lane

    REPEAT(REP_P0) if (IN(0)) { PHASE_IDS();
        LAS float* scr = (LAS float*)(ldsl + RING_OFF + wave * 16640);
        constexpr int I_IN = (D / 64) * (INC / 64), I_OUT = (D / 64) * (D / 64);
        constexpr int NIT = DEPTH * (I_IN + I_OUT);
        for (int it = gw; it < NIT; it += NGW) {
            int r = it; const int l = r / (I_IN + I_OUT); r -= l * (I_IN + I_OUT);
            if (r < I_IN) { const int nb = r % (INC / 64), kb = r / (INC / 64);
                transpose_tile(args.in[2] + (size_t)l * D * INC, INC, kb * 64, nb * 64, WinT + ((size_t)l * INC + nb * 64) * D, D, scr, lane); }
            else { r -= I_IN; const int nb = r % (D / 64), kb = r / (D / 64);
                transpose_tile(args.in[20] + (size_t)l * D * D, D, kb * 64, nb * 64, WoutT + ((size_t)l * D + nb * 64) * D, D, scr, lane); }
        }
        for (int m = gw; m < T; m += NGW) rms_row_to_bf16(args.in[0] + (size_t)m * D, args.in[1], XN + (size_t)m * D, lane);
        for (int it = vcu * (NWAVES * 64) + tid_; it < DEPTH * 48 * D; it += G * NWAVES * 64) { const int d = it & (D - 1), c = (it >> 11) % 48, l = it / (48 * D);
            float w = 0.f; if (c < 4) w = args.in[22][((size_t)l * D + d) * 4 + c]; else if (c < 36) { const int gq = (c - 4) >> 3, e = (c - 4) & 7; w = args.in[24][(((size_t)l * 4 + gq) * D + d) * 8 + e]; }
            WRT[it] = w * args.in[21][(size_t)l * D + d]; }
        s5::build_tables(args.in, ws + WS_S5, vcu * (NWAVES * 64) + tid_, G * NWAVES * 64);
        for (int it = gw; it < DEPTH * 64; it += NGW) { const int l = it >> 6, r = it & 63, nb = r & 7, kb = r >> 3;
            transpose_tile(args.in[12] + (size_t)l * 512 * 512, 512, kb * 64, nb * 64, (bf16*)(ws + WS_S5 + s5::OFF_WG) + ((size_t)l * 512 + nb * 64) * 512, 512, scr, lane); }
        constexpr int NEX = DEPTH * nv::NEXP * 768;
        for (int it = gw; it < NEX; it += NGW) {
            const int le = it / 768; int r = it - le * 768;
            if (r < 512) { const int w3 = r >> 8; r &= 255; const int nb = r & 7, kb = r >> 3; const int n0 = nb * 64;
                const float* W = args.in[w3 ? 27 : 26] + (size_t)le * D * nv::DE;
                transpose_tile(W, nv::DE, kb * 64, n0, W13T + ((size_t)le * 1024 + (n0 >> 7) * 256 + w3 * 128 + (n0 & 127)) * D, D, scr, lane); }
            else { r -= 512; const int nb = r & 31, kb = r >> 5;
                transpose_tile(args.in[28] + (size_t)le * nv::DE * D, D, kb * 64, nb * 64, W2T + ((size_t)le * D + nb * 64) * nv::DE, nv::DE, scr, lane); }
        }
    }
    SEAM(0);
    for (int xb_ = 0; xb_ < REP_BARX; ++xb_) xcd_barrier(bar);
    for (int l = 0; l < DEPTH; ++l) {
        const int pb = 1 + 8 * l;
        REPEAT(REP_A) if (IN(pb + 0)) {
            pg8::Gemm g{XN, WinT + (size_t)l * INC * D, T, INC, D}; pg8::StaticOrder S; S.init(T, INC, G, bx);
            pg8::EpiProj E{PROJ, INC};
            pg8::gemm_phase<pg8::EpiProj, pg8::StaticOrder, PG8_ALIGN, PG8_SP2>(ldsl + RING_OFF, g, S, E);
        }
        SEAM(pb + 0);
        REPEAT(REP_B) { if (IN(pb + 1)) {
#pragma unroll 1
            for (int u = vcu; u < 128; u += G) s5::s5a_unit(l, u & 31, u >> 5, PROJ, ws + WS_S5, ldsl + RING_OFF);
        }
        if (IN(pb + 1)) {
            bf16* O1 = (bf16*)(ws + WS_O1); bf16* O2 = (bf16*)(ws + WS_O2);
#pragma unroll 1
            for (int u = vcu; u < 1024; u += G) { const int i = u >> 8, v = u & 255, combo = v >> 1, sub = v & 1;
                const int qb = ((sub ? 0x4352 : 0x6170) >> (4 * i)) & 7;
                const int b = combo >> 5, rem = combo & 31, h = rem >> 2, mp = (rem >> 1) & 1, vh = rem & 1;
                attn_body::attn_unit<8>(b, qb, (const attn_body::bf16*)(PROJ + nv::C_DQ + h * 128 + mp * 64), (const attn_body::bf16*)(PROJ + nv::C_DK + h * 128 + mp * 64),
                                        (const attn_body::bf16*)(PROJ + nv::C_DV + h * 128 + vh * 64), (attn_body::bf16*)((mp ? O2 : O1) + h * 128 + vh * 64), 1024, (char*)lds + RING_OFF); }
        }
#if !defined(NO_MK_SB)
        if (IN(pb + 1)) {
            bf16* SBO = (bf16*)(ws + WS_SBO);
#pragma unroll 1
            for (int u = vcu; u < 256; u += G) { const int bh = u >> 3, qb = u & 7, b = bh >> 3, h = bh & 7;
                attn_body::sb_unit(b, qb, (const attn_body::bf16*)(PROJ + nv::C_SBQ + h * 64), (const attn_body::bf16*)(PROJ + nv::C_SBK + h * 64),
                                   (const attn_body::bf16*)(PROJ + nv::C_SBV + h * 64), (attn_body::bf16*)(SBO + h * 64), 512, (char*)lds + RING_OFF); }
        }
#endif
        }
        SEAM(pb + 1);
        REPEAT(REP_C) if (IN(pb + 2)) {
#pragma unroll 1
            for (int u = vcu; u < 256; u += G) s5::post_unit(l, u >> 6, u & 63, args.in, PROJ, (const bf16*)(ws + WS_SBO), (const bf16*)(ws + WS_O1), (const bf16*)(ws + WS_O2), Y, ws + WS_S5, ldsl + RING_OFF);
        }
        SEAM(pb + 2);
        REPEAT(l == 0 ? REP_D0 : 1) if (IN(pb + 3)) {
            pg8::Gemm g{Y, WoutT + (size_t)l * D * D, T, D, D}; pg8::StaticOrder S; S.init(T, D, G, bx);
            pg8::EpiResF32 E{l == 0 ? args.in[0] : (const float*)H, H, D};
            pg8::gemm_phase<pg8::EpiResF32, pg8::StaticOrder, PG8_ALIGN, PG8_SP2>(ldsl + RING_OFF, g, S, E);
        }
        SEAM(pb + 3);
        gu32* cnt = ctl + CW_CNT + 2048 * l;
        if (IN(pb + 4)) { PHASE_IDS();
            const float* gF = args.in[21] + (size_t)l * D; const float* rgb = args.in[23] + l * 4; const float* reb = args.in[25] + l * 32;
            const float* wrt = WRT + (size_t)l * 48 * D;
            LAS float* PL = (LAS float*)(ldsl + RING_OFF);
            LAS float* PS = (LAS float*)(ldsl + RING_OFF + 24576);
            LAS float* RR = (LAS float*)(ldsl + RING_OFF + 25600);
            const int tile = wave >> 2, kq = wave & 3, row = lane & 15, kk = lane >> 4;
#pragma unroll 1
            for (int m0 = 32 * vcu; m0 < T; m0 += 32 * G) {
                const GAS f32x4* ap = (const GAS f32x4*)(H + (size_t)(m0 + 16 * tile + row) * D + kq * 512 + kk * 128);
                const GAS f32x4* bp = (const GAS f32x4*)(wrt + (size_t)row * D + kq * 512 + kk * 128);
                f32x4 acc0 = {0.f, 0.f, 0.f, 0.f}, acc1 = acc0, acc2 = acc0; float ssq = 0.f;
#pragma unroll 4
                for (int i = 0; i < 32; ++i) { const f32x4 a4 = ap[i], b0 = bp[i], b1 = bp[i + 16 * D / 4], b2 = bp[i + 32 * D / 4];
                    ssq += (a4.x * a4.x + a4.y * a4.y) + (a4.z * a4.z + a4.w * a4.w);
                    acc0 = __builtin_amdgcn_mfma_f32_16x16x4f32(a4.x, b0.x, acc0, 0, 0, 0); acc1 = __builtin_amdgcn_mfma_f32_16x16x4f32(a4.x, b1.x, acc1, 0, 0, 0); acc2 = __builtin_amdgcn_mfma_f32_16x16x4f32(a4.x, b2.x, acc2, 0, 0, 0);
                    acc0 = __builtin_amdgcn_mfma_f32_16x16x4f32(a4.y, b0.y, acc0, 0, 0, 0); acc1 = __builtin_amdgcn_mfma_f32_16x16x4f32(a4.y, b1.y, acc1, 0, 0, 0); acc2 = __builtin_amdgcn_mfma_f32_16x16x4f32(a4.y, b2.y, acc2, 0, 0, 0);
                    acc0 = __builtin_amdgcn_mfma_f32_16x16x4f32(a4.z, b0.z, acc0, 0, 0, 0); acc1 = __builtin_amdgcn_mfma_f32_16x16x4f32(a4.z, b1.z, acc1, 0, 0, 0); acc2 = __builtin_amdgcn_mfma_f32_16x16x4f32(a4.z, b2.z, acc2, 0, 0, 0);
                    acc0 = __builtin_amdgcn_mfma_f32_16x16x4f32(a4.w, b0.w, acc0, 0, 0, 0); acc1 = __builtin_amdgcn_mfma_f32_16x16x4f32(a4.w, b1.w, acc1, 0, 0, 0); acc2 = __builtin_amdgcn_mfma_f32_16x16x4f32(a4.w, b2.w, acc2, 0, 0, 0); }
                ssq += __shfl_xor(ssq, 16); ssq += __shfl_xor(ssq, 32);
                if (kk == 0) PS[(tile * 4 + kq) * 16 + row] = ssq;
#pragma unroll
                for (int rg = 0; rg < 4; ++rg) { LAS float* p = PL + ((tile * 4 + kq) * 16 + 4 * kk + rg) * 48 + row; p[0] = acc0[rg]; p[16] = acc1[rg]; p[32] = acc2[rg]; }
                LDS_WAIT(); __syncthreads();
                if (wave == 0 && lane < 32) { const int t2 = lane >> 4, rw = lane & 15;
                    float sq = 0.f;
#pragma unroll
                    for (int q = 0; q < 4; ++q) sq += PS[(t2 * 4 + q) * 16 + rw];
                    const float r = rsqrtf(sq * (1.f / D) + EPS); RR[lane] = r;
                    const LAS float* p0 = PL + ((t2 * 4 + 0) * 16 + rw) * 48; const LAS float* p1 = p0 + 16 * 48; const LAS float* p2 = p1 + 16 * 48; const LAS float* p3 = p2 + 16 * 48;
                    float gl[4]; int gi = 0; float gm = -INFINITY;
#pragma unroll
                    for (int q = 0; q < 4; ++q) { gl[q] = ((p0[q] + p1[q]) + (p2[q] + p3[q])) * r + rgb[q]; if (gl[q] > gm) { gm = gl[q]; gi = q; } }
                    const float gtop = 1.f / (expf(gl[0] - gm) + expf(gl[1] - gm) + expf(gl[2] - gm) + expf(gl[3] - gm));
                    float m0v = -INFINITY, m1v = -INFINITY; int i0 = 0, i1 = 0;
#pragma unroll
                    for (int q = 0; q < 8; ++q) { const int c = 4 + gi * 8 + q; const float lv = ((p0[c] + p1[c]) + (p2[c] + p3[c])) * r + reb[gi * 8 + q];
                        if (lv > m0v) { m1v = m0v; i1 = i0; m0v = lv; i0 = q; } else if (lv > m1v) { m1v = lv; i1 = q; } }
                    const float p1e = expf(m1v - m0v); const float w0 = 1.f / (1.f + p1e) * gtop, w1 = p1e / (1.f + p1e) * gtop;
                    const int x0 = gi * 8 + i0, x1 = gi * 8 + i1; const int mr = m0 + lane;
                    const unsigned q0 = __hip_atomic_fetch_add(cnt + 64 * x0, 1u, RLX_AGENT), q1 = __hip_atomic_fetch_add(cnt + 64 * x1, 1u, RLX_AGENT);
                    LIST[x0 * 8192 + q0] = 2 * mr; LIST[x1 * 8192 + q1] = 2 * mr + 1; GATEW[2 * mr] = w0; GATEW[2 * mr + 1] = w1; }
                LDS_WAIT(); __syncthreads();
#pragma unroll 1
                for (int i = 0; i < 4; ++i) { const int mr = m0 + 4 * wave + i; const float r = RR[4 * wave + i];
                    const GAS f32x4* hr = (const GAS f32x4*)(H + (size_t)mr * D) + lane; const GAS f32x4* gr = (const GAS f32x4*)gF + lane;
                    GAS unsigned long long* o8 = (GAS unsigned long long*)(XN + (size_t)mr * D) + lane;
#pragma unroll
                    for (int j = 0; j < 8; ++j) { const f32x4 o = hr[64 * j] * r * gr[64 * j]; o8[64 * j] = (unsigned long long)pk2(o.x, o.y) | ((unsigned long long)pk2(o.z, o.w) << 32); } }
                LDS_WAIT(); __syncthreads();
            }
        }
        SEAM(pb + 4);
#define BUILD_TAB() do { PHASE_IDS(); if (wave == 0) { const int c_ = (lane < 32) ? (int)__hip_atomic_load(cnt + 64 * (lane & 31), RLX_AGENT) : 0; int incl = (c_ + 255) >> 8; \
            _Pragma("unroll") for (int o = 1; o < 32; o <<= 1) { const int t_ = __shfl_up(incl, o); if (lane >= o) incl += t_; } \
            if (lane < 32) { tab[lane] = c_; tab[33 + lane] = incl; } if (lane == 0) tab[32] = 0; } LDS_WAIT(); __syncthreads(); } while (0)
        REPEAT(REP_F) if (IN(pb + 5)) {
            BUILD_TAB();
            pg8::GroupedOrder S{(const LAS int*)tab, 4, G, bx, 1024u * 2048u * 2u};
            pg8::Gemm g{XN, W13T + (size_t)l * nv::NEXP * 1024 * D, 0, 0, D};
            pg8::EpiMoe1 E{HB, LIST, GATEW};
            pg8::gemm_phase_g<pg8::EpiMoe1, true>(ldsl + RING_OFF, g, S, E, LIST);
        }
        SEAM(pb + 5);
        REPEAT(REP_G) if (IN(pb + 6)) {
            BUILD_TAB();
            pg8::GroupedOrder S{(const LAS int*)tab, 8, G, bx, 2048u * 512u * 2u};
            pg8::Gemm g{HB, W2T + (size_t)l * nv::NEXP * D * nv::DE, 0, 0, nv::DE};
            pg8::EpiMoe2 E{YS, LIST};
            pg8::gemm_phase_g<pg8::EpiMoe2, false>(ldsl + RING_OFF, g, S, E, LIST);
        }
        SEAM(pb + 6);
        REPEAT(l == 1 ? REP_H1 : 1) if (IN(pb + 7)) { PHASE_IDS();
            const bool fin = (l + 1 == DEPTH); const float* gN = fin ? args.in[29] : args.in[1] + (size_t)(l + 1) * D;
            for (int m = gw; m < T; m += NGW) {
                GAS f32x4* hr = (GAS f32x4*)(H + (size_t)m * D) + lane; const GAS f32x4* gr = (const GAS f32x4*)gN + lane;
                typedef unsigned u32x2_t __attribute__((ext_vector_type(2))); const GAS u32x2_t* y0 = (const GAS u32x2_t*)(YS + (size_t)(2 * m) * D) + lane; const GAS u32x2_t* y1 = (const GAS u32x2_t*)(YS + (size_t)(2 * m + 1) * D) + lane;
                f32x4 v[8]; float s = 0.f;
#pragma unroll
                for (int j = 0; j < 8; ++j) { const f32x4 h4 = hr[64 * j]; const u32x2_t a = y0[64 * j], b = y1[64 * j];
                    v[j].x = h4.x + __uint_as_float(a.x << 16) + __uint_as_float(b.x << 16); v[j].y = h4.y + __uint_as_float(a.x & 0xffff0000u) + __uint_as_float(b.x & 0xffff0000u);
                    v[j].z = h4.z + __uint_as_float(a.y << 16) + __uint_as_float(b.y << 16); v[j].w = h4.w + __uint_as_float(a.y & 0xffff0000u) + __uint_as_float(b.y & 0xffff0000u);
                    s += (v[j].x * v[j].x + v[j].y * v[j].y) + (v[j].z * v[j].z + v[j].w * v[j].w); }
                const float r = rsqrtf(wave_sum(s) * (1.f / D) + EPS);
                if (fin) { GAS f32x4* orow = (GAS f32x4*)(args.out + (size_t)m * D) + lane;
#pragma unroll
                    for (int j = 0; j < 8; ++j) orow[64 * j] = v[j] * r * gr[64 * j]; }
                else { GAS unsigned long long* o8 = (GAS unsigned long long*)(XN + (size_t)m * D) + lane;
#pragma unroll
                    for (int j = 0; j < 8; ++j) { hr[64 * j] = v[j]; const f32x4 o = v[j] * r * gr[64 * j]; o8[64 * j] = (unsigned long long)pk2(o.x, o.y) | ((unsigned long long)pk2(o.z, o.w) << 32); } }
            }
        }
        SEAM(pb + 7);
    }
#undef IN
#undef SEAM
}

static int g_grid = 0;
static bool mk_setup() {
    if (g_grid != 0) return g_grid > 0;
    int dev = 0, cus = 0, per_cu = 0;
    if (hipGetDevice(&dev) != hipSuccess || hipDeviceGetAttribute(&cus, hipDeviceAttributeMultiprocessorCount, dev) != hipSuccess) { g_grid = -1; return false; }
    if (hipFuncSetAttribute((const void*)mk_fwd, hipFuncAttributeMaxDynamicSharedMemorySize, LDS_BYTES) != hipSuccess) { fprintf(stderr, "mk: hipFuncSetAttribute failed\n"); g_grid = -1; return false; }
    if (hipOccupancyMaxActiveBlocksPerMultiprocessor(&per_cu, (const void*)mk_fwd, NWAVES * 64, LDS_BYTES) != hipSuccess || per_cu < 1) { fprintf(stderr, "mk: occupancy query says %d\n", per_cu); }
    (void)hipGetLastError();
    g_grid = cus;
    return true;
}
static void mk_launch(const MArgs& base, int lo, int hi, int& li, hipStream_t stream) {
    MArgs a = base; a.ph_lo = lo; a.ph_hi = hi; a.li = li++; a.pad = 0;
    hipLaunchKernelGGL(mk_fwd, dim3(g_grid), dim3(NWAVES * 64), LDS_BYTES, stream, a);
}
}
extern "C" void kernel_launch(void* const* d_in, const int* in_sizes, int n_in, void* d_out, int out_size, void* d_ws, size_t ws_size, hipStream_t stream) {
    using namespace nv;
    if (n_in != 30 || ws_size < mk::WS_END) { fprintf(stderr, "kernel_launch: unexpected n_in %d / ws %zu\n", n_in, ws_size); return; }
    if (!mk::mk_setup()) return;
    const float* x = (const float*)d_in[0];
    const float* norm_mix_g = (const float*)d_in[1]; const float* sb_norm_g = (const float*)d_in[3];
    const float* lam_re = (const float*)d_in[4]; const float* lam_im = (const float*)d_in[5]; const float* b_re = (const float*)d_in[6]; const float* b_im = (const float*)d_in[7];
    const float* c_re = (const float*)d_in[8]; const float* c_im = (const float*)d_in[9]; const float* ssm_d = (const float*)d_in[10]; const float* log_dt = (const float*)d_in[11];
    const float* w_glu = (const float*)d_in[12]; const float* b_glu = (const float*)d_in[13]; const float* ssm_norm_g = (const float*)d_in[14];
    const float* lq1 = (const float*)d_in[15]; const float* lk1 = (const float*)d_in[16]; const float* lq2 = (const float*)d_in[17]; const float* lk2 = (const float*)d_in[18];
    const float* subln = (const float*)d_in[19]; const float* norm_ffn_g = (const float*)d_in[21];
    const float* rgw = (const float*)d_in[22]; const float* rgb = (const float*)d_in[23]; const float* rew = (const float*)d_in[24]; const float* reb = (const float*)d_in[25];
    const float* ew1 = (const float*)d_in[26]; const float* ew3 = (const float*)d_in[27]; const float* ew2 = (const float*)d_in[28]; const float* final_g = (const float*)d_in[29];
    char* ws = (char*)d_ws;
    bf16_t* XN = (bf16_t*)(ws + mk::WS_XN); bf16_t* PROJ = (bf16_t*)(ws + mk::WS_PROJ); bf16_t* SBO = (bf16_t*)(ws + mk::WS_SBO);
    bf16_t* O1 = (bf16_t*)(ws + mk::WS_O1); bf16_t* O2 = (bf16_t*)(ws + mk::WS_O2); bf16_t* Y = (bf16_t*)(ws + mk::WS_Y); float* H = (float*)(ws + mk::WS_H);
    bf16_t* YS = (bf16_t*)(ws + mk::WS_YS);
    float2* ST = (float2*)(ws + mk::WS_S5); float* G1 = (float*)(ws + mk::WS_S5 + 128 * mk::MiB); float* SY = (float*)(ws + mk::WS_S5 + 144 * mk::MiB);
    (void)hipMemsetAsync(ws + mk::WS_CTL, 0, mk::CTL_ZERO_BYTES, stream);
    mk::MArgs a{};
    for (int i = 0; i < 30; ++i) a.in[i] = (const float*)d_in[i];
    a.out = (float*)d_out; a.ws = (unsigned char*)d_ws;
    int li = 0;
    mk::mk_launch(a, 0, mk::NPHASE, li, stream);
}
```

```cpp
#include <hip/hip_runtime.h>
#include <hip/hip_bf16.h>
#include <cstdint>
#include <cstdio>
#include <cmath>
__device__ __forceinline__ int opaque_tid() { int t = threadIdx.x; asm volatile("" : "+v"(t)); return t; }
namespace nv {
constexpr int NB = 4, L = 2048, D = 2048, T = NB * L, DEPTH = 2;
constexpr int SBW = 512, SBH = 8, SSMW = 512, SG = 32, SN = 64, SC = 16, DFW = 1024, DFH = 8, DFV = 128;
constexpr int INC = 5120, NEXP = 32, EPG = 8, NGRP = 4, DE = 512;
constexpr int C_SBQ = 0, C_SBK = 512, C_SBV = 1024, C_U = 1536, C_DQ = 2048, C_DK = 3072, C_DV = 4096;
constexpr float EPS = 1e-6f;
constexpr float LOG2E = 1.4426950408889634f;
constexpr float QS_SB = 0.125f * LOG2E, QS_DF = 0.125f * LOG2E;

typedef unsigned short bf16_t;
__device__ __forceinline__ float bf2f(bf16_t v) { return __uint_as_float(((unsigned)v) << 16); }
__device__ __forceinline__ bf16_t f2bf(float f) { unsigned u = __float_as_uint(f); return (bf16_t)((u + 0x7fffu + ((u >> 16) & 1u)) >> 16); }

__device__ __forceinline__ float block_sum(float v, float* red) {
    for (int o = 32; o > 0; o >>= 1) v += __shfl_xor(v, o);
    const int w = threadIdx.x >> 6, nw = blockDim.x >> 6;
    __syncthreads();
    if ((threadIdx.x & 63) == 0) red[w] = v;
    __syncthreads();
    float s = 0.f;
    for (int i = 0; i < nw; ++i) s += red[i];
    return s;
}
__device__ __forceinline__ float block_max(float v, float* red) {
    for (int o = 32; o > 0; o >>= 1) v = fmaxf(v, __shfl_xor(v, o));
    const int w = threadIdx.x >> 6, nw = blockDim.x >> 6;
    __syncthreads();
    if ((threadIdx.x & 63) == 0) red[w] = v;
    __syncthreads();
    float s = -INFINITY;
    for (int i = 0; i < nw; ++i) s = fmaxf(s, red[i]);
    return s;
}

__global__ void __launch_bounds__(256) k_rmsnorm(const float* __restrict__ x, const float* __restrict__ g, bf16_t* __restrict__ out) {
    __shared__ float red[16];
    const int t = blockIdx.x; const float* xr = x + (size_t)t * D;
    float v[8]; float s = 0.f;
    for (int i = 0; i < 8; ++i) { v[i] = xr[threadIdx.x + 256 * i]; s += v[i] * v[i]; }
    s = block_sum(s, red);
    const float r = rsqrtf(s / D + EPS);
    for (int i = 0; i < 8; ++i) out[(size_t)t * D + threadIdx.x + 256 * i] = f2bf(v[i] * r * g[threadIdx.x + 256 * i]);
}

template <int EPI>
__global__ void __launch_bounds__(256) k_gemm(const bf16_t* __restrict__ A, int lda, const float* __restrict__ Bm, int ldb, int K,
                                             void* __restrict__ Cout, int ldc, const float* __restrict__ R) {
    __shared__ float As[16][68];
    __shared__ float Bs[16][68];
    const int tx = threadIdx.x & 15, ty = threadIdx.x >> 4;
    const int m0 = blockIdx.y * 64, n0 = blockIdx.x * 64;
    float acc[4][4];
    for (int i = 0; i < 4; ++i) for (int j = 0; j < 4; ++j) acc[i][j] = 0.f;
    for (int k0 = 0; k0 < K; k0 += 16) {
        for (int e = threadIdx.x; e < 64 * 16; e += 256) { const int r = e >> 4, c = e & 15; As[c][r] = bf2f(A[(size_t)(m0 + r) * lda + k0 + c]); }
        for (int e = threadIdx.x; e < 64 * 16; e += 256) { const int r = e >> 6, c = e & 63; Bs[r][c] = Bm[(size_t)(k0 + r) * ldb + n0 + c]; }
        __syncthreads();
#pragma unroll
        for (int k = 0; k < 16; ++k) {
            float a[4], b[4];
            for (int i = 0; i < 4; ++i) a[i] = As[k][ty * 4 + i];
            for (int j = 0; j < 4; ++j) b[j] = Bs[k][tx * 4 + j];
            for (int i = 0; i < 4; ++i) for (int j = 0; j < 4; ++j) acc[i][j] += a[i] * b[j];
        }
        __syncthreads();
    }
    for (int i = 0; i < 4; ++i) for (int j = 0; j < 4; ++j) {
        const int m = m0 + ty * 4 + i, n = n0 + tx * 4 + j;
        if (EPI == 0) {
            float sc = 1.f; if (n < C_SBK) sc = QS_SB; else if (n >= C_DQ && n < C_DK) sc = QS_DF;
            ((bf16_t*)Cout)[(size_t)m * ldc + n] = f2bf(acc[i][j] * sc);
        } else {
            ((float*)Cout)[(size_t)m * ldc + n] = acc[i][j] + R[(size_t)m * ldc + n];
        }
    }
}

__global__ void __launch_bounds__(256) k_sb_attn(const bf16_t* __restrict__ P, bf16_t* __restrict__ O) {
    __shared__ float zs[L];
    __shared__ float qv[64];
    __shared__ float part[4][64];
    const int t = blockIdx.x, h = blockIdx.y, b = blockIdx.z, tid = threadIdx.x;
    const size_t rowb = (size_t)b * L;
    if (tid < 64) qv[tid] = bf2f(P[(rowb + t) * INC + C_SBQ + h * 64 + tid]);
    __syncthreads();
    for (int s = tid; s < t; s += 256) {
        const bf16_t* kr = P + (rowb + s) * INC + C_SBK + h * 64;
        float z = 0.f;
        for (int d = 0; d < 64; ++d) z += qv[d] * bf2f(kr[d]);
        zs[s] = z;
    }
    __syncthreads();
    if (tid == 0) {
        float Racc = 0.f;
        for (int s = t - 1; s >= 0; --s) {
            const float z = zs[s];
            const float sp = fmaxf(-z, 0.f) + log1pf(expf(-fabsf(z)));
            zs[s] = expf(-sp + Racc);
            Racc += -(sp + z);
        }
    }
    __syncthreads();
    const int d = tid & 63, gq = tid >> 6;
    float o = 0.f;
    for (int s = gq; s < t; s += 4) o += zs[s] * bf2f(P[(rowb + s) * INC + C_SBV + h * 64 + d]);
    part[gq][d] = o;
    __syncthreads();
    if (tid < 64) O[(rowb + t) * SBW + h * 64 + tid] = f2bf(part[0][tid] + part[1][tid] + part[2][tid] + part[3][tid]);
}

__global__ void __launch_bounds__(256) k_diff_attn(const bf16_t* __restrict__ P, bf16_t* __restrict__ O1, bf16_t* __restrict__ O2) {
    __shared__ float ps[L];
    __shared__ float qv[64];
    __shared__ float part[2][128];
    __shared__ float red[16];
    const int t = blockIdx.x, h = blockIdx.y >> 1, mp = blockIdx.y & 1, b = blockIdx.z, tid = threadIdx.x;
    const size_t rowb = (size_t)b * L;
    if (tid < 64) qv[tid] = bf2f(P[(rowb + t) * INC + C_DQ + h * 128 + mp * 64 + tid]);
    __syncthreads();
    float mx = -INFINITY;
    for (int s = tid; s <= t; s += 256) {
        const bf16_t* kr = P + (rowb + s) * INC + C_DK + h * 128 + mp * 64;
        float z = 0.f;
        for (int d = 0; d < 64; ++d) z += qv[d] * bf2f(kr[d]);
        ps[s] = z; mx = fmaxf(mx, z);
    }
    mx = block_max(mx, red);
    float sum = 0.f;
    for (int s = tid; s <= t; s += 256) { const float p = exp2f(ps[s] - mx); ps[s] = p; sum += p; }
    sum = block_sum(sum, red);
    __syncthreads();
    const int d = tid & 127, gq = tid >> 7;
    float o = 0.f;
    for (int s = gq; s <= t; s += 2) o += ps[s] * bf2f(P[(rowb + s) * INC + C_DV + h * 128 + d]);
    part[gq][d] = o;
    __syncthreads();
    if (tid < 128) { bf16_t* O = mp ? O2 : O1; O[(rowb + t) * DFW + h * 128 + tid] = f2bf((part[0][tid] + part[1][tid]) / sum); }
}

__global__ void __launch_bounds__(64) k_s5_scan(const bf16_t* __restrict__ P, const float* lam_re, const float* lam_im, const float* b_re, const float* b_im,
                                                const float* log_dt, float2* __restrict__ ST) {
    const int b = blockIdx.x / SG, g = blockIdx.x % SG, n = threadIdx.x;
    const double dt = exp((double)log_dt[g]);
    const double lr = lam_re[g * SN + n], li = lam_im[g * SN + n];
    const double er = exp(lr * dt), lbr = er * cos(li * dt), lbi = er * sin(li * dt);
    const double nr = lbr - 1.0, ni = lbi, den = lr * lr + li * li;
    const double fr = (nr * lr + ni * li) / den, fi = (ni * lr - nr * li) / den;
    float bbr[SC], bbi[SC];
#pragma unroll
    for (int c = 0; c < SC; ++c) { const double br = b_re[(g * SN + n) * SC + c], bi = b_im[(g * SN + n) * SC + c]; bbr[c] = (float)(fr * br - fi * bi); bbi[c] = (float)(fr * bi + fi * br); }
    const float ar = (float)lbr, ai = (float)lbi;
    float sr = 0.f, si = 0.f;
    for (int t = 0; t < L; ++t) {
        const bf16_t* ur = P + ((size_t)b * L + t) * INC + C_U + g * SC;
        float bur = 0.f, bui = 0.f;
#pragma unroll
        for (int c = 0; c < SC; ++c) { const float u = bf2f(ur[c]); bur += bbr[c] * u; bui += bbi[c] * u; }
        const float nsr = ar * sr - ai * si + bur, nsi = ar * si + ai * sr + bui;
        sr = nsr; si = nsi;
        ST[(((size_t)b * L + t) * SG + g) * SN + n] = make_float2(sr, si);
    }
}
__device__ __forceinline__ float gelu_tanh(float x) { const float u = 0.7978845608028654f * (x + 0.044715f * x * x * x); return 0.5f * x * (1.f + tanhf(u)); }
__global__ void __launch_bounds__(256) k_s5_out(const bf16_t* __restrict__ P, const float2* __restrict__ ST, const float* c_re, const float* c_im, const float* dsk, float* __restrict__ G1) {
    const size_t idx = (size_t)blockIdx.x * 256 + threadIdx.x;
    const int ch = (int)(idx % SSMW); const size_t t = idx / SSMW; const int g = ch / SC, c = ch % SC;
    const float2* st = ST + (t * SG + g) * SN;
    float y = 0.f;
    for (int n = 0; n < SN; ++n) { const float2 s = st[n]; y += c_re[(g * SC + c) * SN + n] * s.x - c_im[(g * SC + c) * SN + n] * s.y; }
    y += dsk[g * SC + c] * bf2f(P[t * INC + C_U + ch]);
    G1[idx] = gelu_tanh(y);
}
__global__ void __launch_bounds__(512) k_glu(const float* __restrict__ G1, const float* __restrict__ w, const float* __restrict__ bg, float* __restrict__ SY) {
    __shared__ float row[SSMW];
    const int t = blockIdx.x, j = threadIdx.x;
    row[j] = G1[(size_t)t * SSMW + j];
    __syncthreads();
    float z = bg[j];
    for (int k = 0; k < SSMW; ++k) z += row[k] * w[(size_t)k * SSMW + j];
    SY[(size_t)t * SSMW + j] = row[j] / (1.f + expf(-z));
}
__global__ void __launch_bounds__(256) k_post(const bf16_t* __restrict__ SBO, const float* __restrict__ SY, const bf16_t* __restrict__ O1, const bf16_t* __restrict__ O2,
                                             const float* sbg, const float* ssmg, const float* dfg, const float* lq1, const float* lk1, const float* lq2, const float* lk2,
                                             float lam_init, bf16_t* __restrict__ Y) {
    __shared__ float red[16];
    const int t = blockIdx.x, tid = threadIdx.x;
    float a = 0.f, c = 0.f;
    if (tid < 64) { a = lq1[tid] * lk1[tid]; c = lq2[tid] * lk2[tid]; }
    a = block_sum(a, red); c = block_sum(c, red);
    const float lam = expf(a) - expf(c) + lam_init;
    { float v0 = bf2f(SBO[(size_t)t * SBW + tid]), v1 = bf2f(SBO[(size_t)t * SBW + 256 + tid]);
      const float s = block_sum(v0 * v0 + v1 * v1, red); const float r = rsqrtf(s / SBW + EPS);
      Y[(size_t)t * D + tid] = f2bf(v0 * r * sbg[tid]); Y[(size_t)t * D + 256 + tid] = f2bf(v1 * r * sbg[256 + tid]); }
    { float v0 = SY[(size_t)t * SSMW + tid], v1 = SY[(size_t)t * SSMW + 256 + tid];
      const float s = block_sum(v0 * v0 + v1 * v1, red); const float r = rsqrtf(s / SSMW + EPS);
      Y[(size_t)t * D + 512 + tid] = f2bf(v0 * r * ssmg[tid]); Y[(size_t)t * D + 768 + tid] = f2bf(v1 * r * ssmg[256 + tid]); }
    for (int i = 0; i < 4; ++i) {
        const int e = tid + 256 * i; const int dv = e & 127;
        const float v = bf2f(O1[(size_t)t * DFW + e]) - lam * bf2f(O2[(size_t)t * DFW + e]);
        float s = v * v;
        for (int o = 32; o > 0; o >>= 1) s += __shfl_xor(s, o);
        __syncthreads();
        if ((tid & 63) == 0) red[tid >> 6] = s;
        __syncthreads();
        const int w = tid >> 6; const float tot = red[w & ~1] + red[(w & ~1) + 1];
        const float r = rsqrtf(tot / DFV + EPS);
        Y[(size_t)t * D + 1024 + e] = f2bf(v * r * dfg[dv] * (1.f - lam_init));
    }
}
__global__ void __launch_bounds__(256) k_route(const float* __restrict__ H, const float* __restrict__ g, const float* __restrict__ rgw, const float* __restrict__ rgb,
                                              const float* __restrict__ rew, const float* __restrict__ reb, bf16_t* __restrict__ HN, int* __restrict__ EI, float* __restrict__ EW) {
    __shared__ float red[16];
    __shared__ float hn[D];
    const int t = blockIdx.x, tid = threadIdx.x;
    float s = 0.f;
    for (int i = 0; i < 8; ++i) { const float v = H[(size_t)t * D + tid + 256 * i]; hn[tid + 256 * i] = v; s += v * v; }
    s = block_sum(s, red);
    const float r = rsqrtf(s / D + EPS);
    for (int i = 0; i < 8; ++i) { const int d = tid + 256 * i; const float v = hn[d] * r * g[d]; hn[d] = v; HN[(size_t)t * D + d] = f2bf(v); }
    __syncthreads();
    float gl[NGRP];
#pragma unroll
    for (int j = 0; j < NGRP; ++j) { float p = 0.f; for (int i = 0; i < 8; ++i) { const int d = tid + 256 * i; p += hn[d] * rgw[(size_t)d * NGRP + j]; } gl[j] = block_sum(p, red) + rgb[j]; }
    int gi = 0; float gm = gl[0];
#pragma unroll
    for (int j = 1; j < NGRP; ++j) if (gl[j] > gm) { gm = gl[j]; gi = j; }
    float gs = 0.f;
#pragma unroll
    for (int j = 0; j < NGRP; ++j) gs += expf(gl[j] - gm);
    const float gtop = 1.f / gs;
    float m0 = -INFINITY, m1 = -INFINITY; int i0 = 0, i1 = 0;
#pragma unroll
    for (int e = 0; e < EPG; ++e) { float p = 0.f; for (int i = 0; i < 8; ++i) { const int d = tid + 256 * i; p += hn[d] * rew[((size_t)gi * D + d) * EPG + e]; }
        const float v = block_sum(p, red) + reb[gi * EPG + e];
        if (v > m0) { m1 = m0; i1 = i0; m0 = v; i0 = e; } else if (v > m1) { m1 = v; i1 = e; } }
    const float p1 = expf(m1 - m0);
    const float w0 = 1.f / (1.f + p1) * gtop, w1 = p1 / (1.f + p1) * gtop;
    if (tid == 0) { EI[t * 2] = gi * EPG + i0; EI[t * 2 + 1] = gi * EPG + i1; EW[t * 2] = w0; EW[t * 2 + 1] = w1; }
}
__global__ void __launch_bounds__(512) k_moe_h(const bf16_t* __restrict__ HN, const int* __restrict__ EI, const float* __restrict__ EW, const float* __restrict__ w1, const float* __restrict__ w3, float* __restrict__ HB) {
    __shared__ float xr[D];
    const int ts = blockIdx.x, t = ts >> 1, f = threadIdx.x;
    for (int i = 0; i < 4; ++i) xr[f + 512 * i] = bf2f(HN[(size_t)t * D + f + 512 * i]);
    __syncthreads();
    const int e = EI[ts]; const float gw = EW[ts];
    const float* a1 = w1 + (size_t)e * D * DE + f; const float* a3 = w3 + (size_t)e * D * DE + f;
    float a = 0.f, b = 0.f;
    for (int d = 0; d < D; ++d) { a += xr[d] * a1[(size_t)d * DE]; b += xr[d] * a3[(size_t)d * DE]; }
    HB[(size_t)ts * DE + f] = a / (1.f + expf(-a)) * b * gw;
}
__global__ void __launch_bounds__(512) k_moe_y(const float* __restrict__ HB, const int* __restrict__ EI, const float* __restrict__ w2, bf16_t* __restrict__ YS) {
    __shared__ float hr[DE];
    const int ts = blockIdx.x, j = threadIdx.x;
    hr[j] = HB[(size_t)ts * DE + j];
    __syncthreads();
    const int e = EI[ts];
    const float* w = w2 + (size_t)e * DE * D;
    float acc[4] = {0.f, 0.f, 0.f, 0.f};
    for (int f = 0; f < DE; ++f) { const float hv = hr[f]; for (int i = 0; i < 4; ++i) acc[i] += hv * w[(size_t)f * D + j + 512 * i]; }
    for (int i = 0; i < 4; ++i) YS[(size_t)ts * D + j + 512 * i] = f2bf(acc[i]);
}
__global__ void __launch_bounds__(256) k_combine(float* __restrict__ H, const bf16_t* __restrict__ YS, const float* __restrict__ g, bf16_t* __restrict__ XN, float* __restrict__ out) {
    __shared__ float red[16];
    const int t = blockIdx.x, tid = threadIdx.x;
    float v[8]; float s = 0.f;
    for (int i = 0; i < 8; ++i) { const int d = tid + 256 * i; v[i] = H[(size_t)t * D + d] + bf2f(YS[((size_t)t * 2) * D + d]) + bf2f(YS[((size_t)t * 2 + 1) * D + d]); s += v[i] * v[i]; }
    s = block_sum(s, red);
    const float r = rsqrtf(s / D + EPS);
    for (int i = 0; i < 8; ++i) { const int d = tid + 256 * i;
        if (out) out[(size_t)t * D + d] = v[i] * r * g[d];
        else { H[(size_t)t * D + d] = v[i]; XN[(size_t)t * D + d] = f2bf(v[i] * r * g[d]); } }
}
}

namespace pg8 {
#define PG8_LAS __attribute__((address_space(3)))
typedef unsigned short bf16_t;
typedef short bf16x8 __attribute__((ext_vector_type(8)));
typedef float f32x4 __attribute__((ext_vector_type(4)));
typedef unsigned u32x4 __attribute__((ext_vector_type(4)));
constexpr int BM = 256, BK = 64, HALF = 128, HTB = HALF * BK * 2  , STAGE_BYTES = 8 * HTB, NXCD = 8, WGM = 8;

__host__ __device__ __forceinline__ int lds_byte(int r, int c) { const int st = (r >> 4) * 2 + (c >> 5), rr = r & 15, cc = c & 31, ob = rr * 64 + cc * 2; return st * 1024 + (ob ^ (((ob >> 9) & 1) << 5)); }
__host__ __device__ __forceinline__ void stage_rc(int b, int& R, int& C) { const int st = b / 1024, sb = b % 1024, swz = sb ^ (((sb >> 9) & 1) << 5); R = (st >> 1) * 16 + swz / 64; C = (st & 1) * 32 + (swz % 64) / 2; }
__host__ __device__ __forceinline__ int perm32(int rho) { const int n = rho >> 4, i = rho & 15; return 8 * (i >> 2) + 4 * n + (i & 3); }

struct Unit { int pm, pn; };
struct Gemm { const bf16_t* A; const bf16_t* Bt; int M, N, K; };

struct StaticOrder {
    int nM, nN, nwg, G, c;
    __host__ __device__ void init(int M, int N, int G_, int c_) { nM = M / BM; nN = N / BM; nwg = nM * nN; G = G_; c = c_; }
    __host__ __device__ bool next(int i, Unit& u) const {
        const long L = (long)i * G + c; if (L >= nwg) return false;
        int wgid = (int)L; { const int q = nwg / NXCD, r = nwg % NXCD, xcd = wgid % NXCD, off = wgid / NXCD; wgid = (xcd < r ? xcd * (q + 1) : r * (q + 1) + (xcd - r) * q) + off; }
        const int nig = WGM * nN, gid = wgid / nig, fm = gid * WGM, gsz = (nM - fm) < WGM ? (nM - fm) : WGM;
        u.pm = fm + ((wgid % nig) % gsz); u.pn = (wgid % nig) / gsz; return true;
    }
    __device__ __forceinline__ void a_ready(const Unit&) const {}
    __device__ __forceinline__ void done(const Unit&) const {}
};

__device__ __forceinline__ unsigned cvt_pk_bf16(float lo, float hi) { unsigned r; asm volatile("v_cvt_pk_bf16_f32 %0, %1, %2" : "=v"(r) : "v"(lo), "v"(hi)); return r; }
typedef float f32x2 __attribute__((ext_vector_type(2)));
__device__ __forceinline__ f32x2 gelu_pk(f32x2 v) {
    const f32x2 av = __builtin_elementwise_abs(v), d = av * 0.2316418882f + 1.0f;
    f32x2 t; t.x = __builtin_amdgcn_rcpf(d.x); t.y = __builtin_amdgcn_rcpf(d.y);
    f32x2 q = t * 0.5307027145f + (-0.7265760135f); q = q * t + 0.7107068705f; q = q * t + (-0.142248368f); q = q * t + 0.127414796f; q = q * t;
    const f32x2 s = (v * v) * (-0.72134752044f);
    f32x2 e; e.x = __builtin_amdgcn_exp2f(s.x); e.y = __builtin_amdgcn_exp2f(s.y);
    const f32x2 m = v * (q * e), r = v - m;
    f32x2 o; o.x = v.x < 0.f ? m.x : r.x; o.y = v.y < 0.f ? m.y : r.y; return o;
}

template <int ACT  > struct EpiBf16 {
    static constexpr bool PERM = true, AFTER_DRAIN = false; static_assert(ACT == 0 || ACT == 1, "EpiBf16: ACT is 0 (none) or 1 (gelu_pk)");
    bf16_t* O; int ldc; const float* bias; int split_cols; size_t split_stride; float scale0;
    __device__ __forceinline__ void operator()(const f32x4 (&acc)[2][2][4][2], const Unit& u, int wr, int wc, int fr, int fq) const {
        const int row0 = u.pm * BM + wr * 64 + fr; int colt = u.pn * BM; bf16_t* base = O;
        float sc = 1.f; if (split_cols) { const int t = colt / split_cols; base += (size_t)t * split_stride; colt -= t * split_cols; if (t == 0) sc = scale0; }
        const int col0 = colt + wc * 32 + 8 * fq, bcol0 = u.pn * BM + wc * 32 + 8 * fq;
        f32x4 bv[2][2];
#pragma unroll
        for (int bj = 0; bj < 2; ++bj)
#pragma unroll
            for (int n = 0; n < 2; ++n) bv[bj][n] = bias ? *(const f32x4*)(bias + bcol0 + bj * HALF + 4 * n) : (f32x4){0.f, 0.f, 0.f, 0.f};
#pragma unroll
        for (int ai = 0; ai < 2; ++ai)
#pragma unroll
            for (int m = 0; m < 4; ++m) { bf16_t* rowp = base + (size_t)(row0 + ai * HALF + m * 16) * ldc + col0;
#pragma unroll
                for (int bj = 0; bj < 2; ++bj) { f32x4 v0 = acc[ai][bj][m][0] + bv[bj][0], v1 = acc[ai][bj][m][1] + bv[bj][1];
                    if (ACT == 1) { f32x2 a = gelu_pk((f32x2){v0[0], v0[1]}), b = gelu_pk((f32x2){v0[2], v0[3]}), c = gelu_pk((f32x2){v1[0], v1[1]}), d = gelu_pk((f32x2){v1[2], v1[3]});
                        v0 = (f32x4){a.x, a.y, b.x, b.y}; v1 = (f32x4){c.x, c.y, d.x, d.y}; }
                    v0 = v0 * sc; v1 = v1 * sc; u32x4 w; w.x = cvt_pk_bf16(v0[0], v0[1]); w.y = cvt_pk_bf16(v0[2], v0[3]); w.z = cvt_pk_bf16(v1[0], v1[1]); w.w = cvt_pk_bf16(v1[2], v1[3]);
                    *(u32x4*)(rowp + bj * HALF) = w; } }
    }
};
template <class Epi, class Sched, bool ALIGN_EPI = false, bool SP2 = false>
__device__ __forceinline__ void gemm_phase(PG8_LAS unsigned char* lds, const Gemm g, const Sched& S, const Epi& E) {
    const int tid = opaque_tid(), wid = __builtin_amdgcn_readfirstlane(tid >> 6), lane = tid & 63, wr = wid >> 2, wc = wid & 3, fr = lane & 15, fq = lane >> 4;
    const int K = g.K, nt = K / BK;
    unsigned voffA[2], voffB[2];
#pragma unroll
    for (int i = 0; i < 2; ++i) { int R, C; stage_rc(tid * 16 + i * 8192, R, C); const int Rb = Epi::PERM ? ((R & ~31) + perm32(R & 31)) : R;
        voffA[i] = (unsigned)(R * K + C) * 2u; voffB[i] = (unsigned)(Rb * K + C) * 2u; }
    const size_t kstep = (size_t)(BK * 2);
    const size_t hstep = (size_t)HALF * K * 2;
    const size_t tstep = 2 * hstep;
    const unsigned ldsw = (unsigned)wid * 1024u;
    const int aoff = lds_byte(wr * 64 + fr, fq * 8), boff = lds_byte(wc * 32 + fr, fq * 8);
#define PG8_SA(b, h) (((b) * 2 + (h)) * HTB)
#define PG8_SB(b, h) ((4 + (b) * 2 + (h)) * HTB)
#define PG8_STAGE(bufoff, gbase, voff) do { _Pragma("unroll") for (int _i = 0; _i < 2; ++_i) \
        __builtin_amdgcn_global_load_lds((const unsigned*)((const char*)(gbase) + (voff)[_i]), (PG8_LAS unsigned*)(lds + (bufoff) + ldsw + _i * 8192), 16, 0, 0); } while (0)
#define PG8_LDA(dst, b, h) do { _Pragma("unroll") for (int m = 0; m < 4; ++m) _Pragma("unroll") for (int k = 0; k < 2; ++k) dst[m][k] = *(const PG8_LAS bf16x8*)(lds + PG8_SA(b, h) + aoff + m * 2048 + k * 1024); } while (0)
#define PG8_LDB(dst, b, h) do { _Pragma("unroll") for (int n = 0; n < 2; ++n) _Pragma("unroll") for (int k = 0; k < 2; ++k) dst[n][k] = *(const PG8_LAS bf16x8*)(lds + PG8_SB(b, h) + boff + n * 2048 + k * 1024); } while (0)
#define PG8_MMA(ai, bj, At, Bt) do { __builtin_amdgcn_s_setprio(1); _Pragma("unroll") for (int m = 0; m < 4; ++m) _Pragma("unroll") for (int n = 0; n < 2; ++n) _Pragma("unroll") for (int k = 0; k < 2; ++k) \
        acc[ai][bj][m][n] = __builtin_amdgcn_mfma_f32_16x16x32_bf16(Bt[n][k], At[m][k], acc[ai][bj][m][n], 0, 0, 0); __builtin_amdgcn_s_setprio(0); } while (0)
#define PG8_WAIT_V(n) asm volatile("s_waitcnt vmcnt(" #n ")" ::: "memory")
#define PG8_WAIT_L(n) asm volatile("s_waitcnt lgkmcnt(" #n ")" ::: "memory")
#define PG8_BAR __builtin_amdgcn_s_barrier()
#define PG8_SCHED __builtin_amdgcn_sched_barrier(0)
    Unit cur, nxt; int ui = 0;
    if (!S.next(0, cur)) return;
    f32x4 acc[2][2][4][2];
#pragma unroll
    for (int a = 0; a < 2; ++a)
#pragma unroll
        for (int b = 0; b < 2; ++b)
#pragma unroll
            for (int m = 0; m < 4; ++m)
#pragma unroll
                for (int n = 0; n < 2; ++n) acc[a][b][m][n] = (f32x4){0.f, 0.f, 0.f, 0.f};
    bf16x8 At[4][2], B0[2][2], B1[2][2];
    const char* cA = (const char*)g.A + (size_t)cur.pm * tstep; const char* cB = (const char*)g.Bt + (size_t)cur.pn * tstep;
    S.a_ready(cur);
    if constexpr (SP2) {
        PG8_STAGE(PG8_SB(0, 0), cB, voffB); PG8_STAGE(PG8_SB(0, 1), cB + hstep, voffB); PG8_STAGE(PG8_SA(0, 0), cA, voffA); PG8_STAGE(PG8_SA(0, 1), cA + hstep, voffA);
        if (wr == 1) PG8_BAR;
        PG8_WAIT_V(2); PG8_BAR;
        PG8_STAGE(PG8_SB(1, 0), cB + kstep, voffB); PG8_STAGE(PG8_SA(1, 0), cA + kstep, voffA); PG8_STAGE(PG8_SB(1, 1), cB + hstep + kstep, voffB);
        PG8_WAIT_V(6); PG8_BAR;
    } else {
        PG8_STAGE(PG8_SB(0, 0), cB, voffB); PG8_STAGE(PG8_SA(0, 0), cA, voffA); PG8_STAGE(PG8_SB(0, 1), cB + hstep, voffB); PG8_STAGE(PG8_SA(0, 1), cA + hstep, voffA);
        if (wr == 1) PG8_BAR;
        PG8_WAIT_V(4); PG8_BAR;
        PG8_STAGE(PG8_SB(1, 0), cB + kstep, voffB); PG8_STAGE(PG8_SA(1, 0), cA + kstep, voffA); PG8_STAGE(PG8_SB(1, 1), cB + hstep + kstep, voffB);
        PG8_WAIT_V(6); PG8_BAR;
    }
    for (;;) {
        const bool has_next = S.next(ui + 1, nxt);
        const char* nA = has_next ? (const char*)g.A + (size_t)nxt.pm * tstep : cA; const char* nB = has_next ? (const char*)g.Bt + (size_t)nxt.pn * tstep : cB;
        for (int t = 0; t < nt; t += 2) {
            const bool last = (t == nt - 2);
            const char* a1 = cA + (size_t)(t + 1) * kstep;
            const char* a2 = last ? nA : cA + (size_t)(t + 2) * kstep; const char* b2 = last ? nB : cB + (size_t)(t + 2) * kstep;
            const char* a3 = a2 + kstep; const char* b3 = b2 + kstep;
            if (last && has_next) S.a_ready(nxt);
            if constexpr (SP2) {
            PG8_LDB(B0, 0, 0); PG8_LDB(B1, 0, 1); PG8_SCHED; PG8_LDA(At, 0, 0); PG8_STAGE(PG8_SA(1, 1), a1 + hstep, voffA);
            PG8_WAIT_V(8); PG8_WAIT_L(0); PG8_BAR; PG8_MMA(0, 0, At, B0); PG8_MMA(0, 1, At, B1); PG8_BAR; PG8_SCHED;
            PG8_LDA(At, 0, 1); PG8_STAGE(PG8_SB(0, 0), b2, voffB); PG8_STAGE(PG8_SB(0, 1), b2 + hstep, voffB); PG8_STAGE(PG8_SA(0, 0), a2, voffA);
            PG8_WAIT_V(8); PG8_WAIT_L(0); PG8_BAR; PG8_MMA(1, 0, At, B0); PG8_MMA(1, 1, At, B1); PG8_BAR; PG8_SCHED;
            PG8_LDB(B0, 1, 0); PG8_LDB(B1, 1, 1); PG8_SCHED; PG8_LDA(At, 1, 0); PG8_STAGE(PG8_SA(0, 1), a2 + hstep, voffA);
            PG8_WAIT_V(8); PG8_WAIT_L(0); PG8_BAR; PG8_MMA(0, 0, At, B0); PG8_MMA(0, 1, At, B1); PG8_BAR; PG8_SCHED;
            PG8_LDA(At, 1, 1); PG8_STAGE(PG8_SB(1, 0), b3, voffB); PG8_STAGE(PG8_SB(1, 1), b3 + hstep, voffB); PG8_STAGE(PG8_SA(1, 0), a3, voffA);
            PG8_WAIT_V(8); PG8_WAIT_L(0); PG8_BAR; PG8_MMA(1, 0, At, B0); PG8_MMA(1, 1, At, B1); PG8_BAR; PG8_SCHED;
            } else {
            PG8_LDB(B0, 0, 0); PG8_SCHED; PG8_LDA(At, 0, 0); PG8_STAGE(PG8_SA(1, 1), a1 + hstep, voffA);
            PG8_WAIT_L(8); PG8_BAR; PG8_WAIT_L(0); PG8_MMA(0, 0, At, B0); PG8_BAR; PG8_SCHED;
            PG8_LDB(B1, 0, 1); PG8_STAGE(PG8_SB(0, 0), b2, voffB);
            PG8_BAR; PG8_WAIT_L(0); PG8_MMA(0, 1, At, B1); PG8_BAR;
            PG8_LDA(At, 0, 1); PG8_STAGE(PG8_SA(0, 0), a2, voffA);
            PG8_BAR; PG8_WAIT_L(0); PG8_MMA(1, 0, At, B0); PG8_BAR; PG8_SCHED;
            PG8_STAGE(PG8_SB(0, 1), b2 + hstep, voffB);
            PG8_WAIT_V(6); PG8_BAR; PG8_MMA(1, 1, At, B1); PG8_BAR;
            PG8_LDB(B0, 1, 0); PG8_SCHED; PG8_LDA(At, 1, 0); PG8_STAGE(PG8_SA(0, 1), a2 + hstep, voffA);
            PG8_WAIT_L(8); PG8_BAR; PG8_WAIT_L(0); PG8_MMA(0, 0, At, B0); PG8_BAR; PG8_SCHED;
            PG8_LDB(B1, 1, 1); PG8_STAGE(PG8_SB(1, 0), b3, voffB);
            PG8_BAR; PG8_WAIT_L(0); PG8_MMA(0, 1, At, B1); PG8_BAR;
            PG8_LDA(At, 1, 1); PG8_STAGE(PG8_SA(1, 0), a3, voffA);
            PG8_BAR; PG8_WAIT_L(0); PG8_MMA(1, 0, At, B0); PG8_BAR; PG8_SCHED;
            PG8_STAGE(PG8_SB(1, 1), b3 + hstep, voffB);
            PG8_WAIT_V(6); PG8_BAR; PG8_MMA(1, 1, At, B1); PG8_BAR;
            }
        }
        if constexpr (ALIGN_EPI) { if (wr == 0) PG8_BAR; }
        if constexpr (!Epi::AFTER_DRAIN) { E(acc, cur, wr, wc, fr, fq); S.done(cur); }
        if (!has_next) break;
#pragma unroll
        for (int a = 0; a < 2; ++a)
#pragma unroll
            for (int b = 0; b < 2; ++b)
#pragma unroll
                for (int m = 0; m < 4; ++m)
#pragma unroll
                    for (int n = 0; n < 2; ++n) acc[a][b][m][n] = (f32x4){0.f, 0.f, 0.f, 0.f};
        cur = nxt; cA = nA; cB = nB; ++ui;
        if constexpr (ALIGN_EPI) { if (wr == 1) PG8_BAR; }
    }
    PG8_WAIT_V(0);
    if constexpr (!ALIGN_EPI) { if (wr == 0) PG8_BAR; }
    PG8_BAR;
    if constexpr (Epi::AFTER_DRAIN) { E.fused(acc, cur, wr, wc, fr, fq, lds, wid, lane); S.done(cur); }
#undef PG8_SA
#undef PG8_SB
#undef PG8_STAGE
#undef PG8_LDA
#undef PG8_LDB
#undef PG8_MMA
#undef PG8_WAIT_V
#undef PG8_WAIT_L
#undef PG8_BAR
#undef PG8_SCHED
}
}

#ifndef PG8_SP2
#define PG8_SP2 true
#endif
#ifndef PG8_ALIGN
#define PG8_ALIGN true
#endif
namespace pg8 {
struct UnitG { int pm, pn, e, r0, nvalid; unsigned boff; };
struct GroupedOrder {
    const PG8_LAS int* tab; int nN, G, c; unsigned bstride;
    __device__ __forceinline__ bool next(int i, UnitG& u) const {
        const int Lx = i * G + c; const int total = __builtin_amdgcn_readfirstlane(tab[64]) * nN; if (Lx >= total) return false;
        int e = 0;
#pragma unroll 4
        for (int k = 1; k < 32; ++k) { const int s = __builtin_amdgcn_readfirstlane(tab[32 + k]) * nN; if (Lx >= s) e = k; }
        const int m0 = __builtin_amdgcn_readfirstlane(tab[32 + e]), m1 = __builtin_amdgcn_readfirstlane(tab[33 + e]), ce = __builtin_amdgcn_readfirstlane(tab[e]);
        const int idx = Lx - m0 * nN, mte = m1 - m0; const int pn = idx / mte, mtl = idx - pn * mte;
        u.pm = m0 + mtl; u.pn = pn; u.e = e; u.r0 = mtl * 256; u.nvalid = ce - mtl * 256; u.boff = (unsigned)e * bstride; return true;
    }
};
template <class Epi, bool GATHER>
__device__ __forceinline__ void gemm_phase_g(PG8_LAS unsigned char* lds, const Gemm g, const GroupedOrder& S, const Epi& E, const int* __restrict__ LIST) {
    const int tid = opaque_tid(), wid = __builtin_amdgcn_readfirstlane(tid >> 6), lane = tid & 63, wr = wid >> 2, wc = wid & 3, fr = lane & 15, fq = lane >> 4;
    const int K = g.K, nt = K / BK;
    unsigned voffB[2]; int RA[2], CA[2];
#pragma unroll
    for (int i = 0; i < 2; ++i) { int R, C; stage_rc(tid * 16 + i * 8192, R, C); const int Rb = Epi::PERM ? ((R & ~31) + perm32(R & 31)) : R;
        RA[i] = R; CA[i] = C; voffB[i] = (unsigned)(Rb * K + C) * 2u; }
    const size_t kstep = (size_t)(BK * 2);
    const size_t hstepB = (size_t)HALF * K * 2;
    const size_t tstepB = 2 * hstepB;
    const unsigned ldsw = (unsigned)wid * 1024u;
    const int aoff = lds_byte(wr * 64 + fr, fq * 8), boff = lds_byte(wc * 32 + fr, fq * 8);
#define PG8_SA(b, h) (((b) * 2 + (h)) * HTB)
#define PG8_SB(b, h) ((4 + (b) * 2 + (h)) * HTB)
#define PG8_STAGE(bufoff, gbase, voff) do { _Pragma("unroll") for (int _i = 0; _i < 2; ++_i) \
        __builtin_amdgcn_global_load_lds((const unsigned*)((const char*)(gbase) + (voff)[_i]), (PG8_LAS unsigned*)(lds + (bufoff) + ldsw + _i * 8192), 16, 0, 0); } while (0)
#define PG8_LDA(dst, b, h) do { _Pragma("unroll") for (int m = 0; m < 4; ++m) _Pragma("unroll") for (int k = 0; k < 2; ++k) dst[m][k] = *(const PG8_LAS bf16x8*)(lds + PG8_SA(b, h) + aoff + m * 2048 + k * 1024); } while (0)
#define PG8_LDB(dst, b, h) do { _Pragma("unroll") for (int n = 0; n < 2; ++n) _Pragma("unroll") for (int k = 0; k < 2; ++k) dst[n][k] = *(const PG8_LAS bf16x8*)(lds + PG8_SB(b, h) + boff + n * 2048 + k * 1024); } while (0)
#define PG8_MMA(ai, bj, At, Bt) do { __builtin_amdgcn_s_setprio(1); _Pragma("unroll") for (int m = 0; m < 4; ++m) _Pragma("unroll") for (int n = 0; n < 2; ++n) _Pragma("unroll") for (int k = 0; k < 2; ++k) \
        acc[ai][bj][m][n] = __builtin_amdgcn_mfma_f32_16x16x32_bf16(Bt[n][k], At[m][k], acc[ai][bj][m][n], 0, 0, 0); __builtin_amdgcn_s_setprio(0); } while (0)
#define PG8_WAIT_V(n) asm volatile("s_waitcnt vmcnt(" #n ")" ::: "memory")
#define PG8_WAIT_L(n) asm volatile("s_waitcnt lgkmcnt(" #n ")" ::: "memory")
#define PG8_BAR __builtin_amdgcn_s_barrier()
#define PG8_SCHED __builtin_amdgcn_sched_barrier(0)
#define PG8_AOFF(u, vo) do { _Pragma("unroll") for (int _h = 0; _h < 2; ++_h) _Pragma("unroll") for (int _i = 0; _i < 2; ++_i) { const int _r = _h * HALF + RA[_i]; int _row; \
        if (GATHER) { _row = 0; if (_r < (u).nvalid) _row = LIST[(u).e * 8192 + (u).r0 + _r] >> 1; } else _row = (u).pm * BM + _r; \
        (vo)[_h][_i] = (unsigned)(_row * K + CA[_i]) * 2u; } } while (0)
    UnitG cur, nxt; int ui = 0;
    if (!S.next(0, cur)) return;
    f32x4 acc[2][2][4][2];
#pragma unroll
    for (int a = 0; a < 2; ++a)
#pragma unroll
        for (int b = 0; b < 2; ++b)
#pragma unroll
            for (int m = 0; m < 4; ++m)
#pragma unroll
                for (int n = 0; n < 2; ++n) acc[a][b][m][n] = (f32x4){0.f, 0.f, 0.f, 0.f};
    bf16x8 At[4][2], B0[2][2], B1[2][2];
    unsigned vA[2][2], vN[2][2];
    PG8_AOFF(cur, vA);
    const char* gA = (const char*)g.A;
    const char* cB = (const char*)g.Bt + cur.boff + (size_t)cur.pn * tstepB;
    PG8_STAGE(PG8_SB(0, 0), cB, voffB); PG8_STAGE(PG8_SB(0, 1), cB + hstepB, voffB); PG8_STAGE(PG8_SA(0, 0), gA, vA[0]); PG8_STAGE(PG8_SA(0, 1), gA, vA[1]);
    if (wr == 1) PG8_BAR;
    PG8_WAIT_V(2); PG8_BAR;
    PG8_STAGE(PG8_SB(1, 0), cB + kstep, voffB); PG8_STAGE(PG8_SA(1, 0), gA + kstep, vA[0]); PG8_STAGE(PG8_SB(1, 1), cB + hstepB + kstep, voffB);
    PG8_WAIT_V(6); PG8_BAR;
    for (;;) {
        const bool has_next = S.next(ui + 1, nxt);
        if (has_next) { PG8_AOFF(nxt, vN); } else {
#pragma unroll
            for (int _h = 0; _h < 2; ++_h)
#pragma unroll
                for (int _i = 0; _i < 2; ++_i) vN[_h][_i] = vA[_h][_i]; }
        const char* nB = has_next ? (const char*)g.Bt + nxt.boff + (size_t)nxt.pn * tstepB : cB;
        for (int t = 0; t < nt; t += 2) {
            const bool last = (t == nt - 2);
            const char* a1 = gA + (size_t)(t + 1) * kstep;
            const char* a2 = last ? gA : gA + (size_t)(t + 2) * kstep; const char* b2 = last ? nB : cB + (size_t)(t + 2) * kstep;
            const char* a3 = a2 + kstep; const char* b3 = b2 + kstep;
            unsigned v2a[2], v2b[2];
#pragma unroll
            for (int _i = 0; _i < 2; ++_i) { v2a[_i] = last ? vN[0][_i] : vA[0][_i]; v2b[_i] = last ? vN[1][_i] : vA[1][_i]; }
            PG8_LDB(B0, 0, 0); PG8_LDB(B1, 0, 1); PG8_SCHED; PG8_LDA(At, 0, 0); PG8_STAGE(PG8_SA(1, 1), a1, vA[1]);
            PG8_WAIT_V(8); PG8_WAIT_L(0); PG8_BAR; PG8_MMA(0, 0, At, B0); PG8_MMA(0, 1, At, B1); PG8_BAR; PG8_SCHED;
            PG8_LDA(At, 0, 1); PG8_STAGE(PG8_SB(0, 0), b2, voffB); PG8_STAGE(PG8_SB(0, 1), b2 + hstepB, voffB); PG8_STAGE(PG8_SA(0, 0), a2, v2a);
            PG8_WAIT_V(8); PG8_WAIT_L(0); PG8_BAR; PG8_MMA(1, 0, At, B0); PG8_MMA(1, 1, At, B1); PG8_BAR; PG8_SCHED;
            PG8_LDB(B0, 1, 0); PG8_LDB(B1, 1, 1); PG8_SCHED; PG8_LDA(At, 1, 0); PG8_STAGE(PG8_SA(0, 1), a2, v2b);
            PG8_WAIT_V(8); PG8_WAIT_L(0); PG8_BAR; PG8_MMA(0, 0, At, B0); PG8_MMA(0, 1, At, B1); PG8_BAR; PG8_SCHED;
            PG8_LDA(At, 1, 1); PG8_STAGE(PG8_SB(1, 0), b3, voffB); PG8_STAGE(PG8_SB(1, 1), b3 + hstepB, voffB); PG8_STAGE(PG8_SA(1, 0), a3, v2a);
            PG8_WAIT_V(8); PG8_WAIT_L(0); PG8_BAR; PG8_MMA(1, 0, At, B0); PG8_MMA(1, 1, At, B1); PG8_BAR; PG8_SCHED;
        }
        if (wr == 0) PG8_BAR;
        E(acc, cur, wr, wc, fr, fq);
        if (!has_next) break;
#pragma unroll
        for (int a = 0; a < 2; ++a)
#pragma unroll
            for (int b = 0; b < 2; ++b)
#pragma unroll
                for (int m = 0; m < 4; ++m)
#pragma unroll
                    for (int n = 0; n < 2; ++n) acc[a][b][m][n] = (f32x4){0.f, 0.f, 0.f, 0.f};
        cur = nxt; cB = nB; ++ui;
#pragma unroll
        for (int _h = 0; _h < 2; ++_h)
#pragma unroll
            for (int _i = 0; _i < 2; ++_i) vA[_h][_i] = vN[_h][_i];
        if (wr == 1) PG8_BAR;
    }
    PG8_WAIT_V(0);
    PG8_BAR;
#undef PG8_AOFF
#undef PG8_SA
#undef PG8_SB
#undef PG8_STAGE
#undef PG8_LDA
#undef PG8_LDB
#undef PG8_MMA
#undef PG8_WAIT_V
#undef PG8_WAIT_L
#undef PG8_BAR
#undef PG8_SCHED
}
__device__ __forceinline__ float silu_f(float a) { return a * __builtin_amdgcn_rcpf(1.f + __builtin_amdgcn_exp2f(-1.4426950408889634f * a)); }
struct EpiMoe1 {
    static constexpr bool PERM = true, AFTER_DRAIN = false;
    bf16_t* HB; const int* LIST; const float* GATEW;
    __device__ __forceinline__ void operator()(const f32x4 (&acc)[2][2][4][2], const UnitG& u, int wr, int wc, int fr, int fq) const {
#pragma unroll
        for (int ai = 0; ai < 2; ++ai)
#pragma unroll
            for (int m = 0; m < 4; ++m) { const int r = ai * HALF + wr * 64 + m * 16 + fr;
                float gate = 0.f; if (r < u.nvalid) gate = GATEW[LIST[u.e * 8192 + u.r0 + r]];
                bf16_t* rowp = HB + (size_t)(u.pm * BM + r) * 512 + u.pn * 128 + wc * 32 + 8 * fq;
                const f32x4 a0 = acc[ai][0][m][0], a1 = acc[ai][0][m][1], b0 = acc[ai][1][m][0], b1 = acc[ai][1][m][1];
                f32x4 h0, h1;
#pragma unroll
                for (int j = 0; j < 4; ++j) { h0[j] = silu_f(a0[j]) * b0[j] * gate; h1[j] = silu_f(a1[j]) * b1[j] * gate; }
                u32x4 w; w.x = cvt_pk_bf16(h0[0], h0[1]); w.y = cvt_pk_bf16(h0[2], h0[3]); w.z = cvt_pk_bf16(h1[0], h1[1]); w.w = cvt_pk_bf16(h1[2], h1[3]);
                *(u32x4*)rowp = w; }
    }
};
struct EpiMoe2 {
    static constexpr bool PERM = true, AFTER_DRAIN = false;
    bf16_t* YS; const int* LIST;
    __device__ __forceinline__ void operator()(const f32x4 (&acc)[2][2][4][2], const UnitG& u, int wr, int wc, int fr, int fq) const {
#pragma unroll
        for (int ai = 0; ai < 2; ++ai)
#pragma unroll
            for (int m = 0; m < 4; ++m) { const int r = ai * HALF + wr * 64 + m * 16 + fr;
                if (r < u.nvalid) { const int idx = LIST[u.e * 8192 + u.r0 + r];
                    bf16_t* rowp = YS + (size_t)idx * 2048 + u.pn * BM + wc * 32 + 8 * fq;
#pragma unroll
                    for (int bj = 0; bj < 2; ++bj) { const f32x4 v0 = acc[ai][bj][m][0], v1 = acc[ai][bj][m][1];
                        u32x4 w; w.x = cvt_pk_bf16(v0[0], v0[1]); w.y = cvt_pk_bf16(v0[2], v0[3]); w.z = cvt_pk_bf16(v1[0], v1[1]); w.w = cvt_pk_bf16(v1[2], v1[3]);
                        *(u32x4*)(rowp + bj * HALF) = w; } } }
    }
};
}
#include <hip/hip_bf16.h>
#include <cmath>
namespace attn_body {
using bf16=__hip_bfloat16;
using bf16x8=__attribute__((ext_vector_type(8)))short;
using s16x4=__attribute__((ext_vector_type(4)))short;
using f32x16=__attribute__((ext_vector_type(16)))float;
using u32x4=__attribute__((ext_vector_type(4)))unsigned;
constexpr int SEQ=2048,D=64,DM=5120;
constexpr int NW=8,QBLK=32,QB=QBLK*NW,KVBLK=64,NQB=SEQ/QB;
constexpr int ATTN_UNIT_ROWS=QB;
__device__ __forceinline__ int crow(int r,int hi){return (r&3)+8*(r>>2)+4*hi;}
#define SBAR() __builtin_amdgcn_sched_barrier(0)
__device__ __forceinline__ void cmask(f32x16&p0,f32x16&p1,int jb,int qrel,int hi){
  const float NEG=-INFINITY; int kb=64*jb+4*hi;
  #pragma unroll
  for(int r=0;r<16;++r){int kv=kb+(r&3)+8*(r>>2); if(kv>qrel)p0[r]=NEG; if(kv+32>qrel)p1[r]=NEG;}
}

constexpr int NSLOT=3, SLOTB=8192;
constexpr int LDS_K=0, LDS_V=NSLOT*SLOTB, LDS_WS=2*NSLOT*SLOTB, LDS_OST=LDS_WS+NW*64*4, LDS_BYTES=LDS_OST+NW*4096;
constexpr float C2=0.125f*1.4426950408889634f;
__device__ __forceinline__ void glds16(const void*gsrc,unsigned lds_dst){unsigned keep;
  asm volatile("s_mov_b32 %0, m0\n\ts_mov_b32 m0, %2\n\ts_nop 0\n\tglobal_load_lds_dwordx4 %1, off\n\ts_mov_b32 m0, %0":"=&s"(keep):"v"(gsrc),"s"(lds_dst):"memory");}
__device__ __forceinline__ float max3f(float a,float b,float c){float r;asm("v_max3_f32 %0, %1, %2, %3":"=v"(r):"v"(a),"v"(b),"v"(c));return r;}
__device__ __forceinline__ float max2f(float a,float b){float r;asm("v_max_f32_e32 %0, %1, %2":"=v"(r):"v"(a),"v"(b));return r;}
__device__ __forceinline__ float fadd_s(float a,float b){float r;asm("v_add_f32_e32 %0, %1, %2":"=v"(r):"v"(a),"v"(b));return r;}
__device__ __forceinline__ float fsub_s(float a,float b){float r;asm("v_sub_f32_e32 %0, %1, %2":"=v"(r):"v"(a),"v"(b));return r;}
typedef float f32x2_t __attribute__((ext_vector_type(2))); typedef __bf16 bf16x2_t __attribute__((ext_vector_type(2)));
__device__ __forceinline__ unsigned cvtpk_s(float lo,float hi){f32x2_t v={lo,hi};bf16x2_t b=__builtin_convertvector(v,bf16x2_t);return __builtin_bit_cast(unsigned,b);}
#define WAIT_BAR(N) asm volatile("s_waitcnt vmcnt(" #N ") lgkmcnt(0)\n\ts_barrier":::"memory")

__device__ __forceinline__ void qkt(f32x16&p0,f32x16&p1,const char*Kslot,const bf16x8*qr,const f32x16&negm,int r32,int hi){
  const char*kb=Kslot+hi*1024+r32*16;
  #pragma unroll
  for(int d0=0;d0<4;++d0){
    const bf16x8 b0=*reinterpret_cast<const bf16x8*>(kb+d0*2048);
    const bf16x8 b1=*reinterpret_cast<const bf16x8*>(kb+d0*2048+512);
    if(d0==0){p0=__builtin_amdgcn_mfma_f32_32x32x16_bf16(b0,qr[0],negm,0,0,0);p1=__builtin_amdgcn_mfma_f32_32x32x16_bf16(b1,qr[0],negm,0,0,0);}
    else{p0=__builtin_amdgcn_mfma_f32_32x32x16_bf16(b0,qr[d0],p0,0,0,0);p1=__builtin_amdgcn_mfma_f32_32x32x16_bf16(b1,qr[d0],p1,0,0,0);}}
}
typedef __attribute__((address_space(3))) const char* lds_cptr;
typedef short v4i16_t __attribute__((ext_vector_type(4)));
__device__ __forceinline__ void kload8(bf16x8*kf,lds_cptr kp){
  kf[0]=*(const __attribute__((address_space(3))) bf16x8*)(kp);      kf[1]=*(const __attribute__((address_space(3))) bf16x8*)(kp+512);
  kf[2]=*(const __attribute__((address_space(3))) bf16x8*)(kp+2048); kf[3]=*(const __attribute__((address_space(3))) bf16x8*)(kp+2560);
  kf[4]=*(const __attribute__((address_space(3))) bf16x8*)(kp+4096); kf[5]=*(const __attribute__((address_space(3))) bf16x8*)(kp+4608);
  kf[6]=*(const __attribute__((address_space(3))) bf16x8*)(kp+6144); kf[7]=*(const __attribute__((address_space(3))) bf16x8*)(kp+6656);
}
__device__ __forceinline__ void kload2(bf16x8*kf,lds_cptr kp,int j){ kf[2*j]=*(const __attribute__((address_space(3))) bf16x8*)(kp+j*2048); kf[2*j+1]=*(const __attribute__((address_space(3))) bf16x8*)(kp+j*2048+512); }
__device__ __forceinline__ s16x4 vtr(lds_cptr p){ return __builtin_bit_cast(s16x4,__builtin_amdgcn_ds_read_tr16_b64_v4i16((__attribute__((address_space(3))) v4i16_t*)p)); }
__device__ __forceinline__ float rowmax(const f32x16&p0,const f32x16&p1){
  float a=max3f(p0[0],p0[1],p1[0]),b=max3f(p0[2],p0[3],p1[1]);a=max3f(a,p1[2],p1[3]);
  #pragma unroll
  for(int r=4;r<16;r+=4){a=max3f(a,p0[r],p0[r+1]);b=max3f(b,p0[r+2],p0[r+3]);a=max3f(a,p1[r],p1[r+1]);b=max3f(b,p1[r+2],p1[r+3]);}
  const float m=max2f(a,b);
  auto rr=__builtin_amdgcn_permlane32_swap(__float_as_uint(m),__float_as_uint(m),false,false);
  return max2f(__uint_as_float(rr[0]),__uint_as_float(rr[1]));
}
__device__ __forceinline__ void pv(f32x16*o,int vb,bf16x8 pa0,bf16x8 pa1,bf16x8 pa2,bf16x8 pa3){
  #pragma unroll
  for(int d0=0;d0<2;++d0){s16x4 lo[4],hi[4];
    #pragma unroll
    for(int ks=0;ks<4;++ks){
      asm volatile("ds_read_b64_tr_b16 %0,%1 offset:%c2":"=&v"(lo[ks]):"v"(vb),"i"(d0*4096+ks*1024):"memory");
      asm volatile("ds_read_b64_tr_b16 %0,%1 offset:%c2":"=&v"(hi[ks]):"v"(vb),"i"(d0*4096+ks*1024+512):"memory");}
    asm volatile("s_waitcnt lgkmcnt(0)":::"memory");SBAR();
    #define PK(k) (bf16x8){lo[k][0],lo[k][1],lo[k][2],lo[k][3],hi[k][0],hi[k][1],hi[k][2],hi[k][3]}
    o[d0]=__builtin_amdgcn_mfma_f32_32x32x16_bf16(pa0,PK(0),o[d0],0,0,0);
    o[d0]=__builtin_amdgcn_mfma_f32_32x32x16_bf16(pa1,PK(1),o[d0],0,0,0);
    o[d0]=__builtin_amdgcn_mfma_f32_32x32x16_bf16(pa2,PK(2),o[d0],0,0,0);
    o[d0]=__builtin_amdgcn_mfma_f32_32x32x16_bf16(pa3,PK(3),o[d0],0,0,0);
    #undef PK
  }
}

#ifndef ATTN_STORE16
#define ATTN_STORE16(p,v) (*(u32x4*)(p)=(v))
#endif
template<int THRL> __device__ __forceinline__ void attn_unit(int b,int qb,const bf16*Q,const bf16*__restrict__ K,const bf16*__restrict__ V,bf16*O,int opitch,char*shm){
  const int tid=opaque_tid(),lane=tid&63,r32=lane&31,hi=lane>>5; const int wid=__builtin_amdgcn_readfirstlane(tid>>6);
  const long rowbase=(long)b*SEQ; const int q0=qb*QB;
  const bf16*Qw=Q+(rowbase+q0+wid*QBLK)*DM;
  const bf16*Kh=K+rowbase*DM,*Vh=V+rowbase*DM;
  const unsigned lds0=(unsigned)(uintptr_t)shm;
  float*wsf=(float*)(shm+LDS_WS)+wid*64;
  const bf16*ksrc=Kh+(long)lane*DM+wid*8;
  const bf16*vsrc=Vh+(long)(16*(wid&3)+(lane>>2))*DM+(wid>>2)*32+(lane&3)*8;
  const unsigned kdst=lds0+LDS_K+wid*1024, vdst=lds0+LDS_V+wid*1024;
  #define DMA_K(t,slot) glds16(ksrc+(long)(t)*KVBLK*DM,(unsigned)__builtin_amdgcn_readfirstlane(kdst+(slot)))
  #define DMA_V(t,slot) glds16(vsrc+(long)(t)*KVBLK*DM,(unsigned)__builtin_amdgcn_readfirstlane(vdst+(slot)))
  const int vb0=(int)(lds0+LDS_V)+((lane>>4)&1)*32+(lane&3)*8+(4*hi+((lane&15)>>2))*64;
  const char*Kbase=shm+LDS_K; bf16x8 kf[8];
  const lds_cptr shm3=(lds_cptr)shm; const lds_cptr kp0=shm3+LDS_K+hi*1024+r32*16; const lds_cptr vp0=shm3+LDS_V+((lane>>4)&1)*32+(lane&3)*8+(4*hi+((lane&15)>>2))*64;
  const int NT=(q0+QB)/KVBLK;
  DMA_K(0,0);DMA_V(0,0);DMA_K(1,SLOTB);
  bf16x8 qr[4];
  #pragma unroll
  for(int d0=0;d0<4;++d0)qr[d0]=*reinterpret_cast<const bf16x8*>(&Qw[(long)r32*DM+d0*16+hi*8]);
  float mhat=0.f,l_reg=0.f;f32x16 o[2];o[0]=f32x16{};o[1]=f32x16{};f32x16 negm=f32x16{};asm volatile("":"+v"(negm));
  const int qrel=wid*QBLK+r32;
  #define CMASK(P0,P1,t) do{int jb_=(t)-(NT-4); if(jb_>=0)cmask(P0,P1,jb_,qrel,hi);}while(0)
  bool resc=false;
  #define START(P0,P1) do{ const float rm=rowmax(P0,P1); resc=false; \
    { const float dl=rm; mhat=fadd_s(mhat,dl); \
      _Pragma("unroll") for(int r=0;r<16;++r){P0[r]=fsub_s(P0[r],dl);P1[r]=fsub_s(P1[r],dl);} \
      _Pragma("unroll") for(int r=0;r<16;++r)negm[r]=-mhat; asm volatile("":"+v"(negm)); } \
    _Pragma("unroll") for(int r=0;r<16;++r)P0[r]=__builtin_amdgcn_exp2f(P0[r]); }while(0)
  #define RESC() do{ if(resc){ asm volatile("s_waitcnt lgkmcnt(0)":::"memory"); \
      _Pragma("unroll") for(int d_=0;d_<2;++d_) _Pragma("unroll") for(int r=0;r<16;++r)o[d_][r]*=wsf[crow(r,hi)]; } }while(0)
  f32x16 pA0,pA1,pB0,pB1;
  int sl_prev=0,sl_cur=0,sl_next=SLOTB;
  #define ROT() do{sl_prev=sl_cur;sl_cur=sl_next;sl_next=(sl_next==(NSLOT-1)*SLOTB)?0:sl_next+SLOTB;}while(0)
  DMA_K(2,2*SLOTB);
  WAIT_BAR(3);
  qkt(pA0,pA1,Kbase,qr,negm,r32,hi);asm volatile("s_nop 15\n\ts_nop 7":"+v"(pA0),"+v"(pA1));CMASK(pA0,pA1,0);
  START(pA0,pA1);
  _Pragma("unroll") for(int r=0;r<16;++r)pA1[r]=__builtin_amdgcn_exp2f(pA1[r]);
  WAIT_BAR(0);
  DMA_K(3,0);DMA_V(1,SLOTB);
  ROT();
  kload8(kf,kp0+sl_cur);
  WAIT_BAR(2);
  s16x4 vlo[8],vhi[8]; u32x4 pw0,pw1,pw2,pw3;
  #define PKW(P,B) cvtpk_s(P[B],P[B+1])
  #define PAF(k) __builtin_bit_cast(bf16x8,pw##k)
  #define VFR(i) (bf16x8){vlo[i][0],vlo[i][1],vlo[i][2],vlo[i][3],vhi[i][0],vhi[i][1],vhi[i][2],vhi[i][3]}
  #define PIN(x) asm volatile("":"+v"(x))
  #define MX3(a,b,c) __builtin_fmaxf(__builtin_fmaxf((a),(b)),(c))
  #define GAPA(MF,A0,A1,A2,A3,W0,W1,PW) do{ MF; sacc+=A0; sacc+=A1; sacc+=A2; sacc+=A3; PIN(sacc); W0; W1; PIN(PW); SBAR(); }while(0)
  #define EX(v) __builtin_amdgcn_exp2f(v)
  #define GAPB(MF,X,B) do{ MF; X[B]=EX(X[B]); X[B+1]=EX(X[B+1]); X[B+2]=EX(X[B+2]); X[B+3]=EX(X[B+3]); PIN(X); SBAR(); }while(0)
  #define VRD(i) do{ vlo[i]=vtr(vp_+(((i)>>2)*4096+((i)&3)*1024)); vhi[i]=vtr(vp_+(((i)>>2)*4096+((i)&3)*1024+512)); }while(0)
  #define KRD(G,j) do{ if(G){ kload2(kf,kp0+sl_next,j); SBAR(); } }while(0)
  #define STEP(C0,C1,P0,P1,t,GK,GV,GL) do{ SBAR(); \
    const lds_cptr vp_=vp0+sl_prev; \
    VRD(0); SBAR(); float sacc=(P0[0]+P0[1]); \
    GAPA(C0=__builtin_amdgcn_mfma_f32_32x32x16_bf16(kf[0],qr[0],negm,0,0,0), P0[2],P0[3],P0[4],P0[5],     pw0[0]=PKW(P0,0), pw0[1]=PKW(P0,2), pw0); \
    VRD(4); SBAR(); GAPA(C1=__builtin_amdgcn_mfma_f32_32x32x16_bf16(kf[1],qr[0],negm,0,0,0), P0[6],P0[7],P0[8],P0[9],     pw0[2]=PKW(P0,4), pw0[3]=PKW(P0,6), pw0); \
    VRD(1); SBAR(); GAPA(C0=__builtin_amdgcn_mfma_f32_32x32x16_bf16(kf[2],qr[1],C0,0,0,0),   P0[10],P0[11],P0[12],P0[13], pw1[0]=PKW(P0,8), pw1[1]=PKW(P0,10), pw1); \
    VRD(5); SBAR(); GAPA(C1=__builtin_amdgcn_mfma_f32_32x32x16_bf16(kf[3],qr[1],C1,0,0,0),   P0[14],P0[15],P1[0],P1[1],   pw1[2]=PKW(P0,12),pw1[3]=PKW(P0,14), pw1); \
    VRD(2); SBAR(); GAPA(C0=__builtin_amdgcn_mfma_f32_32x32x16_bf16(kf[4],qr[2],C0,0,0,0),   P1[2],P1[3],P1[4],P1[5],     pw2[0]=PKW(P1,0), pw2[1]=PKW(P1,2), pw2); \
    VRD(6); SBAR(); GAPA(C1=__builtin_amdgcn_mfma_f32_32x32x16_bf16(kf[5],qr[2],C1,0,0,0),   P1[6],P1[7],P1[8],P1[9],     pw2[2]=PKW(P1,4), pw2[3]=PKW(P1,6), pw2); \
    VRD(3); SBAR(); GAPA(C0=__builtin_amdgcn_mfma_f32_32x32x16_bf16(kf[6],qr[3],C0,0,0,0),   P1[10],P1[11],P1[12],P1[13], pw3[0]=PKW(P1,8), pw3[1]=PKW(P1,10), pw3); \
    VRD(7); SBAR(); GAPA(C1=__builtin_amdgcn_mfma_f32_32x32x16_bf16(kf[7],qr[3],C1,0,0,0),   P1[14],P1[15],0.f,0.f,       pw3[2]=PKW(P1,12),pw3[3]=PKW(P1,14), pw3); \
    l_reg+=sacc; \
    if(GK){DMA_K((t)+3,sl_cur);} if(GV){DMA_V((t)+1,sl_next);} \
    CMASK(C0,C1,t); \
    { float a=MX3(C0[0],C0[1],C1[0]),b=MX3(C0[2],C0[3],C1[1]); a=MX3(a,C1[2],C1[3]); \
      _Pragma("unroll") for(int r=4;r<16;r+=4){a=MX3(a,C0[r],C0[r+1]);b=MX3(b,C0[r+2],C0[r+3]);a=MX3(a,C1[r],C1[r+1]);b=MX3(b,C1[r+2],C1[r+3]);} \
      float rm=__builtin_fmaxf(a,b); { auto rr=__builtin_amdgcn_permlane32_swap(__float_as_uint(rm),__float_as_uint(rm),false,false); rm=__builtin_fmaxf(__uint_as_float(rr[0]),__uint_as_float(rr[1])); } \
      resc=false; \
      if(__builtin_expect(__any(rm>(float)THRL),0)){ const float dl=__builtin_fmaxf(rm,0.f); mhat+=dl; \
        _Pragma("unroll") for(int r=0;r<16;++r){C0[r]-=dl;C1[r]-=dl;} \
        _Pragma("unroll") for(int r=0;r<16;++r)negm[r]=-mhat; asm volatile("":"+v"(negm)); \
        const float f=__builtin_amdgcn_exp2f(-dl); l_reg*=f; if(hi==0)wsf[r32]=f; resc=true; } } \
    SBAR(); \
    GAPB(o[0]=__builtin_amdgcn_mfma_f32_32x32x16_bf16(PAF(0),VFR(0),o[0],0,0,0), C0,0); \
    GAPB(o[1]=__builtin_amdgcn_mfma_f32_32x32x16_bf16(PAF(0),VFR(4),o[1],0,0,0), C0,4); \
    KRD(GL,0); GAPB(o[0]=__builtin_amdgcn_mfma_f32_32x32x16_bf16(PAF(1),VFR(1),o[0],0,0,0), C0,8); \
    KRD(GL,1); GAPB(o[1]=__builtin_amdgcn_mfma_f32_32x32x16_bf16(PAF(1),VFR(5),o[1],0,0,0), C0,12); \
    KRD(GL,2); GAPB(o[0]=__builtin_amdgcn_mfma_f32_32x32x16_bf16(PAF(2),VFR(2),o[0],0,0,0), C1,0); \
    KRD(GL,3); GAPB(o[1]=__builtin_amdgcn_mfma_f32_32x32x16_bf16(PAF(2),VFR(6),o[1],0,0,0), C1,4); \
    GAPB(o[0]=__builtin_amdgcn_mfma_f32_32x32x16_bf16(PAF(3),VFR(3),o[0],0,0,0), C1,8); \
    GAPB(o[1]=__builtin_amdgcn_mfma_f32_32x32x16_bf16(PAF(3),VFR(7),o[1],0,0,0), C1,12); \
    }while(0)
  int t=1;
  #undef CMASK
  #define CMASK(P0,P1,t) do{}while(0)
  for(;t+5<NT;t+=2){
    STEP(pB0,pB1,pA0,pA1,t,true,true,true);     WAIT_BAR(2); RESC(); ROT();
    STEP(pA0,pA1,pB0,pB1,t+1,true,true,true);   WAIT_BAR(2); RESC(); ROT();
  }
  #undef CMASK
  #define CMASK(P0,P1,t) do{int jb_=(t)-(NT-4); if(jb_>=0)cmask(P0,P1,jb_,qrel,hi);}while(0)
  #define ENDW(tt) do{ if((tt)+3<NT){WAIT_BAR(2);} else if((tt)+2<NT){WAIT_BAR(1);} else {WAIT_BAR(0);} }while(0)
  for(;t+1<NT;t+=2){
    STEP(pB0,pB1,pA0,pA1,t,(t+3<NT),(t+1<NT),(t+1<NT));       ENDW(t);   RESC(); ROT();
    STEP(pA0,pA1,pB0,pB1,t+1,(t+4<NT),(t+2<NT),(t+2<NT));     ENDW(t+1); RESC(); ROT();
  }
  STEP(pB0,pB1,pA0,pA1,NT-1,false,false,false); RESC();
  { float sacc=pB0[0]+pB0[1]; _Pragma("unroll") for(int r=2;r<16;++r)sacc+=pB0[r]; _Pragma("unroll") for(int r=0;r<16;++r)sacc+=pB1[r]; l_reg+=sacc;
    pw0=(u32x4){PKW(pB0,0),PKW(pB0,2),PKW(pB0,4),PKW(pB0,6)};pw1=(u32x4){PKW(pB0,8),PKW(pB0,10),PKW(pB0,12),PKW(pB0,14)};pw2=(u32x4){PKW(pB1,0),PKW(pB1,2),PKW(pB1,4),PKW(pB1,6)};pw3=(u32x4){PKW(pB1,8),PKW(pB1,10),PKW(pB1,12),PKW(pB1,14)};
    SBAR(); pv(o,vb0+sl_cur,PAF(0),PAF(1),PAF(2),PAF(3)); }
  #undef PKW
  #undef PAF
  #undef VFR
  #undef PIN
  #undef MX3
  #undef GAPA
  #undef GAPB
  #undef EX
  #undef VRD
  #undef KRD
  #undef STEP
  #undef ENDW
  {auto rr=__builtin_amdgcn_permlane32_swap(__float_as_uint(l_reg),__float_as_uint(l_reg),false,false);l_reg=__uint_as_float(rr[0])+__uint_as_float(rr[1]);}
  if(hi==0)wsf[32+r32]=l_reg;asm volatile("s_waitcnt lgkmcnt(0)":::"memory");
  float rli[16];
  #pragma unroll
  for(int r=0;r<16;++r)rli[r]=__builtin_amdgcn_rcpf(wsf[32+crow(r,hi)]);
  bf16*Ow=O+(rowbase+q0+wid*QBLK)*opitch;
  { bf16*stg=(bf16*)(shm+LDS_OST)+wid*2048;
    #pragma unroll
    for(int r=0;r<16;++r){const int orow=crow(r,hi);
      #pragma unroll
      for(int d0=0;d0<2;++d0)stg[orow*64+d0*32+r32]=__float2bfloat16(o[d0][r]*rli[r]);}
    asm volatile("s_waitcnt lgkmcnt(0)":::"memory");
    #pragma unroll
    for(int i=0;i<4;++i){const int row=i*8+(lane>>3),ch=lane&7; const u32x4 v=*(const u32x4*)(stg+row*64+ch*8); ATTN_STORE16(Ow+(long)row*opitch+ch*8,v);} }
  asm volatile("s_waitcnt lgkmcnt(0)\n\ts_barrier":::"memory");
  #undef DMA_K
  #undef DMA_V
  #undef CMASK
  #undef START
  #undef RESC
  #undef ROT
}

__device__ __forceinline__ void sb_unit(int b,int qb,const bf16*Q,const bf16*__restrict__ K,const bf16*__restrict__ V,bf16*O,int opitch,char*shm){
  const int tid=opaque_tid(),lane=tid&63,r32=lane&31,hi=lane>>5; const int wid=__builtin_amdgcn_readfirstlane(tid>>6);
  const long rowbase=(long)b*SEQ; const int q0=qb*QB;
  const bf16*Qw=Q+(rowbase+q0+wid*QBLK)*DM;
  const bf16*Kh=K+rowbase*DM,*Vh=V+rowbase*DM;
  const unsigned lds0=(unsigned)(uintptr_t)shm;
  const bf16*ksrc=Kh+(long)lane*DM+wid*8;
  const bf16*vsrc=Vh+(long)(16*(wid&3)+(lane>>2))*DM+(wid>>2)*32+(lane&3)*8;
  const unsigned kdst=lds0+LDS_K+wid*1024, vdst=lds0+LDS_V+wid*1024;
  #define DMA_K(t,slot) glds16(ksrc+(long)(t)*KVBLK*DM,(unsigned)__builtin_amdgcn_readfirstlane(kdst+(slot)))
  #define DMA_V(t,slot) glds16(vsrc+(long)(t)*KVBLK*DM,(unsigned)__builtin_amdgcn_readfirstlane(vdst+(slot)))
  const int vb0=(int)(lds0+LDS_V)+((lane>>4)&1)*32+(lane&3)*8+(4*hi+((lane&15)>>2))*64;
  const char*Kbase=shm+LDS_K;
  const int NT=(q0+QB)/KVBLK;
  int j=NT-1;
  DMA_K(j,(j&1)*SLOTB);DMA_V(j,(j&1)*SLOTB);
  bf16x8 qr[4];
  #pragma unroll
  for(int d0=0;d0<4;++d0)qr[d0]=*reinterpret_cast<const bf16x8*>(&Qw[(long)r32*DM+d0*16+hi*8]);
  f32x16 o[2];o[0]=f32x16{};o[1]=f32x16{};
  float R=0.f;
  const int trow=q0+wid*QBLK+r32;
  const int wmax=q0+wid*QBLK+QBLK-1;
  const float selhi=(hi==0)?1.f:0.f;
  volatile int*flg=(volatile int*)(shm+LDS_WS);
  if(lane==0)flg[wid*16]=0;
  #pragma unroll 1
  for(;j>=0;--j){
    WAIT_BAR(0);
    { int nd=0;
      #pragma unroll
      for(int w8=0;w8<8;++w8)nd+=flg[w8*16];
      if(__builtin_amdgcn_readfirstlane(nd)==8)break; }
    if(j>0){DMA_K(j-1,((j-1)&1)*SLOTB);DMA_V(j-1,((j-1)&1)*SLOTB);}
    const int slot=(j&1)*SLOTB;
    if(64*j<wmax){
      f32x16 p0,p1; const f32x16 zero=f32x16{};
      qkt(p0,p1,Kbase+slot,qr,zero,r32,hi);
      const int thr=trow-64*j-4*hi;
      f32x16 l0,l1;
      #pragma unroll
      for(int r=0;r<16;++r){
        { const float z=p0[r]; const float lg=__builtin_amdgcn_logf(1.f+__builtin_amdgcn_exp2f(-__builtin_fabsf(z))); const float sp=__builtin_fmaxf(-z,0.f)+lg;
          const bool ok=((r&3)+8*(r>>2))<thr; l0[r]=ok?-(sp+z):0.f; p0[r]=ok?-sp:-INFINITY; }
        { const float z=p1[r]; const float lg=__builtin_amdgcn_logf(1.f+__builtin_amdgcn_exp2f(-__builtin_fabsf(z))); const float sp=__builtin_fmaxf(-z,0.f)+lg;
          const bool ok=((r&3)+8*(r>>2)+32)<thr; l1[r]=ok?-(sp+z):0.f; p1[r]=ok?-sp:-INFINITY; }
      }
      float gs[8],pt[8];
      #pragma unroll
      for(int g=0;g<4;++g){ gs[g]=(l0[4*g]+l0[4*g+1])+(l0[4*g+2]+l0[4*g+3]); gs[4+g]=(l1[4*g]+l1[4*g+1])+(l1[4*g+2]+l1[4*g+3]); }
      #pragma unroll
      for(int g=0;g<8;++g){ auto rr=__builtin_amdgcn_permlane32_swap(__float_as_uint(gs[g]),__float_as_uint(gs[g]),false,false); pt[g]=__uint_as_float(rr[0])+__uint_as_float(rr[1]); }
      float base[8]; float run=R;
      #pragma unroll
      for(int g=7;g>=0;--g){ base[g]=run+selhi*(pt[g]-gs[g]); run+=pt[g]; }
      R=run;
      if(__all(R<=-152.f)){ if(lane==0)flg[wid*16]=1; }
      #pragma unroll
      for(int g=0;g<4;++g){
        { float a=base[g]; p0[4*g+3]=__builtin_amdgcn_exp2f(p0[4*g+3]+a); a+=l0[4*g+3]; p0[4*g+2]=__builtin_amdgcn_exp2f(p0[4*g+2]+a); a+=l0[4*g+2]; p0[4*g+1]=__builtin_amdgcn_exp2f(p0[4*g+1]+a); a+=l0[4*g+1]; p0[4*g]=__builtin_amdgcn_exp2f(p0[4*g]+a); }
        { float a=base[4+g]; p1[4*g+3]=__builtin_amdgcn_exp2f(p1[4*g+3]+a); a+=l1[4*g+3]; p1[4*g+2]=__builtin_amdgcn_exp2f(p1[4*g+2]+a); a+=l1[4*g+2]; p1[4*g+1]=__builtin_amdgcn_exp2f(p1[4*g+1]+a); a+=l1[4*g+1]; p1[4*g]=__builtin_amdgcn_exp2f(p1[4*g]+a); }
      }
      u32x4 pw0,pw1,pw2,pw3;
      pw0=(u32x4){cvtpk_s(p0[0],p0[1]),cvtpk_s(p0[2],p0[3]),cvtpk_s(p0[4],p0[5]),cvtpk_s(p0[6],p0[7])};
      pw1=(u32x4){cvtpk_s(p0[8],p0[9]),cvtpk_s(p0[10],p0[11]),cvtpk_s(p0[12],p0[13]),cvtpk_s(p0[14],p0[15])};
      pw2=(u32x4){cvtpk_s(p1[0],p1[1]),cvtpk_s(p1[2],p1[3]),cvtpk_s(p1[4],p1[5]),cvtpk_s(p1[6],p1[7])};
      pw3=(u32x4){cvtpk_s(p1[8],p1[9]),cvtpk_s(p1[10],p1[11]),cvtpk_s(p1[12],p1[13]),cvtpk_s(p1[14],p1[15])};
      SBAR();
      pv(o,vb0+slot,__builtin_bit_cast(bf16x8,pw0),__builtin_bit_cast(bf16x8,pw1),__builtin_bit_cast(bf16x8,pw2),__builtin_bit_cast(bf16x8,pw3));
    }
  }
  bf16*Ow=O+(rowbase+q0+wid*QBLK)*opitch;
  { bf16*stg=(bf16*)(shm+LDS_OST)+wid*2048;
    #pragma unroll
    for(int r=0;r<16;++r){const int orow=crow(r,hi);
      #pragma unroll
      for(int d0=0;d0<2;++d0)stg[orow*64+d0*32+r32]=__float2bfloat16(o[d0][r]);}
    asm volatile("s_waitcnt lgkmcnt(0)":::"memory");
    #pragma unroll
    for(int i=0;i<4;++i){const int row=i*8+(lane>>3),ch=lane&7; const u32x4 v=*(const u32x4*)(stg+row*64+ch*8); ATTN_STORE16(Ow+(long)row*opitch+ch*8,v);} }
  asm volatile("s_waitcnt lgkmcnt(0)\n\ts_barrier":::"memory");
  #undef DMA_K
  #undef DMA_V
}
constexpr int ATTN_LDS_BYTES=LDS_BYTES;
#undef SBAR
#undef WAIT_BAR
}
#ifndef PROBE_PH
#define PROBE_PH (-1)
#endif
#define PROBE_AMP 8
#ifndef PROBE_SUB
#define PROBE_SUB (-1)
#endif
#define SUBPROBE(id) do { if (PROBE_SUB >= 0 && bx == 0) { __syncthreads(); if (tid == 0) { const unsigned long long now_ = __builtin_amdgcn_s_memrealtime(); \
        const unsigned long long ps_ = ((unsigned long long)MISC[19] << 32) | MISC[18]; \
        if ((id) == PROBE_SUB) { const unsigned long long dl_ = now_ + PROBE_AMP * (now_ - ps_); while (__builtin_amdgcn_s_memrealtime() < dl_) __builtin_amdgcn_s_sleep(8); } \
        const unsigned long long n1_ = __builtin_amdgcn_s_memrealtime(); MISC[18] = (unsigned)n1_; MISC[19] = (unsigned)(n1_ >> 32); } __syncthreads(); } } while (0)
#ifndef QUOTA_A
#define QUOTA_A 5
#endif
#ifndef QUOTA_F
#define QUOTA_F 6
#endif
#ifndef QUOTA_G
#define QUOTA_G 2
#endif
namespace mk {
using nv::NB; using nv::L; using nv::D; using nv::T; using nv::DEPTH; using nv::INC; using nv::EPS;
constexpr int NWAVES = 8;
constexpr size_t MiB = 1u << 20;
constexpr size_t WS_CTL = 0, CTL_ZERO_BYTES = 1 * MiB;
constexpr size_t WS_WIN = 1 * MiB;
constexpr size_t WS_WOUT = WS_WIN + 40 * MiB;
constexpr size_t WS_XN = WS_WOUT + 16 * MiB;
constexpr size_t WS_PROJ = WS_XN + 32 * MiB;
constexpr size_t WS_SBO = WS_PROJ + 80 * MiB;
constexpr size_t WS_O1 = WS_SBO + 8 * MiB;
constexpr size_t WS_O2 = WS_O1 + 16 * MiB;
constexpr size_t WS_Y = WS_O2 + 16 * MiB;
constexpr size_t WS_H = WS_Y + 32 * MiB;
constexpr size_t WS_YS = WS_H + 64 * MiB;
constexpr size_t WS_HB = WS_YS + 64 * MiB;
constexpr size_t WS_ROUTE = WS_HB + 24 * MiB;
constexpr size_t WS_S5 = WS_ROUTE + 2 * MiB;
constexpr size_t WS_W13 = WS_S5 + 160 * MiB;
constexpr size_t WS_W2 = WS_W13 + 256 * MiB;
constexpr size_t WS_END = WS_W2 + 128 * MiB;
static_assert(WS_END <= 1024 * MiB, "d_ws map must fit 1 GiB");
constexpr int CW_TMO = 0, CW_CODE = 1, CW_Q = 1024;
constexpr int CW_BAR = 4096;
constexpr int MAX_BAR_REGIONS = 40;
constexpr int CW_CNT = 143360;
constexpr int RING_OFF = 0, RING_BYTES = 131072;
constexpr int LDSCTL_OFF = 143360, MISC_OFF = LDSCTL_OFF + 320;
constexpr int LDS_BYTES = 147456;

#define GAS __attribute__((address_space(1)))
#define LAS __attribute__((address_space(3)))
typedef unsigned short bf16;
typedef unsigned v4u __attribute__((ext_vector_type(4)));
typedef float f32x4 __attribute__((ext_vector_type(4)));
typedef short bf16x8 __attribute__((ext_vector_type(8)));
typedef GAS unsigned gu32;
typedef GAS unsigned long long gu64;
#define RLX_AGENT __ATOMIC_RELAXED, __HIP_MEMORY_SCOPE_AGENT
#define LDS_WAIT() asm volatile("s_waitcnt lgkmcnt(0)" ::: "memory")
#define VM_WAIT() asm volatile("s_waitcnt vmcnt(0)" ::: "memory")
__device__ __forceinline__ unsigned long long rt() { return __builtin_amdgcn_s_memrealtime(); }
__device__ __forceinline__ unsigned f2bf(float f) { unsigned u = __builtin_bit_cast(unsigned, f); return (u + 0x7fffu + ((u >> 16) & 1u)) >> 16; }
__device__ __forceinline__ unsigned pk2(float lo, float hi) { return f2bf(lo) | (f2bf(hi) << 16); }

#define XB_TMO      128
#define XB_XCNT(j)  (256  + 64 * (j))
#define XB_XSUB(j)  (1280 + 64 * (j))
#define XB_XGEN(j)  (2304 + 64 * (j))
#define XB_TOP      3328
#define XB_TOPGEN   3392
#define XCD_BAR_WORDS 3456
#define XB_SPIN_CAP (1u << 18)

__device__ __forceinline__ unsigned xb_ld(unsigned* p)              { return __hip_atomic_load(p, __ATOMIC_RELAXED, __HIP_MEMORY_SCOPE_AGENT); }
__device__ __forceinline__ unsigned xb_add(unsigned* p, unsigned v) { return __hip_atomic_fetch_add(p, v, __ATOMIC_RELAXED, __HIP_MEMORY_SCOPE_AGENT); }
__device__ __forceinline__ unsigned xb_xcc_id() { return (unsigned)__builtin_amdgcn_s_getreg((3 << 11) | 20) & 0xFu; }
#define XB_SPIN(cond, bar) do { unsigned _sp = 0; while (cond) { __builtin_amdgcn_s_sleep(1); \
    if ((++_sp & 255u) == 0u) { if (xb_ld(&(bar)[XB_TMO])) break; if (_sp > XB_SPIN_CAP) { atomicAdd(&(bar)[XB_TMO], 1u); break; } } } } while (0)

struct XcdBarrier {
    unsigned* bar; unsigned x;
    volatile LAS unsigned* st;
};

__device__ __forceinline__ XcdBarrier xcd_barrier_post(unsigned* bar, volatile LAS unsigned* st) {
    XcdBarrier b; b.bar = bar; b.x = xb_xcc_id(); b.st = st;
    if (threadIdx.x == 0) (void)xb_add(&bar[XB_XCNT(b.x)], 1u);
    return b;
}
__device__ __forceinline__ void xcd_barrier_complete(unsigned* bar, unsigned x, unsigned& nloc, unsigned& nx) {
    const unsigned G = gridDim.x * gridDim.y * gridDim.z;
    unsigned sum, cnt, mine, sp = 0u;
    for (;;) {
        sum = 0u; cnt = 0u; mine = 0u;
#pragma unroll
        for (unsigned j = 0; j < 16; ++j) { const unsigned c = xb_ld(&bar[XB_XCNT(j)]); sum += c; cnt += (c > 0u) ? 1u : 0u; mine = (j == x) ? c : mine; }
        if (sum == G) break;
        __builtin_amdgcn_s_sleep(1);
        if ((++sp & 255u) == 0u) { if (xb_ld(&bar[XB_TMO])) break; if (sp > XB_SPIN_CAP) { atomicAdd(&bar[XB_TMO], 1u); break; } }
    }
    nloc = mine > 0u ? mine : 1u; nx = cnt > 0u ? cnt : 1u;
}

__device__ __forceinline__ void xcd_barrier(const XcdBarrier& b) {
    asm volatile("s_waitcnt vmcnt(0)" ::: "memory");
    __syncthreads();
    if (threadIdx.x == 0) {
        unsigned* bar = b.bar;
        __builtin_amdgcn_s_waitcnt(0);
        unsigned nloc = b.st[0], nx = b.st[1];
        if (nloc == 0u) { xcd_barrier_complete(bar, b.x, nloc, nx); b.st[0] = nloc; b.st[1] = nx; }
        const unsigned old = xb_add(&bar[XB_XSUB(b.x)], 1u);
        const unsigned gen = old / nloc;
        if (old + 1u == (gen + 1u) * nloc) {
            __builtin_amdgcn_fence(__ATOMIC_RELEASE, "agent");
            asm volatile("s_waitcnt vmcnt(0)" ::: "memory");
            const unsigned og = xb_add(&bar[XB_TOP], 1u);
            const unsigned tg = og / nx;
            if (og + 1u == (tg + 1u) * nx) xb_add(&bar[XB_TOPGEN], 1u);
            else XB_SPIN(xb_ld(&bar[XB_TOPGEN]) == tg, bar);
            __builtin_amdgcn_fence(__ATOMIC_ACQUIRE, "agent");
            xb_add(&bar[XB_XGEN(b.x)], 1u);
            asm volatile("s_waitcnt vmcnt(0)" ::: "memory");
        } else {
            XB_SPIN(xb_ld(&bar[XB_XGEN(b.x)]) == gen, bar);
            __builtin_amdgcn_fence(__ATOMIC_ACQUIRE, "agent");
            asm volatile("s_waitcnt vmcnt(0)" ::: "memory");
        }
    }
    __syncthreads();
}
static_assert((CW_BAR + MAX_BAR_REGIONS * XCD_BAR_WORDS) <= CW_CNT && (CW_CNT + 2 * 2048) * 4 <= (int)CTL_ZERO_BYTES, "barrier regions and expert counters inside the memset region");

__device__ __forceinline__ float wave_sum(float v) {
#pragma unroll
    for (int o = 1; o < 64; o <<= 1) v += __shfl_xor(v, o);
    return v;
}
__device__ __forceinline__ void transpose_tile(const float* __restrict__ W, int N, int k0, int n0, bf16* __restrict__ dst, int Kd, LAS float* scr, int lane) {
    const int kr = lane >> 4, n4 = (lane & 15) * 4;
    f32x4 v[16];
#pragma unroll
    for (int i = 0; i < 16; ++i) v[i] = *(const GAS f32x4*)(W + (size_t)(k0 + i * 4 + kr) * N + n0 + n4);
#pragma unroll
    for (int i = 0; i < 16; ++i) { LAS float* s = scr + (i * 4 + kr) * 65 + n4; s[0] = v[i].x; s[1] = v[i].y; s[2] = v[i].z; s[3] = v[i].w; }
    LDS_WAIT(); asm volatile("" ::: "memory");
    const int c = lane & 7;
#pragma unroll
    for (int j = 0; j < 8; ++j) { const int n = (lane >> 3) + 8 * j; const LAS float* s = scr + (8 * c) * 65 + n;
        v4u o; o.x = pk2(s[0 * 65], s[1 * 65]); o.y = pk2(s[2 * 65], s[3 * 65]); o.z = pk2(s[4 * 65], s[5 * 65]); o.w = pk2(s[6 * 65], s[7 * 65]);
        *(GAS v4u*)(dst + (size_t)n * Kd + k0 + 8 * c) = o; }
    LDS_WAIT(); asm volatile("" ::: "memory");
}
struct TileJob { const float* W; bf16* dst; int N, Kd, k0, n0; };
__device__ __forceinline__ void tile_load(const TileJob& j, f32x4 (&v)[16], int lane) {
    const int kr = lane >> 4, n4 = (lane & 15) * 4;
#pragma unroll
    for (int i = 0; i < 16; ++i) v[i] = __builtin_nontemporal_load((const GAS f32x4*)(j.W + (size_t)(j.k0 + i * 4 + kr) * j.N + j.n0 + n4));
}
__device__ __forceinline__ void tile_store(const TileJob& j, const f32x4 (&v)[16], LAS float* scr, int lane) {
    const int kr = lane >> 4, n4 = (lane & 15) * 4;
#pragma unroll
    for (int i = 0; i < 16; ++i) { LAS float* s = scr + (i * 4 + kr) * 65 + n4; s[0] = v[i].x; s[1] = v[i].y; s[2] = v[i].z; s[3] = v[i].w; }
    LDS_WAIT(); asm volatile("" ::: "memory");
    const int c = lane & 7;
#pragma unroll
    for (int q = 0; q < 8; ++q) { const int n = (lane >> 3) + 8 * q; const LAS float* s = scr + (8 * c) * 65 + n;
        v4u o; o.x = pk2(s[0 * 65], s[1 * 65]); o.y = pk2(s[2 * 65], s[3 * 65]); o.z = pk2(s[4 * 65], s[5 * 65]); o.w = pk2(s[6 * 65], s[7 * 65]);
        *(GAS v4u*)(j.dst + (size_t)n * j.Kd + j.k0 + 8 * c) = o; }
    LDS_WAIT(); asm volatile("" ::: "memory");
}
__device__ __forceinline__ void ex_job(const float* const* in, bf16* W13T, bf16* W2T, int le, int r, TileJob& J) {
    if (r < 512) { const int w3 = r >> 8; r &= 255; const int nb = r & 7, kb = r >> 3, n0 = nb * 64;
        J.W = in[w3 ? 27 : 26] + (size_t)le * nv::D * nv::DE; J.N = nv::DE; J.k0 = kb * 64; J.n0 = n0; J.Kd = nv::D;
        J.dst = W13T + ((size_t)le * 1024 + (n0 >> 7) * 256 + w3 * 128 + (n0 & 127)) * nv::D; }
    else { r -= 512; const int nb = r & 31, kb = r >> 5;
        J.W = in[28] + (size_t)le * nv::DE * nv::D; J.N = nv::D; J.k0 = kb * 64; J.n0 = nb * 64; J.Kd = nv::DE; J.dst = W2T + ((size_t)le * nv::D + nb * 64) * nv::DE; }
}
constexpr int Q_W2L0 = 8192, Q_TOTAL = 32768, Q_BATCH = 16;
__device__ __forceinline__ void q_job(const float* const* in, bf16* W13T, bf16* W2T, int qi, TileJob& J) {
    if (qi < Q_W2L0) ex_job(in, W13T, W2T, qi >> 8, 512 + (qi & 255), J);
    else { const int q2 = qi - Q_W2L0; const int le = q2 / 768; ex_job(in, W13T, W2T, 32 + le, q2 - le * 768, J); }
}
__device__ __forceinline__ void convert_batches(const float* const* in, bf16* W13T, bf16* W2T, gu32* qctr, int nb, int limit, volatile LAS unsigned* qslot, LAS unsigned char* ring) {
    const int tid = opaque_tid(), lane = tid & 63, wave = __builtin_amdgcn_readfirstlane(tid >> 6);
    LAS float* scr = (LAS float*)(ring + wave * 16640);
#pragma unroll 1
    for (int b = 0; ; ++b) {
        if (limit <= 0 && b >= nb) break;
        __syncthreads();
        if (tid == 0) { unsigned base = Q_TOTAL; if (limit <= 0 || __hip_atomic_load(qctr, RLX_AGENT) < (unsigned)limit) base = __hip_atomic_fetch_add(qctr, (unsigned)Q_BATCH, RLX_AGENT); qslot[0] = base; }
        __syncthreads();
        const int base = (int)qslot[0];
        if (base >= Q_TOTAL) break;
        f32x4 va[16], vb[16]; TileJob ja, jb;
        q_job(in, W13T, W2T, base + 2 * wave, ja); tile_load(ja, va, lane);
        q_job(in, W13T, W2T, base + 2 * wave + 1, jb); tile_load(jb, vb, lane);
        tile_store(ja, va, scr, lane); tile_store(jb, vb, scr, lane);
    }
    __syncthreads();
}
__device__ __forceinline__ void rms_row_to_bf16(const float* xrow, const float* g, bf16* orow, int lane) {
    const GAS f32x4* xr = (const GAS f32x4*)xrow + lane; const GAS f32x4* gr = (const GAS f32x4*)g + lane;
    f32x4 v[8]; float s = 0.f;
#pragma unroll
    for (int j = 0; j < 8; ++j) { v[j] = xr[64 * j]; s += (v[j].x * v[j].x + v[j].y * v[j].y) + (v[j].z * v[j].z + v[j].w * v[j].w); }
    const float r = rsqrtf(wave_sum(s) * (1.f / D) + EPS);
    GAS unsigned long long* o8 = (GAS unsigned long long*)orow + lane;
#pragma unroll
    for (int j = 0; j < 8; ++j) { const f32x4 gg = gr[64 * j]; o8[64 * j] = (unsigned long long)pk2(v[j].x * r * gg.x, v[j].y * r * gg.y) | ((unsigned long long)pk2(v[j].z * r * gg.z, v[j].w * r * gg.w) << 32); }
}
}

namespace pg8 {
struct EpiProj {
    static constexpr bool PERM = true, AFTER_DRAIN = false;
    bf16_t* O; int ldc;
    __device__ __forceinline__ void operator()(const f32x4 (&acc)[2][2][4][2], const Unit& u, int wr, int wc, int fr, int fq) const {
        const int row0 = u.pm * BM + wr * 64 + fr; const int colt = u.pn * BM;
        const float sc = (u.pn < 2) ? nv::QS_SB : ((u.pn >= 8 && u.pn < 12) ? nv::QS_DF : 1.f);
        const int col0 = colt + wc * 32 + 8 * fq;
#pragma unroll
        for (int ai = 0; ai < 2; ++ai)
#pragma unroll
            for (int m = 0; m < 4; ++m) { bf16_t* rowp = O + (size_t)(row0 + ai * HALF + m * 16) * ldc + col0;
#pragma unroll
                for (int bj = 0; bj < 2; ++bj) { const f32x4 v0 = acc[ai][bj][m][0] * sc, v1 = acc[ai][bj][m][1] * sc;
                    u32x4 w; w.x = cvt_pk_bf16(v0[0], v0[1]); w.y = cvt_pk_bf16(v0[2], v0[3]); w.z = cvt_pk_bf16(v1[0], v1[1]); w.w = cvt_pk_bf16(v1[2], v1[3]);
                    *(u32x4*)(rowp + bj * HALF) = w; } }
    }
};
struct EpiResF32 {
    static constexpr bool PERM = false, AFTER_DRAIN = false;
    const float* R; float* out; int ldc;
    __device__ __forceinline__ void operator()(const f32x4 (&acc)[2][2][4][2], const Unit& u, int wr, int wc, int fr, int fq) const {
        const int col0 = u.pn * BM + wc * 32 + 4 * fq;
#pragma unroll
        for (int ai = 0; ai < 2; ++ai)
#pragma unroll
            for (int m = 0; m < 4; ++m) { const size_t off = (size_t)(u.pm * BM + ai * HALF + wr * 64 + m * 16 + fr) * ldc + col0;
#pragma unroll
                for (int bj = 0; bj < 2; ++bj)
#pragma unroll
                    for (int n = 0; n < 2; ++n) { const f32x4 r = *(const f32x4*)(R + off + bj * HALF + n * 16); *(f32x4*)(out + off + bj * HALF + n * 16) = acc[ai][bj][m][n] + r; }
                asm volatile("" ::: "memory"); }
    }
};
}

namespace s5 {
using mk::bf16; using mk::f32x4; using mk::bf16x8; using mk::v4u;
typedef float f32x16 __attribute__((ext_vector_type(16)));
typedef float f32x2 __attribute__((ext_vector_type(2)));
constexpr int LC_ = 32, NCH = 64, SG = 32, SN = 64, SC = 16;
constexpr size_t OFF_KT = 0;
constexpr size_t OFF_PT = 1u << 20;
constexpr size_t OFF_LP = 9u << 20;
constexpr size_t OFF_LC = 10u << 20;
constexpr size_t OFF_WG = 12u << 20;
constexpr size_t OFF_YI = 13u << 20;
constexpr size_t OFF_SE = 29u << 20;

__device__ __forceinline__ void cpow(float lr, float li, float dt, float tau, float& pr, float& pi) {
    const float mag = __builtin_amdgcn_exp2f(tau * lr * dt * 1.4426950408889634f);
    double rev = (double)tau * (double)li * (double)dt * 0.15915494309189535; rev -= __builtin_rint(rev);
    const float rv = (float)rev; pr = mag * __builtin_amdgcn_cosf(rv); pi = mag * __builtin_amdgcn_sinf(rv);
}
__device__ __forceinline__ void zoh_f(float lr, float li, float dt, float& fr, float& fi) {
    float br, bi; cpow(lr, li, dt, 1.f, br, bi);
    const float nr = br - 1.f, ni = bi, den = lr * lr + li * li;
    fr = (nr * lr + ni * li) / den; fi = (ni * lr - nr * li) / den;
}
__device__ __forceinline__ void build_tables(const float* const* in, unsigned char* s5ws, int gt, int NTH) {
    const float* lam_re = in[4]; const float* lam_im = in[5]; const float* b_re = in[6]; const float* b_im = in[7]; const float* c_re = in[8]; const float* c_im = in[9]; const float* log_dt = in[11];
    bf16* KT = (bf16*)(s5ws + OFF_KT); bf16* PT = (bf16*)(s5ws + OFF_PT); f32x2* LP = (f32x2*)(s5ws + OFF_LP);
#pragma unroll 1
    for (int it = gt; it < 2 * SG * LC_ * SC; it += NTH) { const int c = it & 15, tau = (it >> 4) & 31, lg = it >> 9;
        const float dt = __expf(log_dt[lg]); float acc[16];
#pragma unroll
        for (int q = 0; q < 16; ++q) acc[q] = 0.f;
#pragma unroll 1
        for (int n = 0; n < SN; ++n) { const float lr = lam_re[lg * SN + n], li = lam_im[lg * SN + n];
            float pr, pi, fr, fi; cpow(lr, li, dt, (float)tau, pr, pi); zoh_f(lr, li, dt, fr, fi);
            const float cr = c_re[(lg * SC + c) * SN + n], ci = c_im[(lg * SC + c) * SN + n];
            const float xr = pr * fr - pi * fi, xi = pr * fi + pi * fr;
            const float wr = cr * xr - ci * xi, wi = cr * xi + ci * xr;
            const f32x4* br4 = (const f32x4*)(b_re + (size_t)(lg * SN + n) * SC); const f32x4* bi4 = (const f32x4*)(b_im + (size_t)(lg * SN + n) * SC);
#pragma unroll
            for (int q = 0; q < 4; ++q) { const f32x4 br = br4[q], bi = bi4[q];
                acc[4 * q] += wr * br.x - wi * bi.x; acc[4 * q + 1] += wr * br.y - wi * bi.y; acc[4 * q + 2] += wr * br.z - wi * bi.z; acc[4 * q + 3] += wr * br.w - wi * bi.w; } }
        v4u o0, o1; o0.x = mk::pk2(acc[0], acc[1]); o0.y = mk::pk2(acc[2], acc[3]); o0.z = mk::pk2(acc[4], acc[5]); o0.w = mk::pk2(acc[6], acc[7]);
        o1.x = mk::pk2(acc[8], acc[9]); o1.y = mk::pk2(acc[10], acc[11]); o1.z = mk::pk2(acc[12], acc[13]); o1.w = mk::pk2(acc[14], acc[15]);
        v4u* dst = (v4u*)(KT + (size_t)it * 16); dst[0] = o0; dst[1] = o1; }
#pragma unroll 1
    for (int it = gt; it < 2 * SG * LC_ * SN; it += NTH) { const int n = it & 63, s = (it >> 6) & 31, lg = it >> 11;
        const float dt = __expf(log_dt[lg]); const float lr = lam_re[lg * SN + n], li = lam_im[lg * SN + n];
        float pr, pi, fr, fi; cpow(lr, li, dt, (float)(31 - s), pr, pi); zoh_f(lr, li, dt, fr, fi);
        const float xr = pr * fr - pi * fi, xi = pr * fi + pi * fr;
        float vr[16], vi[16];
        const f32x4* br4 = (const f32x4*)(b_re + (size_t)(lg * SN + n) * SC); const f32x4* bi4 = (const f32x4*)(b_im + (size_t)(lg * SN + n) * SC);
#pragma unroll
        for (int q = 0; q < 4; ++q) { const f32x4 br = br4[q], bi = bi4[q];
            vr[4 * q] = xr * br.x - xi * bi.x; vr[4 * q + 1] = xr * br.y - xi * bi.y; vr[4 * q + 2] = xr * br.z - xi * bi.z; vr[4 * q + 3] = xr * br.w - xi * bi.w;
            vi[4 * q] = xr * bi.x + xi * br.x; vi[4 * q + 1] = xr * bi.y + xi * br.y; vi[4 * q + 2] = xr * bi.z + xi * br.z; vi[4 * q + 3] = xr * bi.w + xi * br.w; }
        bf16* base = PT + ((size_t)(lg * LC_ + s) * 128) * 16;
        v4u o; v4u* d0 = (v4u*)(base + (size_t)n * 16); v4u* d1 = (v4u*)(base + (size_t)(64 + n) * 16);
        o.x = mk::pk2(vr[0], vr[1]); o.y = mk::pk2(vr[2], vr[3]); o.z = mk::pk2(vr[4], vr[5]); o.w = mk::pk2(vr[6], vr[7]); d0[0] = o;
        o.x = mk::pk2(vr[8], vr[9]); o.y = mk::pk2(vr[10], vr[11]); o.z = mk::pk2(vr[12], vr[13]); o.w = mk::pk2(vr[14], vr[15]); d0[1] = o;
        o.x = mk::pk2(vi[0], vi[1]); o.y = mk::pk2(vi[2], vi[3]); o.z = mk::pk2(vi[4], vi[5]); o.w = mk::pk2(vi[6], vi[7]); d1[0] = o;
        o.x = mk::pk2(vi[8], vi[9]); o.y = mk::pk2(vi[10], vi[11]); o.z = mk::pk2(vi[12], vi[13]); o.w = mk::pk2(vi[14], vi[15]); d1[1] = o; }
#pragma unroll 1
    for (int it = gt; it < 2 * SG * 32 * SN; it += NTH) { const int n = it & 63, t = (it >> 6) & 31, lg = it >> 11;
        const float dt = __expf(log_dt[lg]); float pr, pi; cpow(lam_re[lg * SN + n], lam_im[lg * SN + n], dt, (float)(t + 1), pr, pi); LP[it] = (f32x2){pr, pi}; }
}

__device__ __forceinline__ void s5a_unit(int l, int g, int b, int part, const bf16* PROJ, const unsigned char* s5ws, LAS unsigned char* lds) {
    const int tid = opaque_tid(), lane = tid & 63, wave = __builtin_amdgcn_readfirstlane(tid >> 6), r = lane & 31, h = lane >> 5;
    const bf16* KTg = (const bf16*)(s5ws + OFF_KT) + (size_t)(l * SG + g) * 32 * 256;
    const bf16* PTg = (const bf16*)(s5ws + OFF_PT) + (size_t)(l * SG + g) * 32 * 128 * 16;
    float* YI = (float*)(s5ws + OFF_YI); float* SE = (float*)(s5ws + OFF_SE);
#pragma unroll
    for (int i = 0; i < 8; ++i) { const int p = tid + 512 * i, tok = p >> 1, half = p & 1, chunk = tok >> 5, s = tok & 31;
        const v4u v = *(const GAS v4u*)(PROJ + (size_t)(b * 2048 + tok) * 5120 + nv::C_U + g * 16 + 8 * half);
        *(LAS v4u*)(lds + ((s * 64 + chunk) * 32 + 16 * half)) = v; }
    if (part == 0) {
#pragma unroll
    for (int i = 0; i < 2; ++i) { const int p = tid + 512 * i; const v4u v = *(const GAS v4u*)(KTg + (size_t)p * 8); *(LAS v4u*)(lds + 65536 + 512 + p * 16) = v; }
    }
    { unsigned z0 = 0u; asm volatile("" : "+v"(z0));
      if (tid < 32) *(LAS v4u*)(lds + 65536 + tid * 16) = (v4u){z0, z0, z0, z0}; }
    asm volatile("s_waitcnt vmcnt(0) lgkmcnt(0)" ::: "memory"); __syncthreads();
    const int tl = r >> 4, c = r & 15;
    if (part == 0) {
#pragma unroll 1
    for (int nb = 0; nb < 2; ++nb)
#pragma unroll 1
        for (int half = 0; half < 2; ++half) { const int tb = half ? 15 - wave : wave;
            f32x16 acc = {};
            const LAS unsigned char* ap = lds + 65536 + (2 * tb + tl + 1) * 512 + c * 32 + h * 16;
            const LAS unsigned char* bp = lds + (nb * 32 + r) * 32 + 16 * h;
#pragma unroll 2
            for (int s = 0; s <= 2 * tb + 1; ++s) { const bf16x8 a = *(const LAS bf16x8*)(ap - s * 512); const bf16x8 bb = *(const LAS bf16x8*)(bp + s * 2048);
                acc = __builtin_amdgcn_mfma_f32_32x32x16_bf16(a, bb, acc, 0, 0, 0); }
            const int chunk = nb * 32 + r;
#pragma unroll
            for (int q = 0; q < 4; ++q) { const int tq = q >> 1, c0 = 8 * (q & 1) + 4 * h; const int t = chunk * 32 + 2 * tb + tq;
                *(GAS f32x4*)(YI + (size_t)(b * 2048 + t) * 512 + g * 16 + c0) = (f32x4){acc[4 * q], acc[4 * q + 1], acc[4 * q + 2], acc[4 * q + 3]}; } }
    } else {
    { const int mb = wave >> 1, nb = wave & 1; f32x16 acc = {};
        const bf16* ap = PTg + (size_t)(mb * 32 + r) * 16 + 8 * h; const LAS unsigned char* bp = lds + (nb * 32 + r) * 32 + 16 * h;
#pragma unroll 8
        for (int s = 0; s < 32; ++s) { const bf16x8 a = *(const GAS bf16x8*)(ap + (size_t)s * 128 * 16); const bf16x8 bb = *(const LAS bf16x8*)(bp + s * 2048);
            acc = __builtin_amdgcn_mfma_f32_32x32x16_bf16(a, bb, acc, 0, 0, 0); }
        const int chunk = nb * 32 + r;
        LAS float* SEL = (LAS float*)(lds + 98304);
#pragma unroll
        for (int q = 0; q < 4; ++q) { const int rho = mb * 32 + 8 * q + 4 * h;
#pragma unroll
            for (int i = 0; i < 4; ++i) SEL[(rho + i) * 65 + chunk] = acc[4 * q + i]; } }
    asm volatile("s_waitcnt lgkmcnt(0)" ::: "memory"); __syncthreads();
    if (tid < 64) { const int n = tid; const LAS float* SEL = (const LAS float*)(lds + 98304);
        const f32x2 a32 = ((const f32x2*)(s5ws + OFF_LP))[((size_t)(l * SG + g) * 32 + 31) * SN + n];
        float sr = 0.f, si = 0.f; float* dst = SE + ((size_t)(b * 64) * 32 + g) * 128 + n;
#pragma unroll 4
        for (int k = 0; k < 64; ++k) { dst[(size_t)k * 32 * 128] = sr; dst[(size_t)k * 32 * 128 + 64] = si;
            const float er = SEL[n * 65 + k], ei = SEL[(64 + n) * 65 + k];
            const float nr = a32.x * sr - a32.y * si + er, ni = a32.x * si + a32.y * sr + ei; sr = nr; si = ni; } }
    }
    asm volatile("s_waitcnt lgkmcnt(0)" ::: "memory"); __syncthreads();
}

__device__ __forceinline__ float gelu_tanh(float x) { const float u = 0.7978845608028654f * (x + 0.044715f * x * x * x); const float e = __builtin_amdgcn_exp2f(2.885390081777927f * u);
    const float th = 1.f - 2.f * __builtin_amdgcn_rcpf(e + 1.f); return 0.5f * x * (1.f + th); }
__device__ __forceinline__ bf16x8 pack8(const float (&v)[8]) { v4u o; o.x = mk::pk2(v[0], v[1]); o.y = mk::pk2(v[2], v[3]); o.z = mk::pk2(v[4], v[5]); o.w = mk::pk2(v[6], v[7]); return __builtin_bit_cast(bf16x8, o); }
__device__ __forceinline__ float bflo(unsigned u) { return __uint_as_float(u << 16); }
__device__ __forceinline__ float bfhi(unsigned u) { return __uint_as_float(u & 0xffff0000u); }

__device__ __forceinline__ void post_unit(int l, int b, int k, const float* const* in, const bf16* PROJ, const bf16* SBO, const bf16* O1, const bf16* O2, bf16* Y,
                                          const unsigned char* s5ws, LAS unsigned char* lds) {
    const int tid = opaque_tid(), lane = tid & 63, wave = __builtin_amdgcn_readfirstlane(tid >> 6);
    const f32x2* LP = (const f32x2*)(s5ws + OFF_LP) + (size_t)l * SG * 32 * SN;
    const bf16* WG = (const bf16*)(s5ws + OFF_WG) + (size_t)l * 512 * 512;
    const float* YI = (const float*)(s5ws + OFF_YI); const float* SE = (const float*)(s5ws + OFF_SE);
    const float* c_re = in[8] + (size_t)l * SG * SC * SN; const float* c_im = in[9] + (size_t)l * SG * SC * SN; const float* dsk = in[10] + l * 512;
    const float* b_glu = in[13] + l * 512; const float* ssm_g = in[14] + l * 512; const float* sb_g = in[3] + l * 512; const float* df_g = in[19] + l * 128;
    LAS float* SIN = (LAS float*)lds; LAS unsigned short* G1 = (LAS unsigned short*)(lds + 16384); LAS unsigned short* OUTT = (LAS unsigned short*)(lds + 49664); LAS float* RS = (LAS float*)(lds + 82944);
    const size_t tok0 = (size_t)b * 2048 + (size_t)k * 32;
#pragma unroll
    for (int q = 0; q < 2; ++q) { const int p = tid + 512 * q; *(LAS f32x4*)(SIN + 4 * p) = *(const GAS f32x4*)(SE + ((size_t)(b * 64 + k) * 32) * 128 + 4 * p); }
    asm volatile("s_waitcnt vmcnt(0) lgkmcnt(0)" ::: "memory"); __syncthreads();
    { const int row = lane & 15, kg = lane >> 4;
#pragma unroll 2
      for (int gi = 0; gi < 4; ++gi) { const int g = wave * 4 + gi;
#pragma unroll
        for (int mb = 0; mb < 2; ++mb) { f32x4 acc = {0.f, 0.f, 0.f, 0.f}; const int t = 16 * mb + row;
#pragma unroll
            for (int ks = 0; ks < 4; ++ks) { const int ri = ks >> 1, n0 = 32 * (ks & 1) + 8 * kg;
                const GAS f32x4* lp = (const GAS f32x4*)(LP + ((size_t)g * 32 + t) * SN + n0);
                const f32x4 p0 = lp[0], p1 = lp[1], p2 = lp[2], p3 = lp[3];
                const f32x4 sr0 = *(const LAS f32x4*)(SIN + g * 128 + n0), sr1 = *(const LAS f32x4*)(SIN + g * 128 + n0 + 4);
                const f32x4 si0 = *(const LAS f32x4*)(SIN + g * 128 + 64 + n0), si1 = *(const LAS f32x4*)(SIN + g * 128 + 64 + n0 + 4);
                const float lr[8] = {p0.x, p0.z, p1.x, p1.z, p2.x, p2.z, p3.x, p3.z}, li[8] = {p0.y, p0.w, p1.y, p1.w, p2.y, p2.w, p3.y, p3.w};
                const float sr[8] = {sr0.x, sr0.y, sr0.z, sr0.w, sr1.x, sr1.y, sr1.z, sr1.w}, si[8] = {si0.x, si0.y, si0.z, si0.w, si1.x, si1.y, si1.z, si1.w};
                float w[8], cb[8];
                const GAS f32x4* cp = (const GAS f32x4*)((ri ? c_im : c_re) + (size_t)(g * SC + row) * SN + n0); const f32x4 c0 = cp[0], c1 = cp[1];
                const float sg = ri ? -1.f : 1.f;
                cb[0] = sg * c0.x; cb[1] = sg * c0.y; cb[2] = sg * c0.z; cb[3] = sg * c0.w; cb[4] = sg * c1.x; cb[5] = sg * c1.y; cb[6] = sg * c1.z; cb[7] = sg * c1.w;
#pragma unroll
                for (int j = 0; j < 8; ++j) w[j] = ri ? (lr[j] * si[j] + li[j] * sr[j]) : (lr[j] * sr[j] - li[j] * si[j]);
                acc = __builtin_amdgcn_mfma_f32_16x16x32_bf16(pack8(w), pack8(cb), acc, 0, 0, 0); }
            const int ch = g * SC + row;
            const float dk = dsk[ch];
#pragma unroll
            for (int rg = 0; rg < 4; ++rg) { const int tt = 16 * mb + 4 * kg + rg; const size_t tok = tok0 + tt;
                const float u = bflo((unsigned)PROJ[tok * 5120 + nv::C_U + ch]);
                const float y = acc[rg] + YI[tok * 512 + ch] + dk * u;
                G1[tt * 520 + ch] = (unsigned short)mk::f2bf(gelu_tanh(y)); } } } }
    asm volatile("s_waitcnt lgkmcnt(0)" ::: "memory"); __syncthreads();
    { const int row = lane & 15, kg = lane >> 4; f32x4 acc[2][4];
#pragma unroll
      for (int mb = 0; mb < 2; ++mb)
#pragma unroll
          for (int nb = 0; nb < 4; ++nb) acc[mb][nb] = (f32x4){0.f, 0.f, 0.f, 0.f};
#pragma unroll 8
      for (int ks = 0; ks < 16; ++ks) { bf16x8 a[2], bb[4];
#pragma unroll
          for (int mb = 0; mb < 2; ++mb) a[mb] = *(const LAS bf16x8*)(G1 + (16 * mb + row) * 520 + 32 * ks + 8 * kg);
#pragma unroll
          for (int nb = 0; nb < 4; ++nb) bb[nb] = *(const GAS bf16x8*)(WG + (size_t)(64 * wave + 16 * nb + row) * 512 + 32 * ks + 8 * kg);
#pragma unroll
          for (int mb = 0; mb < 2; ++mb)
#pragma unroll
              for (int nb = 0; nb < 4; ++nb) acc[mb][nb] = __builtin_amdgcn_mfma_f32_16x16x32_bf16(a[mb], bb[nb], acc[mb][nb], 0, 0, 0); }
      float ss[2][4];
#pragma unroll
      for (int mb = 0; mb < 2; ++mb)
#pragma unroll
          for (int rg = 0; rg < 4; ++rg) ss[mb][rg] = 0.f;
#pragma unroll
      for (int nb = 0; nb < 4; ++nb) { const int j = 64 * wave + 16 * nb + row; const float bz = b_glu[j];
#pragma unroll
          for (int mb = 0; mb < 2; ++mb)
#pragma unroll
              for (int rg = 0; rg < 4; ++rg) { const int tt = 16 * mb + 4 * kg + rg; const float z = acc[mb][nb][rg] + bz; const float g1 = bflo((unsigned)G1[tt * 520 + j]);
                  const float o = g1 * __builtin_amdgcn_rcpf(1.f + __builtin_amdgcn_exp2f(-1.4426950408889634f * z)); acc[mb][nb][rg] = o; ss[mb][rg] += o * o; } }
#pragma unroll
      for (int mb = 0; mb < 2; ++mb)
#pragma unroll
          for (int rg = 0; rg < 4; ++rg) { float v = ss[mb][rg]; v += __shfl_xor(v, 1); v += __shfl_xor(v, 2); v += __shfl_xor(v, 4); v += __shfl_xor(v, 8);
              if (row == 0) RS[wave * 32 + 16 * mb + 4 * kg + rg] = v; }
      asm volatile("s_waitcnt lgkmcnt(0)" ::: "memory"); __syncthreads();
#pragma unroll
      for (int mb = 0; mb < 2; ++mb)
#pragma unroll
          for (int rg = 0; rg < 4; ++rg) { const int tt = 16 * mb + 4 * kg + rg; float tot = 0.f;
#pragma unroll
              for (int w8 = 0; w8 < 8; ++w8) tot += RS[w8 * 32 + tt];
              const float rinv = rsqrtf(tot * (1.f / 512.f) + nv::EPS);
#pragma unroll
              for (int nb = 0; nb < 4; ++nb) { const int j = 64 * wave + 16 * nb + row; OUTT[tt * 520 + j] = (unsigned short)mk::f2bf(acc[mb][nb][rg] * rinv * ssm_g[j]); } }
      asm volatile("s_waitcnt lgkmcnt(0)" ::: "memory"); __syncthreads();
#pragma unroll
      for (int i = 0; i < 4; ++i) { const int p = tid + 512 * i, rw = p >> 6, c16 = p & 63; const v4u v = *(const LAS v4u*)(OUTT + rw * 520 + c16 * 8);
          *(GAS v4u*)(Y + (tok0 + rw) * 2048 + 512 + c16 * 8) = v; } }
    { float a_ = in[15][l * 64 + lane] * in[16][l * 64 + lane], c_ = in[17][l * 64 + lane] * in[18][l * 64 + lane];
      a_ = mk::wave_sum(a_); c_ = mk::wave_sum(c_);
      const float lam_init = 0.8f - 0.6f * __expf(-0.3f * (float)l); const float lam = __expf(a_) - __expf(c_) + lam_init;
#pragma unroll 2
      for (int i = 0; i < 4; ++i) { const size_t tok = tok0 + 4 * wave + i;
          { const v4u v = *(const GAS v4u*)(SBO + tok * 512 + lane * 8); const f32x4 g0 = *(const GAS f32x4*)(sb_g + lane * 8), g1 = *(const GAS f32x4*)(sb_g + lane * 8 + 4);
            float x[8] = {bflo(v.x), bfhi(v.x), bflo(v.y), bfhi(v.y), bflo(v.z), bfhi(v.z), bflo(v.w), bfhi(v.w)}; float s = 0.f;
#pragma unroll
            for (int j = 0; j < 8; ++j) s += x[j] * x[j];
            const float rinv = rsqrtf(mk::wave_sum(s) * (1.f / 512.f) + nv::EPS);
            v4u o; o.x = mk::pk2(x[0] * rinv * g0.x, x[1] * rinv * g0.y); o.y = mk::pk2(x[2] * rinv * g0.z, x[3] * rinv * g0.w); o.z = mk::pk2(x[4] * rinv * g1.x, x[5] * rinv * g1.y); o.w = mk::pk2(x[6] * rinv * g1.z, x[7] * rinv * g1.w);
            *(GAS v4u*)(Y + tok * 2048 + lane * 8) = o; }
          { const GAS v4u* p1 = (const GAS v4u*)(O1 + tok * 1024 + lane * 16); const GAS v4u* p2 = (const GAS v4u*)(O2 + tok * 1024 + lane * 16);
            const v4u a0 = p1[0], a1 = p1[1], b0 = p2[0], b1 = p2[1];
            float x[16] = {bflo(a0.x) - lam * bflo(b0.x), bfhi(a0.x) - lam * bfhi(b0.x), bflo(a0.y) - lam * bflo(b0.y), bfhi(a0.y) - lam * bfhi(b0.y),
                           bflo(a0.z) - lam * bflo(b0.z), bfhi(a0.z) - lam * bfhi(b0.z), bflo(a0.w) - lam * bflo(b0.w), bfhi(a0.w) - lam * bfhi(b0.w),
                           bflo(a1.x) - lam * bflo(b1.x), bfhi(a1.x) - lam * bfhi(b1.x), bflo(a1.y) - lam * bflo(b1.y), bfhi(a1.y) - lam * bfhi(b1.y),
                           bflo(a1.z) - lam * bflo(b1.z), bfhi(a1.z) - lam * bfhi(b1.z), bflo(a1.w) - lam * bflo(b1.w), bfhi(a1.w) - lam * bfhi(b1.w)};
            float s = 0.f;
#pragma unroll
            for (int j = 0; j < 16; ++j) s += x[j] * x[j];
            s += __shfl_xor(s, 1); s += __shfl_xor(s, 2); s += __shfl_xor(s, 4);
            const float rinv = rsqrtf(s * (1.f / 128.f) + nv::EPS) * (1.f - lam_init);
            const GAS f32x4* gp = (const GAS f32x4*)(df_g + (lane & 7) * 16); const f32x4 g0 = gp[0], g1 = gp[1], g2 = gp[2], g3 = gp[3];
            v4u o0, o1; o0.x = mk::pk2(x[0] * rinv * g0.x, x[1] * rinv * g0.y); o0.y = mk::pk2(x[2] * rinv * g0.z, x[3] * rinv * g0.w); o0.z = mk::pk2(x[4] * rinv * g1.x, x[5] * rinv * g1.y); o0.w = mk::pk2(x[6] * rinv * g1.z, x[7] * rinv * g1.w);
            o1.x = mk::pk2(x[8] * rinv * g2.x, x[9] * rinv * g2.y); o1.y = mk::pk2(x[10] * rinv * g2.z, x[11] * rinv * g2.w); o1.z = mk::pk2(x[12] * rinv * g3.x, x[13] * rinv * g3.y); o1.w = mk::pk2(x[14] * rinv * g3.z, x[15] * rinv * g3.w);
            GAS v4u* yo = (GAS v4u*)(Y + tok * 2048 + 1024 + lane * 16); yo[0] = o0; yo[1] = o1; } } }
    asm volatile("s_waitcnt lgkmcnt(0)" ::: "memory"); __syncthreads();
}
}

namespace mk {
struct MArgs { const float* in[30]; float* out; unsigned char* ws; int ph_lo, ph_hi, li, pad; };
constexpr int NPHASE = 1 + 8 * DEPTH;

__global__ void __launch_bounds__(NWAVES * 64, 2) mk_fwd(MArgs args) {
    extern __shared__ __attribute__((aligned(16))) unsigned char lds[];
    LAS unsigned char* ldsl = (LAS unsigned char*)lds;
    volatile LAS unsigned* MISC = (volatile LAS unsigned*)(ldsl + MISC_OFF);
    const int tid = threadIdx.x, wave = __builtin_amdgcn_readfirstlane(tid >> 6);
    const int G = gridDim.x; const int bx = blockIdx.x; const int vcu = (G % 8 == 0) ? (bx % 8) * (G / 8) + bx / 8 : bx;
    unsigned char* ws = args.ws;
    gu32* ctl = (gu32*)(ws + WS_CTL);
    for (int u = tid; u < (LDS_BYTES - LDSCTL_OFF) / 4; u += NWAVES * 64) ((LAS unsigned*)(ldsl + LDSCTL_OFF))[u] = 0u;
    __syncthreads();
    XcdBarrier bar = xcd_barrier_post((unsigned*)(ctl + CW_BAR) + args.li * XCD_BAR_WORDS, MISC + 8);
    const int lo = args.ph_lo, hi = args.ph_hi;
    if (PROBE_PH >= 0 && tid == 0) { const unsigned long long n0_ = __builtin_amdgcn_s_memrealtime(); MISC[16] = (unsigned)n0_; MISC[17] = (unsigned)(n0_ >> 32); }
#ifndef REP_P0
#define REP_P0 1
#endif
#ifndef REP_A
#define REP_A 1
#endif
#ifndef REP_B
#define REP_B 1
#endif
#ifndef REP_C
#define REP_C 1
#endif
#ifndef REP_D0
#define REP_D0 1
#endif
#ifndef REP_F
#define REP_F 1
#endif
#ifndef REP_G
#define REP_G 1
#endif
#ifndef REP_BARX
#define REP_BARX 0
#endif
#ifndef REP_E
#define REP_E 1
#endif
#ifndef REP_H1
#define REP_H1 1
#endif
#define IN(k) (lo <= (k) && (k) < hi)
#define REPEAT(n) for (int rep_ = 0; rep_ < (n); ++rep_, ((rep_ < (n)) ? xcd_barrier(bar) : (void)0))
#define SEAM(k) do { if (IN(k) && IN((k) + 1)) xcd_barrier(bar); \
    if (PROBE_PH >= 0) { if (bx == 0) { if (tid == 0) { const unsigned long long now_ = __builtin_amdgcn_s_memrealtime(); \
            const unsigned long long ps_ = ((unsigned long long)MISC[17] << 32) | MISC[16]; \
            if ((k) == PROBE_PH) { const unsigned long long dl_ = now_ + PROBE_AMP * (now_ - ps_); while (__builtin_amdgcn_s_memrealtime() < dl_) __builtin_amdgcn_s_sleep(8); } \
            const unsigned long long n1_ = __builtin_amdgcn_s_memrealtime(); MISC[16] = (unsigned)n1_; MISC[17] = (unsigned)(n1_ >> 32); } __syncthreads(); } } } while (0)
    bf16* WinT = (bf16*)(ws + WS_WIN); bf16* WoutT = (bf16*)(ws + WS_WOUT); bf16* XN = (bf16*)(ws + WS_XN); bf16* PROJ = (bf16*)(ws + WS_PROJ);
    bf16* Y = (bf16*)(ws + WS_Y); float* H = (float*)(ws + WS_H); bf16* YS = (bf16*)(ws + WS_YS); bf16* HB = (bf16*)(ws + WS_HB);
    bf16* W13T = (bf16*)(ws + WS_W13); bf16* W2T = (bf16*)(ws + WS_W2); int* LIST = (int*)(ws + WS_ROUTE); float* GATEW = (float*)(ws + WS_ROUTE + MiB);
    float* WRT = (float*)(ws + WS_ROUTE + MiB + 256 * 1024);
    LAS int* tab = (LAS int*)(ldsl + LDSCTL_OFF + 1024);
    const int NGW = G * NWAVES;
#define PHASE_IDS() const int tid_ = opaque_tid(); const int lane = tid_ & 63; const int gw = vcu * NWAVES + wave; (void)gw; (void)lane

    REPEAT(REP_P0) if (IN(0)) { PHASE_IDS();
        LAS float* scr = (LAS float*)(ldsl + RING_OFF + wave * 16640);
        constexpr int I_IN = (D / 64) * (INC / 64), I_OUT = (D / 64) * (D / 64);
        constexpr int NIT = DEPTH * (I_IN + I_OUT);
        for (int it = gw; it < NIT; it += NGW) {
            int r = it; const int l = r / (I_IN + I_OUT); r -= l * (I_IN + I_OUT);
            if (r < I_IN) { const int nb = r % (INC / 64), kb = r / (INC / 64);
                transpose_tile(args.in[2] + (size_t)l * D * INC, INC, kb * 64, nb * 64, WinT + ((size_t)l * INC + nb * 64) * D, D, scr, lane); }
            else { r -= I_IN; const int nb = r % (D / 64), kb = r / (D / 64);
                transpose_tile(args.in[20] + (size_t)l * D * D, D, kb * 64, nb * 64, WoutT + ((size_t)l * D + nb * 64) * D, D, scr, lane); }
        }
        for (int m = gw; m < T; m += NGW) rms_row_to_bf16(args.in[0] + (size_t)m * D, args.in[1], XN + (size_t)m * D, lane);
        for (int it = vcu * (NWAVES * 64) + tid_; it < DEPTH * 48 * D; it += G * NWAVES * 64) { const int d = it & (D - 1), c = (it >> 11) % 48, l = it / (48 * D);
            float w = 0.f; if (c < 4) w = args.in[22][((size_t)l * D + d) * 4 + c]; else if (c < 36) { const int gq = (c - 4) >> 3, e = (c - 4) & 7; w = args.in[24][(((size_t)l * 4 + gq) * D + d) * 8 + e]; }
            WRT[it] = w * args.in[21][(size_t)l * D + d]; }
        s5::build_tables(args.in, ws + WS_S5, vcu * (NWAVES * 64) + tid_, G * NWAVES * 64);
        for (int it = gw; it < DEPTH * 64; it += NGW) { const int l = it >> 6, r = it & 63, nb = r & 7, kb = r >> 3;
            transpose_tile(args.in[12] + (size_t)l * 512 * 512, 512, kb * 64, nb * 64, (bf16*)(ws + WS_S5 + s5::OFF_WG) + ((size_t)l * 512 + nb * 64) * 512, 512, scr, lane); }
        constexpr int NEX = nv::NEXP * 512;
        { f32x4 va[16], vb[16]; TileJob ja, jb; int it = gw;
          if (it < NEX) { ex_job(args.in, W13T, W2T, it >> 9, it & 511, ja); tile_load(ja, va, lane); }
#pragma unroll 1
          for (; it < NEX; it += 2 * NGW) {
              const int i1 = it + NGW, i2 = it + 2 * NGW;
              if (i1 < NEX) { ex_job(args.in, W13T, W2T, i1 >> 9, i1 & 511, jb); tile_load(jb, vb, lane); }
              tile_store(ja, va, scr, lane);
              if (i1 < NEX) { if (i2 < NEX) { ex_job(args.in, W13T, W2T, i2 >> 9, i2 & 511, ja); tile_load(ja, va, lane); } tile_store(jb, vb, scr, lane); }
          } }
    }
    SEAM(0);
    for (int xb_ = 0; xb_ < REP_BARX; ++xb_) xcd_barrier(bar);
    for (int l = 0; l < DEPTH; ++l) {
        const int pb = 1 + 8 * l;
        REPEAT(REP_A) if (IN(pb + 0)) {
            pg8::Gemm g{XN, WinT + (size_t)l * INC * D, T, INC, D}; pg8::StaticOrder S; S.init(T, INC, G, bx);
            pg8::EpiProj E{PROJ, INC};
            pg8::gemm_phase<pg8::EpiProj, pg8::StaticOrder, PG8_ALIGN, PG8_SP2>(ldsl + RING_OFF, g, S, E);
            { const int total = (T / 256) * (INC / 256), nmax = (total + G - 1) / G, nmine = bx < total ? (total - bx + G - 1) / G : 0;
              if (nmine < nmax) convert_batches(args.in, W13T, W2T, ctl + CW_Q, QUOTA_A, 0, MISC + 20, ldsl + RING_OFF); }
        }
        SEAM(pb + 0);
        REPEAT(REP_B) { if (l == 0) SUBPROBE(0);
        if (IN(pb + 1)) {
#pragma unroll 1
            for (int u = vcu; u < 256; u += G) s5::s5a_unit(l, u & 31, (u >> 5) & 3, u >> 7, PROJ, ws + WS_S5, ldsl + RING_OFF);
        }
        if (l == 0) SUBPROBE(1);
        if (IN(pb + 1)) {
            bf16* O1 = (bf16*)(ws + WS_O1); bf16* O2 = (bf16*)(ws + WS_O2);
#pragma unroll 1
            for (int u = vcu; u < 1024; u += G) { const int i = u >> 8, v = u & 255, combo = v >> 1, sub = v & 1;
                const int qb = ((sub ? 0x4352 : 0x6170) >> (4 * i)) & 7;
                const int b = combo >> 5, rem = combo & 31, h = rem >> 2, mp = (rem >> 1) & 1, vh = rem & 1;
                attn_body::attn_unit<8>(b, qb, (const attn_body::bf16*)(PROJ + nv::C_DQ + h * 128 + mp * 64), (const attn_body::bf16*)(PROJ + nv::C_DK + h * 128 + mp * 64),
                                        (const attn_body::bf16*)(PROJ + nv::C_DV + h * 128 + vh * 64), (attn_body::bf16*)((mp ? O2 : O1) + h * 128 + vh * 64), 1024, (char*)lds + RING_OFF); }
        }
        if (l == 0) SUBPROBE(2);
#if !defined(NO_MK_SB)
        if (IN(pb + 1)) {
            bf16* SBO = (bf16*)(ws + WS_SBO);
#pragma unroll 1
            for (int u = vcu; u < 256; u += G) { const int bh = u >> 3, qb = u & 7, b = bh >> 3, h = bh & 7;
                attn_body::sb_unit(b, qb, (const attn_body::bf16*)(PROJ + nv::C_SBQ + h * 64), (const attn_body::bf16*)(PROJ + nv::C_SBK + h * 64),
                                   (const attn_body::bf16*)(PROJ + nv::C_SBV + h * 64), (attn_body::bf16*)(SBO + h * 64), 512, (char*)lds + RING_OFF); }
        }
#endif
        if (l == 0) SUBPROBE(3);
        }
        SEAM(pb + 1);
        REPEAT(REP_C) if (IN(pb + 2)) {
#pragma unroll 1
            for (int u = vcu; u < 256; u += G) s5::post_unit(l, u >> 6, u & 63, args.in, PROJ, (const bf16*)(ws + WS_SBO), (const bf16*)(ws + WS_O1), (const bf16*)(ws + WS_O2), Y, ws + WS_S5, ldsl + RING_OFF);
        }
        SEAM(pb + 2);
        REPEAT(l == 0 ? REP_D0 : 1) if (IN(pb + 3)) {
            pg8::Gemm g{Y, WoutT + (size_t)l * D * D, T, D, D}; pg8::StaticOrder S; S.init(T, D, G, bx);
            pg8::EpiResF32 E{l == 0 ? args.in[0] : (const float*)H, H, D};
            pg8::gemm_phase<pg8::EpiResF32, pg8::StaticOrder, PG8_ALIGN, PG8_SP2>(ldsl + RING_OFF, g, S, E);
        }
        SEAM(pb + 3);
        gu32* cnt = ctl + CW_CNT + 2048 * l;
        if (IN(pb + 4)) { PHASE_IDS();
            const float* gF = args.in[21] + (size_t)l * D; const float* rgb = args.in[23] + l * 4; const float* reb = args.in[25] + l * 32;
            const float* wrt = WRT + (size_t)l * 48 * D;
            LAS float* PL = (LAS float*)(ldsl + RING_OFF);
            LAS float* PS = (LAS float*)(ldsl + RING_OFF + 24576);
            LAS float* RR = (LAS float*)(ldsl + RING_OFF + 25600);
            const int tile = wave >> 2, kq = wave & 3, row = lane & 15, kk = lane >> 4;
#pragma unroll 1
            for (int m0 = 32 * vcu; m0 < T; m0 += 32 * G) {
                const GAS f32x4* ap = (const GAS f32x4*)(H + (size_t)(m0 + 16 * tile + row) * D + kq * 512 + kk * 4);
                const GAS f32x4* bp = (const GAS f32x4*)(wrt + (size_t)row * D + kq * 512 + kk * 4);
                f32x4 acc0 = {0.f, 0.f, 0.f, 0.f}, acc1 = acc0, acc2 = acc0; float ssq = 0.f;
#pragma unroll 8
                for (int i = 0; i < 32; ++i) { const f32x4 a4 = ap[4 * i], b0 = bp[4 * i], b1 = bp[4 * i + 16 * D / 4], b2 = bp[4 * i + 32 * D / 4];
                    ssq += (a4.x * a4.x + a4.y * a4.y) + (a4.z * a4.z + a4.w * a4.w);
                    acc0 = __builtin_amdgcn_mfma_f32_16x16x4f32(a4.x, b0.x, acc0, 0, 0, 0); acc1 = __builtin_amdgcn_mfma_f32_16x16x4f32(a4.x, b1.x, acc1, 0, 0, 0); acc2 = __builtin_amdgcn_mfma_f32_16x16x4f32(a4.x, b2.x, acc2, 0, 0, 0);
                    acc0 = __builtin_amdgcn_mfma_f32_16x16x4f32(a4.y, b0.y, acc0, 0, 0, 0); acc1 = __builtin_amdgcn_mfma_f32_16x16x4f32(a4.y, b1.y, acc1, 0, 0, 0); acc2 = __builtin_amdgcn_mfma_f32_16x16x4f32(a4.y, b2.y, acc2, 0, 0, 0);
                    acc0 = __builtin_amdgcn_mfma_f32_16x16x4f32(a4.z, b0.z, acc0, 0, 0, 0); acc1 = __builtin_amdgcn_mfma_f32_16x16x4f32(a4.z, b1.z, acc1, 0, 0, 0); acc2 = __builtin_amdgcn_mfma_f32_16x16x4f32(a4.z, b2.z, acc2, 0, 0, 0);
                    acc0 = __builtin_amdgcn_mfma_f32_16x16x4f32(a4.w, b0.w, acc0, 0, 0, 0); acc1 = __builtin_amdgcn_mfma_f32_16x16x4f32(a4.w, b1.w, acc1, 0, 0, 0); acc2 = __builtin_amdgcn_mfma_f32_16x16x4f32(a4.w, b2.w, acc2, 0, 0, 0); }
                ssq += __shfl_xor(ssq, 16); ssq += __shfl_xor(ssq, 32);
                if (kk == 0) PS[(tile * 4 + kq) * 16 + row] = ssq;
#pragma unroll
                for (int rg = 0; rg < 4; ++rg) { LAS float* p = PL + ((tile * 4 + kq) * 16 + 4 * kk + rg) * 48 + row; p[0] = acc0[rg]; p[16] = acc1[rg]; p[32] = acc2[rg]; }
                LDS_WAIT(); __syncthreads();
                if (wave == 0 && lane < 32) { const int t2 = lane >> 4, rw = lane & 15;
                    float sq = 0.f;
#pragma unroll
                    for (int q = 0; q < 4; ++q) sq += PS[(t2 * 4 + q) * 16 + rw];
                    const float r = rsqrtf(sq * (1.f / D) + EPS); RR[lane] = r;
                    const LAS float* p0 = PL + ((t2 * 4 + 0) * 16 + rw) * 48; const LAS float* p1 = p0 + 16 * 48; const LAS float* p2 = p1 + 16 * 48; const LAS float* p3 = p2 + 16 * 48;
                    float gl[4]; int gi = 0; float gm = -INFINITY;
#pragma unroll
                    for (int q = 0; q < 4; ++q) { gl[q] = ((p0[q] + p1[q]) + (p2[q] + p3[q])) * r + rgb[q]; if (gl[q] > gm) { gm = gl[q]; gi = q; } }
                    const float gtop = 1.f / (expf(gl[0] - gm) + expf(gl[1] - gm) + expf(gl[2] - gm) + expf(gl[3] - gm));
                    float m0v = -INFINITY, m1v = -INFINITY; int i0 = 0, i1 = 0;
#pragma unroll
                    for (int q = 0; q < 8; ++q) { const int c = 4 + gi * 8 + q; const float lv = ((p0[c] + p1[c]) + (p2[c] + p3[c])) * r + reb[gi * 8 + q];
                        if (lv > m0v) { m1v = m0v; i1 = i0; m0v = lv; i0 = q; } else if (lv > m1v) { m1v = lv; i1 = q; } }
                    const float p1e = expf(m1v - m0v); const float w0 = 1.f / (1.f + p1e) * gtop, w1 = p1e / (1.f + p1e) * gtop;
                    const int x0 = gi * 8 + i0, x1 = gi * 8 + i1; const int mr = m0 + lane;
                    const unsigned q0 = __hip_atomic_fetch_add(cnt + 64 * x0, 1u, RLX_AGENT), q1 = __hip_atomic_fetch_add(cnt + 64 * x1, 1u, RLX_AGENT);
                    LIST[x0 * 8192 + q0] = 2 * mr; LIST[x1 * 8192 + q1] = 2 * mr + 1; GATEW[2 * mr] = w0; GATEW[2 * mr + 1] = w1; }
                LDS_WAIT(); __syncthreads();
#pragma unroll 2
                for (int i = 0; i < 4; ++i) { const int mr = m0 + 4 * wave + i; const float r = RR[4 * wave + i];
                    const GAS f32x4* hr = (const GAS f32x4*)(H + (size_t)mr * D) + lane; const GAS f32x4* gr = (const GAS f32x4*)gF + lane;
                    GAS unsigned long long* o8 = (GAS unsigned long long*)(XN + (size_t)mr * D) + lane;
                    f32x4 hv[8];
#pragma unroll
                    for (int j = 0; j < 8; ++j) hv[j] = hr[64 * j];
#pragma unroll
                    for (int j = 0; j < 8; ++j) { const f32x4 o = hv[j] * r * gr[64 * j]; o8[64 * j] = (unsigned long long)pk2(o.x, o.y) | ((unsigned long long)pk2(o.z, o.w) << 32); } }
                LDS_WAIT(); __syncthreads();
            }
            if (l == 1) convert_batches(args.in, W13T, W2T, ctl + CW_Q, 0, Q_TOTAL, MISC + 20, ldsl + RING_OFF);
        }
        SEAM(pb + 4);
#define BUILD_TAB() do { PHASE_IDS(); if (wave == 0) { const int c_ = (lane < 32) ? (int)__hip_atomic_load(cnt + 64 * (lane & 31), RLX_AGENT) : 0; int incl = (c_ + 255) >> 8; \
            _Pragma("unroll") for (int o = 1; o < 32; o <<= 1) { const int t_ = __shfl_up(incl, o); if (lane >= o) incl += t_; } \
            if (lane < 32) { tab[lane] = c_; tab[33 + lane] = incl; } if (lane == 0) tab[32] = 0; } LDS_WAIT(); __syncthreads(); } while (0)
        REPEAT(REP_F) if (IN(pb + 5)) {
            BUILD_TAB();
            pg8::GroupedOrder S{(const LAS int*)tab, 4, G, bx, 1024u * 2048u * 2u};
            pg8::Gemm g{XN, W13T + (size_t)l * nv::NEXP * 1024 * D, 0, 0, D};
            pg8::EpiMoe1 E{HB, LIST, GATEW};
            pg8::gemm_phase_g<pg8::EpiMoe1, true>(ldsl + RING_OFF, g, S, E, LIST);
            { const int total = tab[64] * 4, nmax = (total + G - 1) / G, nmine = bx < total ? (total - bx + G - 1) / G : 0;
              if (nmine < nmax) convert_batches(args.in, W13T, W2T, ctl + CW_Q, QUOTA_F, 0, MISC + 20, ldsl + RING_OFF); }
            if (l == 0) convert_batches(args.in, W13T, W2T, ctl + CW_Q, 0, Q_W2L0, MISC + 20, ldsl + RING_OFF);
        }
        SEAM(pb + 5);
        REPEAT(REP_G) if (IN(pb + 6)) {
            BUILD_TAB();
            pg8::GroupedOrder S{(const LAS int*)tab, 8, G, bx, 2048u * 512u * 2u};
            pg8::Gemm g{HB, W2T + (size_t)l * nv::NEXP * D * nv::DE, 0, 0, nv::DE};
            pg8::EpiMoe2 E{YS, LIST};
            pg8::gemm_phase_g<pg8::EpiMoe2, false>(ldsl + RING_OFF, g, S, E, LIST);
            { const int total = tab[64] * 8, nmax = (total + G - 1) / G, nmine = bx < total ? (total - bx + G - 1) / G : 0;
              if (nmine < nmax) convert_batches(args.in, W13T, W2T, ctl + CW_Q, QUOTA_G, 0, MISC + 20, ldsl + RING_OFF); }
        }
        SEAM(pb + 6);
        REPEAT(l == 1 ? REP_H1 : 1) if (IN(pb + 7)) { PHASE_IDS();
            const bool fin = (l + 1 == DEPTH); const float* gN = fin ? args.in[29] : args.in[1] + (size_t)(l + 1) * D;
            for (int m = gw; m < T; m += NGW) {
                GAS f32x4* hr = (GAS f32x4*)(H + (size_t)m * D) + lane; const GAS f32x4* gr = (const GAS f32x4*)gN + lane;
                typedef unsigned u32x2_t __attribute__((ext_vector_type(2))); const GAS u32x2_t* y0 = (const GAS u32x2_t*)(YS + (size_t)(2 * m) * D) + lane; const GAS u32x2_t* y1 = (const GAS u32x2_t*)(YS + (size_t)(2 * m + 1) * D) + lane;
                f32x4 v[8]; float s = 0.f;
#pragma unroll
                for (int j = 0; j < 8; ++j) { const f32x4 h4 = hr[64 * j]; const u32x2_t a = y0[64 * j], b = y1[64 * j];
                    v[j].x = h4.x + __uint_as_float(a.x << 16) + __uint_as_float(b.x << 16); v[j].y = h4.y + __uint_as_float(a.x & 0xffff0000u) + __uint_as_float(b.x & 0xffff0000u);
                    v[j].z = h4.z + __uint_as_float(a.y << 16) + __uint_as_float(b.y << 16); v[j].w = h4.w + __uint_as_float(a.y & 0xffff0000u) + __uint_as_float(b.y & 0xffff0000u);
                    s += (v[j].x * v[j].x + v[j].y * v[j].y) + (v[j].z * v[j].z + v[j].w * v[j].w); }
                const float r = rsqrtf(wave_sum(s) * (1.f / D) + EPS);
                if (fin) { GAS f32x4* orow = (GAS f32x4*)(args.out + (size_t)m * D) + lane;
#pragma unroll
                    for (int j = 0; j < 8; ++j) orow[64 * j] = v[j] * r * gr[64 * j]; }
                else { GAS unsigned long long* o8 = (GAS unsigned long long*)(XN + (size_t)m * D) + lane;
#pragma unroll
                    for (int j = 0; j < 8; ++j) { hr[64 * j] = v[j]; const f32x4 o = v[j] * r * gr[64 * j]; o8[64 * j] = (unsigned long long)pk2(o.x, o.y) | ((unsigned long long)pk2(o.z, o.w) << 32); } }
            }
        }
        SEAM(pb + 7);
    }
#undef IN
#undef SEAM
}

static int g_grid = 0;
static bool mk_setup() {
    if (g_grid != 0) return g_grid > 0;
    int dev = 0, cus = 0, per_cu = 0;
    if (hipGetDevice(&dev) != hipSuccess || hipDeviceGetAttribute(&cus, hipDeviceAttributeMultiprocessorCount, dev) != hipSuccess) { g_grid = -1; return false; }
    if (hipFuncSetAttribute((const void*)mk_fwd, hipFuncAttributeMaxDynamicSharedMemorySize, LDS_BYTES) != hipSuccess) { fprintf(stderr, "mk: hipFuncSetAttribute failed\n"); g_grid = -1; return false; }
    if (hipOccupancyMaxActiveBlocksPerMultiprocessor(&per_cu, (const void*)mk_fwd, NWAVES * 64, LDS_BYTES) != hipSuccess || per_cu < 1) { fprintf(stderr, "mk: occupancy query says %d\n", per_cu); }
    (void)hipGetLastError();
    g_grid = cus;
    return true;
}
static void mk_launch(const MArgs& base, int lo, int hi, int& li, hipStream_t stream) {
    MArgs a = base; a.ph_lo = lo; a.ph_hi = hi; a.li = li++; a.pad = 0;
    hipLaunchKernelGGL(mk_fwd, dim3(g_grid), dim3(NWAVES * 64), LDS_BYTES, stream, a);
}
}
extern "C" void kernel_launch(void* const* d_in, const int* in_sizes, int n_in, void* d_out, int out_size, void* d_ws, size_t ws_size, hipStream_t stream) {
    using namespace nv;
    if (n_in != 30 || ws_size < mk::WS_END) { fprintf(stderr, "kernel_launch: unexpected n_in %d / ws %zu\n", n_in, ws_size); return; }
    if (!mk::mk_setup()) return;
    const float* x = (const float*)d_in[0];
    const float* norm_mix_g = (const float*)d_in[1]; const float* sb_norm_g = (const float*)d_in[3];
    const float* lam_re = (const float*)d_in[4]; const float* lam_im = (const float*)d_in[5]; const float* b_re = (const float*)d_in[6]; const float* b_im = (const float*)d_in[7];
    const float* c_re = (const float*)d_in[8]; const float* c_im = (const float*)d_in[9]; const float* ssm_d = (const float*)d_in[10]; const float* log_dt = (const float*)d_in[11];
    const float* w_glu = (const float*)d_in[12]; const float* b_glu = (const float*)d_in[13]; const float* ssm_norm_g = (const float*)d_in[14];
    const float* lq1 = (const float*)d_in[15]; const float* lk1 = (const float*)d_in[16]; const float* lq2 = (const float*)d_in[17]; const float* lk2 = (const float*)d_in[18];
    const float* subln = (const float*)d_in[19]; const float* norm_ffn_g = (const float*)d_in[21];
    const float* rgw = (const float*)d_in[22]; const float* rgb = (const float*)d_in[23]; const float* rew = (const float*)d_in[24]; const float* reb = (const float*)d_in[25];
    const float* ew1 = (const float*)d_in[26]; const float* ew3 = (const float*)d_in[27]; const float* ew2 = (const float*)d_in[28]; const float* final_g = (const float*)d_in[29];
    char* ws = (char*)d_ws;
    bf16_t* XN = (bf16_t*)(ws + mk::WS_XN); bf16_t* PROJ = (bf16_t*)(ws + mk::WS_PROJ); bf16_t* SBO = (bf16_t*)(ws + mk::WS_SBO);
    bf16_t* O1 = (bf16_t*)(ws + mk::WS_O1); bf16_t* O2 = (bf16_t*)(ws + mk::WS_O2); bf16_t* Y = (bf16_t*)(ws + mk::WS_Y); float* H = (float*)(ws + mk::WS_H);
    bf16_t* YS = (bf16_t*)(ws + mk::WS_YS);
    float2* ST = (float2*)(ws + mk::WS_S5); float* G1 = (float*)(ws + mk::WS_S5 + 128 * mk::MiB); float* SY = (float*)(ws + mk::WS_S5 + 144 * mk::MiB);
    (void)hipMemsetAsync(ws + mk::WS_CTL, 0, mk::CTL_ZERO_BYTES, stream);
    mk::MArgs a{};
    for (int i = 0; i < 30; ++i) a.in[i] = (const float*)d_in[i];
    a.out = (float*)d_out; a.ws = (unsigned char*)d_ws;
    int li = 0;
    mk::mk_launch(a, 0, mk::NPHASE, li, stream);
}
```

```cpp
#include <hip/hip_runtime.h>
#include <hip/hip_bf16.h>
#include <cstdint>
#include <cstdio>
#include <cmath>
__device__ __forceinline__ int opaque_tid() { int t = threadIdx.x; asm volatile("" : "+v"(t)); return t; }
namespace nv {
constexpr int NB = 4, L = 2048, D = 2048, T = NB * L, DEPTH = 2;
constexpr int SBW = 512, SBH = 8, SSMW = 512, SG = 32, SN = 64, SC = 16, DFW = 1024, DFH = 8, DFV = 128;
constexpr int INC = 5120, NEXP = 32, EPG = 8, NGRP = 4, DE = 512;
constexpr int C_SBQ = 0, C_SBK = 512, C_SBV = 1024, C_U = 1536, C_DQ = 2048, C_DK = 3072, C_DV = 4096;
constexpr float EPS = 1e-6f;
constexpr float LOG2E = 1.4426950408889634f;
constexpr float QS_SB = 0.125f * LOG2E, QS_DF = 0.125f * LOG2E;

typedef unsigned short bf16_t;
__device__ __forceinline__ float bf2f(bf16_t v) { return __uint_as_float(((unsigned)v) << 16); }
__device__ __forceinline__ bf16_t f2bf(float f) { unsigned u = __float_as_uint(f); return (bf16_t)((u + 0x7fffu + ((u >> 16) & 1u)) >> 16); }

__device__ __forceinline__ float block_sum(float v, float* red) {
    for (int o = 32; o > 0; o >>= 1) v += __shfl_xor(v, o);
    const int w = threadIdx.x >> 6, nw = blockDim.x >> 6;
    __syncthreads();
    if ((threadIdx.x & 63) == 0) red[w] = v;
    __syncthreads();
    float s = 0.f;
    for (int i = 0; i < nw; ++i) s += red[i];
    return s;
}
__device__ __forceinline__ float block_max(float v, float* red) {
    for (int o = 32; o > 0; o >>= 1) v = fmaxf(v, __shfl_xor(v, o));
    const int w = threadIdx.x >> 6, nw = blockDim.x >> 6;
    __syncthreads();
    if ((threadIdx.x & 63) == 0) red[w] = v;
    __syncthreads();
    float s = -INFINITY;
    for (int i = 0; i < nw; ++i) s = fmaxf(s, red[i]);
    return s;
}

__global__ void __launch_bounds__(256) k_rmsnorm(const float* __restrict__ x, const float* __restrict__ g, bf16_t* __restrict__ out) {
    __shared__ float red[16];
    const int t = blockIdx.x; const float* xr = x + (size_t)t * D;
    float v[8]; float s = 0.f;
    for (int i = 0; i < 8; ++i) { v[i] = xr[threadIdx.x + 256 * i]; s += v[i] * v[i]; }
    s = block_sum(s, red);
    const float r = rsqrtf(s / D + EPS);
    for (int i = 0; i < 8; ++i) out[(size_t)t * D + threadIdx.x + 256 * i] = f2bf(v[i] * r * g[threadIdx.x + 256 * i]);
}

template <int EPI>
__global__ void __launch_bounds__(256) k_gemm(const bf16_t* __restrict__ A, int lda, const float* __restrict__ Bm, int ldb, int K,
                                             void* __restrict__ Cout, int ldc, const float* __restrict__ R) {
    __shared__ float As[16][68];
    __shared__ float Bs[16][68];
    const int tx = threadIdx.x & 15, ty = threadIdx.x >> 4;
    const int m0 = blockIdx.y * 64, n0 = blockIdx.x * 64;
    float acc[4][4];
    for (int i = 0; i < 4; ++i) for (int j = 0; j < 4; ++j) acc[i][j] = 0.f;
    for (int k0 = 0; k0 < K; k0 += 16) {
        for (int e = threadIdx.x; e < 64 * 16; e += 256) { const int r = e >> 4, c = e & 15; As[c][r] = bf2f(A[(size_t)(m0 + r) * lda + k0 + c]); }
        for (int e = threadIdx.x; e < 64 * 16; e += 256) { const int r = e >> 6, c = e & 63; Bs[r][c] = Bm[(size_t)(k0 + r) * ldb + n0 + c]; }
        __syncthreads();
#pragma unroll
        for (int k = 0; k < 16; ++k) {
            float a[4], b[4];
            for (int i = 0; i < 4; ++i) a[i] = As[k][ty * 4 + i];
            for (int j = 0; j < 4; ++j) b[j] = Bs[k][tx * 4 + j];
            for (int i = 0; i < 4; ++i) for (int j = 0; j < 4; ++j) acc[i][j] += a[i] * b[j];
        }
        __syncthreads();
    }
    for (int i = 0; i < 4; ++i) for (int j = 0; j < 4; ++j) {
        const int m = m0 + ty * 4 + i, n = n0 + tx * 4 + j;
        if (EPI == 0) {
            float sc = 1.f; if (n < C_SBK) sc = QS_SB; else if (n >= C_DQ && n < C_DK) sc = QS_DF;
            ((bf16_t*)Cout)[(size_t)m * ldc + n] = f2bf(acc[i][j] * sc);
        } else {
            ((float*)Cout)[(size_t)m * ldc + n] = acc[i][j] + R[(size_t)m * ldc + n];
        }
    }
}

__global__ void __launch_bounds__(256) k_sb_attn(const bf16_t* __restrict__ P, bf16_t* __restrict__ O) {
    __shared__ float zs[L];
    __shared__ float qv[64];
    __shared__ float part[4][64];
    const int t = blockIdx.x, h = blockIdx.y, b = blockIdx.z, tid = threadIdx.x;
    const size_t rowb = (size_t)b * L;
    if (tid < 64) qv[tid] = bf2f(P[(rowb + t) * INC + C_SBQ + h * 64 + tid]);
    __syncthreads();
    for (int s = tid; s < t; s += 256) {
        const bf16_t* kr = P + (rowb + s) * INC + C_SBK + h * 64;
        float z = 0.f;
        for (int d = 0; d < 64; ++d) z += qv[d] * bf2f(kr[d]);
        zs[s] = z;
    }
    __syncthreads();
    if (tid == 0) {
        float Racc = 0.f;
        for (int s = t - 1; s >= 0; --s) {
            const float z = zs[s];
            const float sp = fmaxf(-z, 0.f) + log1pf(expf(-fabsf(z)));
            zs[s] = expf(-sp + Racc);
            Racc += -(sp + z);
        }
    }
    __syncthreads();
    const int d = tid & 63, gq = tid >> 6;
    float o = 0.f;
    for (int s = gq; s < t; s += 4) o += zs[s] * bf2f(P[(rowb + s) * INC + C_SBV + h * 64 + d]);
    part[gq][d] = o;
    __syncthreads();
    if (tid < 64) O[(rowb + t) * SBW + h * 64 + tid] = f2bf(part[0][tid] + part[1][tid] + part[2][tid] + part[3][tid]);
}

__global__ void __launch_bounds__(256) k_diff_attn(const bf16_t* __restrict__ P, bf16_t* __restrict__ O1, bf16_t* __restrict__ O2) {
    __shared__ float ps[L];
    __shared__ float qv[64];
    __shared__ float part[2][128];
    __shared__ float red[16];
    const int t = blockIdx.x, h = blockIdx.y >> 1, mp = blockIdx.y & 1, b = blockIdx.z, tid = threadIdx.x;
    const size_t rowb = (size_t)b * L;
    if (tid < 64) qv[tid] = bf2f(P[(rowb + t) * INC + C_DQ + h * 128 + mp * 64 + tid]);
    __syncthreads();
    float mx = -INFINITY;
    for (int s = tid; s <= t; s += 256) {
        const bf16_t* kr = P + (rowb + s) * INC + C_DK + h * 128 + mp * 64;
        float z = 0.f;
        for (int d = 0; d < 64; ++d) z += qv[d] * bf2f(kr[d]);
        ps[s] = z; mx = fmaxf(mx, z);
    }
    mx = block_max(mx, red);
    float sum = 0.f;
    for (int s = tid; s <= t; s += 256) { const float p = exp2f(ps[s] - mx); ps[s] = p; sum += p; }
    sum = block_sum(sum, red);
    __syncthreads();
    const int d = tid & 127, gq = tid >> 7;
    float o = 0.f;
    for (int s = gq; s <= t; s += 2) o += ps[s] * bf2f(P[(rowb + s) * INC + C_DV + h * 128 + d]);
    part[gq][d] = o;
    __syncthreads();
    if (tid < 128) { bf16_t* O = mp ? O2 : O1; O[(rowb + t) * DFW + h * 128 + tid] = f2bf((part[0][tid] + part[1][tid]) / sum); }
}

__global__ void __launch_bounds__(64) k_s5_scan(const bf16_t* __restrict__ P, const float* lam_re, const float* lam_im, const float* b_re, const float* b_im,
                                                const float* log_dt, float2* __restrict__ ST) {
    const int b = blockIdx.x / SG, g = blockIdx.x % SG, n = threadIdx.x;
    const double dt = exp((double)log_dt[g]);
    const double lr = lam_re[g * SN + n], li = lam_im[g * SN + n];
    const double er = exp(lr * dt), lbr = er * cos(li * dt), lbi = er * sin(li * dt);
    const double nr = lbr - 1.0, ni = lbi, den = lr * lr + li * li;
    const double fr = (nr * lr + ni * li) / den, fi = (ni * lr - nr * li) / den;
    float bbr[SC], bbi[SC];
#pragma unroll
    for (int c = 0; c < SC; ++c) { const double br = b_re[(g * SN + n) * SC + c], bi = b_im[(g * SN + n) * SC + c]; bbr[c] = (float)(fr * br - fi * bi); bbi[c] = (float)(fr * bi + fi * br); }
    const float ar = (float)lbr, ai = (float)lbi;
    float sr = 0.f, si = 0.f;
    for (int t = 0; t < L; ++t) {
        const bf16_t* ur = P + ((size_t)b * L + t) * INC + C_U + g * SC;
        float bur = 0.f, bui = 0.f;
#pragma unroll
        for (int c = 0; c < SC; ++c) { const float u = bf2f(ur[c]); bur += bbr[c] * u; bui += bbi[c] * u; }
        const float nsr = ar * sr - ai * si + bur, nsi = ar * si + ai * sr + bui;
        sr = nsr; si = nsi;
        ST[(((size_t)b * L + t) * SG + g) * SN + n] = make_float2(sr, si);
    }
}
__device__ __forceinline__ float gelu_tanh(float x) { const float u = 0.7978845608028654f * (x + 0.044715f * x * x * x); return 0.5f * x * (1.f + tanhf(u)); }
__global__ void __launch_bounds__(256) k_s5_out(const bf16_t* __restrict__ P, const float2* __restrict__ ST, const float* c_re, const float* c_im, const float* dsk, float* __restrict__ G1) {
    const size_t idx = (size_t)blockIdx.x * 256 + threadIdx.x;
    const int ch = (int)(idx % SSMW); const size_t t = idx / SSMW; const int g = ch / SC, c = ch % SC;
    const float2* st = ST + (t * SG + g) * SN;
    float y = 0.f;
    for (int n = 0; n < SN; ++n) { const float2 s = st[n]; y += c_re[(g * SC + c) * SN + n] * s.x - c_im[(g * SC + c) * SN + n] * s.y; }
    y += dsk[g * SC + c] * bf2f(P[t * INC + C_U + ch]);
    G1[idx] = gelu_tanh(y);
}
__global__ void __launch_bounds__(512) k_glu(const float* __restrict__ G1, const float* __restrict__ w, const float* __restrict__ bg, float* __restrict__ SY) {
    __shared__ float row[SSMW];
    const int t = blockIdx.x, j = threadIdx.x;
    row[j] = G1[(size_t)t * SSMW + j];
    __syncthreads();
    float z = bg[j];
    for (int k = 0; k < SSMW; ++k) z += row[k] * w[(size_t)k * SSMW + j];
    SY[(size_t)t * SSMW + j] = row[j] / (1.f + expf(-z));
}
__global__ void __launch_bounds__(256) k_post(const bf16_t* __restrict__ SBO, const float* __restrict__ SY, const bf16_t* __restrict__ O1, const bf16_t* __restrict__ O2,
                                             const float* sbg, const float* ssmg, const float* dfg, const float* lq1, const float* lk1, const float* lq2, const float* lk2,
                                             float lam_init, bf16_t* __restrict__ Y) {
    __shared__ float red[16];
    const int t = blockIdx.x, tid = threadIdx.x;
    float a = 0.f, c = 0.f;
    if (tid < 64) { a = lq1[tid] * lk1[tid]; c = lq2[tid] * lk2[tid]; }
    a = block_sum(a, red); c = block_sum(c, red);
    const float lam = expf(a) - expf(c) + lam_init;
    { float v0 = bf2f(SBO[(size_t)t * SBW + tid]), v1 = bf2f(SBO[(size_t)t * SBW + 256 + tid]);
      const float s = block_sum(v0 * v0 + v1 * v1, red); const float r = rsqrtf(s / SBW + EPS);
      Y[(size_t)t * D + tid] = f2bf(v0 * r * sbg[tid]); Y[(size_t)t * D + 256 + tid] = f2bf(v1 * r * sbg[256 + tid]); }
    { float v0 = SY[(size_t)t * SSMW + tid], v1 = SY[(size_t)t * SSMW + 256 + tid];
      const float s = block_sum(v0 * v0 + v1 * v1, red); const float r = rsqrtf(s / SSMW + EPS);
      Y[(size_t)t * D + 512 + tid] = f2bf(v0 * r * ssmg[tid]); Y[(size_t)t * D + 768 + tid] = f2bf(v1 * r * ssmg[256 + tid]); }
    for (int i = 0; i < 4; ++i) {
        const int e = tid + 256 * i; const int dv = e & 127;
        const float v = bf2f(O1[(size_t)t * DFW + e]) - lam * bf2f(O2[(size_t)t * DFW + e]);
        float s = v * v;
        for (int o = 32; o > 0; o >>= 1) s += __shfl_xor(s, o);
        __syncthreads();
        if ((tid & 63) == 0) red[tid >> 6] = s;
        __syncthreads();
        const int w = tid >> 6; const float tot = red[w & ~1] + red[(w & ~1) + 1];
        const float r = rsqrtf(tot / DFV + EPS);
        Y[(size_t)t * D + 1024 + e] = f2bf(v * r * dfg[dv] * (1.f - lam_init));
    }
}
__global__ void __launch_bounds__(256) k_route(const float* __restrict__ H, const float* __restrict__ g, const float* __restrict__ rgw, const float* __restrict__ rgb,
                                              const float* __restrict__ rew, const float* __restrict__ reb, bf16_t* __restrict__ HN, int* __restrict__ EI, float* __restrict__ EW) {
    __shared__ float red[16];
    __shared__ float hn[D];
    const int t = blockIdx.x, tid = threadIdx.x;
    float s = 0.f;
    for (int i = 0; i < 8; ++i) { const float v = H[(size_t)t * D + tid + 256 * i]; hn[tid + 256 * i] = v; s += v * v; }
    s = block_sum(s, red);
    const float r = rsqrtf(s / D + EPS);
    for (int i = 0; i < 8; ++i) { const int d = tid + 256 * i; const float v = hn[d] * r * g[d]; hn[d] = v; HN[(size_t)t * D + d] = f2bf(v); }
    __syncthreads();
    float gl[NGRP];
#pragma unroll
    for (int j = 0; j < NGRP; ++j) { float p = 0.f; for (int i = 0; i < 8; ++i) { const int d = tid + 256 * i; p += hn[d] * rgw[(size_t)d * NGRP + j]; } gl[j] = block_sum(p, red) + rgb[j]; }
    int gi = 0; float gm = gl[0];
#pragma unroll
    for (int j = 1; j < NGRP; ++j) if (gl[j] > gm) { gm = gl[j]; gi = j; }
    float gs = 0.f;
#pragma unroll
    for (int j = 0; j < NGRP; ++j) gs += expf(gl[j] - gm);
    const float gtop = 1.f / gs;
    float m0 = -INFINITY, m1 = -INFINITY; int i0 = 0, i1 = 0;
#pragma unroll
    for (int e = 0; e < EPG; ++e) { float p = 0.f; for (int i = 0; i < 8; ++i) { const int d = tid + 256 * i; p += hn[d] * rew[((size_t)gi * D + d) * EPG + e]; }
        const float v = block_sum(p, red) + reb[gi * EPG + e];
        if (v > m0) { m1 = m0; i1 = i0; m0 = v; i0 = e; } else if (v > m1) { m1 = v; i1 = e; } }
    const float p1 = expf(m1 - m0);
    const float w0 = 1.f / (1.f + p1) * gtop, w1 = p1 / (1.f + p1) * gtop;
    if (tid == 0) { EI[t * 2] = gi * EPG + i0; EI[t * 2 + 1] = gi * EPG + i1; EW[t * 2] = w0; EW[t * 2 + 1] = w1; }
}
__global__ void __launch_bounds__(512) k_moe_h(const bf16_t* __restrict__ HN, const int* __restrict__ EI, const float* __restrict__ EW, const float* __restrict__ w1, const float* __restrict__ w3, float* __restrict__ HB) {
    __shared__ float xr[D];
    const int ts = blockIdx.x, t = ts >> 1, f = threadIdx.x;
    for (int i = 0; i < 4; ++i) xr[f + 512 * i] = bf2f(HN[(size_t)t * D + f + 512 * i]);
    __syncthreads();
    const int e = EI[ts]; const float gw = EW[ts];
    const float* a1 = w1 + (size_t)e * D * DE + f; const float* a3 = w3 + (size_t)e * D * DE + f;
    float a = 0.f, b = 0.f;
    for (int d = 0; d < D; ++d) { a += xr[d] * a1[(size_t)d * DE]; b += xr[d] * a3[(size_t)d * DE]; }
    HB[(size_t)ts * DE + f] = a / (1.f + expf(-a)) * b * gw;
}
__global__ void __launch_bounds__(512) k_moe_y(const float* __restrict__ HB, const int* __restrict__ EI, const float* __restrict__ w2, bf16_t* __restrict__ YS) {
    __shared__ float hr[DE];
    const int ts = blockIdx.x, j = threadIdx.x;
    hr[j] = HB[(size_t)ts * DE + j];
    __syncthreads();
    const int e = EI[ts];
    const float* w = w2 + (size_t)e * DE * D;
    float acc[4] = {0.f, 0.f, 0.f, 0.f};
    for (int f = 0; f < DE; ++f) { const float hv = hr[f]; for (int i = 0; i < 4; ++i) acc[i] += hv * w[(size_t)f * D + j + 512 * i]; }
    for (int i = 0; i < 4; ++i) YS[(size_t)ts * D + j + 512 * i] = f2bf(acc[i]);
}
__global__ void __launch_bounds__(256) k_combine(float* __restrict__ H, const bf16_t* __restrict__ YS, const float* __restrict__ g, bf16_t* __restrict__ XN, float* __restrict__ out) {
    __shared__ float red[16];
    const int t = blockIdx.x, tid = threadIdx.x;
    float v[8]; float s = 0.f;
    for (int i = 0; i < 8; ++i) { const int d = tid + 256 * i; v[i] = H[(size_t)t * D + d] + bf2f(YS[((size_t)t * 2) * D + d]) + bf2f(YS[((size_t)t * 2 + 1) * D + d]); s += v[i] * v[i]; }
    s = block_sum(s, red);
    const float r = rsqrtf(s / D + EPS);
    for (int i = 0; i < 8; ++i) { const int d = tid + 256 * i;
        if (out) out[(size_t)t * D + d] = v[i] * r * g[d];
        else { H[(size_t)t * D + d] = v[i]; XN[(size_t)t * D + d] = f2bf(v[i] * r * g[d]); } }
}
}

namespace pg8 {
#define PG8_LAS __attribute__((address_space(3)))
typedef unsigned short bf16_t;
typedef short bf16x8 __attribute__((ext_vector_type(8)));
typedef float f32x4 __attribute__((ext_vector_type(4)));
typedef unsigned u32x4 __attribute__((ext_vector_type(4)));
constexpr int BM = 256, BK = 64, HALF = 128, HTB = HALF * BK * 2  , STAGE_BYTES = 8 * HTB, NXCD = 8, WGM = 8;

__host__ __device__ __forceinline__ int lds_byte(int r, int c) { const int st = (r >> 4) * 2 + (c >> 5), rr = r & 15, cc = c & 31, ob = rr * 64 + cc * 2; return st * 1024 + (ob ^ (((ob >> 9) & 1) << 5)); }
__host__ __device__ __forceinline__ void stage_rc(int b, int& R, int& C) { const int st = b / 1024, sb = b % 1024, swz = sb ^ (((sb >> 9) & 1) << 5); R = (st >> 1) * 16 + swz / 64; C = (st & 1) * 32 + (swz % 64) / 2; }
__host__ __device__ __forceinline__ int perm32(int rho) { const int n = rho >> 4, i = rho & 15; return 8 * (i >> 2) + 4 * n + (i & 3); }

struct Unit { int pm, pn; };
struct Gemm { const bf16_t* A; const bf16_t* Bt; int M, N, K; };

struct StaticOrder {
    int nM, nN, nwg, G, c;
    __host__ __device__ void init(int M, int N, int G_, int c_) { nM = M / BM; nN = N / BM; nwg = nM * nN; G = G_; c = c_; }
    __host__ __device__ bool next(int i, Unit& u) const {
        const long L = (long)i * G + c; if (L >= nwg) return false;
        int wgid = (int)L; { const int q = nwg / NXCD, r = nwg % NXCD, xcd = wgid % NXCD, off = wgid / NXCD; wgid = (xcd < r ? xcd * (q + 1) : r * (q + 1) + (xcd - r) * q) + off; }
        const int nig = WGM * nN, gid = wgid / nig, fm = gid * WGM, gsz = (nM - fm) < WGM ? (nM - fm) : WGM;
        u.pm = fm + ((wgid % nig) % gsz); u.pn = (wgid % nig) / gsz; return true;
    }
    __device__ __forceinline__ void a_ready(const Unit&) const {}
    __device__ __forceinline__ void done(const Unit&) const {}
};

__device__ __forceinline__ unsigned cvt_pk_bf16(float lo, float hi) { unsigned r; asm volatile("v_cvt_pk_bf16_f32 %0, %1, %2" : "=v"(r) : "v"(lo), "v"(hi)); return r; }
typedef float f32x2 __attribute__((ext_vector_type(2)));
__device__ __forceinline__ f32x2 gelu_pk(f32x2 v) {
    const f32x2 av = __builtin_elementwise_abs(v), d = av * 0.2316418882f + 1.0f;
    f32x2 t; t.x = __builtin_amdgcn_rcpf(d.x); t.y = __builtin_amdgcn_rcpf(d.y);
    f32x2 q = t * 0.5307027145f + (-0.7265760135f); q = q * t + 0.7107068705f; q = q * t + (-0.142248368f); q = q * t + 0.127414796f; q = q * t;
    const f32x2 s = (v * v) * (-0.72134752044f);
    f32x2 e; e.x = __builtin_amdgcn_exp2f(s.x); e.y = __builtin_amdgcn_exp2f(s.y);
    const f32x2 m = v * (q * e), r = v - m;
    f32x2 o; o.x = v.x < 0.f ? m.x : r.x; o.y = v.y < 0.f ? m.y : r.y; return o;
}

template <int ACT  > struct EpiBf16 {
    static constexpr bool PERM = true, AFTER_DRAIN = false; static_assert(ACT == 0 || ACT == 1, "EpiBf16: ACT is 0 (none) or 1 (gelu_pk)");
    bf16_t* O; int ldc; const float* bias; int split_cols; size_t split_stride; float scale0;
    __device__ __forceinline__ void operator()(const f32x4 (&acc)[2][2][4][2], const Unit& u, int wr, int wc, int fr, int fq) const {
        const int row0 = u.pm * BM + wr * 64 + fr; int colt = u.pn * BM; bf16_t* base = O;
        float sc = 1.f; if (split_cols) { const int t = colt / split_cols; base += (size_t)t * split_stride; colt -= t * split_cols; if (t == 0) sc = scale0; }
        const int col0 = colt + wc * 32 + 8 * fq, bcol0 = u.pn * BM + wc * 32 + 8 * fq;
        f32x4 bv[2][2];
#pragma unroll
        for (int bj = 0; bj < 2; ++bj)
#pragma unroll
            for (int n = 0; n < 2; ++n) bv[bj][n] = bias ? *(const f32x4*)(bias + bcol0 + bj * HALF + 4 * n) : (f32x4){0.f, 0.f, 0.f, 0.f};
#pragma unroll
        for (int ai = 0; ai < 2; ++ai)
#pragma unroll
            for (int m = 0; m < 4; ++m) { bf16_t* rowp = base + (size_t)(row0 + ai * HALF + m * 16) * ldc + col0;
#pragma unroll
                for (int bj = 0; bj < 2; ++bj) { f32x4 v0 = acc[ai][bj][m][0] + bv[bj][0], v1 = acc[ai][bj][m][1] + bv[bj][1];
                    if (ACT == 1) { f32x2 a = gelu_pk((f32x2){v0[0], v0[1]}), b = gelu_pk((f32x2){v0[2], v0[3]}), c = gelu_pk((f32x2){v1[0], v1[1]}), d = gelu_pk((f32x2){v1[2], v1[3]});
                        v0 = (f32x4){a.x, a.y, b.x, b.y}; v1 = (f32x4){c.x, c.y, d.x, d.y}; }
                    v0 = v0 * sc; v1 = v1 * sc; u32x4 w; w.x = cvt_pk_bf16(v0[0], v0[1]); w.y = cvt_pk_bf16(v0[2], v0[3]); w.z = cvt_pk_bf16(v1[0], v1[1]); w.w = cvt_pk_bf16(v1[2], v1[3]);
                    *(u32x4*)(rowp + bj * HALF) = w; } }
    }
};
template <class Epi, class Sched, bool ALIGN_EPI = false, bool SP2 = false>
__device__ __forceinline__ void gemm_phase(PG8_LAS unsigned char* lds, const Gemm g, const Sched& S, const Epi& E) {
    const int tid = opaque_tid(), wid = __builtin_amdgcn_readfirstlane(tid >> 6), lane = tid & 63, wr = wid >> 2, wc = wid & 3, fr = lane & 15, fq = lane >> 4;
    const int K = g.K, nt = K / BK;
    unsigned voffA[2], voffB[2];
#pragma unroll
    for (int i = 0; i < 2; ++i) { int R, C; stage_rc(tid * 16 + i * 8192, R, C); const int Rb = Epi::PERM ? ((R & ~31) + perm32(R & 31)) : R;
        voffA[i] = (unsigned)(R * K + C) * 2u; voffB[i] = (unsigned)(Rb * K + C) * 2u; }
    const size_t kstep = (size_t)(BK * 2);
    const size_t hstep = (size_t)HALF * K * 2;
    const size_t tstep = 2 * hstep;
    const unsigned ldsw = (unsigned)wid * 1024u;
    const int aoff = lds_byte(wr * 64 + fr, fq * 8), boff = lds_byte(wc * 32 + fr, fq * 8);
#define PG8_SA(b, h) (((b) * 2 + (h)) * HTB)
#define PG8_SB(b, h) ((4 + (b) * 2 + (h)) * HTB)
#define PG8_STAGE(bufoff, gbase, voff) do { _Pragma("unroll") for (int _i = 0; _i < 2; ++_i) \
        __builtin_amdgcn_global_load_lds((const unsigned*)((const char*)(gbase) + (voff)[_i]), (PG8_LAS unsigned*)(lds + (bufoff) + ldsw + _i * 8192), 16, 0, 0); } while (0)
#define PG8_LDA(dst, b, h) do { _Pragma("unroll") for (int m = 0; m < 4; ++m) _Pragma("unroll") for (int k = 0; k < 2; ++k) dst[m][k] = *(const PG8_LAS bf16x8*)(lds + PG8_SA(b, h) + aoff + m * 2048 + k * 1024); } while (0)
#define PG8_LDB(dst, b, h) do { _Pragma("unroll") for (int n = 0; n < 2; ++n) _Pragma("unroll") for (int k = 0; k < 2; ++k) dst[n][k] = *(const PG8_LAS bf16x8*)(lds + PG8_SB(b, h) + boff + n * 2048 + k * 1024); } while (0)
#define PG8_MMA(ai, bj, At, Bt) do { __builtin_amdgcn_s_setprio(1); _Pragma("unroll") for (int m = 0; m < 4; ++m) _Pragma("unroll") for (int n = 0; n < 2; ++n) _Pragma("unroll") for (int k = 0; k < 2; ++k) \
        acc[ai][bj][m][n] = __builtin_amdgcn_mfma_f32_16x16x32_bf16(Bt[n][k], At[m][k], acc[ai][bj][m][n], 0, 0, 0); __builtin_amdgcn_s_setprio(0); } while (0)
#define PG8_WAIT_V(n) asm volatile("s_waitcnt vmcnt(" #n ")" ::: "memory")
#define PG8_WAIT_L(n) asm volatile("s_waitcnt lgkmcnt(" #n ")" ::: "memory")
#define PG8_BAR __builtin_amdgcn_s_barrier()
#define PG8_SCHED __builtin_amdgcn_sched_barrier(0)
    Unit cur, nxt; int ui = 0;
    if (!S.next(0, cur)) return;
    f32x4 acc[2][2][4][2];
#pragma unroll
    for (int a = 0; a < 2; ++a)
#pragma unroll
        for (int b = 0; b < 2; ++b)
#pragma unroll
            for (int m = 0; m < 4; ++m)
#pragma unroll
                for (int n = 0; n < 2; ++n) acc[a][b][m][n] = (f32x4){0.f, 0.f, 0.f, 0.f};
    bf16x8 At[4][2], B0[2][2], B1[2][2];
    const char* cA = (const char*)g.A + (size_t)cur.pm * tstep; const char* cB = (const char*)g.Bt + (size_t)cur.pn * tstep;
    S.a_ready(cur);
    if constexpr (SP2) {
        PG8_STAGE(PG8_SB(0, 0), cB, voffB); PG8_STAGE(PG8_SB(0, 1), cB + hstep, voffB); PG8_STAGE(PG8_SA(0, 0), cA, voffA); PG8_STAGE(PG8_SA(0, 1), cA + hstep, voffA);
        if (wr == 1) PG8_BAR;
        PG8_WAIT_V(2); PG8_BAR;
        PG8_STAGE(PG8_SB(1, 0), cB + kstep, voffB); PG8_STAGE(PG8_SA(1, 0), cA + kstep, voffA); PG8_STAGE(PG8_SB(1, 1), cB + hstep + kstep, voffB);
        PG8_WAIT_V(6); PG8_BAR;
    } else {
        PG8_STAGE(PG8_SB(0, 0), cB, voffB); PG8_STAGE(PG8_SA(0, 0), cA, voffA); PG8_STAGE(PG8_SB(0, 1), cB + hstep, voffB); PG8_STAGE(PG8_SA(0, 1), cA + hstep, voffA);
        if (wr == 1) PG8_BAR;
        PG8_WAIT_V(4); PG8_BAR;
        PG8_STAGE(PG8_SB(1, 0), cB + kstep, voffB); PG8_STAGE(PG8_SA(1, 0), cA + kstep, voffA); PG8_STAGE(PG8_SB(1, 1), cB + hstep + kstep, voffB);
        PG8_WAIT_V(6); PG8_BAR;
    }
    for (;;) {
        const bool has_next = S.next(ui + 1, nxt);
        const char* nA = has_next ? (const char*)g.A + (size_t)nxt.pm * tstep : cA; const char* nB = has_next ? (const char*)g.Bt + (size_t)nxt.pn * tstep : cB;
        for (int t = 0; t < nt; t += 2) {
            const bool last = (t == nt - 2);
            const char* a1 = cA + (size_t)(t + 1) * kstep;
            const char* a2 = last ? nA : cA + (size_t)(t + 2) * kstep; const char* b2 = last ? nB : cB + (size_t)(t + 2) * kstep;
            const char* a3 = a2 + kstep; const char* b3 = b2 + kstep;
            if (last && has_next) S.a_ready(nxt);
            if constexpr (SP2) {
            PG8_LDB(B0, 0, 0); PG8_LDB(B1, 0, 1); PG8_SCHED; PG8_LDA(At, 0, 0); PG8_STAGE(PG8_SA(1, 1), a1 + hstep, voffA);
            PG8_WAIT_V(8); PG8_WAIT_L(0); PG8_BAR; PG8_MMA(0, 0, At, B0); PG8_MMA(0, 1, At, B1); PG8_BAR; PG8_SCHED;
            PG8_LDA(At, 0, 1); PG8_STAGE(PG8_SB(0, 0), b2, voffB); PG8_STAGE(PG8_SB(0, 1), b2 + hstep, voffB); PG8_STAGE(PG8_SA(0, 0), a2, voffA);
            PG8_WAIT_V(8); PG8_WAIT_L(0); PG8_BAR; PG8_MMA(1, 0, At, B0); PG8_MMA(1, 1, At, B1); PG8_BAR; PG8_SCHED;
            PG8_LDB(B0, 1, 0); PG8_LDB(B1, 1, 1); PG8_SCHED; PG8_LDA(At, 1, 0); PG8_STAGE(PG8_SA(0, 1), a2 + hstep, voffA);
            PG8_WAIT_V(8); PG8_WAIT_L(0); PG8_BAR; PG8_MMA(0, 0, At, B0); PG8_MMA(0, 1, At, B1); PG8_BAR; PG8_SCHED;
            PG8_LDA(At, 1, 1); PG8_STAGE(PG8_SB(1, 0), b3, voffB); PG8_STAGE(PG8_SB(1, 1), b3 + hstep, voffB); PG8_STAGE(PG8_SA(1, 0), a3, voffA);
            PG8_WAIT_V(8); PG8_WAIT_L(0); PG8_BAR; PG8_MMA(1, 0, At, B0); PG8_MMA(1, 1, At, B1); PG8_BAR; PG8_SCHED;
            } else {
            PG8_LDB(B0, 0, 0); PG8_SCHED; PG8_LDA(At, 0, 0); PG8_STAGE(PG8_SA(1, 1), a1 + hstep, voffA);
            PG8_WAIT_L(8); PG8_BAR; PG8_WAIT_L(0); PG8_MMA(0, 0, At, B0); PG8_BAR; PG8_SCHED;
            PG8_LDB(B1, 0, 1); PG8_STAGE(PG8_SB(0, 0), b2, voffB);
            PG8_BAR; PG8_WAIT_L(0); PG8_MMA(0, 1, At, B1); PG8_BAR;
            PG8_LDA(At, 0, 1); PG8_STAGE(PG8_SA(0, 0), a2, voffA);
            PG8_BAR; PG8_WAIT_L(0); PG8_MMA(1, 0, At, B0); PG8_BAR; PG8_SCHED;
            PG8_STAGE(PG8_SB(0, 1), b2 + hstep, voffB);
            PG8_WAIT_V(6); PG8_BAR; PG8_MMA(1, 1, At, B1); PG8_BAR;
            PG8_LDB(B0, 1, 0); PG8_SCHED; PG8_LDA(At, 1, 0); PG8_STAGE(PG8_SA(0, 1), a2 + hstep, voffA);
            PG8_WAIT_L(8); PG8_BAR; PG8_WAIT_L(0); PG8_MMA(0, 0, At, B0); PG8_BAR; PG8_SCHED;
            PG8_LDB(B1, 1, 1); PG8_STAGE(PG8_SB(1, 0), b3, voffB);
            PG8_BAR; PG8_WAIT_L(0); PG8_MMA(0, 1, At, B1); PG8_BAR;
            PG8_LDA(At, 1, 1); PG8_STAGE(PG8_SA(1, 0), a3, voffA);
            PG8_BAR; PG8_WAIT_L(0); PG8_MMA(1, 0, At, B0); PG8_BAR; PG8_SCHED;
            PG8_STAGE(PG8_SB(1, 1), b3 + hstep, voffB);
            PG8_WAIT_V(6); PG8_BAR; PG8_MMA(1, 1, At, B1); PG8_BAR;
            }
        }
        if constexpr (ALIGN_EPI) { if (wr == 0) PG8_BAR; }
        if constexpr (!Epi::AFTER_DRAIN) { E(acc, cur, wr, wc, fr, fq); S.done(cur); }
        if (!has_next) break;
#pragma unroll
        for (int a = 0; a < 2; ++a)
#pragma unroll
            for (int b = 0; b < 2; ++b)
#pragma unroll
                for (int m = 0; m < 4; ++m)
#pragma unroll
                    for (int n = 0; n < 2; ++n) acc[a][b][m][n] = (f32x4){0.f, 0.f, 0.f, 0.f};
        cur = nxt; cA = nA; cB = nB; ++ui;
        if constexpr (ALIGN_EPI) { if (wr == 1) PG8_BAR; }
    }
    PG8_WAIT_V(0);
    if constexpr (!ALIGN_EPI) { if (wr == 0) PG8_BAR; }
    PG8_BAR;
    if constexpr (Epi::AFTER_DRAIN) { E.fused(acc, cur, wr, wc, fr, fq, lds, wid, lane); S.done(cur); }
#undef PG8_SA
#undef PG8_SB
#undef PG8_STAGE
#undef PG8_LDA
#undef PG8_LDB
#undef PG8_MMA
#undef PG8_WAIT_V
#undef PG8_WAIT_L
#undef PG8_BAR
#undef PG8_SCHED
}
}

#ifndef PG8_SP2
#define PG8_SP2 true
#endif
#ifndef PG8_ALIGN
#define PG8_ALIGN true
#endif
namespace pg8 {
struct UnitG { int pm, pn, e, r0, nvalid; unsigned boff; };
struct GroupedOrder {
    const PG8_LAS int* tab; int nN, G, c; unsigned bstride;
    __device__ __forceinline__ bool next(int i, UnitG& u) const {
        int Lx = i * G + c; const int totH = __builtin_amdgcn_readfirstlane(tab[97]) * nN, totL = __builtin_amdgcn_readfirstlane(tab[130]) * nN;
        if (Lx >= totH + totL) return false;
        const bool light = Lx >= totH; const int off = light ? 98 : 65; if (light) Lx -= totH;
        int e = 0;
#pragma unroll 4
        for (int k = 1; k < 32; ++k) { const int s = __builtin_amdgcn_readfirstlane(tab[off + k]) * nN; if (Lx >= s) e = k; }
        const int p0 = __builtin_amdgcn_readfirstlane(tab[off + e]), p1 = __builtin_amdgcn_readfirstlane(tab[off + 1 + e]), ce = __builtin_amdgcn_readfirstlane(tab[e]);
        const int m0 = __builtin_amdgcn_readfirstlane(tab[32 + e]);
        const int idx = Lx - p0 * nN, ne = p1 - p0; const int pn = idx / ne; int mtl = idx - pn * ne;
        if (light) mtl = (ce + 127) >> 8;
        u.pm = m0 + mtl; u.pn = pn; u.e = e; u.r0 = mtl * 256; u.nvalid = ce - mtl * 256; u.boff = (unsigned)e * bstride; return true;
    }
};
template <class Epi, bool GATHER>
__device__ __forceinline__ void gemm_phase_g(PG8_LAS unsigned char* lds, const Gemm g, const GroupedOrder& S, const Epi& E, const int* __restrict__ LIST) {
    const int tid = opaque_tid(), wid = __builtin_amdgcn_readfirstlane(tid >> 6), lane = tid & 63, wr = wid >> 2, wc = wid & 3, fr = lane & 15, fq = lane >> 4;
    const int K = g.K, nt = K / BK;
    unsigned voffB[2]; int RA[2], CA[2];
#pragma unroll
    for (int i = 0; i < 2; ++i) { int R, C; stage_rc(tid * 16 + i * 8192, R, C); const int Rb = Epi::PERM ? ((R & ~31) + perm32(R & 31)) : R;
        RA[i] = R; CA[i] = C; voffB[i] = (unsigned)(Rb * K + C) * 2u; }
    const size_t kstep = (size_t)(BK * 2);
    const size_t hstepB = (size_t)HALF * K * 2;
    const size_t tstepB = 2 * hstepB;
    const unsigned ldsw = (unsigned)wid * 1024u;
    const int aoff = lds_byte(wr * 64 + fr, fq * 8), boff = lds_byte(wc * 32 + fr, fq * 8);
#define PG8_SA(b, h) (((b) * 2 + (h)) * HTB)
#define PG8_SB(b, h) ((4 + (b) * 2 + (h)) * HTB)
#define PG8_STAGE(bufoff, gbase, voff) do { _Pragma("unroll") for (int _i = 0; _i < 2; ++_i) \
        __builtin_amdgcn_global_load_lds((const unsigned*)((const char*)(gbase) + (voff)[_i]), (PG8_LAS unsigned*)(lds + (bufoff) + ldsw + _i * 8192), 16, 0, 0); } while (0)
#define PG8_LDA(dst, b, h) do { _Pragma("unroll") for (int m = 0; m < 4; ++m) _Pragma("unroll") for (int k = 0; k < 2; ++k) dst[m][k] = *(const PG8_LAS bf16x8*)(lds + PG8_SA(b, h) + aoff + m * 2048 + k * 1024); } while (0)
#define PG8_LDB(dst, b, h) do { _Pragma("unroll") for (int n = 0; n < 2; ++n) _Pragma("unroll") for (int k = 0; k < 2; ++k) dst[n][k] = *(const PG8_LAS bf16x8*)(lds + PG8_SB(b, h) + boff + n * 2048 + k * 1024); } while (0)
#define PG8_MMA(ai, bj, At, Bt) do { __builtin_amdgcn_s_setprio(1); _Pragma("unroll") for (int m = 0; m < 4; ++m) _Pragma("unroll") for (int n = 0; n < 2; ++n) _Pragma("unroll") for (int k = 0; k < 2; ++k) \
        acc[ai][bj][m][n] = __builtin_amdgcn_mfma_f32_16x16x32_bf16(Bt[n][k], At[m][k], acc[ai][bj][m][n], 0, 0, 0); __builtin_amdgcn_s_setprio(0); } while (0)
#define PG8_WAIT_V(n) asm volatile("s_waitcnt vmcnt(" #n ")" ::: "memory")
#define PG8_WAIT_L(n) asm volatile("s_waitcnt lgkmcnt(" #n ")" ::: "memory")
#define PG8_BAR __builtin_amdgcn_s_barrier()
#define PG8_SCHED __builtin_amdgcn_sched_barrier(0)
#define PG8_AOFF(u, vo) do { _Pragma("unroll") for (int _h = 0; _h < 2; ++_h) _Pragma("unroll") for (int _i = 0; _i < 2; ++_i) { const int _r = _h * HALF + RA[_i]; int _row; \
        if (GATHER) { _row = 0; if (_r < (u).nvalid) _row = LIST[(u).e * 8192 + (u).r0 + _r] >> 1; } else _row = (u).pm * BM + _r; \
        (vo)[_h][_i] = (unsigned)(_row * K + CA[_i]) * 2u; } } while (0)
    UnitG cur, nxt; int ui = 0;
    if (!S.next(0, cur)) return;
    f32x4 acc[2][2][4][2];
#pragma unroll
    for (int a = 0; a < 2; ++a)
#pragma unroll
        for (int b = 0; b < 2; ++b)
#pragma unroll
            for (int m = 0; m < 4; ++m)
#pragma unroll
                for (int n = 0; n < 2; ++n) acc[a][b][m][n] = (f32x4){0.f, 0.f, 0.f, 0.f};
    bf16x8 At[4][2], B0[2][2], B1[2][2];
    unsigned vA[2][2], vN[2][2];
    PG8_AOFF(cur, vA);
    const char* gA = (const char*)g.A;
    const char* cB = (const char*)g.Bt + cur.boff + (size_t)cur.pn * tstepB;
    PG8_STAGE(PG8_SB(0, 0), cB, voffB); PG8_STAGE(PG8_SB(0, 1), cB + hstepB, voffB); PG8_STAGE(PG8_SA(0, 0), gA, vA[0]); PG8_STAGE(PG8_SA(0, 1), gA, vA[1]);
    if (wr == 1) PG8_BAR;
    PG8_WAIT_V(2); PG8_BAR;
    PG8_STAGE(PG8_SB(1, 0), cB + kstep, voffB); PG8_STAGE(PG8_SA(1, 0), gA + kstep, vA[0]); PG8_STAGE(PG8_SB(1, 1), cB + hstepB + kstep, voffB);
    PG8_WAIT_V(6); PG8_BAR;
    for (;;) {
        const bool has_next = S.next(ui + 1, nxt);
        if (has_next) { PG8_AOFF(nxt, vN); } else {
#pragma unroll
            for (int _h = 0; _h < 2; ++_h)
#pragma unroll
                for (int _i = 0; _i < 2; ++_i) vN[_h][_i] = vA[_h][_i]; }
        const char* nB = has_next ? (const char*)g.Bt + nxt.boff + (size_t)nxt.pn * tstepB : cB;
        const bool heavy = cur.nvalid > HALF;
        for (int t = 0; t < nt; t += 2) {
            const bool last = (t == nt - 2);
            const char* a1 = gA + (size_t)(t + 1) * kstep;
            const char* a2 = last ? gA : gA + (size_t)(t + 2) * kstep; const char* b2 = last ? nB : cB + (size_t)(t + 2) * kstep;
            const char* a3 = a2 + kstep; const char* b3 = b2 + kstep;
            unsigned v2a[2], v2b[2];
#pragma unroll
            for (int _i = 0; _i < 2; ++_i) { v2a[_i] = last ? vN[0][_i] : vA[0][_i]; v2b[_i] = last ? vN[1][_i] : vA[1][_i]; }
            PG8_LDB(B0, 0, 0); PG8_LDB(B1, 0, 1); PG8_SCHED; PG8_LDA(At, 0, 0); PG8_STAGE(PG8_SA(1, 1), a1, vA[1]);
            PG8_WAIT_V(8); PG8_WAIT_L(0); PG8_BAR; PG8_MMA(0, 0, At, B0); PG8_MMA(0, 1, At, B1); PG8_BAR; PG8_SCHED;
            PG8_LDA(At, 0, 1); PG8_STAGE(PG8_SB(0, 0), b2, voffB); PG8_STAGE(PG8_SB(0, 1), b2 + hstepB, voffB); PG8_STAGE(PG8_SA(0, 0), a2, v2a);
            PG8_WAIT_V(8); PG8_WAIT_L(0); PG8_BAR; if (heavy) { PG8_MMA(1, 0, At, B0); PG8_MMA(1, 1, At, B1); } PG8_BAR; PG8_SCHED;
            PG8_LDB(B0, 1, 0); PG8_LDB(B1, 1, 1); PG8_SCHED; PG8_LDA(At, 1, 0); PG8_STAGE(PG8_SA(0, 1), a2, v2b);
            PG8_WAIT_V(8); PG8_WAIT_L(0); PG8_BAR; PG8_MMA(0, 0, At, B0); PG8_MMA(0, 1, At, B1); PG8_BAR; PG8_SCHED;
            PG8_LDA(At, 1, 1); PG8_STAGE(PG8_SB(1, 0), b3, voffB); PG8_STAGE(PG8_SB(1, 1), b3 + hstepB, voffB); PG8_STAGE(PG8_SA(1, 0), a3, v2a);
            PG8_WAIT_V(8); PG8_WAIT_L(0); PG8_BAR; if (heavy) { PG8_MMA(1, 0, At, B0); PG8_MMA(1, 1, At, B1); } PG8_BAR; PG8_SCHED;
        }
        if (wr == 0) PG8_BAR;
        E(acc, cur, wr, wc, fr, fq);
        if (!has_next) break;
#pragma unroll
        for (int a = 0; a < 2; ++a)
#pragma unroll
            for (int b = 0; b < 2; ++b)
#pragma unroll
                for (int m = 0; m < 4; ++m)
#pragma unroll
                    for (int n = 0; n < 2; ++n) acc[a][b][m][n] = (f32x4){0.f, 0.f, 0.f, 0.f};
        cur = nxt; cB = nB; ++ui;
#pragma unroll
        for (int _h = 0; _h < 2; ++_h)
#pragma unroll
            for (int _i = 0; _i < 2; ++_i) vA[_h][_i] = vN[_h][_i];
        if (wr == 1) PG8_BAR;
    }
    PG8_WAIT_V(0);
    PG8_BAR;
#undef PG8_AOFF
#undef PG8_SA
#undef PG8_SB
#undef PG8_STAGE
#undef PG8_LDA
#undef PG8_LDB
#undef PG8_MMA
#undef PG8_WAIT_V
#undef PG8_WAIT_L
#undef PG8_BAR
#undef PG8_SCHED
}
__device__ __forceinline__ float silu_f(float a) { return a * __builtin_amdgcn_rcpf(1.f + __builtin_amdgcn_exp2f(-1.4426950408889634f * a)); }
struct EpiMoe1 {
    static constexpr bool PERM = true, AFTER_DRAIN = false;
    bf16_t* HB; const int* LIST; const float* GATEW;
    __device__ __forceinline__ void operator()(const f32x4 (&acc)[2][2][4][2], const UnitG& u, int wr, int wc, int fr, int fq) const {
#pragma unroll
        for (int ai = 0; ai < 2; ++ai)
#pragma unroll
            for (int m = 0; m < 4; ++m) { const int r = ai * HALF + wr * 64 + m * 16 + fr;
                float gate = 0.f; if (r < u.nvalid) gate = GATEW[LIST[u.e * 8192 + u.r0 + r]];
                bf16_t* rowp = HB + (size_t)(u.pm * BM + r) * 512 + u.pn * 128 + wc * 32 + 8 * fq;
                const f32x4 a0 = acc[ai][0][m][0], a1 = acc[ai][0][m][1], b0 = acc[ai][1][m][0], b1 = acc[ai][1][m][1];
                f32x4 h0, h1;
#pragma unroll
                for (int j = 0; j < 4; ++j) { h0[j] = silu_f(a0[j]) * b0[j] * gate; h1[j] = silu_f(a1[j]) * b1[j] * gate; }
                u32x4 w; w.x = cvt_pk_bf16(h0[0], h0[1]); w.y = cvt_pk_bf16(h0[2], h0[3]); w.z = cvt_pk_bf16(h1[0], h1[1]); w.w = cvt_pk_bf16(h1[2], h1[3]);
                *(u32x4*)rowp = w; }
    }
};
struct EpiMoe2 {
    static constexpr bool PERM = true, AFTER_DRAIN = false;
    bf16_t* YS; const int* LIST;
    __device__ __forceinline__ void operator()(const f32x4 (&acc)[2][2][4][2], const UnitG& u, int wr, int wc, int fr, int fq) const {
#pragma unroll
        for (int ai = 0; ai < 2; ++ai)
#pragma unroll
            for (int m = 0; m < 4; ++m) { const int r = ai * HALF + wr * 64 + m * 16 + fr;
                if (r < u.nvalid) { const int idx = LIST[u.e * 8192 + u.r0 + r];
                    bf16_t* rowp = YS + (size_t)idx * 2048 + u.pn * BM + wc * 32 + 8 * fq;
#pragma unroll
                    for (int bj = 0; bj < 2; ++bj) { const f32x4 v0 = acc[ai][bj][m][0], v1 = acc[ai][bj][m][1];
                        u32x4 w; w.x = cvt_pk_bf16(v0[0], v0[1]); w.y = cvt_pk_bf16(v0[2], v0[3]); w.z = cvt_pk_bf16(v1[0], v1[1]); w.w = cvt_pk_bf16(v1[2], v1[3]);
                        *(u32x4*)(rowp + bj * HALF) = w; } } }
    }
};
}
#include <hip/hip_bf16.h>
#include <cmath>
namespace attn_body {
using bf16=__hip_bfloat16;
using bf16x8=__attribute__((ext_vector_type(8)))short;
using s16x4=__attribute__((ext_vector_type(4)))short;
using f32x16=__attribute__((ext_vector_type(16)))float;
using u32x4=__attribute__((ext_vector_type(4)))unsigned;
constexpr int SEQ=2048,D=64,DM=5120;
constexpr int NW=8,QBLK=32,QB=QBLK*NW,KVBLK=64,NQB=SEQ/QB;
constexpr int ATTN_UNIT_ROWS=QB;
__device__ __forceinline__ int crow(int r,int hi){return (r&3)+8*(r>>2)+4*hi;}
#define SBAR() __builtin_amdgcn_sched_barrier(0)
__device__ __forceinline__ void cmask(f32x16&p0,f32x16&p1,int jb,int qrel,int hi){
  const float NEG=-INFINITY; int kb=64*jb+4*hi;
  #pragma unroll
  for(int r=0;r<16;++r){int kv=kb+(r&3)+8*(r>>2); if(kv>qrel)p0[r]=NEG; if(kv+32>qrel)p1[r]=NEG;}
}

constexpr int NSLOT=3, SLOTB=8192;
constexpr int LDS_K=0, LDS_V=NSLOT*SLOTB, LDS_WS=2*NSLOT*SLOTB, LDS_OST=LDS_WS+NW*64*4, LDS_BYTES=LDS_OST+NW*4096;
constexpr float C2=0.125f*1.4426950408889634f;
__device__ __forceinline__ void glds16(const void*gsrc,unsigned lds_dst){unsigned keep;
  asm volatile("s_mov_b32 %0, m0\n\ts_mov_b32 m0, %2\n\ts_nop 0\n\tglobal_load_lds_dwordx4 %1, off\n\ts_mov_b32 m0, %0":"=&s"(keep):"v"(gsrc),"s"(lds_dst):"memory");}
__device__ __forceinline__ float max3f(float a,float b,float c){float r;asm("v_max3_f32 %0, %1, %2, %3":"=v"(r):"v"(a),"v"(b),"v"(c));return r;}
__device__ __forceinline__ float max2f(float a,float b){float r;asm("v_max_f32_e32 %0, %1, %2":"=v"(r):"v"(a),"v"(b));return r;}
__device__ __forceinline__ float fadd_s(float a,float b){float r;asm("v_add_f32_e32 %0, %1, %2":"=v"(r):"v"(a),"v"(b));return r;}
__device__ __forceinline__ float fsub_s(float a,float b){float r;asm("v_sub_f32_e32 %0, %1, %2":"=v"(r):"v"(a),"v"(b));return r;}
typedef float f32x2_t __attribute__((ext_vector_type(2))); typedef __bf16 bf16x2_t __attribute__((ext_vector_type(2)));
__device__ __forceinline__ unsigned cvtpk_s(float lo,float hi){f32x2_t v={lo,hi};bf16x2_t b=__builtin_convertvector(v,bf16x2_t);return __builtin_bit_cast(unsigned,b);}
#define WAIT_BAR(N) asm volatile("s_waitcnt vmcnt(" #N ") lgkmcnt(0)\n\ts_barrier":::"memory")

__device__ __forceinline__ void qkt(f32x16&p0,f32x16&p1,const char*Kslot,const bf16x8*qr,const f32x16&negm,int r32,int hi){
  const char*kb=Kslot+hi*1024+r32*16;
  #pragma unroll
  for(int d0=0;d0<4;++d0){
    const bf16x8 b0=*reinterpret_cast<const bf16x8*>(kb+d0*2048);
    const bf16x8 b1=*reinterpret_cast<const bf16x8*>(kb+d0*2048+512);
    if(d0==0){p0=__builtin_amdgcn_mfma_f32_32x32x16_bf16(b0,qr[0],negm,0,0,0);p1=__builtin_amdgcn_mfma_f32_32x32x16_bf16(b1,qr[0],negm,0,0,0);}
    else{p0=__builtin_amdgcn_mfma_f32_32x32x16_bf16(b0,qr[d0],p0,0,0,0);p1=__builtin_amdgcn_mfma_f32_32x32x16_bf16(b1,qr[d0],p1,0,0,0);}}
}
typedef __attribute__((address_space(3))) const char* lds_cptr;
typedef short v4i16_t __attribute__((ext_vector_type(4)));
__device__ __forceinline__ void kload8(bf16x8*kf,lds_cptr kp){
  kf[0]=*(const __attribute__((address_space(3))) bf16x8*)(kp);      kf[1]=*(const __attribute__((address_space(3))) bf16x8*)(kp+512);
  kf[2]=*(const __attribute__((address_space(3))) bf16x8*)(kp+2048); kf[3]=*(const __attribute__((address_space(3))) bf16x8*)(kp+2560);
  kf[4]=*(const __attribute__((address_space(3))) bf16x8*)(kp+4096); kf[5]=*(const __attribute__((address_space(3))) bf16x8*)(kp+4608);
  kf[6]=*(const __attribute__((address_space(3))) bf16x8*)(kp+6144); kf[7]=*(const __attribute__((address_space(3))) bf16x8*)(kp+6656);
}
__device__ __forceinline__ void kload2(bf16x8*kf,lds_cptr kp,int j){ kf[2*j]=*(const __attribute__((address_space(3))) bf16x8*)(kp+j*2048); kf[2*j+1]=*(const __attribute__((address_space(3))) bf16x8*)(kp+j*2048+512); }
__device__ __forceinline__ s16x4 vtr(lds_cptr p){ return __builtin_bit_cast(s16x4,__builtin_amdgcn_ds_read_tr16_b64_v4i16((__attribute__((address_space(3))) v4i16_t*)p)); }
__device__ __forceinline__ float rowmax(const f32x16&p0,const f32x16&p1){
  float a=max3f(p0[0],p0[1],p1[0]),b=max3f(p0[2],p0[3],p1[1]);a=max3f(a,p1[2],p1[3]);
  #pragma unroll
  for(int r=4;r<16;r+=4){a=max3f(a,p0[r],p0[r+1]);b=max3f(b,p0[r+2],p0[r+3]);a=max3f(a,p1[r],p1[r+1]);b=max3f(b,p1[r+2],p1[r+3]);}
  const float m=max2f(a,b);
  auto rr=__builtin_amdgcn_permlane32_swap(__float_as_uint(m),__float_as_uint(m),false,false);
  return max2f(__uint_as_float(rr[0]),__uint_as_float(rr[1]));
}
__device__ __forceinline__ void pv(f32x16*o,int vb,bf16x8 pa0,bf16x8 pa1,bf16x8 pa2,bf16x8 pa3){
  #pragma unroll
  for(int d0=0;d0<2;++d0){s16x4 lo[4],hi[4];
    #pragma unroll
    for(int ks=0;ks<4;++ks){
      asm volatile("ds_read_b64_tr_b16 %0,%1 offset:%c2":"=&v"(lo[ks]):"v"(vb),"i"(d0*4096+ks*1024):"memory");
      asm volatile("ds_read_b64_tr_b16 %0,%1 offset:%c2":"=&v"(hi[ks]):"v"(vb),"i"(d0*4096+ks*1024+512):"memory");}
    asm volatile("s_waitcnt lgkmcnt(0)":::"memory");SBAR();
    #define PK(k) (bf16x8){lo[k][0],lo[k][1],lo[k][2],lo[k][3],hi[k][0],hi[k][1],hi[k][2],hi[k][3]}
    o[d0]=__builtin_amdgcn_mfma_f32_32x32x16_bf16(pa0,PK(0),o[d0],0,0,0);
    o[d0]=__builtin_amdgcn_mfma_f32_32x32x16_bf16(pa1,PK(1),o[d0],0,0,0);
    o[d0]=__builtin_amdgcn_mfma_f32_32x32x16_bf16(pa2,PK(2),o[d0],0,0,0);
    o[d0]=__builtin_amdgcn_mfma_f32_32x32x16_bf16(pa3,PK(3),o[d0],0,0,0);
    #undef PK
  }
}

#ifndef ATTN_STORE16
#define ATTN_STORE16(p,v) (*(u32x4*)(p)=(v))
#endif
template<int THRL> __device__ __forceinline__ void attn_unit(int b,int qb,const bf16*Q,const bf16*__restrict__ K,const bf16*__restrict__ V,bf16*O,int opitch,char*shm){
  const int tid=opaque_tid(),lane=tid&63,r32=lane&31,hi=lane>>5; const int wid=__builtin_amdgcn_readfirstlane(tid>>6);
  const long rowbase=(long)b*SEQ; const int q0=qb*QB;
  const bf16*Qw=Q+(rowbase+q0+wid*QBLK)*DM;
  const bf16*Kh=K+rowbase*DM,*Vh=V+rowbase*DM;
  const unsigned lds0=(unsigned)(uintptr_t)shm;
  float*wsf=(float*)(shm+LDS_WS)+wid*64;
  const bf16*ksrc=Kh+(long)lane*DM+wid*8;
  const bf16*vsrc=Vh+(long)(16*(wid&3)+(lane>>2))*DM+(wid>>2)*32+(lane&3)*8;
  const unsigned kdst=lds0+LDS_K+wid*1024, vdst=lds0+LDS_V+wid*1024;
  #define DMA_K(t,slot) glds16(ksrc+(long)(t)*KVBLK*DM,(unsigned)__builtin_amdgcn_readfirstlane(kdst+(slot)))
  #define DMA_V(t,slot) glds16(vsrc+(long)(t)*KVBLK*DM,(unsigned)__builtin_amdgcn_readfirstlane(vdst+(slot)))
  const int vb0=(int)(lds0+LDS_V)+((lane>>4)&1)*32+(lane&3)*8+(4*hi+((lane&15)>>2))*64;
  const char*Kbase=shm+LDS_K; bf16x8 kf[8];
  const lds_cptr shm3=(lds_cptr)shm; const lds_cptr kp0=shm3+LDS_K+hi*1024+r32*16; const lds_cptr vp0=shm3+LDS_V+((lane>>4)&1)*32+(lane&3)*8+(4*hi+((lane&15)>>2))*64;
  const int NT=(q0+QB)/KVBLK;
  DMA_K(0,0);DMA_V(0,0);DMA_K(1,SLOTB);
  bf16x8 qr[4];
  #pragma unroll
  for(int d0=0;d0<4;++d0)qr[d0]=*reinterpret_cast<const bf16x8*>(&Qw[(long)r32*DM+d0*16+hi*8]);
  float mhat=0.f,l_reg=0.f;f32x16 o[2];o[0]=f32x16{};o[1]=f32x16{};f32x16 negm=f32x16{};asm volatile("":"+v"(negm));
  const int qrel=wid*QBLK+r32;
  #define CMASK(P0,P1,t) do{int jb_=(t)-(NT-4); if(jb_>=0)cmask(P0,P1,jb_,qrel,hi);}while(0)
  bool resc=false;
  #define START(P0,P1) do{ const float rm=rowmax(P0,P1); resc=false; \
    { const float dl=rm; mhat=fadd_s(mhat,dl); \
      _Pragma("unroll") for(int r=0;r<16;++r){P0[r]=fsub_s(P0[r],dl);P1[r]=fsub_s(P1[r],dl);} \
      _Pragma("unroll") for(int r=0;r<16;++r)negm[r]=-mhat; asm volatile("":"+v"(negm)); } \
    _Pragma("unroll") for(int r=0;r<16;++r)P0[r]=__builtin_amdgcn_exp2f(P0[r]); }while(0)
  #define RESC() do{ if(resc){ asm volatile("s_waitcnt lgkmcnt(0)":::"memory"); \
      _Pragma("unroll") for(int d_=0;d_<2;++d_) _Pragma("unroll") for(int r=0;r<16;++r)o[d_][r]*=wsf[crow(r,hi)]; } }while(0)
  f32x16 pA0,pA1,pB0,pB1;
  int sl_prev=0,sl_cur=0,sl_next=SLOTB;
  #define ROT() do{sl_prev=sl_cur;sl_cur=sl_next;sl_next=(sl_next==(NSLOT-1)*SLOTB)?0:sl_next+SLOTB;}while(0)
  DMA_K(2,2*SLOTB);
  WAIT_BAR(3);
  qkt(pA0,pA1,Kbase,qr,negm,r32,hi);asm volatile("s_nop 15\n\ts_nop 7":"+v"(pA0),"+v"(pA1));CMASK(pA0,pA1,0);
  START(pA0,pA1);
  _Pragma("unroll") for(int r=0;r<16;++r)pA1[r]=__builtin_amdgcn_exp2f(pA1[r]);
  WAIT_BAR(0);
  DMA_K(3,0);DMA_V(1,SLOTB);
  ROT();
  kload8(kf,kp0+sl_cur);
  WAIT_BAR(2);
  s16x4 vlo[8],vhi[8]; u32x4 pw0,pw1,pw2,pw3;
  #define PKW(P,B) cvtpk_s(P[B],P[B+1])
  #define PAF(k) __builtin_bit_cast(bf16x8,pw##k)
  #define VFR(i) (bf16x8){vlo[i][0],vlo[i][1],vlo[i][2],vlo[i][3],vhi[i][0],vhi[i][1],vhi[i][2],vhi[i][3]}
  #define PIN(x) asm volatile("":"+v"(x))
  #define MX3(a,b,c) __builtin_fmaxf(__builtin_fmaxf((a),(b)),(c))
  #define GAPA(MF,A0,A1,A2,A3,W0,W1,PW) do{ MF; sacc+=A0; sacc+=A1; sacc+=A2; sacc+=A3; PIN(sacc); W0; W1; PIN(PW); SBAR(); }while(0)
  #define EX(v) __builtin_amdgcn_exp2f(v)
  #define GAPB(MF,X,B) do{ MF; X[B]=EX(X[B]); X[B+1]=EX(X[B+1]); X[B+2]=EX(X[B+2]); X[B+3]=EX(X[B+3]); PIN(X); SBAR(); }while(0)
  #define VRD(i) do{ vlo[i]=vtr(vp_+(((i)>>2)*4096+((i)&3)*1024)); vhi[i]=vtr(vp_+(((i)>>2)*4096+((i)&3)*1024+512)); }while(0)
  #define KRD(G,j) do{ if(G){ kload2(kf,kp0+sl_next,j); SBAR(); } }while(0)
  #define STEP(C0,C1,P0,P1,t,GK,GV,GL) do{ SBAR(); \
    const lds_cptr vp_=vp0+sl_prev; \
    VRD(0); SBAR(); float sacc=(P0[0]+P0[1]); \
    GAPA(C0=__builtin_amdgcn_mfma_f32_32x32x16_bf16(kf[0],qr[0],negm,0,0,0), P0[2],P0[3],P0[4],P0[5],     pw0[0]=PKW(P0,0), pw0[1]=PKW(P0,2), pw0); \
    VRD(4); SBAR(); GAPA(C1=__builtin_amdgcn_mfma_f32_32x32x16_bf16(kf[1],qr[0],negm,0,0,0), P0[6],P0[7],P0[8],P0[9],     pw0[2]=PKW(P0,4), pw0[3]=PKW(P0,6), pw0); \
    VRD(1); SBAR(); GAPA(C0=__builtin_amdgcn_mfma_f32_32x32x16_bf16(kf[2],qr[1],C0,0,0,0),   P0[10],P0[11],P0[12],P0[13], pw1[0]=PKW(P0,8), pw1[1]=PKW(P0,10), pw1); \
    VRD(5); SBAR(); GAPA(C1=__builtin_amdgcn_mfma_f32_32x32x16_bf16(kf[3],qr[1],C1,0,0,0),   P0[14],P0[15],P1[0],P1[1],   pw1[2]=PKW(P0,12),pw1[3]=PKW(P0,14), pw1); \
    VRD(2); SBAR(); GAPA(C0=__builtin_amdgcn_mfma_f32_32x32x16_bf16(kf[4],qr[2],C0,0,0,0),   P1[2],P1[3],P1[4],P1[5],     pw2[0]=PKW(P1,0), pw2[1]=PKW(P1,2), pw2); \
    VRD(6); SBAR(); GAPA(C1=__builtin_amdgcn_mfma_f32_32x32x16_bf16(kf[5],qr[2],C1,0,0,0),   P1[6],P1[7],P1[8],P1[9],     pw2[2]=PKW(P1,4), pw2[3]=PKW(P1,6), pw2); \
    VRD(3); SBAR(); GAPA(C0=__builtin_amdgcn_mfma_f32_32x32x16_bf16(kf[6],qr[3],C0,0,0,0),   P1[10],P1[11],P1[12],P1[13], pw3[0]=PKW(P1,8), pw3[1]=PKW(P1,10), pw3); \
    VRD(7); SBAR(); GAPA(C1=__builtin_amdgcn_mfma_f32_32x32x16_bf16(kf[7],qr[3],C1,0,0,0),   P1[14],P1[15],0.f,0.f,       pw3[2]=PKW(P1,12),pw3[3]=PKW(P1,14), pw3); \
    l_reg+=sacc; \
    if(GK){DMA_K((t)+3,sl_cur);} if(GV){DMA_V((t)+1,sl_next);} \
    CMASK(C0,C1,t); \
    { float a=MX3(C0[0],C0[1],C1[0]),b=MX3(C0[2],C0[3],C1[1]); a=MX3(a,C1[2],C1[3]); \
      _Pragma("unroll") for(int r=4;r<16;r+=4){a=MX3(a,C0[r],C0[r+1]);b=MX3(b,C0[r+2],C0[r+3]);a=MX3(a,C1[r],C1[r+1]);b=MX3(b,C1[r+2],C1[r+3]);} \
      float rm=__builtin_fmaxf(a,b); { auto rr=__builtin_amdgcn_permlane32_swap(__float_as_uint(rm),__float_as_uint(rm),false,false); rm=__builtin_fmaxf(__uint_as_float(rr[0]),__uint_as_float(rr[1])); } \
      resc=false; \
      if(__builtin_expect(__any(rm>(float)THRL),0)){ const float dl=__builtin_fmaxf(rm,0.f); mhat+=dl; \
        _Pragma("unroll") for(int r=0;r<16;++r){C0[r]-=dl;C1[r]-=dl;} \
        _Pragma("unroll") for(int r=0;r<16;++r)negm[r]=-mhat; asm volatile("":"+v"(negm)); \
        const float f=__builtin_amdgcn_exp2f(-dl); l_reg*=f; if(hi==0)wsf[r32]=f; resc=true; } } \
    SBAR(); \
    GAPB(o[0]=__builtin_amdgcn_mfma_f32_32x32x16_bf16(PAF(0),VFR(0),o[0],0,0,0), C0,0); \
    GAPB(o[1]=__builtin_amdgcn_mfma_f32_32x32x16_bf16(PAF(0),VFR(4),o[1],0,0,0), C0,4); \
    KRD(GL,0); GAPB(o[0]=__builtin_amdgcn_mfma_f32_32x32x16_bf16(PAF(1),VFR(1),o[0],0,0,0), C0,8); \
    KRD(GL,1); GAPB(o[1]=__builtin_amdgcn_mfma_f32_32x32x16_bf16(PAF(1),VFR(5),o[1],0,0,0), C0,12); \
    KRD(GL,2); GAPB(o[0]=__builtin_amdgcn_mfma_f32_32x32x16_bf16(PAF(2),VFR(2),o[0],0,0,0), C1,0); \
    KRD(GL,3); GAPB(o[1]=__builtin_amdgcn_mfma_f32_32x32x16_bf16(PAF(2),VFR(6),o[1],0,0,0), C1,4); \
    GAPB(o[0]=__builtin_amdgcn_mfma_f32_32x32x16_bf16(PAF(3),VFR(3),o[0],0,0,0), C1,8); \
    GAPB(o[1]=__builtin_amdgcn_mfma_f32_32x32x16_bf16(PAF(3),VFR(7),o[1],0,0,0), C1,12); \
    }while(0)
  int t=1;
  #undef CMASK
  #define CMASK(P0,P1,t) do{}while(0)
  for(;t+5<NT;t+=2){
    STEP(pB0,pB1,pA0,pA1,t,true,true,true);     WAIT_BAR(2); RESC(); ROT();
    STEP(pA0,pA1,pB0,pB1,t+1,true,true,true);   WAIT_BAR(2); RESC(); ROT();
  }
  #undef CMASK
  #define CMASK(P0,P1,t) do{int jb_=(t)-(NT-4); if(jb_>=0)cmask(P0,P1,jb_,qrel,hi);}while(0)
  #define ENDW(tt) do{ if((tt)+3<NT){WAIT_BAR(2);} else if((tt)+2<NT){WAIT_BAR(1);} else {WAIT_BAR(0);} }while(0)
  for(;t+1<NT;t+=2){
    STEP(pB0,pB1,pA0,pA1,t,(t+3<NT),(t+1<NT),(t+1<NT));       ENDW(t);   RESC(); ROT();
    STEP(pA0,pA1,pB0,pB1,t+1,(t+4<NT),(t+2<NT),(t+2<NT));     ENDW(t+1); RESC(); ROT();
  }
  STEP(pB0,pB1,pA0,pA1,NT-1,false,false,false); RESC();
  { float sacc=pB0[0]+pB0[1]; _Pragma("unroll") for(int r=2;r<16;++r)sacc+=pB0[r]; _Pragma("unroll") for(int r=0;r<16;++r)sacc+=pB1[r]; l_reg+=sacc;
    pw0=(u32x4){PKW(pB0,0),PKW(pB0,2),PKW(pB0,4),PKW(pB0,6)};pw1=(u32x4){PKW(pB0,8),PKW(pB0,10),PKW(pB0,12),PKW(pB0,14)};pw2=(u32x4){PKW(pB1,0),PKW(pB1,2),PKW(pB1,4),PKW(pB1,6)};pw3=(u32x4){PKW(pB1,8),PKW(pB1,10),PKW(pB1,12),PKW(pB1,14)};
    SBAR(); pv(o,vb0+sl_cur,PAF(0),PAF(1),PAF(2),PAF(3)); }
  #undef PKW
  #undef PAF
  #undef VFR
  #undef PIN
  #undef MX3
  #undef GAPA
  #undef GAPB
  #undef EX
  #undef VRD
  #undef KRD
  #undef STEP
  #undef ENDW
  {auto rr=__builtin_amdgcn_permlane32_swap(__float_as_uint(l_reg),__float_as_uint(l_reg),false,false);l_reg=__uint_as_float(rr[0])+__uint_as_float(rr[1]);}
  if(hi==0)wsf[32+r32]=l_reg;asm volatile("s_waitcnt lgkmcnt(0)":::"memory");
  float rli[16];
  #pragma unroll
  for(int r=0;r<16;++r)rli[r]=__builtin_amdgcn_rcpf(wsf[32+crow(r,hi)]);
  bf16*Ow=O+(rowbase+q0+wid*QBLK)*opitch;
  { bf16*stg=(bf16*)(shm+LDS_OST)+wid*2048;
    #pragma unroll
    for(int r=0;r<16;++r){const int orow=crow(r,hi);
      #pragma unroll
      for(int d0=0;d0<2;++d0)stg[orow*64+d0*32+r32]=__float2bfloat16(o[d0][r]*rli[r]);}
    asm volatile("s_waitcnt lgkmcnt(0)":::"memory");
    #pragma unroll
    for(int i=0;i<4;++i){const int row=i*8+(lane>>3),ch=lane&7; const u32x4 v=*(const u32x4*)(stg+row*64+ch*8); ATTN_STORE16(Ow+(long)row*opitch+ch*8,v);} }
  asm volatile("s_waitcnt lgkmcnt(0)\n\ts_barrier":::"memory");
  #undef DMA_K
  #undef DMA_V
  #undef CMASK
  #undef START
  #undef RESC
  #undef ROT
}

__device__ __forceinline__ void sb_unit(int b,int qb,const bf16*Q,const bf16*__restrict__ K,const bf16*__restrict__ V,bf16*O,int opitch,char*shm){
  const int tid=opaque_tid(),lane=tid&63,r32=lane&31,hi=lane>>5; const int wid=__builtin_amdgcn_readfirstlane(tid>>6);
  const long rowbase=(long)b*SEQ; const int q0=qb*QB;
  const bf16*Qw=Q+(rowbase+q0+wid*QBLK)*DM;
  const bf16*Kh=K+rowbase*DM,*Vh=V+rowbase*DM;
  const unsigned lds0=(unsigned)(uintptr_t)shm;
  const bf16*ksrc=Kh+(long)lane*DM+wid*8;
  const bf16*vsrc=Vh+(long)(16*(wid&3)+(lane>>2))*DM+(wid>>2)*32+(lane&3)*8;
  const unsigned kdst=lds0+LDS_K+wid*1024, vdst=lds0+LDS_V+wid*1024;
  #define DMA_K(t,slot) glds16(ksrc+(long)(t)*KVBLK*DM,(unsigned)__builtin_amdgcn_readfirstlane(kdst+(slot)))
  #define DMA_V(t,slot) glds16(vsrc+(long)(t)*KVBLK*DM,(unsigned)__builtin_amdgcn_readfirstlane(vdst+(slot)))
  const int vb0=(int)(lds0+LDS_V)+((lane>>4)&1)*32+(lane&3)*8+(4*hi+((lane&15)>>2))*64;
  const char*Kbase=shm+LDS_K;
  const int NT=(q0+QB)/KVBLK;
  int j=NT-1;
  DMA_K(j,(j&1)*SLOTB);DMA_V(j,(j&1)*SLOTB);
  bf16x8 qr[4];
  #pragma unroll
  for(int d0=0;d0<4;++d0)qr[d0]=*reinterpret_cast<const bf16x8*>(&Qw[(long)r32*DM+d0*16+hi*8]);
  f32x16 o[2];o[0]=f32x16{};o[1]=f32x16{};
  float R=0.f;
  const int trow=q0+wid*QBLK+r32;
  const int wmax=q0+wid*QBLK+QBLK-1;
  const float selhi=(hi==0)?1.f:0.f;
  volatile int*flg=(volatile int*)(shm+LDS_WS);
  if(lane==0){flg[wid*16]=0;flg[wid*16+8]=0;}
  #pragma unroll 1
  for(;j>=0;--j){
    WAIT_BAR(0);
    { int nd=0; const int rs=((j+1)&1)*8;
      #pragma unroll
      for(int w8=0;w8<8;++w8)nd+=flg[w8*16+rs];
      if(__builtin_amdgcn_readfirstlane(nd)==8)break; }
    if(j>0){DMA_K(j-1,((j-1)&1)*SLOTB);DMA_V(j-1,((j-1)&1)*SLOTB);}
    const int slot=(j&1)*SLOTB;
    if(!(64*j<wmax)){ if(lane==0)flg[wid*16+(j&1)*8]=0; }
    if(64*j<wmax){
      f32x16 p0,p1; const f32x16 zero=f32x16{};
      qkt(p0,p1,Kbase+slot,qr,zero,r32,hi);
      const int thr=trow-64*j-4*hi;
      f32x16 l0,l1;
      #pragma unroll
      for(int r=0;r<16;++r){
        { const float z=p0[r]; const float lg=__builtin_amdgcn_logf(1.f+__builtin_amdgcn_exp2f(-__builtin_fabsf(z))); const float sp=__builtin_fmaxf(-z,0.f)+lg;
          const bool ok=((r&3)+8*(r>>2))<thr; l0[r]=ok?-(sp+z):0.f; p0[r]=ok?-sp:-INFINITY; }
        { const float z=p1[r]; const float lg=__builtin_amdgcn_logf(1.f+__builtin_amdgcn_exp2f(-__builtin_fabsf(z))); const float sp=__builtin_fmaxf(-z,0.f)+lg;
          const bool ok=((r&3)+8*(r>>2)+32)<thr; l1[r]=ok?-(sp+z):0.f; p1[r]=ok?-sp:-INFINITY; }
      }
      float gs[8],pt[8];
      #pragma unroll
      for(int g=0;g<4;++g){ gs[g]=(l0[4*g]+l0[4*g+1])+(l0[4*g+2]+l0[4*g+3]); gs[4+g]=(l1[4*g]+l1[4*g+1])+(l1[4*g+2]+l1[4*g+3]); }
      #pragma unroll
      for(int g=0;g<8;++g){ auto rr=__builtin_amdgcn_permlane32_swap(__float_as_uint(gs[g]),__float_as_uint(gs[g]),false,false); pt[g]=__uint_as_float(rr[0])+__uint_as_float(rr[1]); }
      float base[8]; float run=R;
      #pragma unroll
      for(int g=7;g>=0;--g){ base[g]=run+selhi*(pt[g]-gs[g]); run+=pt[g]; }
      R=run;
      { const int dn=__all(R<=-152.f)?1:0; if(lane==0)flg[wid*16+(j&1)*8]=dn; }
      #pragma unroll
      for(int g=0;g<4;++g){
        { float a=base[g]; p0[4*g+3]=__builtin_amdgcn_exp2f(p0[4*g+3]+a); a+=l0[4*g+3]; p0[4*g+2]=__builtin_amdgcn_exp2f(p0[4*g+2]+a); a+=l0[4*g+2]; p0[4*g+1]=__builtin_amdgcn_exp2f(p0[4*g+1]+a); a+=l0[4*g+1]; p0[4*g]=__builtin_amdgcn_exp2f(p0[4*g]+a); }
        { float a=base[4+g]; p1[4*g+3]=__builtin_amdgcn_exp2f(p1[4*g+3]+a); a+=l1[4*g+3]; p1[4*g+2]=__builtin_amdgcn_exp2f(p1[4*g+2]+a); a+=l1[4*g+2]; p1[4*g+1]=__builtin_amdgcn_exp2f(p1[4*g+1]+a); a+=l1[4*g+1]; p1[4*g]=__builtin_amdgcn_exp2f(p1[4*g]+a); }
      }
      u32x4 pw0,pw1,pw2,pw3;
      pw0=(u32x4){cvtpk_s(p0[0],p0[1]),cvtpk_s(p0[2],p0[3]),cvtpk_s(p0[4],p0[5]),cvtpk_s(p0[6],p0[7])};
      pw1=(u32x4){cvtpk_s(p0[8],p0[9]),cvtpk_s(p0[10],p0[11]),cvtpk_s(p0[12],p0[13]),cvtpk_s(p0[14],p0[15])};
      pw2=(u32x4){cvtpk_s(p1[0],p1[1]),cvtpk_s(p1[2],p1[3]),cvtpk_s(p1[4],p1[5]),cvtpk_s(p1[6],p1[7])};
      pw3=(u32x4){cvtpk_s(p1[8],p1[9]),cvtpk_s(p1[10],p1[11]),cvtpk_s(p1[12],p1[13]),cvtpk_s(p1[14],p1[15])};
      SBAR();
      pv(o,vb0+slot,__builtin_bit_cast(bf16x8,pw0),__builtin_bit_cast(bf16x8,pw1),__builtin_bit_cast(bf16x8,pw2),__builtin_bit_cast(bf16x8,pw3));
    }
  }
  bf16*Ow=O+(rowbase+q0+wid*QBLK)*opitch;
  { bf16*stg=(bf16*)(shm+LDS_OST)+wid*2048;
    #pragma unroll
    for(int r=0;r<16;++r){const int orow=crow(r,hi);
      #pragma unroll
      for(int d0=0;d0<2;++d0)stg[orow*64+d0*32+r32]=__float2bfloat16(o[d0][r]);}
    asm volatile("s_waitcnt lgkmcnt(0)":::"memory");
    #pragma unroll
    for(int i=0;i<4;++i){const int row=i*8+(lane>>3),ch=lane&7; const u32x4 v=*(const u32x4*)(stg+row*64+ch*8); ATTN_STORE16(Ow+(long)row*opitch+ch*8,v);} }
  asm volatile("s_waitcnt lgkmcnt(0)\n\ts_barrier":::"memory");
  #undef DMA_K
  #undef DMA_V
}
constexpr int ATTN_LDS_BYTES=LDS_BYTES;
#undef SBAR
#undef WAIT_BAR
}
#ifndef PROBE_PH
#define PROBE_PH (-1)
#endif
#define PROBE_AMP 8
#ifndef PROBE_SUB
#define PROBE_SUB (-1)
#endif
#define SUBPROBE(id) do { if (PROBE_SUB >= 0 && bx == 0) { __syncthreads(); if (tid == 0) { const unsigned long long now_ = __builtin_amdgcn_s_memrealtime(); \
        const unsigned long long ps_ = ((unsigned long long)MISC[19] << 32) | MISC[18]; \
        if ((id) == PROBE_SUB) { const unsigned long long dl_ = now_ + PROBE_AMP * (now_ - ps_); while (__builtin_amdgcn_s_memrealtime() < dl_) __builtin_amdgcn_s_sleep(8); } \
        const unsigned long long n1_ = __builtin_amdgcn_s_memrealtime(); MISC[18] = (unsigned)n1_; MISC[19] = (unsigned)(n1_ >> 32); } __syncthreads(); } } while (0)
#ifndef QUOTA_A
#define QUOTA_A 5
#endif
#ifndef QUOTA_F
#define QUOTA_F 6
#endif
#ifndef QUOTA_G
#define QUOTA_G 2
#endif
namespace mk {
using nv::NB; using nv::L; using nv::D; using nv::T; using nv::DEPTH; using nv::INC; using nv::EPS;
constexpr int NWAVES = 8;
constexpr size_t MiB = 1u << 20;
constexpr size_t WS_CTL = 0, CTL_ZERO_BYTES = 1 * MiB;
constexpr size_t WS_WIN = 1 * MiB;
constexpr size_t WS_WOUT = WS_WIN + 40 * MiB;
constexpr size_t WS_XN = WS_WOUT + 16 * MiB;
constexpr size_t WS_PROJ = WS_XN + 32 * MiB;
constexpr size_t WS_SBO = WS_PROJ + 80 * MiB;
constexpr size_t WS_O1 = WS_SBO + 8 * MiB;
constexpr size_t WS_O2 = WS_O1 + 16 * MiB;
constexpr size_t WS_Y = WS_O2 + 16 * MiB;
constexpr size_t WS_H = WS_Y + 32 * MiB;
constexpr size_t WS_YS = WS_H + 64 * MiB;
constexpr size_t WS_HB = WS_YS + 64 * MiB;
constexpr size_t WS_ROUTE = WS_HB + 24 * MiB;
constexpr size_t WS_S5 = WS_ROUTE + 2 * MiB;
constexpr size_t WS_W13 = WS_S5 + 160 * MiB;
constexpr size_t WS_W2 = WS_W13 + 256 * MiB;
constexpr size_t WS_END = WS_W2 + 128 * MiB;
static_assert(WS_END <= 1024 * MiB, "d_ws map must fit 1 GiB");
constexpr int CW_TMO = 0, CW_CODE = 1, CW_Q = 1024;
constexpr int CW_BAR = 4096;
constexpr int MAX_BAR_REGIONS = 40;
constexpr int CW_CNT = 143360;
constexpr int RING_OFF = 0, RING_BYTES = 131072;
constexpr int LDSCTL_OFF = 143360, MISC_OFF = LDSCTL_OFF + 320;
constexpr int LDS_BYTES = 147456;

#define GAS __attribute__((address_space(1)))
#define LAS __attribute__((address_space(3)))
typedef unsigned short bf16;
typedef unsigned v4u __attribute__((ext_vector_type(4)));
typedef float f32x4 __attribute__((ext_vector_type(4)));
typedef short bf16x8 __attribute__((ext_vector_type(8)));
typedef GAS unsigned gu32;
typedef GAS unsigned long long gu64;
#define RLX_AGENT __ATOMIC_RELAXED, __HIP_MEMORY_SCOPE_AGENT
#define LDS_WAIT() asm volatile("s_waitcnt lgkmcnt(0)" ::: "memory")
#define VM_WAIT() asm volatile("s_waitcnt vmcnt(0)" ::: "memory")
__device__ __forceinline__ unsigned long long rt() { return __builtin_amdgcn_s_memrealtime(); }
__device__ __forceinline__ unsigned f2bf(float f) { unsigned u = __builtin_bit_cast(unsigned, f); return (u + 0x7fffu + ((u >> 16) & 1u)) >> 16; }
__device__ __forceinline__ unsigned pk2(float lo, float hi) { return f2bf(lo) | (f2bf(hi) << 16); }

#define XB_TMO      128
#define XB_XCNT(j)  (256  + 64 * (j))
#define XB_XSUB(j)  (1280 + 64 * (j))
#define XB_XGEN(j)  (2304 + 64 * (j))
#define XB_TOP      3328
#define XB_TOPGEN   3392
#define XCD_BAR_WORDS 3456
#define XB_SPIN_CAP (1u << 18)

__device__ __forceinline__ unsigned xb_ld(unsigned* p)              { return __hip_atomic_load(p, __ATOMIC_RELAXED, __HIP_MEMORY_SCOPE_AGENT); }
__device__ __forceinline__ unsigned xb_add(unsigned* p, unsigned v) { return __hip_atomic_fetch_add(p, v, __ATOMIC_RELAXED, __HIP_MEMORY_SCOPE_AGENT); }
__device__ __forceinline__ unsigned xb_xcc_id() { return (unsigned)__builtin_amdgcn_s_getreg((3 << 11) | 20) & 0xFu; }
#define XB_SPIN(cond, bar) do { unsigned _sp = 0; while (cond) { __builtin_amdgcn_s_sleep(1); \
    if ((++_sp & 255u) == 0u) { if (xb_ld(&(bar)[XB_TMO])) break; if (_sp > XB_SPIN_CAP) { atomicAdd(&(bar)[XB_TMO], 1u); break; } } } } while (0)

struct XcdBarrier {
    unsigned* bar; unsigned x;
    volatile LAS unsigned* st;
};

__device__ __forceinline__ XcdBarrier xcd_barrier_post(unsigned* bar, volatile LAS unsigned* st) {
    XcdBarrier b; b.bar = bar; b.x = xb_xcc_id(); b.st = st;
    if (threadIdx.x == 0) (void)xb_add(&bar[XB_XCNT(b.x)], 1u);
    return b;
}
__device__ __forceinline__ void xcd_barrier_complete(unsigned* bar, unsigned x, unsigned& nloc, unsigned& nx) {
    const unsigned G = gridDim.x * gridDim.y * gridDim.z;
    unsigned sum, cnt, mine, sp = 0u;
    for (;;) {
        sum = 0u; cnt = 0u; mine = 0u;
#pragma unroll
        for (unsigned j = 0; j < 16; ++j) { const unsigned c = xb_ld(&bar[XB_XCNT(j)]); sum += c; cnt += (c > 0u) ? 1u : 0u; mine = (j == x) ? c : mine; }
        if (sum == G) break;
        __builtin_amdgcn_s_sleep(1);
        if ((++sp & 255u) == 0u) { if (xb_ld(&bar[XB_TMO])) break; if (sp > XB_SPIN_CAP) { atomicAdd(&bar[XB_TMO], 1u); break; } }
    }
    nloc = mine > 0u ? mine : 1u; nx = cnt > 0u ? cnt : 1u;
}

__device__ __forceinline__ void xcd_barrier(const XcdBarrier& b) {
    asm volatile("s_waitcnt vmcnt(0)" ::: "memory");
    __syncthreads();
    if (threadIdx.x == 0) {
        unsigned* bar = b.bar;
        __builtin_amdgcn_s_waitcnt(0);
        unsigned nloc = b.st[0], nx = b.st[1];
        if (nloc == 0u) { xcd_barrier_complete(bar, b.x, nloc, nx); b.st[0] = nloc; b.st[1] = nx; }
        const unsigned old = xb_add(&bar[XB_XSUB(b.x)], 1u);
        const unsigned gen = old / nloc;
        if (old + 1u == (gen + 1u) * nloc) {
            __builtin_amdgcn_fence(__ATOMIC_RELEASE, "agent");
            asm volatile("s_waitcnt vmcnt(0)" ::: "memory");
            const unsigned og = xb_add(&bar[XB_TOP], 1u);
            const unsigned tg = og / nx;
            if (og + 1u == (tg + 1u) * nx) xb_add(&bar[XB_TOPGEN], 1u);
            else XB_SPIN(xb_ld(&bar[XB_TOPGEN]) == tg, bar);
            __builtin_amdgcn_fence(__ATOMIC_ACQUIRE, "agent");
            xb_add(&bar[XB_XGEN(b.x)], 1u);
            asm volatile("s_waitcnt vmcnt(0)" ::: "memory");
        } else {
            XB_SPIN(xb_ld(&bar[XB_XGEN(b.x)]) == gen, bar);
            __builtin_amdgcn_fence(__ATOMIC_ACQUIRE, "agent");
            asm volatile("s_waitcnt vmcnt(0)" ::: "memory");
        }
    }
    __syncthreads();
}
static_assert((CW_BAR + MAX_BAR_REGIONS * XCD_BAR_WORDS) <= CW_CNT && (CW_CNT + 2 * 2048) * 4 <= (int)CTL_ZERO_BYTES, "barrier regions and expert counters inside the memset region");

__device__ __forceinline__ float wave_sum(float v) {
#pragma unroll
    for (int o = 1; o < 64; o <<= 1) v += __shfl_xor(v, o);
    return v;
}
__device__ __forceinline__ void transpose_tile(const float* __restrict__ W, int N, int k0, int n0, bf16* __restrict__ dst, int Kd, LAS float* scr, int lane) {
    const int kr = lane >> 4, n4 = (lane & 15) * 4;
    f32x4 v[16];
#pragma unroll
    for (int i = 0; i < 16; ++i) v[i] = *(const GAS f32x4*)(W + (size_t)(k0 + i * 4 + kr) * N + n0 + n4);
#pragma unroll
    for (int i = 0; i < 16; ++i) { LAS float* s = scr + (i * 4 + kr) * 65 + n4; s[0] = v[i].x; s[1] = v[i].y; s[2] = v[i].z; s[3] = v[i].w; }
    LDS_WAIT(); asm volatile("" ::: "memory");
    const int c = lane & 7;
#pragma unroll
    for (int j = 0; j < 8; ++j) { const int n = (lane >> 3) + 8 * j; const LAS float* s = scr + (8 * c) * 65 + n;
        v4u o; o.x = pk2(s[0 * 65], s[1 * 65]); o.y = pk2(s[2 * 65], s[3 * 65]); o.z = pk2(s[4 * 65], s[5 * 65]); o.w = pk2(s[6 * 65], s[7 * 65]);
        *(GAS v4u*)(dst + (size_t)n * Kd + k0 + 8 * c) = o; }
    LDS_WAIT(); asm volatile("" ::: "memory");
}
struct TileJob { const float* W; bf16* dst; int N, Kd, k0, n0; };
__device__ __forceinline__ void tile_load(const TileJob& j, f32x4 (&v)[16], int lane) {
    const int kr = lane >> 4, n4 = (lane & 15) * 4;
#pragma unroll
    for (int i = 0; i < 16; ++i) v[i] = __builtin_nontemporal_load((const GAS f32x4*)(j.W + (size_t)(j.k0 + i * 4 + kr) * j.N + j.n0 + n4));
}
__device__ __forceinline__ void tile_store(const TileJob& j, const f32x4 (&v)[16], LAS float* scr, int lane) {
    const int kr = lane >> 4, n4 = (lane & 15) * 4;
#pragma unroll
    for (int i = 0; i < 16; ++i) { LAS float* s = scr + (i * 4 + kr) * 65 + n4; s[0] = v[i].x; s[1] = v[i].y; s[2] = v[i].z; s[3] = v[i].w; }
    LDS_WAIT(); asm volatile("" ::: "memory");
    const int c = lane & 7;
#pragma unroll
    for (int q = 0; q < 8; ++q) { const int n = (lane >> 3) + 8 * q; const LAS float* s = scr + (8 * c) * 65 + n;
        v4u o; o.x = pk2(s[0 * 65], s[1 * 65]); o.y = pk2(s[2 * 65], s[3 * 65]); o.z = pk2(s[4 * 65], s[5 * 65]); o.w = pk2(s[6 * 65], s[7 * 65]);
        *(GAS v4u*)(j.dst + (size_t)n * j.Kd + j.k0 + 8 * c) = o; }
    LDS_WAIT(); asm volatile("" ::: "memory");
}
__device__ __forceinline__ void ex_job(const float* const* in, bf16* W13T, bf16* W2T, int le, int r, TileJob& J) {
    if (r < 512) { const int w3 = r >> 8; r &= 255; const int nb = r & 7, kb = r >> 3, n0 = nb * 64;
        J.W = in[w3 ? 27 : 26] + (size_t)le * nv::D * nv::DE; J.N = nv::DE; J.k0 = kb * 64; J.n0 = n0; J.Kd = nv::D;
        J.dst = W13T + ((size_t)le * 1024 + (n0 >> 7) * 256 + w3 * 128 + (n0 & 127)) * nv::D; }
    else { r -= 512; const int nb = r & 31, kb = r >> 5;
        J.W = in[28] + (size_t)le * nv::DE * nv::D; J.N = nv::D; J.k0 = kb * 64; J.n0 = nb * 64; J.Kd = nv::DE; J.dst = W2T + ((size_t)le * nv::D + nb * 64) * nv::DE; }
}
__device__ __forceinline__ void dense_job(const float* const* in, bf16* WinT, bf16* WoutT, int l, int r, TileJob& J) {
    if (r < 2560) { const int nb = r % 80, kb = r / 80; J.W = in[2] + (size_t)l * nv::D * nv::INC; J.N = nv::INC; J.k0 = kb * 64; J.n0 = nb * 64; J.Kd = nv::D; J.dst = WinT + ((size_t)l * nv::INC + nb * 64) * nv::D; }
    else { r -= 2560; const int nb = r & 31, kb = r >> 5; J.W = in[20] + (size_t)l * nv::D * nv::D; J.N = nv::D; J.k0 = kb * 64; J.n0 = nb * 64; J.Kd = nv::D; J.dst = WoutT + ((size_t)l * nv::D + nb * 64) * nv::D; }
}
struct ConvCtx { const float* const* in; bf16* W13T; bf16* W2T; bf16* WinT; bf16* WoutT; bf16* WG; };
constexpr int Q_W2L0 = 8192, Q_DENSE1 = 11776, Q_TOTAL = 36352, Q_BATCH = 16;
__device__ __forceinline__ void q_job(const ConvCtx& C, int qi, TileJob& J) {
    if (qi < Q_W2L0) ex_job(C.in, C.W13T, C.W2T, qi >> 8, 512 + (qi & 255), J);
    else if (qi < Q_DENSE1) dense_job(C.in, C.WinT, C.WoutT, 1, qi - Q_W2L0, J);
    else { const int q2 = qi - Q_DENSE1; const int le = q2 / 768; ex_job(C.in, C.W13T, C.W2T, 32 + le, q2 - le * 768, J); }
}
constexpr int P0_TILES = 20096;
__device__ __forceinline__ void p0_job(const ConvCtx& C, int it, TileJob& J) {
    if (it < 3584) dense_job(C.in, C.WinT, C.WoutT, 0, it, J);
    else if (it < 3712) { const int r = it - 3584, l = r >> 6, q = r & 63, nb = q & 7, kb = q >> 3; J.W = C.in[12] + (size_t)l * 512 * 512; J.N = 512; J.k0 = kb * 64; J.n0 = nb * 64; J.Kd = 512; J.dst = C.WG + ((size_t)l * 512 + nb * 64) * 512; }
    else { const int r = it - 3712; ex_job(C.in, C.W13T, C.W2T, r >> 9, r & 511, J); }
}
__device__ __forceinline__ void convert_batches(const ConvCtx& C, gu32* qctr, int nb, int limit, volatile LAS unsigned* qslot, LAS unsigned char* ring) {
    const int tid = opaque_tid(), lane = tid & 63, wave = __builtin_amdgcn_readfirstlane(tid >> 6);
    LAS float* scr = (LAS float*)(ring + wave * 16640);
#pragma unroll 1
    for (int b = 0; ; ++b) {
        if (limit <= 0 && b >= nb) break;
        __syncthreads();
        if (tid == 0) { unsigned base = Q_TOTAL; if (limit <= 0 || __hip_atomic_load(qctr, RLX_AGENT) < (unsigned)limit) base = __hip_atomic_fetch_add(qctr, (unsigned)Q_BATCH, RLX_AGENT); qslot[0] = base; }
        __syncthreads();
        const int base = (int)qslot[0];
        if (base >= Q_TOTAL) break;
        f32x4 va[16], vb[16]; TileJob ja, jb;
        q_job(C, base + 2 * wave, ja); tile_load(ja, va, lane);
        q_job(C, base + 2 * wave + 1, jb); tile_load(jb, vb, lane);
        tile_store(ja, va, scr, lane); tile_store(jb, vb, scr, lane);
    }
    __syncthreads();
}
__device__ __forceinline__ void rms_row_to_bf16(const float* xrow, const float* g, bf16* orow, int lane) {
    const GAS f32x4* xr = (const GAS f32x4*)xrow + lane; const GAS f32x4* gr = (const GAS f32x4*)g + lane;
    f32x4 v[8]; float s = 0.f;
#pragma unroll
    for (int j = 0; j < 8; ++j) { v[j] = xr[64 * j]; s += (v[j].x * v[j].x + v[j].y * v[j].y) + (v[j].z * v[j].z + v[j].w * v[j].w); }
    const float r = rsqrtf(wave_sum(s) * (1.f / D) + EPS);
    GAS unsigned long long* o8 = (GAS unsigned long long*)orow + lane;
#pragma unroll
    for (int j = 0; j < 8; ++j) { const f32x4 gg = gr[64 * j]; o8[64 * j] = (unsigned long long)pk2(v[j].x * r * gg.x, v[j].y * r * gg.y) | ((unsigned long long)pk2(v[j].z * r * gg.z, v[j].w * r * gg.w) << 32); }
}
}

namespace pg8 {
struct EpiProj {
    static constexpr bool PERM = true, AFTER_DRAIN = false;
    bf16_t* O; int ldc;
    __device__ __forceinline__ void operator()(const f32x4 (&acc)[2][2][4][2], const Unit& u, int wr, int wc, int fr, int fq) const {
        const int row0 = u.pm * BM + wr * 64 + fr; const int colt = u.pn * BM;
        const float sc = (u.pn < 2) ? nv::QS_SB : ((u.pn >= 8 && u.pn < 12) ? nv::QS_DF : 1.f);
        const int col0 = colt + wc * 32 + 8 * fq;
#pragma unroll
        for (int ai = 0; ai < 2; ++ai)
#pragma unroll
            for (int m = 0; m < 4; ++m) { bf16_t* rowp = O + (size_t)(row0 + ai * HALF + m * 16) * ldc + col0;
#pragma unroll
                for (int bj = 0; bj < 2; ++bj) { const f32x4 v0 = acc[ai][bj][m][0] * sc, v1 = acc[ai][bj][m][1] * sc;
                    u32x4 w; w.x = cvt_pk_bf16(v0[0], v0[1]); w.y = cvt_pk_bf16(v0[2], v0[3]); w.z = cvt_pk_bf16(v1[0], v1[1]); w.w = cvt_pk_bf16(v1[2], v1[3]);
                    *(u32x4*)(rowp + bj * HALF) = w; } }
    }
};
struct EpiResF32 {
    static constexpr bool PERM = false, AFTER_DRAIN = false;
    const float* R; float* out; int ldc;
    __device__ __forceinline__ void operator()(const f32x4 (&acc)[2][2][4][2], const Unit& u, int wr, int wc, int fr, int fq) const {
        const int col0 = u.pn * BM + wc * 32 + 4 * fq;
#pragma unroll
        for (int ai = 0; ai < 2; ++ai)
#pragma unroll
            for (int m = 0; m < 4; ++m) { const size_t off = (size_t)(u.pm * BM + ai * HALF + wr * 64 + m * 16 + fr) * ldc + col0;
#pragma unroll
                for (int bj = 0; bj < 2; ++bj)
#pragma unroll
                    for (int n = 0; n < 2; ++n) { const f32x4 r = *(const f32x4*)(R + off + bj * HALF + n * 16); *(f32x4*)(out + off + bj * HALF + n * 16) = acc[ai][bj][m][n] + r; }
                asm volatile("" ::: "memory"); }
    }
};
}

namespace s5 {
using mk::bf16; using mk::f32x4; using mk::bf16x8; using mk::v4u;
typedef float f32x16 __attribute__((ext_vector_type(16)));
typedef float f32x2 __attribute__((ext_vector_type(2)));
constexpr int LC_ = 32, NCH = 64, SG = 32, SN = 64, SC = 16;
constexpr size_t OFF_KT = 0;
constexpr size_t OFF_PT = 1u << 20;
constexpr size_t OFF_LP = 9u << 20;
constexpr size_t OFF_LC = 10u << 20;
constexpr size_t OFF_CB = 11u << 20;
constexpr size_t OFF_WG = 12u << 20;
constexpr size_t OFF_YI = 13u << 20;
constexpr size_t OFF_SE = 29u << 20;

__device__ __forceinline__ void cpow(float lr, float li, float dt, float tau, float& pr, float& pi) {
    const float mag = __builtin_amdgcn_exp2f(tau * lr * dt * 1.4426950408889634f);
    double rev = (double)tau * (double)li * (double)dt * 0.15915494309189535; rev -= __builtin_rint(rev);
    const float rv = (float)rev; pr = mag * __builtin_amdgcn_cosf(rv); pi = mag * __builtin_amdgcn_sinf(rv);
}
__device__ __forceinline__ void zoh_f(float lr, float li, float dt, float& fr, float& fi) {
    float br, bi; cpow(lr, li, dt, 1.f, br, bi);
    const float nr = br - 1.f, ni = bi, den = lr * lr + li * li;
    fr = (nr * lr + ni * li) / den; fi = (ni * lr - nr * li) / den;
}
__device__ __forceinline__ void build_tables(const float* const* in, unsigned char* s5ws, int gt, int NTH) {
    const float* lam_re = in[4]; const float* lam_im = in[5]; const float* b_re = in[6]; const float* b_im = in[7]; const float* c_re = in[8]; const float* c_im = in[9]; const float* log_dt = in[11];
    bf16* KT = (bf16*)(s5ws + OFF_KT); bf16* PT = (bf16*)(s5ws + OFF_PT);
#pragma unroll 1
    for (int it = gt; it < 2 * SG * LC_ * SC; it += NTH) { const int c = it & 15, tau = (it >> 4) & 31, lg = it >> 9;
        const float dt = __expf(log_dt[lg]); float acc[16];
#pragma unroll
        for (int q = 0; q < 16; ++q) acc[q] = 0.f;
#pragma unroll 1
        for (int n = 0; n < SN; ++n) { const float lr = lam_re[lg * SN + n], li = lam_im[lg * SN + n];
            float pr, pi, fr, fi; cpow(lr, li, dt, (float)tau, pr, pi); zoh_f(lr, li, dt, fr, fi);
            const float cr = c_re[(lg * SC + c) * SN + n], ci = c_im[(lg * SC + c) * SN + n];
            const float xr = pr * fr - pi * fi, xi = pr * fi + pi * fr;
            const float wr = cr * xr - ci * xi, wi = cr * xi + ci * xr;
            const f32x4* br4 = (const f32x4*)(b_re + (size_t)(lg * SN + n) * SC); const f32x4* bi4 = (const f32x4*)(b_im + (size_t)(lg * SN + n) * SC);
#pragma unroll
            for (int q = 0; q < 4; ++q) { const f32x4 br = br4[q], bi = bi4[q];
                acc[4 * q] += wr * br.x - wi * bi.x; acc[4 * q + 1] += wr * br.y - wi * bi.y; acc[4 * q + 2] += wr * br.z - wi * bi.z; acc[4 * q + 3] += wr * br.w - wi * bi.w; } }
        v4u o0, o1; o0.x = mk::pk2(acc[0], acc[1]); o0.y = mk::pk2(acc[2], acc[3]); o0.z = mk::pk2(acc[4], acc[5]); o0.w = mk::pk2(acc[6], acc[7]);
        o1.x = mk::pk2(acc[8], acc[9]); o1.y = mk::pk2(acc[10], acc[11]); o1.z = mk::pk2(acc[12], acc[13]); o1.w = mk::pk2(acc[14], acc[15]);
        v4u* dst = (v4u*)(KT + (size_t)it * 16); dst[0] = o0; dst[1] = o1; }
#pragma unroll 1
    for (int it = gt; it < 2 * SG * LC_ * SN; it += NTH) { const int n = it & 63, s = (it >> 6) & 31, lg = it >> 11;
        const float dt = __expf(log_dt[lg]); const float lr = lam_re[lg * SN + n], li = lam_im[lg * SN + n];
        float pr, pi, fr, fi; cpow(lr, li, dt, (float)(31 - s), pr, pi); zoh_f(lr, li, dt, fr, fi);
        const float xr = pr * fr - pi * fi, xi = pr * fi + pi * fr;
        float vr[16], vi[16];
        const f32x4* br4 = (const f32x4*)(b_re + (size_t)(lg * SN + n) * SC); const f32x4* bi4 = (const f32x4*)(b_im + (size_t)(lg * SN + n) * SC);
#pragma unroll
        for (int q = 0; q < 4; ++q) { const f32x4 br = br4[q], bi = bi4[q];
            vr[4 * q] = xr * br.x - xi * bi.x; vr[4 * q + 1] = xr * br.y - xi * bi.y; vr[4 * q + 2] = xr * br.z - xi * bi.z; vr[4 * q + 3] = xr * br.w - xi * bi.w;
            vi[4 * q] = xr * bi.x + xi * br.x; vi[4 * q + 1] = xr * bi.y + xi * br.y; vi[4 * q + 2] = xr * bi.z + xi * br.z; vi[4 * q + 3] = xr * bi.w + xi * br.w; }
        bf16* base = PT + ((size_t)(lg * LC_ + s) * 128) * 16;
        v4u o; v4u* d0 = (v4u*)(base + (size_t)n * 16); v4u* d1 = (v4u*)(base + (size_t)(64 + n) * 16);
        o.x = mk::pk2(vr[0], vr[1]); o.y = mk::pk2(vr[2], vr[3]); o.z = mk::pk2(vr[4], vr[5]); o.w = mk::pk2(vr[6], vr[7]); d0[0] = o;
        o.x = mk::pk2(vr[8], vr[9]); o.y = mk::pk2(vr[10], vr[11]); o.z = mk::pk2(vr[12], vr[13]); o.w = mk::pk2(vr[14], vr[15]); d0[1] = o;
        o.x = mk::pk2(vi[0], vi[1]); o.y = mk::pk2(vi[2], vi[3]); o.z = mk::pk2(vi[4], vi[5]); o.w = mk::pk2(vi[6], vi[7]); d1[0] = o;
        o.x = mk::pk2(vi[8], vi[9]); o.y = mk::pk2(vi[10], vi[11]); o.z = mk::pk2(vi[12], vi[13]); o.w = mk::pk2(vi[14], vi[15]); d1[1] = o; }
    f32x4* LPF = (f32x4*)(s5ws + OFF_LP);
#pragma unroll 1
    for (int it = gt; it < 2 * SG * 2 * 2 * 4 * 64; it += NTH) { const int ln = it & 63, i = (it >> 6) & 3, kh = (it >> 8) & 1, mb = (it >> 9) & 1, lg = it >> 10;
        const int t = 16 * mb + (ln & 15), n = 32 * kh + 8 * (ln >> 4) + 2 * i; const float dt = __expf(log_dt[lg]);
        float ar, ai, br, bi; cpow(lam_re[lg * SN + n], lam_im[lg * SN + n], dt, (float)(t + 1), ar, ai); cpow(lam_re[lg * SN + n + 1], lam_im[lg * SN + n + 1], dt, (float)(t + 1), br, bi);
        LPF[it] = (f32x4){ar, ai, br, bi}; }
    f32x2* L32 = (f32x2*)(s5ws + OFF_LC);
#pragma unroll 1
    for (int it = gt; it < 2 * SG * SN; it += NTH) { const int n = it & 63, lg = it >> 6; const float dt = __expf(log_dt[lg]); float pr, pi; cpow(lam_re[lg * SN + n], lam_im[lg * SN + n], dt, 32.f, pr, pi); L32[it] = (f32x2){pr, pi}; }
    v4u* CBF = (v4u*)(s5ws + OFF_CB);
#pragma unroll 1
    for (int it = gt; it < 2 * SG * 4 * 64; it += NTH) { const int ln = it & 63, ks = (it >> 6) & 3, lg = it >> 8; const int c = ln & 15, n0 = 32 * (ks & 1) + 8 * (ln >> 4);
        const float* src = ((ks >> 1) ? c_im : c_re) + (size_t)(lg * SC + c) * SN + n0; const float sg = (ks >> 1) ? -1.f : 1.f;
        v4u o; o.x = mk::pk2(sg * src[0], sg * src[1]); o.y = mk::pk2(sg * src[2], sg * src[3]); o.z = mk::pk2(sg * src[4], sg * src[5]); o.w = mk::pk2(sg * src[6], sg * src[7]); CBF[it] = o; }
}

__device__ __forceinline__ void s5a_unit(int l, int g, int b, int part, const bf16* PROJ, const unsigned char* s5ws, LAS unsigned char* lds) {
    const int tid = opaque_tid(), lane = tid & 63, wave = __builtin_amdgcn_readfirstlane(tid >> 6), r = lane & 31, h = lane >> 5;
    const bf16* KTg = (const bf16*)(s5ws + OFF_KT) + (size_t)(l * SG + g) * 32 * 256;
    const bf16* PTg = (const bf16*)(s5ws + OFF_PT) + (size_t)(l * SG + g) * 32 * 128 * 16;
    float* YI = (float*)(s5ws + OFF_YI); float* SE = (float*)(s5ws + OFF_SE);
#pragma unroll
    for (int i = 0; i < 8; ++i) { const int p = tid + 512 * i, tok = p >> 1, half = p & 1, chunk = tok >> 5, s = tok & 31;
        const v4u v = *(const GAS v4u*)(PROJ + (size_t)(b * 2048 + tok) * 5120 + nv::C_U + g * 16 + 8 * half);
        *(LAS v4u*)(lds + ((s * 64 + chunk) * 32 + 16 * half)) = v; }
    if (part == 0) {
#pragma unroll
    for (int i = 0; i < 2; ++i) { const int p = tid + 512 * i; const v4u v = *(const GAS v4u*)(KTg + (size_t)p * 8); *(LAS v4u*)(lds + 65536 + 512 + p * 16) = v; }
    }
    { unsigned z0 = 0u; asm volatile("" : "+v"(z0));
      if (tid < 32) *(LAS v4u*)(lds + 65536 + tid * 16) = (v4u){z0, z0, z0, z0}; }
    asm volatile("s_waitcnt vmcnt(0) lgkmcnt(0)" ::: "memory"); __syncthreads();
    const int tl = r >> 4, c = r & 15;
    if (part == 0) {
#pragma unroll 1
    for (int nb = 0; nb < 2; ++nb)
#pragma unroll 1
        for (int half = 0; half < 2; ++half) { const int tb = half ? 15 - wave : wave;
            f32x16 acc = {};
            const LAS unsigned char* ap = lds + 65536 + (2 * tb + tl + 1) * 512 + c * 32 + h * 16;
            const LAS unsigned char* bp = lds + (nb * 32 + r) * 32 + 16 * h;
#pragma unroll 2
            for (int s = 0; s <= 2 * tb + 1; ++s) { const bf16x8 a = *(const LAS bf16x8*)(ap - s * 512); const bf16x8 bb = *(const LAS bf16x8*)(bp + s * 2048);
                acc = __builtin_amdgcn_mfma_f32_32x32x16_bf16(a, bb, acc, 0, 0, 0); }
            const int chunk = nb * 32 + r;
#pragma unroll
            for (int q = 0; q < 4; ++q) { const int tq = q >> 1, c0 = 8 * (q & 1) + 4 * h; const int t = chunk * 32 + 2 * tb + tq;
                *(GAS f32x4*)(YI + (size_t)(b * 2048 + t) * 512 + g * 16 + c0) = (f32x4){acc[4 * q], acc[4 * q + 1], acc[4 * q + 2], acc[4 * q + 3]}; } }
    } else {
    { const int mb = wave >> 1, nb = wave & 1; f32x16 acc = {};
        const bf16* ap = PTg + (size_t)(mb * 32 + r) * 16 + 8 * h; const LAS unsigned char* bp = lds + (nb * 32 + r) * 32 + 16 * h;
#pragma unroll 8
        for (int s = 0; s < 32; ++s) { const bf16x8 a = *(const GAS bf16x8*)(ap + (size_t)s * 128 * 16); const bf16x8 bb = *(const LAS bf16x8*)(bp + s * 2048);
            acc = __builtin_amdgcn_mfma_f32_32x32x16_bf16(a, bb, acc, 0, 0, 0); }
        const int chunk = nb * 32 + r;
        LAS float* SEL = (LAS float*)(lds + 98304);
#pragma unroll
        for (int q = 0; q < 4; ++q) { const int rho = mb * 32 + 8 * q + 4 * h;
#pragma unroll
            for (int i = 0; i < 4; ++i) SEL[(rho + i) * 65 + chunk] = acc[4 * q + i]; } }
    asm volatile("s_waitcnt lgkmcnt(0)" ::: "memory"); __syncthreads();
    if (tid < 64) { const int n = tid; const LAS float* SEL = (const LAS float*)(lds + 98304);
        const f32x2 a32 = ((const f32x2*)(s5ws + OFF_LC))[(size_t)(l * SG + g) * SN + n];
        float sr = 0.f, si = 0.f; float* dst = SE + ((size_t)(b * 64) * 32 + g) * 128 + n;
#pragma unroll 4
        for (int k = 0; k < 64; ++k) { dst[(size_t)k * 32 * 128] = sr; dst[(size_t)k * 32 * 128 + 64] = si;
            const float er = SEL[n * 65 + k], ei = SEL[(64 + n) * 65 + k];
            const float nr = a32.x * sr - a32.y * si + er, ni = a32.x * si + a32.y * sr + ei; sr = nr; si = ni; } }
    }
    asm volatile("s_waitcnt lgkmcnt(0)" ::: "memory"); __syncthreads();
}

__device__ __forceinline__ float gelu_tanh(float x) { const float u = 0.7978845608028654f * (x + 0.044715f * x * x * x); const float e = __builtin_amdgcn_exp2f(2.885390081777927f * u);
    const float th = 1.f - 2.f * __builtin_amdgcn_rcpf(e + 1.f); return 0.5f * x * (1.f + th); }
__device__ __forceinline__ bf16x8 pack8(const float (&v)[8]) { v4u o; o.x = mk::pk2(v[0], v[1]); o.y = mk::pk2(v[2], v[3]); o.z = mk::pk2(v[4], v[5]); o.w = mk::pk2(v[6], v[7]); return __builtin_bit_cast(bf16x8, o); }
__device__ __forceinline__ float bflo(unsigned u) { return __uint_as_float(u << 16); }
__device__ __forceinline__ float bfhi(unsigned u) { return __uint_as_float(u & 0xffff0000u); }

#ifndef PROBE_SUB
#define PROBE_SUB (-1)
#endif
#define S5PROBE(id) do { if (PROBE_SUB >= 10 && blockIdx.x == 0 && l == 0) { __syncthreads(); if (threadIdx.x == 0) { const unsigned long long now_ = __builtin_amdgcn_s_memrealtime(); \
        const unsigned long long ps_ = ((unsigned long long)misc[19] << 32) | misc[18]; \
        if ((id) == PROBE_SUB) { const unsigned long long dl_ = now_ + 8 * (now_ - ps_); while (__builtin_amdgcn_s_memrealtime() < dl_) __builtin_amdgcn_s_sleep(8); } \
        const unsigned long long n1_ = __builtin_amdgcn_s_memrealtime(); misc[18] = (unsigned)n1_; misc[19] = (unsigned)(n1_ >> 32); } __syncthreads(); } } while (0)
__device__ __forceinline__ void post_unit(int l, int b, int k, const float* const* in, const bf16* PROJ, const bf16* SBO, const bf16* O1, const bf16* O2, bf16* Y,
                                          const unsigned char* s5ws, LAS unsigned char* lds, volatile LAS unsigned* misc) {
    const int tid = opaque_tid(), lane = tid & 63, wave = __builtin_amdgcn_readfirstlane(tid >> 6);
    const f32x4* LPF = (const f32x4*)(s5ws + OFF_LP) + (size_t)l * SG * 1024; const bf16x8* CBF = (const bf16x8*)(s5ws + OFF_CB) + (size_t)l * SG * 256;
    const bf16* WG = (const bf16*)(s5ws + OFF_WG) + (size_t)l * 512 * 512;
    const float* YI = (const float*)(s5ws + OFF_YI); const float* SE = (const float*)(s5ws + OFF_SE);
    const float* c_re = in[8] + (size_t)l * SG * SC * SN; const float* c_im = in[9] + (size_t)l * SG * SC * SN; const float* dsk = in[10] + l * 512;
    const float* b_glu = in[13] + l * 512; const float* ssm_g = in[14] + l * 512; const float* sb_g = in[3] + l * 512; const float* df_g = in[19] + l * 128;
    LAS float* SIN = (LAS float*)lds; LAS unsigned short* G1 = (LAS unsigned short*)(lds + 16384); LAS unsigned short* OUTT = (LAS unsigned short*)(lds + 49664); LAS float* RS = (LAS float*)(lds + 82944);
    const size_t tok0 = (size_t)b * 2048 + (size_t)k * 32;
    S5PROBE(10);
#pragma unroll
    for (int q = 0; q < 2; ++q) { const int p = tid + 512 * q; *(LAS f32x4*)(SIN + 4 * p) = *(const GAS f32x4*)(SE + ((size_t)(b * 64 + k) * 32) * 128 + 4 * p); }
    asm volatile("s_waitcnt vmcnt(0) lgkmcnt(0)" ::: "memory"); __syncthreads();
    S5PROBE(11);
    { const int row = lane & 15, kg = lane >> 4;
      float yi[4][2][4], uu[4][2][4], dk[4];
#pragma unroll
      for (int gi = 0; gi < 4; ++gi) { const int ch = (wave * 4 + gi) * SC + row; dk[gi] = dsk[ch];
#pragma unroll
          for (int mb = 0; mb < 2; ++mb)
#pragma unroll
              for (int rg = 0; rg < 4; ++rg) { const size_t tok = tok0 + 16 * mb + 4 * kg + rg; yi[gi][mb][rg] = YI[tok * 512 + ch]; uu[gi][mb][rg] = bflo((unsigned)PROJ[tok * 5120 + nv::C_U + ch]); } }
#pragma unroll
      for (int gi = 0; gi < 4; ++gi) { const int g = wave * 4 + gi;
        f32x4 lpv[2][2][4]; bf16x8 cbv[4];
#pragma unroll
        for (int mb = 0; mb < 2; ++mb)
#pragma unroll
            for (int kh = 0; kh < 2; ++kh) { const GAS f32x4* lp = (const GAS f32x4*)(LPF + (((size_t)g * 2 + mb) * 2 + kh) * 256 + lane);
#pragma unroll
                for (int i = 0; i < 4; ++i) lpv[mb][kh][i] = lp[64 * i]; }
#pragma unroll
        for (int ks = 0; ks < 4; ++ks) cbv[ks] = *(const GAS bf16x8*)(CBF + ((size_t)g * 4 + ks) * 64 + lane);
        f32x4 srv[2][2], siv[2][2];
#pragma unroll
        for (int kh = 0; kh < 2; ++kh) { const int n0 = 32 * kh + 8 * kg;
            srv[kh][0] = *(const LAS f32x4*)(SIN + g * 128 + n0); srv[kh][1] = *(const LAS f32x4*)(SIN + g * 128 + n0 + 4);
            siv[kh][0] = *(const LAS f32x4*)(SIN + g * 128 + 64 + n0); siv[kh][1] = *(const LAS f32x4*)(SIN + g * 128 + 64 + n0 + 4); }
#pragma unroll
        for (int mb = 0; mb < 2; ++mb) { f32x4 acc = {0.f, 0.f, 0.f, 0.f};
#pragma unroll
            for (int ks = 0; ks < 4; ++ks) { const int ri = ks >> 1, kh = ks & 1;
                const f32x4 p0 = lpv[mb][kh][0], p1 = lpv[mb][kh][1], p2 = lpv[mb][kh][2], p3 = lpv[mb][kh][3];
                const f32x4 sr0 = srv[kh][0], sr1 = srv[kh][1], si0 = siv[kh][0], si1 = siv[kh][1];
                const float lr[8] = {p0.x, p0.z, p1.x, p1.z, p2.x, p2.z, p3.x, p3.z}, li[8] = {p0.y, p0.w, p1.y, p1.w, p2.y, p2.w, p3.y, p3.w};
                const float sr[8] = {sr0.x, sr0.y, sr0.z, sr0.w, sr1.x, sr1.y, sr1.z, sr1.w}, si[8] = {si0.x, si0.y, si0.z, si0.w, si1.x, si1.y, si1.z, si1.w};
                float w[8];
#pragma unroll
                for (int j = 0; j < 8; ++j) w[j] = ri ? (lr[j] * si[j] + li[j] * sr[j]) : (lr[j] * sr[j] - li[j] * si[j]);
                v4u wp; wp.x = attn_body::cvtpk_s(w[0], w[1]); wp.y = attn_body::cvtpk_s(w[2], w[3]); wp.z = attn_body::cvtpk_s(w[4], w[5]); wp.w = attn_body::cvtpk_s(w[6], w[7]);
                acc = __builtin_amdgcn_mfma_f32_16x16x32_bf16(__builtin_bit_cast(bf16x8, wp), cbv[ks], acc, 0, 0, 0); }
            const int ch = g * SC + row;
#pragma unroll
            for (int rg = 0; rg < 4; ++rg) { const int tt = 16 * mb + 4 * kg + rg;
                const float y = acc[rg] + yi[gi][mb][rg] + dk[gi] * uu[gi][mb][rg];
                G1[tt * 520 + ch] = (unsigned short)mk::f2bf(gelu_tanh(y)); } }
        asm volatile("" ::: "memory"); } }
    asm volatile("s_waitcnt lgkmcnt(0)" ::: "memory"); __syncthreads();
    S5PROBE(12);
    { const int row = lane & 15, kg = lane >> 4; f32x4 acc[2][4]; float bzv[4], sgv[4];
#pragma unroll
      for (int nb = 0; nb < 4; ++nb) { const int j = 64 * wave + 16 * nb + row; bzv[nb] = b_glu[j]; sgv[nb] = ssm_g[j]; }
#pragma unroll
      for (int mb = 0; mb < 2; ++mb)
#pragma unroll
          for (int nb = 0; nb < 4; ++nb) acc[mb][nb] = (f32x4){0.f, 0.f, 0.f, 0.f};
#pragma unroll
      for (int kh = 0; kh < 2; ++kh) {
          bf16x8 bbv[8][4];
#pragma unroll
          for (int k8 = 0; k8 < 8; ++k8)
#pragma unroll
              for (int nb = 0; nb < 4; ++nb) bbv[k8][nb] = *(const GAS bf16x8*)(WG + (size_t)(64 * wave + 16 * nb + row) * 512 + 32 * (8 * kh + k8) + 8 * kg);
#pragma unroll
          for (int k8 = 0; k8 < 8; ++k8) { const int ks = 8 * kh + k8; bf16x8 a[2];
#pragma unroll
              for (int mb = 0; mb < 2; ++mb) a[mb] = *(const LAS bf16x8*)(G1 + (16 * mb + row) * 520 + 32 * ks + 8 * kg);
#pragma unroll
              for (int mb = 0; mb < 2; ++mb)
#pragma unroll
                  for (int nb = 0; nb < 4; ++nb) acc[mb][nb] = __builtin_amdgcn_mfma_f32_16x16x32_bf16(a[mb], bbv[k8][nb], acc[mb][nb], 0, 0, 0); }
          asm volatile("" ::: "memory"); }
      float ss[2][4];
#pragma unroll
      for (int mb = 0; mb < 2; ++mb)
#pragma unroll
          for (int rg = 0; rg < 4; ++rg) ss[mb][rg] = 0.f;
#pragma unroll
      for (int nb = 0; nb < 4; ++nb) { const int j = 64 * wave + 16 * nb + row; const float bz = bzv[nb];
#pragma unroll
          for (int mb = 0; mb < 2; ++mb)
#pragma unroll
              for (int rg = 0; rg < 4; ++rg) { const int tt = 16 * mb + 4 * kg + rg; const float z = acc[mb][nb][rg] + bz; const float g1 = bflo((unsigned)G1[tt * 520 + j]);
                  const float o = g1 * __builtin_amdgcn_rcpf(1.f + __builtin_amdgcn_exp2f(-1.4426950408889634f * z)); acc[mb][nb][rg] = o; ss[mb][rg] += o * o; } }
#pragma unroll
      for (int mb = 0; mb < 2; ++mb)
#pragma unroll
          for (int rg = 0; rg < 4; ++rg) { float v = ss[mb][rg]; v += __shfl_xor(v, 1); v += __shfl_xor(v, 2); v += __shfl_xor(v, 4); v += __shfl_xor(v, 8);
              if (row == 0) RS[wave * 32 + 16 * mb + 4 * kg + rg] = v; }
      asm volatile("s_waitcnt lgkmcnt(0)" ::: "memory"); __syncthreads();
#pragma unroll
      for (int mb = 0; mb < 2; ++mb)
#pragma unroll
          for (int rg = 0; rg < 4; ++rg) { const int tt = 16 * mb + 4 * kg + rg; float tot = 0.f;
#pragma unroll
              for (int w8 = 0; w8 < 8; ++w8) tot += RS[w8 * 32 + tt];
              const float rinv = rsqrtf(tot * (1.f / 512.f) + nv::EPS);
#pragma unroll
              for (int nb = 0; nb < 4; ++nb) { const int j = 64 * wave + 16 * nb + row; OUTT[tt * 520 + j] = (unsigned short)mk::f2bf(acc[mb][nb][rg] * rinv * sgv[nb]); } }
      asm volatile("s_waitcnt lgkmcnt(0)" ::: "memory"); __syncthreads();
#pragma unroll
      for (int i = 0; i < 4; ++i) { const int p = tid + 512 * i, rw = p >> 6, c16 = p & 63; const v4u v = *(const LAS v4u*)(OUTT + rw * 520 + c16 * 8);
          *(GAS v4u*)(Y + (tok0 + rw) * 2048 + 512 + c16 * 8) = v; } }
    S5PROBE(13);
    { float a_ = in[15][l * 64 + lane] * in[16][l * 64 + lane], c_ = in[17][l * 64 + lane] * in[18][l * 64 + lane];
      a_ = mk::wave_sum(a_); c_ = mk::wave_sum(c_);
      const float lam_init = 0.8f - 0.6f * __expf(-0.3f * (float)l); const float lam = __expf(a_) - __expf(c_) + lam_init;
#pragma unroll 4
      for (int i = 0; i < 4; ++i) { const size_t tok = tok0 + 4 * wave + i;
          { const v4u v = *(const GAS v4u*)(SBO + tok * 512 + lane * 8); const f32x4 g0 = *(const GAS f32x4*)(sb_g + lane * 8), g1 = *(const GAS f32x4*)(sb_g + lane * 8 + 4);
            float x[8] = {bflo(v.x), bfhi(v.x), bflo(v.y), bfhi(v.y), bflo(v.z), bfhi(v.z), bflo(v.w), bfhi(v.w)}; float s = 0.f;
#pragma unroll
            for (int j = 0; j < 8; ++j) s += x[j] * x[j];
            const float rinv = rsqrtf(mk::wave_sum(s) * (1.f / 512.f) + nv::EPS);
            v4u o; o.x = mk::pk2(x[0] * rinv * g0.x, x[1] * rinv * g0.y); o.y = mk::pk2(x[2] * rinv * g0.z, x[3] * rinv * g0.w); o.z = mk::pk2(x[4] * rinv * g1.x, x[5] * rinv * g1.y); o.w = mk::pk2(x[6] * rinv * g1.z, x[7] * rinv * g1.w);
            *(GAS v4u*)(Y + tok * 2048 + lane * 8) = o; }
          { const GAS v4u* p1 = (const GAS v4u*)(O1 + tok * 1024 + lane * 16); const GAS v4u* p2 = (const GAS v4u*)(O2 + tok * 1024 + lane * 16);
            const v4u a0 = p1[0], a1 = p1[1], b0 = p2[0], b1 = p2[1];
            float x[16] = {bflo(a0.x) - lam * bflo(b0.x), bfhi(a0.x) - lam * bfhi(b0.x), bflo(a0.y) - lam * bflo(b0.y), bfhi(a0.y) - lam * bfhi(b0.y),
                           bflo(a0.z) - lam * bflo(b0.z), bfhi(a0.z) - lam * bfhi(b0.z), bflo(a0.w) - lam * bflo(b0.w), bfhi(a0.w) - lam * bfhi(b0.w),
                           bflo(a1.x) - lam * bflo(b1.x), bfhi(a1.x) - lam * bfhi(b1.x), bflo(a1.y) - lam * bflo(b1.y), bfhi(a1.y) - lam * bfhi(b1.y),
                           bflo(a1.z) - lam * bflo(b1.z), bfhi(a1.z) - lam * bfhi(b1.z), bflo(a1.w) - lam * bflo(b1.w), bfhi(a1.w) - lam * bfhi(b1.w)};
            float s = 0.f;
#pragma unroll
            for (int j = 0; j < 16; ++j) s += x[j] * x[j];
            s += __shfl_xor(s, 1); s += __shfl_xor(s, 2); s += __shfl_xor(s, 4);
            const float rinv = rsqrtf(s * (1.f / 128.f) + nv::EPS) * (1.f - lam_init);
            const GAS f32x4* gp = (const GAS f32x4*)(df_g + (lane & 7) * 16); const f32x4 g0 = gp[0], g1 = gp[1], g2 = gp[2], g3 = gp[3];
            v4u o0, o1; o0.x = mk::pk2(x[0] * rinv * g0.x, x[1] * rinv * g0.y); o0.y = mk::pk2(x[2] * rinv * g0.z, x[3] * rinv * g0.w); o0.z = mk::pk2(x[4] * rinv * g1.x, x[5] * rinv * g1.y); o0.w = mk::pk2(x[6] * rinv * g1.z, x[7] * rinv * g1.w);
            o1.x = mk::pk2(x[8] * rinv * g2.x, x[9] * rinv * g2.y); o1.y = mk::pk2(x[10] * rinv * g2.z, x[11] * rinv * g2.w); o1.z = mk::pk2(x[12] * rinv * g3.x, x[13] * rinv * g3.y); o1.w = mk::pk2(x[14] * rinv * g3.z, x[15] * rinv * g3.w);
            GAS v4u* yo = (GAS v4u*)(Y + tok * 2048 + 1024 + lane * 16); yo[0] = o0; yo[1] = o1; } } }
    S5PROBE(14);
    asm volatile("s_waitcnt lgkmcnt(0)" ::: "memory"); __syncthreads();
}
}

namespace mk {
struct MArgs { const float* in[30]; float* out; unsigned char* ws; int ph_lo, ph_hi, li, pad; };
constexpr int NPHASE = 1 + 8 * DEPTH;

__global__ void __launch_bounds__(NWAVES * 64, 2) mk_fwd(MArgs args) {
    extern __shared__ __attribute__((aligned(16))) unsigned char lds[];
    LAS unsigned char* ldsl = (LAS unsigned char*)lds;
    volatile LAS unsigned* MISC = (volatile LAS unsigned*)(ldsl + MISC_OFF);
    const int tid = threadIdx.x, wave = __builtin_amdgcn_readfirstlane(tid >> 6);
    const int G = gridDim.x; const int bx = blockIdx.x; const int vcu = (G % 8 == 0) ? (bx % 8) * (G / 8) + bx / 8 : bx;
    unsigned char* ws = args.ws;
    gu32* ctl = (gu32*)(ws + WS_CTL);
    for (int u = tid; u < (LDS_BYTES - LDSCTL_OFF) / 4; u += NWAVES * 64) ((LAS unsigned*)(ldsl + LDSCTL_OFF))[u] = 0u;
    __syncthreads();
    XcdBarrier bar = xcd_barrier_post((unsigned*)(ctl + CW_BAR) + args.li * XCD_BAR_WORDS, MISC + 8);
    const int lo = args.ph_lo, hi = args.ph_hi;
    if (PROBE_PH >= 0 && tid == 0) { const unsigned long long n0_ = __builtin_amdgcn_s_memrealtime(); MISC[16] = (unsigned)n0_; MISC[17] = (unsigned)(n0_ >> 32); }
#ifndef REP_P0
#define REP_P0 1
#endif
#ifndef REP_A
#define REP_A 1
#endif
#ifndef REP_B
#define REP_B 1
#endif
#ifndef REP_C
#define REP_C 1
#endif
#ifndef REP_D0
#define REP_D0 1
#endif
#ifndef REP_F
#define REP_F 1
#endif
#ifndef REP_G
#define REP_G 1
#endif
#ifndef REP_BARX
#define REP_BARX 0
#endif
#ifndef REP_E
#define REP_E 1
#endif
#ifndef REP_H1
#define REP_H1 1
#endif
#define IN(k) (lo <= (k) && (k) < hi)
#define REPEAT(n) for (int rep_ = 0; rep_ < (n); ++rep_, ((rep_ < (n)) ? xcd_barrier(bar) : (void)0))
#define SEAM(k) do { if (IN(k) && IN((k) + 1)) xcd_barrier(bar); \
    if (PROBE_PH >= 0) { if (bx == 0) { if (tid == 0) { const unsigned long long now_ = __builtin_amdgcn_s_memrealtime(); \
            const unsigned long long ps_ = ((unsigned long long)MISC[17] << 32) | MISC[16]; \
            if ((k) == PROBE_PH) { const unsigned long long dl_ = now_ + PROBE_AMP * (now_ - ps_); while (__builtin_amdgcn_s_memrealtime() < dl_) __builtin_amdgcn_s_sleep(8); } \
            const unsigned long long n1_ = __builtin_amdgcn_s_memrealtime(); MISC[16] = (unsigned)n1_; MISC[17] = (unsigned)(n1_ >> 32); } __syncthreads(); } } } while (0)
    bf16* WinT = (bf16*)(ws + WS_WIN); bf16* WoutT = (bf16*)(ws + WS_WOUT); bf16* XN = (bf16*)(ws + WS_XN); bf16* PROJ = (bf16*)(ws + WS_PROJ);
    bf16* Y = (bf16*)(ws + WS_Y); float* H = (float*)(ws + WS_H); bf16* YS = (bf16*)(ws + WS_YS); bf16* HB = (bf16*)(ws + WS_HB);
    bf16* W13T = (bf16*)(ws + WS_W13); bf16* W2T = (bf16*)(ws + WS_W2); int* LIST = (int*)(ws + WS_ROUTE); float* GATEW = (float*)(ws + WS_ROUTE + MiB);
    float* WRT = (float*)(ws + WS_ROUTE + MiB + 256 * 1024);
    LAS int* tab = (LAS int*)(ldsl + LDSCTL_OFF + 1024);
    const ConvCtx CC{args.in, W13T, W2T, WinT, WoutT, (bf16*)(ws + WS_S5 + s5::OFF_WG)};
    const int NGW = G * NWAVES;
#define PHASE_IDS() const int tid_ = opaque_tid(); const int lane = tid_ & 63; const int gw = vcu * NWAVES + wave; (void)gw; (void)lane

    REPEAT(REP_P0) if (IN(0)) { PHASE_IDS();
        LAS float* scr = (LAS float*)(ldsl + RING_OFF + wave * 16640);
        for (int m = gw; m < T; m += NGW) rms_row_to_bf16(args.in[0] + (size_t)m * D, args.in[1], XN + (size_t)m * D, lane);
        for (int it = vcu * (NWAVES * 64) + tid_; it < DEPTH * 48 * D; it += G * NWAVES * 64) { const int d = it & (D - 1), c = (it >> 11) % 48, l = it / (48 * D);
            float w = 0.f; if (c < 4) w = args.in[22][((size_t)l * D + d) * 4 + c]; else if (c < 36) { const int gq = (c - 4) >> 3, e = (c - 4) & 7; w = args.in[24][(((size_t)l * 4 + gq) * D + d) * 8 + e]; }
            WRT[it] = w * args.in[21][(size_t)l * D + d]; }
        s5::build_tables(args.in, ws + WS_S5, vcu * (NWAVES * 64) + tid_, G * NWAVES * 64);
        { f32x4 va[16], vb[16]; TileJob ja, jb; int it = gw;
          if (it < P0_TILES) { p0_job(CC, it, ja); tile_load(ja, va, lane); }
#pragma unroll 1
          for (; it < P0_TILES; it += 2 * NGW) {
              const int i1 = it + NGW, i2 = it + 2 * NGW;
              if (i1 < P0_TILES) { p0_job(CC, i1, jb); tile_load(jb, vb, lane); }
              tile_store(ja, va, scr, lane);
              if (i1 < P0_TILES) { if (i2 < P0_TILES) { p0_job(CC, i2, ja); tile_load(ja, va, lane); } tile_store(jb, vb, scr, lane); }
          } }
    }
    SEAM(0);
    for (int xb_ = 0; xb_ < REP_BARX; ++xb_) xcd_barrier(bar);
    for (int l = 0; l < DEPTH; ++l) {
        const int pb = 1 + 8 * l;
        REPEAT(REP_A) if (IN(pb + 0)) {
            pg8::Gemm g{XN, WinT + (size_t)l * INC * D, T, INC, D}; pg8::StaticOrder S; S.init(T, INC, G, bx);
            pg8::EpiProj E{PROJ, INC};
            pg8::gemm_phase<pg8::EpiProj, pg8::StaticOrder, PG8_ALIGN, PG8_SP2>(ldsl + RING_OFF, g, S, E);
            { const int total = (T / 256) * (INC / 256), nmax = (total + G - 1) / G, nmine = bx < total ? (total - bx + G - 1) / G : 0;
              if (nmine < nmax) convert_batches(CC, ctl + CW_Q, QUOTA_A, 0, MISC + 20, ldsl + RING_OFF); }
        }
        SEAM(pb + 0);
        REPEAT(REP_B) { if (l == 0) SUBPROBE(0);
        if (IN(pb + 1)) {
#pragma unroll 1
            for (int u = vcu; u < 256; u += G) s5::s5a_unit(l, u & 31, (u >> 5) & 3, u >> 7, PROJ, ws + WS_S5, ldsl + RING_OFF);
        }
        if (l == 0) SUBPROBE(1);
        if (IN(pb + 1)) {
            bf16* O1 = (bf16*)(ws + WS_O1); bf16* O2 = (bf16*)(ws + WS_O2);
#pragma unroll 1
            for (int u = vcu; u < 1024; u += G) { const int i = u >> 8, v = u & 255, combo = v >> 1, sub = v & 1;
                const int qb = ((sub ? 0x4352 : 0x6170) >> (4 * i)) & 7;
                const int b = combo >> 5, rem = combo & 31, h = rem >> 2, mp = (rem >> 1) & 1, vh = rem & 1;
                attn_body::attn_unit<8>(b, qb, (const attn_body::bf16*)(PROJ + nv::C_DQ + h * 128 + mp * 64), (const attn_body::bf16*)(PROJ + nv::C_DK + h * 128 + mp * 64),
                                        (const attn_body::bf16*)(PROJ + nv::C_DV + h * 128 + vh * 64), (attn_body::bf16*)((mp ? O2 : O1) + h * 128 + vh * 64), 1024, (char*)lds + RING_OFF); }
        }
        if (l == 0) SUBPROBE(2);
#if !defined(NO_MK_SB)
        if (IN(pb + 1)) {
            bf16* SBO = (bf16*)(ws + WS_SBO);
#pragma unroll 1
            for (int u = vcu; u < 256; u += G) { const int bh = u >> 3, qb = u & 7, b = bh >> 3, h = bh & 7;
                attn_body::sb_unit(b, qb, (const attn_body::bf16*)(PROJ + nv::C_SBQ + h * 64), (const attn_body::bf16*)(PROJ + nv::C_SBK + h * 64),
                                   (const attn_body::bf16*)(PROJ + nv::C_SBV + h * 64), (attn_body::bf16*)(SBO + h * 64), 512, (char*)lds + RING_OFF); }
        }
#endif
        if (l == 0) SUBPROBE(3);
        }
        SEAM(pb + 1);
        REPEAT(REP_C) if (IN(pb + 2)) {
#pragma unroll 1
            for (int u = vcu; u < 256; u += G) s5::post_unit(l, u >> 6, u & 63, args.in, PROJ, (const bf16*)(ws + WS_SBO), (const bf16*)(ws + WS_O1), (const bf16*)(ws + WS_O2), Y, ws + WS_S5, ldsl + RING_OFF, MISC);
        }
        SEAM(pb + 2);
        REPEAT(l == 0 ? REP_D0 : 1) if (IN(pb + 3)) {
            pg8::Gemm g{Y, WoutT + (size_t)l * D * D, T, D, D}; pg8::StaticOrder S; S.init(T, D, G, bx);
            pg8::EpiResF32 E{l == 0 ? args.in[0] : (const float*)H, H, D};
            pg8::gemm_phase<pg8::EpiResF32, pg8::StaticOrder, PG8_ALIGN, PG8_SP2>(ldsl + RING_OFF, g, S, E);
        }
        SEAM(pb + 3);
        gu32* cnt = ctl + CW_CNT + 2048 * l;
        if (IN(pb + 4)) { PHASE_IDS();
            const float* gF = args.in[21] + (size_t)l * D; const float* rgb = args.in[23] + l * 4; const float* reb = args.in[25] + l * 32;
            const float* wrt = WRT + (size_t)l * 48 * D;
            LAS float* PL = (LAS float*)(ldsl + RING_OFF);
            LAS float* PS = (LAS float*)(ldsl + RING_OFF + 24576);
            LAS float* RR = (LAS float*)(ldsl + RING_OFF + 25600);
            const int tile = wave >> 2, kq = wave & 3, row = lane & 15, kk = lane >> 4;
#pragma unroll 1
            for (int m0 = 32 * vcu; m0 < T; m0 += 32 * G) {
                const GAS f32x4* ap = (const GAS f32x4*)(H + (size_t)(m0 + 16 * tile + row) * D + kq * 512 + kk * 4);
                const GAS f32x4* bp = (const GAS f32x4*)(wrt + (size_t)row * D + kq * 512 + kk * 4);
                f32x4 acc0 = {0.f, 0.f, 0.f, 0.f}, acc1 = acc0, acc2 = acc0; float ssq = 0.f;
#pragma unroll 8
                for (int i = 0; i < 32; ++i) { const f32x4 a4 = ap[4 * i], b0 = bp[4 * i], b1 = bp[4 * i + 16 * D / 4], b2 = bp[4 * i + 32 * D / 4];
                    ssq += (a4.x * a4.x + a4.y * a4.y) + (a4.z * a4.z + a4.w * a4.w);
                    acc0 = __builtin_amdgcn_mfma_f32_16x16x4f32(a4.x, b0.x, acc0, 0, 0, 0); acc1 = __builtin_amdgcn_mfma_f32_16x16x4f32(a4.x, b1.x, acc1, 0, 0, 0); acc2 = __builtin_amdgcn_mfma_f32_16x16x4f32(a4.x, b2.x, acc2, 0, 0, 0);
                    acc0 = __builtin_amdgcn_mfma_f32_16x16x4f32(a4.y, b0.y, acc0, 0, 0, 0); acc1 = __builtin_amdgcn_mfma_f32_16x16x4f32(a4.y, b1.y, acc1, 0, 0, 0); acc2 = __builtin_amdgcn_mfma_f32_16x16x4f32(a4.y, b2.y, acc2, 0, 0, 0);
                    acc0 = __builtin_amdgcn_mfma_f32_16x16x4f32(a4.z, b0.z, acc0, 0, 0, 0); acc1 = __builtin_amdgcn_mfma_f32_16x16x4f32(a4.z, b1.z, acc1, 0, 0, 0); acc2 = __builtin_amdgcn_mfma_f32_16x16x4f32(a4.z, b2.z, acc2, 0, 0, 0);
                    acc0 = __builtin_amdgcn_mfma_f32_16x16x4f32(a4.w, b0.w, acc0, 0, 0, 0); acc1 = __builtin_amdgcn_mfma_f32_16x16x4f32(a4.w, b1.w, acc1, 0, 0, 0); acc2 = __builtin_amdgcn_mfma_f32_16x16x4f32(a4.w, b2.w, acc2, 0, 0, 0); }
                ssq += __shfl_xor(ssq, 16); ssq += __shfl_xor(ssq, 32);
                if (kk == 0) PS[(tile * 4 + kq) * 16 + row] = ssq;
#pragma unroll
                for (int rg = 0; rg < 4; ++rg) { LAS float* p = PL + ((tile * 4 + kq) * 16 + 4 * kk + rg) * 48 + row; p[0] = acc0[rg]; p[16] = acc1[rg]; p[32] = acc2[rg]; }
                LDS_WAIT(); __syncthreads();
                if (wave == 0 && lane < 32) { const int t2 = lane >> 4, rw = lane & 15;
                    float sq = 0.f;
#pragma unroll
                    for (int q = 0; q < 4; ++q) sq += PS[(t2 * 4 + q) * 16 + rw];
                    const float r = rsqrtf(sq * (1.f / D) + EPS); RR[lane] = r;
                    const LAS float* p0 = PL + ((t2 * 4 + 0) * 16 + rw) * 48; const LAS float* p1 = p0 + 16 * 48; const LAS float* p2 = p1 + 16 * 48; const LAS float* p3 = p2 + 16 * 48;
                    float gl[4]; int gi = 0; float gm = -INFINITY;
#pragma unroll
                    for (int q = 0; q < 4; ++q) { gl[q] = ((p0[q] + p1[q]) + (p2[q] + p3[q])) * r + rgb[q]; if (gl[q] > gm) { gm = gl[q]; gi = q; } }
                    const float gtop = 1.f / (expf(gl[0] - gm) + expf(gl[1] - gm) + expf(gl[2] - gm) + expf(gl[3] - gm));
                    float m0v = -INFINITY, m1v = -INFINITY; int i0 = 0, i1 = 0;
#pragma unroll
                    for (int q = 0; q < 8; ++q) { const int c = 4 + gi * 8 + q; const float lv = ((p0[c] + p1[c]) + (p2[c] + p3[c])) * r + reb[gi * 8 + q];
                        if (lv > m0v) { m1v = m0v; i1 = i0; m0v = lv; i0 = q; } else if (lv > m1v) { m1v = lv; i1 = q; } }
                    const float p1e = expf(m1v - m0v); const float w0 = 1.f / (1.f + p1e) * gtop, w1 = p1e / (1.f + p1e) * gtop;
                    const int x0 = gi * 8 + i0, x1 = gi * 8 + i1; const int mr = m0 + lane;
                    const unsigned q0 = __hip_atomic_fetch_add(cnt + 64 * x0, 1u, RLX_AGENT), q1 = __hip_atomic_fetch_add(cnt + 64 * x1, 1u, RLX_AGENT);
                    LIST[x0 * 8192 + q0] = 2 * mr; LIST[x1 * 8192 + q1] = 2 * mr + 1; GATEW[2 * mr] = w0; GATEW[2 * mr + 1] = w1; }
                LDS_WAIT(); __syncthreads();
#pragma unroll 2
                for (int i = 0; i < 4; ++i) { const int mr = m0 + 4 * wave + i; const float r = RR[4 * wave + i];
                    const GAS f32x4* hr = (const GAS f32x4*)(H + (size_t)mr * D) + lane; const GAS f32x4* gr = (const GAS f32x4*)gF + lane;
                    GAS unsigned long long* o8 = (GAS unsigned long long*)(XN + (size_t)mr * D) + lane;
                    f32x4 hv[8];
#pragma unroll
                    for (int j = 0; j < 8; ++j) hv[j] = hr[64 * j];
#pragma unroll
                    for (int j = 0; j < 8; ++j) { const f32x4 o = hv[j] * r * gr[64 * j]; o8[64 * j] = (unsigned long long)pk2(o.x, o.y) | ((unsigned long long)pk2(o.z, o.w) << 32); } }
                LDS_WAIT(); __syncthreads();
            }
            if (l == 1) convert_batches(CC, ctl + CW_Q, 0, Q_TOTAL, MISC + 20, ldsl + RING_OFF);
        }
        SEAM(pb + 4);
#define BUILD_TAB() do { PHASE_IDS(); if (wave == 0) { const int c_ = (lane < 32) ? (int)__hip_atomic_load(cnt + 64 * (lane & 31), RLX_AGENT) : 0; \
            const int mt_ = (c_ + 255) >> 8, hv_ = (c_ + 127) >> 8; int incl = mt_, inh = hv_, inl = mt_ - hv_; \
            _Pragma("unroll") for (int o = 1; o < 32; o <<= 1) { const int t_ = __shfl_up(incl, o), th_ = __shfl_up(inh, o), tl_ = __shfl_up(inl, o); if (lane >= o) { incl += t_; inh += th_; inl += tl_; } } \
            if (lane < 32) { tab[lane] = c_; tab[33 + lane] = incl; tab[66 + lane] = inh; tab[99 + lane] = inl; } if (lane == 0) { tab[32] = 0; tab[65] = 0; tab[98] = 0; } } LDS_WAIT(); __syncthreads(); } while (0)
        REPEAT(REP_F) if (IN(pb + 5)) {
            BUILD_TAB();
            pg8::GroupedOrder S{(const LAS int*)tab, 4, G, bx, 1024u * 2048u * 2u};
            pg8::Gemm g{XN, W13T + (size_t)l * nv::NEXP * 1024 * D, 0, 0, D};
            pg8::EpiMoe1 E{HB, LIST, GATEW};
            pg8::gemm_phase_g<pg8::EpiMoe1, true>(ldsl + RING_OFF, g, S, E, LIST);
            { const int total = tab[64] * 4, nmax = (total + G - 1) / G, nmine = bx < total ? (total - bx + G - 1) / G : 0;
              if (nmine < nmax) convert_batches(CC, ctl + CW_Q, QUOTA_F, 0, MISC + 20, ldsl + RING_OFF); }
            if (l == 0) convert_batches(CC, ctl + CW_Q, 0, Q_W2L0, MISC + 20, ldsl + RING_OFF);
        }
        SEAM(pb + 5);
        REPEAT(REP_G) if (IN(pb + 6)) {
            BUILD_TAB();
            pg8::GroupedOrder S{(const LAS int*)tab, 8, G, bx, 2048u * 512u * 2u};
            pg8::Gemm g{HB, W2T + (size_t)l * nv::NEXP * D * nv::DE, 0, 0, nv::DE};
            pg8::EpiMoe2 E{YS, LIST};
            pg8::gemm_phase_g<pg8::EpiMoe2, false>(ldsl + RING_OFF, g, S, E, LIST);
            { const int total = tab[64] * 8, nmax = (total + G - 1) / G, nmine = bx < total ? (total - bx + G - 1) / G : 0;
              if (nmine < nmax) convert_batches(CC, ctl + CW_Q, QUOTA_G, 0, MISC + 20, ldsl + RING_OFF); }
        }
        SEAM(pb + 6);
        REPEAT(l == 1 ? REP_H1 : 1) if (IN(pb + 7)) { PHASE_IDS();
            const bool fin = (l + 1 == DEPTH); const float* gN = fin ? args.in[29] : args.in[1] + (size_t)(l + 1) * D;
            for (int m = gw; m < T; m += NGW) {
                GAS f32x4* hr = (GAS f32x4*)(H + (size_t)m * D) + lane; const GAS f32x4* gr = (const GAS f32x4*)gN + lane;
                typedef unsigned u32x2_t __attribute__((ext_vector_type(2))); const GAS u32x2_t* y0 = (const GAS u32x2_t*)(YS + (size_t)(2 * m) * D) + lane; const GAS u32x2_t* y1 = (const GAS u32x2_t*)(YS + (size_t)(2 * m + 1) * D) + lane;
                f32x4 v[8]; float s = 0.f;
#pragma unroll
                for (int j = 0; j < 8; ++j) { const f32x4 h4 = hr[64 * j]; const u32x2_t a = y0[64 * j], b = y1[64 * j];
                    v[j].x = h4.x + __uint_as_float(a.x << 16) + __uint_as_float(b.x << 16); v[j].y = h4.y + __uint_as_float(a.x & 0xffff0000u) + __uint_as_float(b.x & 0xffff0000u);
                    v[j].z = h4.z + __uint_as_float(a.y << 16) + __uint_as_float(b.y << 16); v[j].w = h4.w + __uint_as_float(a.y & 0xffff0000u) + __uint_as_float(b.y & 0xffff0000u);
                    s += (v[j].x * v[j].x + v[j].y * v[j].y) + (v[j].z * v[j].z + v[j].w * v[j].w); }
                const float r = rsqrtf(wave_sum(s) * (1.f / D) + EPS);
                if (fin) { GAS f32x4* orow = (GAS f32x4*)(args.out + (size_t)m * D) + lane;
#pragma unroll
                    for (int j = 0; j < 8; ++j) orow[64 * j] = v[j] * r * gr[64 * j]; }
                else { GAS unsigned long long* o8 = (GAS unsigned long long*)(XN + (size_t)m * D) + lane;
#pragma unroll
                    for (int j = 0; j < 8; ++j) { hr[64 * j] = v[j]; const f32x4 o = v[j] * r * gr[64 * j]; o8[64 * j] = (unsigned long long)pk2(o.x, o.y) | ((unsigned long long)pk2(o.z, o.w) << 32); } }
            }
        }
        if (IN(pb + 7) && l == 0) convert_batches(CC, ctl + CW_Q, 0, Q_DENSE1, MISC + 20, ldsl + RING_OFF);
        SEAM(pb + 7);
    }
#undef IN
#undef SEAM
}

static int g_grid = 0;
static bool mk_setup() {
    if (g_grid != 0) return g_grid > 0;
    int dev = 0, cus = 0, per_cu = 0;
    if (hipGetDevice(&dev) != hipSuccess || hipDeviceGetAttribute(&cus, hipDeviceAttributeMultiprocessorCount, dev) != hipSuccess) { g_grid = -1; return false; }
    if (hipFuncSetAttribute((const void*)mk_fwd, hipFuncAttributeMaxDynamicSharedMemorySize, LDS_BYTES) != hipSuccess) { fprintf(stderr, "mk: hipFuncSetAttribute failed\n"); g_grid = -1; return false; }
    if (hipOccupancyMaxActiveBlocksPerMultiprocessor(&per_cu, (const void*)mk_fwd, NWAVES * 64, LDS_BYTES) != hipSuccess || per_cu < 1) { fprintf(stderr, "mk: occupancy query says %d\n", per_cu); }
    (void)hipGetLastError();
    g_grid = cus;
    return true;
}
static void mk_launch(const MArgs& base, int lo, int hi, int& li, hipStream_t stream) {
    MArgs a = base; a.ph_lo = lo; a.ph_hi = hi; a.li = li++; a.pad = 0;
    hipLaunchKernelGGL(mk_fwd, dim3(g_grid), dim3(NWAVES * 64), LDS_BYTES, stream, a);
}
}
extern "C" void kernel_launch(void* const* d_in, const int* in_sizes, int n_in, void* d_out, int out_size, void* d_ws, size_t ws_size, hipStream_t stream) {
    using namespace nv;
    if (n_in != 30 || ws_size < mk::WS_END) { fprintf(stderr, "kernel_launch: unexpected n_in %d / ws %zu\n", n_in, ws_size); return; }
    if (!mk::mk_setup()) return;
    const float* x = (const float*)d_in[0];
    const float* norm_mix_g = (const float*)d_in[1]; const float* sb_norm_g = (const float*)d_in[3];
    const float* lam_re = (const float*)d_in[4]; const float* lam_im = (const float*)d_in[5]; const float* b_re = (const float*)d_in[6]; const float* b_im = (const float*)d_in[7];
    const float* c_re = (const float*)d_in[8]; const float* c_im = (const float*)d_in[9]; const float* ssm_d = (const float*)d_in[10]; const float* log_dt = (const float*)d_in[11];
    const float* w_glu = (const float*)d_in[12]; const float* b_glu = (const float*)d_in[13]; const float* ssm_norm_g = (const float*)d_in[14];
    const float* lq1 = (const float*)d_in[15]; const float* lk1 = (const float*)d_in[16]; const float* lq2 = (const float*)d_in[17]; const float* lk2 = (const float*)d_in[18];
    const float* subln = (const float*)d_in[19]; const float* norm_ffn_g = (const float*)d_in[21];
    const float* rgw = (const float*)d_in[22]; const float* rgb = (const float*)d_in[23]; const float* rew = (const float*)d_in[24]; const float* reb = (const float*)d_in[25];
    const float* ew1 = (const float*)d_in[26]; const float* ew3 = (const float*)d_in[27]; const float* ew2 = (const float*)d_in[28]; const float* final_g = (const float*)d_in[29];
    char* ws = (char*)d_ws;
    bf16_t* XN = (bf16_t*)(ws + mk::WS_XN); bf16_t* PROJ = (bf16_t*)(ws + mk::WS_PROJ); bf16_t* SBO = (bf16_t*)(ws + mk::WS_SBO);
    bf16_t* O1 = (bf16_t*)(ws + mk::WS_O1); bf16_t* O2 = (bf16_t*)(ws + mk::WS_O2); bf16_t* Y = (bf16_t*)(ws + mk::WS_Y); float* H = (float*)(ws + mk::WS_H);
    bf16_t* YS = (bf16_t*)(ws + mk::WS_YS);
    float2* ST = (float2*)(ws + mk::WS_S5); float* G1 = (float*)(ws + mk::WS_S5 + 128 * mk::MiB); float* SY = (float*)(ws + mk::WS_S5 + 144 * mk::MiB);
    (void)hipMemsetAsync(ws + mk::WS_CTL, 0, mk::CTL_ZERO_BYTES, stream);
    mk::MArgs a{};
    for (int i = 0; i < 30; ++i) a.in[i] = (const float*)d_in[i];
    a.out = (float*)d_out; a.ws = (unsigned char*)d_ws;
    int li = 0;
    mk::mk_launch(a, 0, mk::NPHASE, li, stream);
}
```

```cpp
#include <hip/hip_runtime.h>
#include <hip/hip_bf16.h>
#include <cstdint>
#include <cstdio>
#include <cmath>
__device__ __forceinline__ int opaque_tid() { int t = threadIdx.x; asm volatile("" : "+v"(t)); return t; }
namespace nv {
constexpr int NB = 4, L = 2048, D = 2048, T = NB * L, DEPTH = 2;
constexpr int SBW = 512, SBH = 8, SSMW = 512, SG = 32, SN = 64, SC = 16, DFW = 1024, DFH = 8, DFV = 128;
constexpr int INC = 5120, NEXP = 32, EPG = 8, NGRP = 4, DE = 512;
constexpr int C_SBQ = 0, C_SBK = 512, C_SBV = 1024, C_U = 1536, C_DQ = 2048, C_DK = 3072, C_DV = 4096;
constexpr float EPS = 1e-6f;
constexpr float LOG2E = 1.4426950408889634f;
constexpr float QS_SB = 0.125f * LOG2E, QS_DF = 0.125f * LOG2E;

typedef unsigned short bf16_t;
__device__ __forceinline__ float bf2f(bf16_t v) { return __uint_as_float(((unsigned)v) << 16); }
__device__ __forceinline__ bf16_t f2bf(float f) { unsigned u = __float_as_uint(f); return (bf16_t)((u + 0x7fffu + ((u >> 16) & 1u)) >> 16); }

__device__ __forceinline__ float block_sum(float v, float* red) {
    for (int o = 32; o > 0; o >>= 1) v += __shfl_xor(v, o);
    const int w = threadIdx.x >> 6, nw = blockDim.x >> 6;
    __syncthreads();
    if ((threadIdx.x & 63) == 0) red[w] = v;
    __syncthreads();
    float s = 0.f;
    for (int i = 0; i < nw; ++i) s += red[i];
    return s;
}
__device__ __forceinline__ float block_max(float v, float* red) {
    for (int o = 32; o > 0; o >>= 1) v = fmaxf(v, __shfl_xor(v, o));
    const int w = threadIdx.x >> 6, nw = blockDim.x >> 6;
    __syncthreads();
    if ((threadIdx.x & 63) == 0) red[w] = v;
    __syncthreads();
    float s = -INFINITY;
    for (int i = 0; i < nw; ++i) s = fmaxf(s, red[i]);
    return s;
}

__global__ void __launch_bounds__(256) k_rmsnorm(const float* __restrict__ x, const float* __restrict__ g, bf16_t* __restrict__ out) {
    __shared__ float red[16];
    const int t = blockIdx.x; const float* xr = x + (size_t)t * D;
    float v[8]; float s = 0.f;
    for (int i = 0; i < 8; ++i) { v[i] = xr[threadIdx.x + 256 * i]; s += v[i] * v[i]; }
    s = block_sum(s, red);
    const float r = rsqrtf(s / D + EPS);
    for (int i = 0; i < 8; ++i) out[(size_t)t * D + threadIdx.x + 256 * i] = f2bf(v[i] * r * g[threadIdx.x + 256 * i]);
}

template <int EPI>
__global__ void __launch_bounds__(256) k_gemm(const bf16_t* __restrict__ A, int lda, const float* __restrict__ Bm, int ldb, int K,
                                             void* __restrict__ Cout, int ldc, const float* __restrict__ R) {
    __shared__ float As[16][68];
    __shared__ float Bs[16][68];
    const int tx = threadIdx.x & 15, ty = threadIdx.x >> 4;
    const int m0 = blockIdx.y * 64, n0 = blockIdx.x * 64;
    float acc[4][4];
    for (int i = 0; i < 4; ++i) for (int j = 0; j < 4; ++j) acc[i][j] = 0.f;
    for (int k0 = 0; k0 < K; k0 += 16) {
        for (int e = threadIdx.x; e < 64 * 16; e += 256) { const int r = e >> 4, c = e & 15; As[c][r] = bf2f(A[(size_t)(m0 + r) * lda + k0 + c]); }
        for (int e = threadIdx.x; e < 64 * 16; e += 256) { const int r = e >> 6, c = e & 63; Bs[r][c] = Bm[(size_t)(k0 + r) * ldb + n0 + c]; }
        __syncthreads();
#pragma unroll
        for (int k = 0; k < 16; ++k) {
            float a[4], b[4];
            for (int i = 0; i < 4; ++i) a[i] = As[k][ty * 4 + i];
            for (int j = 0; j < 4; ++j) b[j] = Bs[k][tx * 4 + j];
            for (int i = 0; i < 4; ++i) for (int j = 0; j < 4; ++j) acc[i][j] += a[i] * b[j];
        }
        __syncthreads();
    }
    for (int i = 0; i < 4; ++i) for (int j = 0; j < 4; ++j) {
        const int m = m0 + ty * 4 + i, n = n0 + tx * 4 + j;
        if (EPI == 0) {
            float sc = 1.f; if (n < C_SBK) sc = QS_SB; else if (n >= C_DQ && n < C_DK) sc = QS_DF;
            ((bf16_t*)Cout)[(size_t)m * ldc + n] = f2bf(acc[i][j] * sc);
        } else {
            ((float*)Cout)[(size_t)m * ldc + n] = acc[i][j] + R[(size_t)m * ldc + n];
        }
    }
}

__global__ void __launch_bounds__(256) k_sb_attn(const bf16_t* __restrict__ P, bf16_t* __restrict__ O) {
    __shared__ float zs[L];
    __shared__ float qv[64];
    __shared__ float part[4][64];
    const int t = blockIdx.x, h = blockIdx.y, b = blockIdx.z, tid = threadIdx.x;
    const size_t rowb = (size_t)b * L;
    if (tid < 64) qv[tid] = bf2f(P[(rowb + t) * INC + C_SBQ + h * 64 + tid]);
    __syncthreads();
    for (int s = tid; s < t; s += 256) {
        const bf16_t* kr = P + (rowb + s) * INC + C_SBK + h * 64;
        float z = 0.f;
        for (int d = 0; d < 64; ++d) z += qv[d] * bf2f(kr[d]);
        zs[s] = z;
    }
    __syncthreads();
    if (tid == 0) {
        float Racc = 0.f;
        for (int s = t - 1; s >= 0; --s) {
            const float z = zs[s];
            const float sp = fmaxf(-z, 0.f) + log1pf(expf(-fabsf(z)));
            zs[s] = expf(-sp + Racc);
            Racc += -(sp + z);
        }
    }
    __syncthreads();
    const int d = tid & 63, gq = tid >> 6;
    float o = 0.f;
    for (int s = gq; s < t; s += 4) o += zs[s] * bf2f(P[(rowb + s) * INC + C_SBV + h * 64 + d]);
    part[gq][d] = o;
    __syncthreads();
    if (tid < 64) O[(rowb + t) * SBW + h * 64 + tid] = f2bf(part[0][tid] + part[1][tid] + part[2][tid] + part[3][tid]);
}

__global__ void __launch_bounds__(256) k_diff_attn(const bf16_t* __restrict__ P, bf16_t* __restrict__ O1, bf16_t* __restrict__ O2) {
    __shared__ float ps[L];
    __shared__ float qv[64];
    __shared__ float part[2][128];
    __shared__ float red[16];
    const int t = blockIdx.x, h = blockIdx.y >> 1, mp = blockIdx.y & 1, b = blockIdx.z, tid = threadIdx.x;
    const size_t rowb = (size_t)b * L;
    if (tid < 64) qv[tid] = bf2f(P[(rowb + t) * INC + C_DQ + h * 128 + mp * 64 + tid]);
    __syncthreads();
    float mx = -INFINITY;
    for (int s = tid; s <= t; s += 256) {
        const bf16_t* kr = P + (rowb + s) * INC + C_DK + h * 128 + mp * 64;
        float z = 0.f;
        for (int d = 0; d < 64; ++d) z += qv[d] * bf2f(kr[d]);
        ps[s] = z; mx = fmaxf(mx, z);
    }
    mx = block_max(mx, red);
    float sum = 0.f;
    for (int s = tid; s <= t; s += 256) { const float p = exp2f(ps[s] - mx); ps[s] = p; sum += p; }
    sum = block_sum(sum, red);
    __syncthreads();
    const int d = tid & 127, gq = tid >> 7;
    float o = 0.f;
    for (int s = gq; s <= t; s += 2) o += ps[s] * bf2f(P[(rowb + s) * INC + C_DV + h * 128 + d]);
    part[gq][d] = o;
    __syncthreads();
    if (tid < 128) { bf16_t* O = mp ? O2 : O1; O[(rowb + t) * DFW + h * 128 + tid] = f2bf((part[0][tid] + part[1][tid]) / sum); }
}

__global__ void __launch_bounds__(64) k_s5_scan(const bf16_t* __restrict__ P, const float* lam_re, const float* lam_im, const float* b_re, const float* b_im,
                                                const float* log_dt, float2* __restrict__ ST) {
    const int b = blockIdx.x / SG, g = blockIdx.x % SG, n = threadIdx.x;
    const double dt = exp((double)log_dt[g]);
    const double lr = lam_re[g * SN + n], li = lam_im[g * SN + n];
    const double er = exp(lr * dt), lbr = er * cos(li * dt), lbi = er * sin(li * dt);
    const double nr = lbr - 1.0, ni = lbi, den = lr * lr + li * li;
    const double fr = (nr * lr + ni * li) / den, fi = (ni * lr - nr * li) / den;
    float bbr[SC], bbi[SC];
#pragma unroll
    for (int c = 0; c < SC; ++c) { const double br = b_re[(g * SN + n) * SC + c], bi = b_im[(g * SN + n) * SC + c]; bbr[c] = (float)(fr * br - fi * bi); bbi[c] = (float)(fr * bi + fi * br); }
    const float ar = (float)lbr, ai = (float)lbi;
    float sr = 0.f, si = 0.f;
    for (int t = 0; t < L; ++t) {
        const bf16_t* ur = P + ((size_t)b * L + t) * INC + C_U + g * SC;
        float bur = 0.f, bui = 0.f;
#pragma unroll
        for (int c = 0; c < SC; ++c) { const float u = bf2f(ur[c]); bur += bbr[c] * u; bui += bbi[c] * u; }
        const float nsr = ar * sr - ai * si + bur, nsi = ar * si + ai * sr + bui;
        sr = nsr; si = nsi;
        ST[(((size_t)b * L + t) * SG + g) * SN + n] = make_float2(sr, si);
    }
}
__device__ __forceinline__ float gelu_tanh(float x) { const float u = 0.7978845608028654f * (x + 0.044715f * x * x * x); return 0.5f * x * (1.f + tanhf(u)); }
__global__ void __launch_bounds__(256) k_s5_out(const bf16_t* __restrict__ P, const float2* __restrict__ ST, const float* c_re, const float* c_im, const float* dsk, float* __restrict__ G1) {
    const size_t idx = (size_t)blockIdx.x * 256 + threadIdx.x;
    const int ch = (int)(idx % SSMW); const size_t t = idx / SSMW; const int g = ch / SC, c = ch % SC;
    const float2* st = ST + (t * SG + g) * SN;
    float y = 0.f;
    for (int n = 0; n < SN; ++n) { const float2 s = st[n]; y += c_re[(g * SC + c) * SN + n] * s.x - c_im[(g * SC + c) * SN + n] * s.y; }
    y += dsk[g * SC + c] * bf2f(P[t * INC + C_U + ch]);
    G1[idx] = gelu_tanh(y);
}
__global__ void __launch_bounds__(512) k_glu(const float* __restrict__ G1, const float* __restrict__ w, const float* __restrict__ bg, float* __restrict__ SY) {
    __shared__ float row[SSMW];
    const int t = blockIdx.x, j = threadIdx.x;
    row[j] = G1[(size_t)t * SSMW + j];
    __syncthreads();
    float z = bg[j];
    for (int k = 0; k < SSMW; ++k) z += row[k] * w[(size_t)k * SSMW + j];
    SY[(size_t)t * SSMW + j] = row[j] / (1.f + expf(-z));
}
__global__ void __launch_bounds__(256) k_post(const bf16_t* __restrict__ SBO, const float* __restrict__ SY, const bf16_t* __restrict__ O1, const bf16_t* __restrict__ O2,
                                             const float* sbg, const float* ssmg, const float* dfg, const float* lq1, const float* lk1, const float* lq2, const float* lk2,
                                             float lam_init, bf16_t* __restrict__ Y) {
    __shared__ float red[16];
    const int t = blockIdx.x, tid = threadIdx.x;
    float a = 0.f, c = 0.f;
    if (tid < 64) { a = lq1[tid] * lk1[tid]; c = lq2[tid] * lk2[tid]; }
    a = block_sum(a, red); c = block_sum(c, red);
    const float lam = expf(a) - expf(c) + lam_init;
    { float v0 = bf2f(SBO[(size_t)t * SBW + tid]), v1 = bf2f(SBO[(size_t)t * SBW + 256 + tid]);
      const float s = block_sum(v0 * v0 + v1 * v1, red); const float r = rsqrtf(s / SBW + EPS);
      Y[(size_t)t * D + tid] = f2bf(v0 * r * sbg[tid]); Y[(size_t)t * D + 256 + tid] = f2bf(v1 * r * sbg[256 + tid]); }
    { float v0 = SY[(size_t)t * SSMW + tid], v1 = SY[(size_t)t * SSMW + 256 + tid];
      const float s = block_sum(v0 * v0 + v1 * v1, red); const float r = rsqrtf(s / SSMW + EPS);
      Y[(size_t)t * D + 512 + tid] = f2bf(v0 * r * ssmg[tid]); Y[(size_t)t * D + 768 + tid] = f2bf(v1 * r * ssmg[256 + tid]); }
    for (int i = 0; i < 4; ++i) {
        const int e = tid + 256 * i; const int dv = e & 127;
        const float v = bf2f(O1[(size_t)t * DFW + e]) - lam * bf2f(O2[(size_t)t * DFW + e]);
        float s = v * v;
        for (int o = 32; o > 0; o >>= 1) s += __shfl_xor(s, o);
        __syncthreads();
        if ((tid & 63) == 0) red[tid >> 6] = s;
        __syncthreads();
        const int w = tid >> 6; const float tot = red[w & ~1] + red[(w & ~1) + 1];
        const float r = rsqrtf(tot / DFV + EPS);
        Y[(size_t)t * D + 1024 + e] = f2bf(v * r * dfg[dv] * (1.f - lam_init));
    }
}
__global__ void __launch_bounds__(256) k_route(const float* __restrict__ H, const float* __restrict__ g, const float* __restrict__ rgw, const float* __restrict__ rgb,
                                              const float* __restrict__ rew, const float* __restrict__ reb, bf16_t* __restrict__ HN, int* __restrict__ EI, float* __restrict__ EW) {
    __shared__ float red[16];
    __shared__ float hn[D];
    const int t = blockIdx.x, tid = threadIdx.x;
    float s = 0.f;
    for (int i = 0; i < 8; ++i) { const float v = H[(size_t)t * D + tid + 256 * i]; hn[tid + 256 * i] = v; s += v * v; }
    s = block_sum(s, red);
    const float r = rsqrtf(s / D + EPS);
    for (int i = 0; i < 8; ++i) { const int d = tid + 256 * i; const float v = hn[d] * r * g[d]; hn[d] = v; HN[(size_t)t * D + d] = f2bf(v); }
    __syncthreads();
    float gl[NGRP];
#pragma unroll
    for (int j = 0; j < NGRP; ++j) { float p = 0.f; for (int i = 0; i < 8; ++i) { const int d = tid + 256 * i; p += hn[d] * rgw[(size_t)d * NGRP + j]; } gl[j] = block_sum(p, red) + rgb[j]; }
    int gi = 0; float gm = gl[0];
#pragma unroll
    for (int j = 1; j < NGRP; ++j) if (gl[j] > gm) { gm = gl[j]; gi = j; }
    float gs = 0.f;
#pragma unroll
    for (int j = 0; j < NGRP; ++j) gs += expf(gl[j] - gm);
    const float gtop = 1.f / gs;
    float m0 = -INFINITY, m1 = -INFINITY; int i0 = 0, i1 = 0;
#pragma unroll
    for (int e = 0; e < EPG; ++e) { float p = 0.f; for (int i = 0; i < 8; ++i) { const int d = tid + 256 * i; p += hn[d] * rew[((size_t)gi * D + d) * EPG + e]; }
        const float v = block_sum(p, red) + reb[gi * EPG + e];
        if (v > m0) { m1 = m0; i1 = i0; m0 = v; i0 = e; } else if (v > m1) { m1 = v; i1 = e; } }
    const float p1 = expf(m1 - m0);
    const float w0 = 1.f / (1.f + p1) * gtop, w1 = p1 / (1.f + p1) * gtop;
    if (tid == 0) { EI[t * 2] = gi * EPG + i0; EI[t * 2 + 1] = gi * EPG + i1; EW[t * 2] = w0; EW[t * 2 + 1] = w1; }
}
__global__ void __launch_bounds__(512) k_moe_h(const bf16_t* __restrict__ HN, const int* __restrict__ EI, const float* __restrict__ EW, const float* __restrict__ w1, const float* __restrict__ w3, float* __restrict__ HB) {
    __shared__ float xr[D];
    const int ts = blockIdx.x, t = ts >> 1, f = threadIdx.x;
    for (int i = 0; i < 4; ++i) xr[f + 512 * i] = bf2f(HN[(size_t)t * D + f + 512 * i]);
    __syncthreads();
    const int e = EI[ts]; const float gw = EW[ts];
    const float* a1 = w1 + (size_t)e * D * DE + f; const float* a3 = w3 + (size_t)e * D * DE + f;
    float a = 0.f, b = 0.f;
    for (int d = 0; d < D; ++d) { a += xr[d] * a1[(size_t)d * DE]; b += xr[d] * a3[(size_t)d * DE]; }
    HB[(size_t)ts * DE + f] = a / (1.f + expf(-a)) * b * gw;
}
__global__ void __launch_bounds__(512) k_moe_y(const float* __restrict__ HB, const int* __restrict__ EI, const float* __restrict__ w2, bf16_t* __restrict__ YS) {
    __shared__ float hr[DE];
    const int ts = blockIdx.x, j = threadIdx.x;
    hr[j] = HB[(size_t)ts * DE + j];
    __syncthreads();
    const int e = EI[ts];
    const float* w = w2 + (size_t)e * DE * D;
    float acc[4] = {0.f, 0.f, 0.f, 0.f};
    for (int f = 0; f < DE; ++f) { const float hv = hr[f]; for (int i = 0; i < 4; ++i) acc[i] += hv * w[(size_t)f * D + j + 512 * i]; }
    for (int i = 0; i < 4; ++i) YS[(size_t)ts * D + j + 512 * i] = f2bf(acc[i]);
}
__global__ void __launch_bounds__(256) k_combine(float* __restrict__ H, const bf16_t* __restrict__ YS, const float* __restrict__ g, bf16_t* __restrict__ XN, float* __restrict__ out) {
    __shared__ float red[16];
    const int t = blockIdx.x, tid = threadIdx.x;
    float v[8]; float s = 0.f;
    for (int i = 0; i < 8; ++i) { const int d = tid + 256 * i; v[i] = H[(size_t)t * D + d] + bf2f(YS[((size_t)t * 2) * D + d]) + bf2f(YS[((size_t)t * 2 + 1) * D + d]); s += v[i] * v[i]; }
    s = block_sum(s, red);
    const float r = rsqrtf(s / D + EPS);
    for (int i = 0; i < 8; ++i) { const int d = tid + 256 * i;
        if (out) out[(size_t)t * D + d] = v[i] * r * g[d];
        else { H[(size_t)t * D + d] = v[i]; XN[(size_t)t * D + d] = f2bf(v[i] * r * g[d]); } }
}
}

namespace pg8 {
#define PG8_LAS __attribute__((address_space(3)))
typedef unsigned short bf16_t;
typedef short bf16x8 __attribute__((ext_vector_type(8)));
typedef float f32x4 __attribute__((ext_vector_type(4)));
typedef unsigned u32x4 __attribute__((ext_vector_type(4)));
constexpr int BM = 256, BK = 64, HALF = 128, HTB = HALF * BK * 2  , STAGE_BYTES = 8 * HTB, NXCD = 8, WGM = 8;

__host__ __device__ __forceinline__ int lds_byte(int r, int c) { const int st = (r >> 4) * 2 + (c >> 5), rr = r & 15, cc = c & 31, ob = rr * 64 + cc * 2; return st * 1024 + (ob ^ (((ob >> 9) & 1) << 5)); }
__host__ __device__ __forceinline__ void stage_rc(int b, int& R, int& C) { const int st = b / 1024, sb = b % 1024, swz = sb ^ (((sb >> 9) & 1) << 5); R = (st >> 1) * 16 + swz / 64; C = (st & 1) * 32 + (swz % 64) / 2; }
__host__ __device__ __forceinline__ int perm32(int rho) { const int n = rho >> 4, i = rho & 15; return 8 * (i >> 2) + 4 * n + (i & 3); }

struct Unit { int pm, pn; };
struct Gemm { const bf16_t* A; const bf16_t* Bt; int M, N, K; };

struct StaticOrder {
    int nM, nN, nwg, G, c;
    __host__ __device__ void init(int M, int N, int G_, int c_) { nM = M / BM; nN = N / BM; nwg = nM * nN; G = G_; c = c_; }
    __host__ __device__ bool next(int i, Unit& u) const {
        const long L = (long)i * G + c; if (L >= nwg) return false;
        int wgid = (int)L; { const int q = nwg / NXCD, r = nwg % NXCD, xcd = wgid % NXCD, off = wgid / NXCD; wgid = (xcd < r ? xcd * (q + 1) : r * (q + 1) + (xcd - r) * q) + off; }
        const int nig = WGM * nN, gid = wgid / nig, fm = gid * WGM, gsz = (nM - fm) < WGM ? (nM - fm) : WGM;
        u.pm = fm + ((wgid % nig) % gsz); u.pn = (wgid % nig) / gsz; return true;
    }
    __device__ __forceinline__ void a_ready(const Unit&) const {}
    __device__ __forceinline__ void done(const Unit&) const {}
};

__device__ __forceinline__ unsigned cvt_pk_bf16(float lo, float hi) { unsigned r; asm volatile("v_cvt_pk_bf16_f32 %0, %1, %2" : "=v"(r) : "v"(lo), "v"(hi)); return r; }
typedef float f32x2 __attribute__((ext_vector_type(2)));
__device__ __forceinline__ f32x2 gelu_pk(f32x2 v) {
    const f32x2 av = __builtin_elementwise_abs(v), d = av * 0.2316418882f + 1.0f;
    f32x2 t; t.x = __builtin_amdgcn_rcpf(d.x); t.y = __builtin_amdgcn_rcpf(d.y);
    f32x2 q = t * 0.5307027145f + (-0.7265760135f); q = q * t + 0.7107068705f; q = q * t + (-0.142248368f); q = q * t + 0.127414796f; q = q * t;
    const f32x2 s = (v * v) * (-0.72134752044f);
    f32x2 e; e.x = __builtin_amdgcn_exp2f(s.x); e.y = __builtin_amdgcn_exp2f(s.y);
    const f32x2 m = v * (q * e), r = v - m;
    f32x2 o; o.x = v.x < 0.f ? m.x : r.x; o.y = v.y < 0.f ? m.y : r.y; return o;
}

template <int ACT  > struct EpiBf16 {
    static constexpr bool PERM = true, AFTER_DRAIN = false; static_assert(ACT == 0 || ACT == 1, "EpiBf16: ACT is 0 (none) or 1 (gelu_pk)");
    bf16_t* O; int ldc; const float* bias; int split_cols; size_t split_stride; float scale0;
    __device__ __forceinline__ void operator()(const f32x4 (&acc)[2][2][4][2], const Unit& u, int wr, int wc, int fr, int fq) const {
        const int row0 = u.pm * BM + wr * 64 + fr; int colt = u.pn * BM; bf16_t* base = O;
        float sc = 1.f; if (split_cols) { const int t = colt / split_cols; base += (size_t)t * split_stride; colt -= t * split_cols; if (t == 0) sc = scale0; }
        const int col0 = colt + wc * 32 + 8 * fq, bcol0 = u.pn * BM + wc * 32 + 8 * fq;
        f32x4 bv[2][2];
#pragma unroll
        for (int bj = 0; bj < 2; ++bj)
#pragma unroll
            for (int n = 0; n < 2; ++n) bv[bj][n] = bias ? *(const f32x4*)(bias + bcol0 + bj * HALF + 4 * n) : (f32x4){0.f, 0.f, 0.f, 0.f};
#pragma unroll
        for (int ai = 0; ai < 2; ++ai)
#pragma unroll
            for (int m = 0; m < 4; ++m) { bf16_t* rowp = base + (size_t)(row0 + ai * HALF + m * 16) * ldc + col0;
#pragma unroll
                for (int bj = 0; bj < 2; ++bj) { f32x4 v0 = acc[ai][bj][m][0] + bv[bj][0], v1 = acc[ai][bj][m][1] + bv[bj][1];
                    if (ACT == 1) { f32x2 a = gelu_pk((f32x2){v0[0], v0[1]}), b = gelu_pk((f32x2){v0[2], v0[3]}), c = gelu_pk((f32x2){v1[0], v1[1]}), d = gelu_pk((f32x2){v1[2], v1[3]});
                        v0 = (f32x4){a.x, a.y, b.x, b.y}; v1 = (f32x4){c.x, c.y, d.x, d.y}; }
                    v0 = v0 * sc; v1 = v1 * sc; u32x4 w; w.x = cvt_pk_bf16(v0[0], v0[1]); w.y = cvt_pk_bf16(v0[2], v0[3]); w.z = cvt_pk_bf16(v1[0], v1[1]); w.w = cvt_pk_bf16(v1[2], v1[3]);
                    *(u32x4*)(rowp + bj * HALF) = w; } }
    }
};
template <class Epi, class Sched, bool ALIGN_EPI = false, bool SP2 = false>
__device__ __forceinline__ void gemm_phase(PG8_LAS unsigned char* lds, const Gemm g, const Sched& S, const Epi& E) {
    const int tid = opaque_tid(), wid = __builtin_amdgcn_readfirstlane(tid >> 6), lane = tid & 63, wr = wid >> 2, wc = wid & 3, fr = lane & 15, fq = lane >> 4;
    const int K = g.K, nt = K / BK;
    unsigned voffA[2], voffB[2];
#pragma unroll
    for (int i = 0; i < 2; ++i) { int R, C; stage_rc(tid * 16 + i * 8192, R, C); const int Rb = Epi::PERM ? ((R & ~31) + perm32(R & 31)) : R;
        voffA[i] = (unsigned)(R * K + C) * 2u; voffB[i] = (unsigned)(Rb * K + C) * 2u; }
    const size_t kstep = (size_t)(BK * 2);
    const size_t hstep = (size_t)HALF * K * 2;
    const size_t tstep = 2 * hstep;
    const unsigned ldsw = (unsigned)wid * 1024u;
    const int aoff = lds_byte(wr * 64 + fr, fq * 8), boff = lds_byte(wc * 32 + fr, fq * 8);
#define PG8_SA(b, h) (((b) * 2 + (h)) * HTB)
#define PG8_SB(b, h) ((4 + (b) * 2 + (h)) * HTB)
#define PG8_STAGE(bufoff, gbase, voff) do { _Pragma("unroll") for (int _i = 0; _i < 2; ++_i) \
        __builtin_amdgcn_global_load_lds((const unsigned*)((const char*)(gbase) + (voff)[_i]), (PG8_LAS unsigned*)(lds + (bufoff) + ldsw + _i * 8192), 16, 0, 0); } while (0)
#define PG8_LDA(dst, b, h) do { _Pragma("unroll") for (int m = 0; m < 4; ++m) _Pragma("unroll") for (int k = 0; k < 2; ++k) dst[m][k] = *(const PG8_LAS bf16x8*)(lds + PG8_SA(b, h) + aoff + m * 2048 + k * 1024); } while (0)
#define PG8_LDB(dst, b, h) do { _Pragma("unroll") for (int n = 0; n < 2; ++n) _Pragma("unroll") for (int k = 0; k < 2; ++k) dst[n][k] = *(const PG8_LAS bf16x8*)(lds + PG8_SB(b, h) + boff + n * 2048 + k * 1024); } while (0)
#define PG8_MMA(ai, bj, At, Bt) do { __builtin_amdgcn_s_setprio(1); _Pragma("unroll") for (int m = 0; m < 4; ++m) _Pragma("unroll") for (int n = 0; n < 2; ++n) _Pragma("unroll") for (int k = 0; k < 2; ++k) \
        acc[ai][bj][m][n] = __builtin_amdgcn_mfma_f32_16x16x32_bf16(Bt[n][k], At[m][k], acc[ai][bj][m][n], 0, 0, 0); __builtin_amdgcn_s_setprio(0); } while (0)
#define PG8_WAIT_V(n) asm volatile("s_waitcnt vmcnt(" #n ")" ::: "memory")
#define PG8_WAIT_L(n) asm volatile("s_waitcnt lgkmcnt(" #n ")" ::: "memory")
#define PG8_BAR __builtin_amdgcn_s_barrier()
#define PG8_SCHED __builtin_amdgcn_sched_barrier(0)
    Unit cur, nxt; int ui = 0;
    if (!S.next(0, cur)) return;
    f32x4 acc[2][2][4][2];
#pragma unroll
    for (int a = 0; a < 2; ++a)
#pragma unroll
        for (int b = 0; b < 2; ++b)
#pragma unroll
            for (int m = 0; m < 4; ++m)
#pragma unroll
                for (int n = 0; n < 2; ++n) acc[a][b][m][n] = (f32x4){0.f, 0.f, 0.f, 0.f};
    bf16x8 At[4][2], B0[2][2], B1[2][2];
    const char* cA = (const char*)g.A + (size_t)cur.pm * tstep; const char* cB = (const char*)g.Bt + (size_t)cur.pn * tstep;
    S.a_ready(cur);
    if constexpr (SP2) {
        PG8_STAGE(PG8_SB(0, 0), cB, voffB); PG8_STAGE(PG8_SB(0, 1), cB + hstep, voffB); PG8_STAGE(PG8_SA(0, 0), cA, voffA); PG8_STAGE(PG8_SA(0, 1), cA + hstep, voffA);
        if (wr == 1) PG8_BAR;
        PG8_WAIT_V(2); PG8_BAR;
        PG8_STAGE(PG8_SB(1, 0), cB + kstep, voffB); PG8_STAGE(PG8_SA(1, 0), cA + kstep, voffA); PG8_STAGE(PG8_SB(1, 1), cB + hstep + kstep, voffB);
        PG8_WAIT_V(6); PG8_BAR;
    } else {
        PG8_STAGE(PG8_SB(0, 0), cB, voffB); PG8_STAGE(PG8_SA(0, 0), cA, voffA); PG8_STAGE(PG8_SB(0, 1), cB + hstep, voffB); PG8_STAGE(PG8_SA(0, 1), cA + hstep, voffA);
        if (wr == 1) PG8_BAR;
        PG8_WAIT_V(4); PG8_BAR;
        PG8_STAGE(PG8_SB(1, 0), cB + kstep, voffB); PG8_STAGE(PG8_SA(1, 0), cA + kstep, voffA); PG8_STAGE(PG8_SB(1, 1), cB + hstep + kstep, voffB);
        PG8_WAIT_V(6); PG8_BAR;
    }
    for (;;) {
        const bool has_next = S.next(ui + 1, nxt);
        const char* nA = has_next ? (const char*)g.A + (size_t)nxt.pm * tstep : cA; const char* nB = has_next ? (const char*)g.Bt + (size_t)nxt.pn * tstep : cB;
        for (int t = 0; t < nt; t += 2) {
            const bool last = (t == nt - 2);
            const char* a1 = cA + (size_t)(t + 1) * kstep;
            const char* a2 = last ? nA : cA + (size_t)(t + 2) * kstep; const char* b2 = last ? nB : cB + (size_t)(t + 2) * kstep;
            const char* a3 = a2 + kstep; const char* b3 = b2 + kstep;
            if (last && has_next) S.a_ready(nxt);
            if constexpr (SP2) {
            PG8_LDB(B0, 0, 0); PG8_LDB(B1, 0, 1); PG8_SCHED; PG8_LDA(At, 0, 0); PG8_STAGE(PG8_SA(1, 1), a1 + hstep, voffA);
            PG8_WAIT_V(8); PG8_WAIT_L(0); PG8_BAR; PG8_MMA(0, 0, At, B0); PG8_MMA(0, 1, At, B1); PG8_BAR; PG8_SCHED;
            PG8_LDA(At, 0, 1); PG8_STAGE(PG8_SB(0, 0), b2, voffB); PG8_STAGE(PG8_SB(0, 1), b2 + hstep, voffB); PG8_STAGE(PG8_SA(0, 0), a2, voffA);
            PG8_WAIT_V(8); PG8_WAIT_L(0); PG8_BAR; PG8_MMA(1, 0, At, B0); PG8_MMA(1, 1, At, B1); PG8_BAR; PG8_SCHED;
            PG8_LDB(B0, 1, 0); PG8_LDB(B1, 1, 1); PG8_SCHED; PG8_LDA(At, 1, 0); PG8_STAGE(PG8_SA(0, 1), a2 + hstep, voffA);
            PG8_WAIT_V(8); PG8_WAIT_L(0); PG8_BAR; PG8_MMA(0, 0, At, B0); PG8_MMA(0, 1, At, B1); PG8_BAR; PG8_SCHED;
            PG8_LDA(At, 1, 1); PG8_STAGE(PG8_SB(1, 0), b3, voffB); PG8_STAGE(PG8_SB(1, 1), b3 + hstep, voffB); PG8_STAGE(PG8_SA(1, 0), a3, voffA);
            PG8_WAIT_V(8); PG8_WAIT_L(0); PG8_BAR; PG8_MMA(1, 0, At, B0); PG8_MMA(1, 1, At, B1); PG8_BAR; PG8_SCHED;
            } else {
            PG8_LDB(B0, 0, 0); PG8_SCHED; PG8_LDA(At, 0, 0); PG8_STAGE(PG8_SA(1, 1), a1 + hstep, voffA);
            PG8_WAIT_L(8); PG8_BAR; PG8_WAIT_L(0); PG8_MMA(0, 0, At, B0); PG8_BAR; PG8_SCHED;
            PG8_LDB(B1, 0, 1); PG8_STAGE(PG8_SB(0, 0), b2, voffB);
            PG8_BAR; PG8_WAIT_L(0); PG8_MMA(0, 1, At, B1); PG8_BAR;
            PG8_LDA(At, 0, 1); PG8_STAGE(PG8_SA(0, 0), a2, voffA);
            PG8_BAR; PG8_WAIT_L(0); PG8_MMA(1, 0, At, B0); PG8_BAR; PG8_SCHED;
            PG8_STAGE(PG8_SB(0, 1), b2 + hstep, voffB);
            PG8_WAIT_V(6); PG8_BAR; PG8_MMA(1, 1, At, B1); PG8_BAR;
            PG8_LDB(B0, 1, 0); PG8_SCHED; PG8_LDA(At, 1, 0); PG8_STAGE(PG8_SA(0, 1), a2 + hstep, voffA);
            PG8_WAIT_L(8); PG8_BAR; PG8_WAIT_L(0); PG8_MMA(0, 0, At, B0); PG8_BAR; PG8_SCHED;
            PG8_LDB(B1, 1, 1); PG8_STAGE(PG8_SB(1, 0), b3, voffB);
            PG8_BAR; PG8_WAIT_L(0); PG8_MMA(0, 1, At, B1); PG8_BAR;
            PG8_LDA(At, 1, 1); PG8_STAGE(PG8_SA(1, 0), a3, voffA);
            PG8_BAR; PG8_WAIT_L(0); PG8_MMA(1, 0, At, B0); PG8_BAR; PG8_SCHED;
            PG8_STAGE(PG8_SB(1, 1), b3 + hstep, voffB);
            PG8_WAIT_V(6); PG8_BAR; PG8_MMA(1, 1, At, B1); PG8_BAR;
            }
        }
        if constexpr (ALIGN_EPI) { if (wr == 0) PG8_BAR; }
        if constexpr (!Epi::AFTER_DRAIN) { E(acc, cur, wr, wc, fr, fq); S.done(cur); }
        if (!has_next) break;
#pragma unroll
        for (int a = 0; a < 2; ++a)
#pragma unroll
            for (int b = 0; b < 2; ++b)
#pragma unroll
                for (int m = 0; m < 4; ++m)
#pragma unroll
                    for (int n = 0; n < 2; ++n) acc[a][b][m][n] = (f32x4){0.f, 0.f, 0.f, 0.f};
        cur = nxt; cA = nA; cB = nB; ++ui;
        if constexpr (ALIGN_EPI) { if (wr == 1) PG8_BAR; }
    }
    PG8_WAIT_V(0);
    if constexpr (!ALIGN_EPI) { if (wr == 0) PG8_BAR; }
    PG8_BAR;
    if constexpr (Epi::AFTER_DRAIN) { E.fused(acc, cur, wr, wc, fr, fq, lds, wid, lane); S.done(cur); }
#undef PG8_SA
#undef PG8_SB
#undef PG8_STAGE
#undef PG8_LDA
#undef PG8_LDB
#undef PG8_MMA
#undef PG8_WAIT_V
#undef PG8_WAIT_L
#undef PG8_BAR
#undef PG8_SCHED
}
}

#ifndef PG8_SP2
#define PG8_SP2 true
#endif
#ifndef PG8_ALIGN
#define PG8_ALIGN true
#endif
namespace pg8 {
struct UnitG { int pm, pn, e, r0, nvalid; unsigned boff; };
struct GroupedOrder {
    const PG8_LAS int* tab; int nN, G, c; unsigned bstride;
    __device__ __forceinline__ bool next(int i, UnitG& u) const {
        int Lx = i * G + c; const int totH = __builtin_amdgcn_readfirstlane(tab[97]) * nN, totL = __builtin_amdgcn_readfirstlane(tab[130]) * nN;
        if (Lx >= totH + totL) return false;
        const bool light = Lx >= totH; const int off = light ? 98 : 65; if (light) Lx -= totH;
        int e = 0;
#pragma unroll 4
        for (int k = 1; k < 32; ++k) { const int s = __builtin_amdgcn_readfirstlane(tab[off + k]) * nN; if (Lx >= s) e = k; }
        const int p0 = __builtin_amdgcn_readfirstlane(tab[off + e]), p1 = __builtin_amdgcn_readfirstlane(tab[off + 1 + e]), ce = __builtin_amdgcn_readfirstlane(tab[e]);
        const int m0 = __builtin_amdgcn_readfirstlane(tab[32 + e]);
        const int idx = Lx - p0 * nN, ne = p1 - p0; const int pn = idx / ne; int mtl = idx - pn * ne;
        if (light) mtl = (ce + 127) >> 8;
        u.pm = m0 + mtl; u.pn = pn; u.e = e; u.r0 = mtl * 256; u.nvalid = ce - mtl * 256; u.boff = (unsigned)e * bstride; return true;
    }
};
template <class Epi, bool GATHER>
__device__ __forceinline__ void gemm_phase_g(PG8_LAS unsigned char* lds, const Gemm g, const GroupedOrder& S, const Epi& E, const int* __restrict__ LIST) {
    const int tid = opaque_tid(), wid = __builtin_amdgcn_readfirstlane(tid >> 6), lane = tid & 63, wr = wid >> 2, wc = wid & 3, fr = lane & 15, fq = lane >> 4;
    const int K = g.K, nt = K / BK;
    unsigned voffB[2]; int RA[2], CA[2];
#pragma unroll
    for (int i = 0; i < 2; ++i) { int R, C; stage_rc(tid * 16 + i * 8192, R, C); const int Rb = Epi::PERM ? ((R & ~31) + perm32(R & 31)) : R;
        RA[i] = R; CA[i] = C; voffB[i] = (unsigned)(Rb * K + C) * 2u; }
    const size_t kstep = (size_t)(BK * 2);
    const size_t hstepB = (size_t)HALF * K * 2;
    const size_t tstepB = 2 * hstepB;
    const unsigned ldsw = (unsigned)wid * 1024u;
    const int aoff = lds_byte(wr * 64 + fr, fq * 8), boff = lds_byte(wc * 32 + fr, fq * 8);
#define PG8_SA(b, h) (((b) * 2 + (h)) * HTB)
#define PG8_SB(b, h) ((4 + (b) * 2 + (h)) * HTB)
#define PG8_STAGE(bufoff, gbase, voff) do { _Pragma("unroll") for (int _i = 0; _i < 2; ++_i) \
        __builtin_amdgcn_global_load_lds((const unsigned*)((const char*)(gbase) + (voff)[_i]), (PG8_LAS unsigned*)(lds + (bufoff) + ldsw + _i * 8192), 16, 0, 0); } while (0)
#define PG8_LDA(dst, b, h) do { _Pragma("unroll") for (int m = 0; m < 4; ++m) _Pragma("unroll") for (int k = 0; k < 2; ++k) dst[m][k] = *(const PG8_LAS bf16x8*)(lds + PG8_SA(b, h) + aoff + m * 2048 + k * 1024); } while (0)
#define PG8_LDB(dst, b, h) do { _Pragma("unroll") for (int n = 0; n < 2; ++n) _Pragma("unroll") for (int k = 0; k < 2; ++k) dst[n][k] = *(const PG8_LAS bf16x8*)(lds + PG8_SB(b, h) + boff + n * 2048 + k * 1024); } while (0)
#define PG8_MMA(ai, bj, At, Bt) do { __builtin_amdgcn_s_setprio(1); _Pragma("unroll") for (int m = 0; m < 4; ++m) _Pragma("unroll") for (int n = 0; n < 2; ++n) _Pragma("unroll") for (int k = 0; k < 2; ++k) \
        acc[ai][bj][m][n] = __builtin_amdgcn_mfma_f32_16x16x32_bf16(Bt[n][k], At[m][k], acc[ai][bj][m][n], 0, 0, 0); __builtin_amdgcn_s_setprio(0); } while (0)
#define PG8_WAIT_V(n) asm volatile("s_waitcnt vmcnt(" #n ")" ::: "memory")
#define PG8_WAIT_L(n) asm volatile("s_waitcnt lgkmcnt(" #n ")" ::: "memory")
#define PG8_BAR __builtin_amdgcn_s_barrier()
#define PG8_SCHED __builtin_amdgcn_sched_barrier(0)
#define PG8_AOFF(u, vo) do { _Pragma("unroll") for (int _h = 0; _h < 2; ++_h) _Pragma("unroll") for (int _i = 0; _i < 2; ++_i) { const int _r = _h * HALF + RA[_i]; int _row; \
        if (GATHER) { _row = 0; if (_r < (u).nvalid) _row = LIST[(u).e * 8192 + (u).r0 + _r] >> 1; } else _row = (u).pm * BM + _r; \
        (vo)[_h][_i] = (unsigned)(_row * K + CA[_i]) * 2u; } } while (0)
    UnitG cur, nxt; int ui = 0;
    if (!S.next(0, cur)) return;
    f32x4 acc[2][2][4][2];
#pragma unroll
    for (int a = 0; a < 2; ++a)
#pragma unroll
        for (int b = 0; b < 2; ++b)
#pragma unroll
            for (int m = 0; m < 4; ++m)
#pragma unroll
                for (int n = 0; n < 2; ++n) acc[a][b][m][n] = (f32x4){0.f, 0.f, 0.f, 0.f};
    bf16x8 At[4][2], B0[2][2], B1[2][2];
    unsigned vA[2][2], vN[2][2];
    PG8_AOFF(cur, vA);
    const char* gA = (const char*)g.A;
    const char* cB = (const char*)g.Bt + cur.boff + (size_t)cur.pn * tstepB;
    PG8_STAGE(PG8_SB(0, 0), cB, voffB); PG8_STAGE(PG8_SB(0, 1), cB + hstepB, voffB); PG8_STAGE(PG8_SA(0, 0), gA, vA[0]); PG8_STAGE(PG8_SA(0, 1), gA, vA[1]);
    if (wr == 1) PG8_BAR;
    PG8_WAIT_V(2); PG8_BAR;
    PG8_STAGE(PG8_SB(1, 0), cB + kstep, voffB); PG8_STAGE(PG8_SA(1, 0), gA + kstep, vA[0]); PG8_STAGE(PG8_SB(1, 1), cB + hstepB + kstep, voffB);
    PG8_WAIT_V(6); PG8_BAR;
    for (;;) {
        const bool has_next = S.next(ui + 1, nxt);
        if (has_next) { PG8_AOFF(nxt, vN); } else {
#pragma unroll
            for (int _h = 0; _h < 2; ++_h)
#pragma unroll
                for (int _i = 0; _i < 2; ++_i) vN[_h][_i] = vA[_h][_i]; }
        const char* nB = has_next ? (const char*)g.Bt + nxt.boff + (size_t)nxt.pn * tstepB : cB;
        const bool heavy = cur.nvalid > HALF;
        for (int t = 0; t < nt; t += 2) {
            const bool last = (t == nt - 2);
            const char* a1 = gA + (size_t)(t + 1) * kstep;
            const char* a2 = last ? gA : gA + (size_t)(t + 2) * kstep; const char* b2 = last ? nB : cB + (size_t)(t + 2) * kstep;
            const char* a3 = a2 + kstep; const char* b3 = b2 + kstep;
            unsigned v2a[2], v2b[2];
#pragma unroll
            for (int _i = 0; _i < 2; ++_i) { v2a[_i] = last ? vN[0][_i] : vA[0][_i]; v2b[_i] = last ? vN[1][_i] : vA[1][_i]; }
            PG8_LDB(B0, 0, 0); PG8_LDB(B1, 0, 1); PG8_SCHED; PG8_LDA(At, 0, 0); PG8_STAGE(PG8_SA(1, 1), a1, vA[1]);
            PG8_WAIT_V(8); PG8_WAIT_L(0); PG8_BAR; PG8_MMA(0, 0, At, B0); PG8_MMA(0, 1, At, B1); PG8_BAR; PG8_SCHED;
            PG8_LDA(At, 0, 1); PG8_STAGE(PG8_SB(0, 0), b2, voffB); PG8_STAGE(PG8_SB(0, 1), b2 + hstepB, voffB); PG8_STAGE(PG8_SA(0, 0), a2, v2a);
            PG8_WAIT_V(8); PG8_WAIT_L(0); PG8_BAR; if (heavy) { PG8_MMA(1, 0, At, B0); PG8_MMA(1, 1, At, B1); } PG8_BAR; PG8_SCHED;
            PG8_LDB(B0, 1, 0); PG8_LDB(B1, 1, 1); PG8_SCHED; PG8_LDA(At, 1, 0); PG8_STAGE(PG8_SA(0, 1), a2, v2b);
            PG8_WAIT_V(8); PG8_WAIT_L(0); PG8_BAR; PG8_MMA(0, 0, At, B0); PG8_MMA(0, 1, At, B1); PG8_BAR; PG8_SCHED;
            PG8_LDA(At, 1, 1); PG8_STAGE(PG8_SB(1, 0), b3, voffB); PG8_STAGE(PG8_SB(1, 1), b3 + hstepB, voffB); PG8_STAGE(PG8_SA(1, 0), a3, v2a);
            PG8_WAIT_V(8); PG8_WAIT_L(0); PG8_BAR; if (heavy) { PG8_MMA(1, 0, At, B0); PG8_MMA(1, 1, At, B1); } PG8_BAR; PG8_SCHED;
        }
        if (wr == 0) PG8_BAR;
        E(acc, cur, wr, wc, fr, fq);
        if (!has_next) break;
#pragma unroll
        for (int a = 0; a < 2; ++a)
#pragma unroll
            for (int b = 0; b < 2; ++b)
#pragma unroll
                for (int m = 0; m < 4; ++m)
#pragma unroll
                    for (int n = 0; n < 2; ++n) acc[a][b][m][n] = (f32x4){0.f, 0.f, 0.f, 0.f};
        cur = nxt; cB = nB; ++ui;
#pragma unroll
        for (int _h = 0; _h < 2; ++_h)
#pragma unroll
            for (int _i = 0; _i < 2; ++_i) vA[_h][_i] = vN[_h][_i];
        if (wr == 1) PG8_BAR;
    }
    PG8_WAIT_V(0);
    PG8_BAR;
#undef PG8_AOFF
#undef PG8_SA
#undef PG8_SB
#undef PG8_STAGE
#undef PG8_LDA
#undef PG8_LDB
#undef PG8_MMA
#undef PG8_WAIT_V
#undef PG8_WAIT_L
#undef PG8_BAR
#undef PG8_SCHED
}
__device__ __forceinline__ float silu_f(float a) { return a * __builtin_amdgcn_rcpf(1.f + __builtin_amdgcn_exp2f(-1.4426950408889634f * a)); }
struct EpiMoe1 {
    static constexpr bool PERM = true, AFTER_DRAIN = false;
    bf16_t* HB; const int* LIST; const float* GATEW;
    __device__ __forceinline__ void operator()(const f32x4 (&acc)[2][2][4][2], const UnitG& u, int wr, int wc, int fr, int fq) const {
        int idx[2][4]; f32x2 gr[2][4];
#pragma unroll
        for (int ai = 0; ai < 2; ++ai)
#pragma unroll
            for (int m = 0; m < 4; ++m) { const int r = ai * HALF + wr * 64 + m * 16 + fr; idx[ai][m] = (r < u.nvalid) ? LIST[u.e * 8192 + u.r0 + r] : -1; }
#pragma unroll
        for (int ai = 0; ai < 2; ++ai)
#pragma unroll
            for (int m = 0; m < 4; ++m) gr[ai][m] = (idx[ai][m] >= 0) ? *(const f32x2*)(GATEW + 2 * idx[ai][m]) : (f32x2){0.f, 0.f};
#pragma unroll
        for (int ai = 0; ai < 2; ++ai)
#pragma unroll
            for (int m = 0; m < 4; ++m) { const int r = ai * HALF + wr * 64 + m * 16 + fr;
                const float gate = gr[ai][m].x, rr = gr[ai][m].y;
                bf16_t* rowp = HB + (size_t)(u.pm * BM + r) * 512 + u.pn * 128 + wc * 32 + 8 * fq;
                const f32x4 a0 = acc[ai][0][m][0], a1 = acc[ai][0][m][1], b0 = acc[ai][1][m][0], b1 = acc[ai][1][m][1];
                f32x4 h0, h1;
#pragma unroll
                for (int j = 0; j < 4; ++j) { h0[j] = silu_f(a0[j] * rr) * (b0[j] * rr) * gate; h1[j] = silu_f(a1[j] * rr) * (b1[j] * rr) * gate; }
                u32x4 w; w.x = cvt_pk_bf16(h0[0], h0[1]); w.y = cvt_pk_bf16(h0[2], h0[3]); w.z = cvt_pk_bf16(h1[0], h1[1]); w.w = cvt_pk_bf16(h1[2], h1[3]);
                *(u32x4*)rowp = w; }
    }
};
struct EpiMoe2 {
    static constexpr bool PERM = true, AFTER_DRAIN = false;
    bf16_t* YS; const int* LIST;
    __device__ __forceinline__ void operator()(const f32x4 (&acc)[2][2][4][2], const UnitG& u, int wr, int wc, int fr, int fq) const {
        int idx[2][4];
#pragma unroll
        for (int ai = 0; ai < 2; ++ai)
#pragma unroll
            for (int m = 0; m < 4; ++m) { const int r = ai * HALF + wr * 64 + m * 16 + fr; idx[ai][m] = (r < u.nvalid) ? LIST[u.e * 8192 + u.r0 + r] : -1; }
#pragma unroll
        for (int ai = 0; ai < 2; ++ai)
#pragma unroll
            for (int m = 0; m < 4; ++m) {
                if (idx[ai][m] >= 0) { bf16_t* rowp = YS + (size_t)idx[ai][m] * 2048 + u.pn * BM + wc * 32 + 8 * fq;
#pragma unroll
                    for (int bj = 0; bj < 2; ++bj) { const f32x4 v0 = acc[ai][bj][m][0], v1 = acc[ai][bj][m][1];
                        u32x4 w; w.x = cvt_pk_bf16(v0[0], v0[1]); w.y = cvt_pk_bf16(v0[2], v0[3]); w.z = cvt_pk_bf16(v1[0], v1[1]); w.w = cvt_pk_bf16(v1[2], v1[3]);
                        *(u32x4*)(rowp + bj * HALF) = w; } } }
    }
};
}
#include <hip/hip_bf16.h>
#include <cmath>
namespace attn_body {
using bf16=__hip_bfloat16;
using bf16x8=__attribute__((ext_vector_type(8)))short;
using s16x4=__attribute__((ext_vector_type(4)))short;
using f32x16=__attribute__((ext_vector_type(16)))float;
using u32x4=__attribute__((ext_vector_type(4)))unsigned;
constexpr int SEQ=2048,D=64,DM=5120;
constexpr int NW=8,QBLK=32,QB=QBLK*NW,KVBLK=64,NQB=SEQ/QB;
constexpr int ATTN_UNIT_ROWS=QB;
__device__ __forceinline__ int crow(int r,int hi){return (r&3)+8*(r>>2)+4*hi;}
#define SBAR() __builtin_amdgcn_sched_barrier(0)
__device__ __forceinline__ void cmask(f32x16&p0,f32x16&p1,int jb,int qrel,int hi){
  const float NEG=-INFINITY; int kb=64*jb+4*hi;
  #pragma unroll
  for(int r=0;r<16;++r){int kv=kb+(r&3)+8*(r>>2); if(kv>qrel)p0[r]=NEG; if(kv+32>qrel)p1[r]=NEG;}
}

constexpr int NSLOT=3, SLOTB=8192;
constexpr int LDS_K=0, LDS_V=NSLOT*SLOTB, LDS_WS=2*NSLOT*SLOTB, LDS_OST=LDS_WS+NW*64*4, LDS_BYTES=LDS_OST+NW*4096;
constexpr float C2=0.125f*1.4426950408889634f;
__device__ __forceinline__ void glds16(const void*gsrc,unsigned lds_dst){unsigned keep;
  asm volatile("s_mov_b32 %0, m0\n\ts_mov_b32 m0, %2\n\ts_nop 0\n\tglobal_load_lds_dwordx4 %1, off\n\ts_mov_b32 m0, %0":"=&s"(keep):"v"(gsrc),"s"(lds_dst):"memory");}
__device__ __forceinline__ float max3f(float a,float b,float c){float r;asm("v_max3_f32 %0, %1, %2, %3":"=v"(r):"v"(a),"v"(b),"v"(c));return r;}
__device__ __forceinline__ float max2f(float a,float b){float r;asm("v_max_f32_e32 %0, %1, %2":"=v"(r):"v"(a),"v"(b));return r;}
__device__ __forceinline__ float fadd_s(float a,float b){float r;asm("v_add_f32_e32 %0, %1, %2":"=v"(r):"v"(a),"v"(b));return r;}
__device__ __forceinline__ float fsub_s(float a,float b){float r;asm("v_sub_f32_e32 %0, %1, %2":"=v"(r):"v"(a),"v"(b));return r;}
typedef float f32x2_t __attribute__((ext_vector_type(2))); typedef __bf16 bf16x2_t __attribute__((ext_vector_type(2)));
__device__ __forceinline__ unsigned cvtpk_s(float lo,float hi){f32x2_t v={lo,hi};bf16x2_t b=__builtin_convertvector(v,bf16x2_t);return __builtin_bit_cast(unsigned,b);}
#define WAIT_BAR(N) asm volatile("s_waitcnt vmcnt(" #N ") lgkmcnt(0)\n\ts_barrier":::"memory")

__device__ __forceinline__ void qkt(f32x16&p0,f32x16&p1,const char*Kslot,const bf16x8*qr,const f32x16&negm,int r32,int hi){
  const char*kb=Kslot+hi*1024+r32*16;
  #pragma unroll
  for(int d0=0;d0<4;++d0){
    const bf16x8 b0=*reinterpret_cast<const bf16x8*>(kb+d0*2048);
    const bf16x8 b1=*reinterpret_cast<const bf16x8*>(kb+d0*2048+512);
    if(d0==0){p0=__builtin_amdgcn_mfma_f32_32x32x16_bf16(b0,qr[0],negm,0,0,0);p1=__builtin_amdgcn_mfma_f32_32x32x16_bf16(b1,qr[0],negm,0,0,0);}
    else{p0=__builtin_amdgcn_mfma_f32_32x32x16_bf16(b0,qr[d0],p0,0,0,0);p1=__builtin_amdgcn_mfma_f32_32x32x16_bf16(b1,qr[d0],p1,0,0,0);}}
}
typedef __attribute__((address_space(3))) const char* lds_cptr;
typedef short v4i16_t __attribute__((ext_vector_type(4)));
__device__ __forceinline__ void kload8(bf16x8*kf,lds_cptr kp){
  kf[0]=*(const __attribute__((address_space(3))) bf16x8*)(kp);      kf[1]=*(const __attribute__((address_space(3))) bf16x8*)(kp+512);
  kf[2]=*(const __attribute__((address_space(3))) bf16x8*)(kp+2048); kf[3]=*(const __attribute__((address_space(3))) bf16x8*)(kp+2560);
  kf[4]=*(const __attribute__((address_space(3))) bf16x8*)(kp+4096); kf[5]=*(const __attribute__((address_space(3))) bf16x8*)(kp+4608);
  kf[6]=*(const __attribute__((address_space(3))) bf16x8*)(kp+6144); kf[7]=*(const __attribute__((address_space(3))) bf16x8*)(kp+6656);
}
__device__ __forceinline__ void kload2(bf16x8*kf,lds_cptr kp,int j){ kf[2*j]=*(const __attribute__((address_space(3))) bf16x8*)(kp+j*2048); kf[2*j+1]=*(const __attribute__((address_space(3))) bf16x8*)(kp+j*2048+512); }
__device__ __forceinline__ s16x4 vtr(lds_cptr p){ return __builtin_bit_cast(s16x4,__builtin_amdgcn_ds_read_tr16_b64_v4i16((__attribute__((address_space(3))) v4i16_t*)p)); }
__device__ __forceinline__ float rowmax(const f32x16&p0,const f32x16&p1){
  float a=max3f(p0[0],p0[1],p1[0]),b=max3f(p0[2],p0[3],p1[1]);a=max3f(a,p1[2],p1[3]);
  #pragma unroll
  for(int r=4;r<16;r+=4){a=max3f(a,p0[r],p0[r+1]);b=max3f(b,p0[r+2],p0[r+3]);a=max3f(a,p1[r],p1[r+1]);b=max3f(b,p1[r+2],p1[r+3]);}
  const float m=max2f(a,b);
  auto rr=__builtin_amdgcn_permlane32_swap(__float_as_uint(m),__float_as_uint(m),false,false);
  return max2f(__uint_as_float(rr[0]),__uint_as_float(rr[1]));
}
__device__ __forceinline__ void pv(f32x16*o,int vb,bf16x8 pa0,bf16x8 pa1,bf16x8 pa2,bf16x8 pa3){
  #pragma unroll
  for(int d0=0;d0<2;++d0){s16x4 lo[4],hi[4];
    #pragma unroll
    for(int ks=0;ks<4;++ks){
      asm volatile("ds_read_b64_tr_b16 %0,%1 offset:%c2":"=&v"(lo[ks]):"v"(vb),"i"(d0*4096+ks*1024):"memory");
      asm volatile("ds_read_b64_tr_b16 %0,%1 offset:%c2":"=&v"(hi[ks]):"v"(vb),"i"(d0*4096+ks*1024+512):"memory");}
    asm volatile("s_waitcnt lgkmcnt(0)":::"memory");SBAR();
    #define PK(k) (bf16x8){lo[k][0],lo[k][1],lo[k][2],lo[k][3],hi[k][0],hi[k][1],hi[k][2],hi[k][3]}
    o[d0]=__builtin_amdgcn_mfma_f32_32x32x16_bf16(pa0,PK(0),o[d0],0,0,0);
    o[d0]=__builtin_amdgcn_mfma_f32_32x32x16_bf16(pa1,PK(1),o[d0],0,0,0);
    o[d0]=__builtin_amdgcn_mfma_f32_32x32x16_bf16(pa2,PK(2),o[d0],0,0,0);
    o[d0]=__builtin_amdgcn_mfma_f32_32x32x16_bf16(pa3,PK(3),o[d0],0,0,0);
    #undef PK
  }
}

#ifndef ATTN_STORE16
#define ATTN_STORE16(p,v) (*(u32x4*)(p)=(v))
#endif
template<int THRL> __device__ __forceinline__ void attn_unit(int b,int qb,const bf16*Q,const bf16*__restrict__ K,const bf16*__restrict__ V,bf16*O,int opitch,char*shm){
  const int tid=opaque_tid(),lane=tid&63,r32=lane&31,hi=lane>>5; const int wid=__builtin_amdgcn_readfirstlane(tid>>6);
  const long rowbase=(long)b*SEQ; const int q0=qb*QB;
  const bf16*Qw=Q+(rowbase+q0+wid*QBLK)*DM;
  const bf16*Kh=K+rowbase*DM,*Vh=V+rowbase*DM;
  const unsigned lds0=(unsigned)(uintptr_t)shm;
  float*wsf=(float*)(shm+LDS_WS)+wid*64;
  const bf16*ksrc=Kh+(long)lane*DM+wid*8;
  const bf16*vsrc=Vh+(long)(16*(wid&3)+(lane>>2))*DM+(wid>>2)*32+(lane&3)*8;
  const unsigned kdst=lds0+LDS_K+wid*1024, vdst=lds0+LDS_V+wid*1024;
  #define DMA_K(t,slot) glds16(ksrc+(long)(t)*KVBLK*DM,(unsigned)__builtin_amdgcn_readfirstlane(kdst+(slot)))
  #define DMA_V(t,slot) glds16(vsrc+(long)(t)*KVBLK*DM,(unsigned)__builtin_amdgcn_readfirstlane(vdst+(slot)))
  const int vb0=(int)(lds0+LDS_V)+((lane>>4)&1)*32+(lane&3)*8+(4*hi+((lane&15)>>2))*64;
  const char*Kbase=shm+LDS_K; bf16x8 kf[8];
  const lds_cptr shm3=(lds_cptr)shm; const lds_cptr kp0=shm3+LDS_K+hi*1024+r32*16; const lds_cptr vp0=shm3+LDS_V+((lane>>4)&1)*32+(lane&3)*8+(4*hi+((lane&15)>>2))*64;
  const int NT=(q0+QB)/KVBLK;
  DMA_K(0,0);DMA_V(0,0);DMA_K(1,SLOTB);
  bf16x8 qr[4];
  #pragma unroll
  for(int d0=0;d0<4;++d0)qr[d0]=*reinterpret_cast<const bf16x8*>(&Qw[(long)r32*DM+d0*16+hi*8]);
  float mhat=0.f,l_reg=0.f;f32x16 o[2];o[0]=f32x16{};o[1]=f32x16{};f32x16 negm=f32x16{};asm volatile("":"+v"(negm));
  const int qrel=wid*QBLK+r32;
  #define CMASK(P0,P1,t) do{int jb_=(t)-(NT-4); if(jb_>=0)cmask(P0,P1,jb_,qrel,hi);}while(0)
  bool resc=false;
  #define START(P0,P1) do{ const float rm=rowmax(P0,P1); resc=false; \
    { const float dl=rm; mhat=fadd_s(mhat,dl); \
      _Pragma("unroll") for(int r=0;r<16;++r){P0[r]=fsub_s(P0[r],dl);P1[r]=fsub_s(P1[r],dl);} \
      _Pragma("unroll") for(int r=0;r<16;++r)negm[r]=-mhat; asm volatile("":"+v"(negm)); } \
    _Pragma("unroll") for(int r=0;r<16;++r)P0[r]=__builtin_amdgcn_exp2f(P0[r]); }while(0)
  #define RESC() do{ if(resc){ asm volatile("s_waitcnt lgkmcnt(0)":::"memory"); \
      _Pragma("unroll") for(int d_=0;d_<2;++d_) _Pragma("unroll") for(int r=0;r<16;++r)o[d_][r]*=wsf[crow(r,hi)]; } }while(0)
  f32x16 pA0,pA1,pB0,pB1;
  int sl_prev=0,sl_cur=0,sl_next=SLOTB;
  #define ROT() do{sl_prev=sl_cur;sl_cur=sl_next;sl_next=(sl_next==(NSLOT-1)*SLOTB)?0:sl_next+SLOTB;}while(0)
  DMA_K(2,2*SLOTB);
  WAIT_BAR(3);
  qkt(pA0,pA1,Kbase,qr,negm,r32,hi);asm volatile("s_nop 15\n\ts_nop 7":"+v"(pA0),"+v"(pA1));CMASK(pA0,pA1,0);
  START(pA0,pA1);
  _Pragma("unroll") for(int r=0;r<16;++r)pA1[r]=__builtin_amdgcn_exp2f(pA1[r]);
  WAIT_BAR(0);
  DMA_K(3,0);DMA_V(1,SLOTB);
  ROT();
  kload8(kf,kp0+sl_cur);
  WAIT_BAR(2);
  s16x4 vlo[8],vhi[8]; u32x4 pw0,pw1,pw2,pw3;
  #define PKW(P,B) cvtpk_s(P[B],P[B+1])
  #define PAF(k) __builtin_bit_cast(bf16x8,pw##k)
  #define VFR(i) (bf16x8){vlo[i][0],vlo[i][1],vlo[i][2],vlo[i][3],vhi[i][0],vhi[i][1],vhi[i][2],vhi[i][3]}
  #define PIN(x) asm volatile("":"+v"(x))
  #define MX3(a,b,c) __builtin_fmaxf(__builtin_fmaxf((a),(b)),(c))
  #define GAPA(MF,A0,A1,A2,A3,W0,W1,PW) do{ MF; sacc+=A0; sacc+=A1; sacc+=A2; sacc+=A3; PIN(sacc); W0; W1; PIN(PW); SBAR(); }while(0)
  #define EX(v) __builtin_amdgcn_exp2f(v)
  #define GAPB(MF,X,B) do{ MF; X[B]=EX(X[B]); X[B+1]=EX(X[B+1]); X[B+2]=EX(X[B+2]); X[B+3]=EX(X[B+3]); PIN(X); SBAR(); }while(0)
  #define VRD(i) do{ vlo[i]=vtr(vp_+(((i)>>2)*4096+((i)&3)*1024)); vhi[i]=vtr(vp_+(((i)>>2)*4096+((i)&3)*1024+512)); }while(0)
  #define KRD(G,j) do{ if(G){ kload2(kf,kp0+sl_next,j); SBAR(); } }while(0)
  #define STEP(C0,C1,P0,P1,t,GK,GV,GL) do{ SBAR(); \
    const lds_cptr vp_=vp0+sl_prev; \
    VRD(0); SBAR(); float sacc=(P0[0]+P0[1]); \
    GAPA(C0=__builtin_amdgcn_mfma_f32_32x32x16_bf16(kf[0],qr[0],negm,0,0,0), P0[2],P0[3],P0[4],P0[5],     pw0[0]=PKW(P0,0), pw0[1]=PKW(P0,2), pw0); \
    VRD(4); SBAR(); GAPA(C1=__builtin_amdgcn_mfma_f32_32x32x16_bf16(kf[1],qr[0],negm,0,0,0), P0[6],P0[7],P0[8],P0[9],     pw0[2]=PKW(P0,4), pw0[3]=PKW(P0,6), pw0); \
    VRD(1); SBAR(); GAPA(C0=__builtin_amdgcn_mfma_f32_32x32x16_bf16(kf[2],qr[1],C0,0,0,0),   P0[10],P0[11],P0[12],P0[13], pw1[0]=PKW(P0,8), pw1[1]=PKW(P0,10), pw1); \
    VRD(5); SBAR(); GAPA(C1=__builtin_amdgcn_mfma_f32_32x32x16_bf16(kf[3],qr[1],C1,0,0,0),   P0[14],P0[15],P1[0],P1[1],   pw1[2]=PKW(P0,12),pw1[3]=PKW(P0,14), pw1); \
    VRD(2); SBAR(); GAPA(C0=__builtin_amdgcn_mfma_f32_32x32x16_bf16(kf[4],qr[2],C0,0,0,0),   P1[2],P1[3],P1[4],P1[5],     pw2[0]=PKW(P1,0), pw2[1]=PKW(P1,2), pw2); \
    VRD(6); SBAR(); GAPA(C1=__builtin_amdgcn_mfma_f32_32x32x16_bf16(kf[5],qr[2],C1,0,0,0),   P1[6],P1[7],P1[8],P1[9],     pw2[2]=PKW(P1,4), pw2[3]=PKW(P1,6), pw2); \
    VRD(3); SBAR(); GAPA(C0=__builtin_amdgcn_mfma_f32_32x32x16_bf16(kf[6],qr[3],C0,0,0,0),   P1[10],P1[11],P1[12],P1[13], pw3[0]=PKW(P1,8), pw3[1]=PKW(P1,10), pw3); \
    VRD(7); SBAR(); GAPA(C1=__builtin_amdgcn_mfma_f32_32x32x16_bf16(kf[7],qr[3],C1,0,0,0),   P1[14],P1[15],0.f,0.f,       pw3[2]=PKW(P1,12),pw3[3]=PKW(P1,14), pw3); \
    l_reg+=sacc; \
    if(GK){DMA_K((t)+3,sl_cur);} if(GV){DMA_V((t)+1,sl_next);} \
    CMASK(C0,C1,t); \
    { float a=MX3(C0[0],C0[1],C1[0]),b=MX3(C0[2],C0[3],C1[1]); a=MX3(a,C1[2],C1[3]); \
      _Pragma("unroll") for(int r=4;r<16;r+=4){a=MX3(a,C0[r],C0[r+1]);b=MX3(b,C0[r+2],C0[r+3]);a=MX3(a,C1[r],C1[r+1]);b=MX3(b,C1[r+2],C1[r+3]);} \
      float rm=__builtin_fmaxf(a,b); { auto rr=__builtin_amdgcn_permlane32_swap(__float_as_uint(rm),__float_as_uint(rm),false,false); rm=__builtin_fmaxf(__uint_as_float(rr[0]),__uint_as_float(rr[1])); } \
      resc=false; \
      if(__builtin_expect(__any(rm>(float)THRL),0)){ const float dl=__builtin_fmaxf(rm,0.f); mhat+=dl; \
        _Pragma("unroll") for(int r=0;r<16;++r){C0[r]-=dl;C1[r]-=dl;} \
        _Pragma("unroll") for(int r=0;r<16;++r)negm[r]=-mhat; asm volatile("":"+v"(negm)); \
        const float f=__builtin_amdgcn_exp2f(-dl); l_reg*=f; if(hi==0)wsf[r32]=f; resc=true; } } \
    SBAR(); \
    GAPB(o[0]=__builtin_amdgcn_mfma_f32_32x32x16_bf16(PAF(0),VFR(0),o[0],0,0,0), C0,0); \
    GAPB(o[1]=__builtin_amdgcn_mfma_f32_32x32x16_bf16(PAF(0),VFR(4),o[1],0,0,0), C0,4); \
    KRD(GL,0); GAPB(o[0]=__builtin_amdgcn_mfma_f32_32x32x16_bf16(PAF(1),VFR(1),o[0],0,0,0), C0,8); \
    KRD(GL,1); GAPB(o[1]=__builtin_amdgcn_mfma_f32_32x32x16_bf16(PAF(1),VFR(5),o[1],0,0,0), C0,12); \
    KRD(GL,2); GAPB(o[0]=__builtin_amdgcn_mfma_f32_32x32x16_bf16(PAF(2),VFR(2),o[0],0,0,0), C1,0); \
    KRD(GL,3); GAPB(o[1]=__builtin_amdgcn_mfma_f32_32x32x16_bf16(PAF(2),VFR(6),o[1],0,0,0), C1,4); \
    GAPB(o[0]=__builtin_amdgcn_mfma_f32_32x32x16_bf16(PAF(3),VFR(3),o[0],0,0,0), C1,8); \
    GAPB(o[1]=__builtin_amdgcn_mfma_f32_32x32x16_bf16(PAF(3),VFR(7),o[1],0,0,0), C1,12); \
    }while(0)
  int t=1;
  #undef CMASK
  #define CMASK(P0,P1,t) do{}while(0)
  for(;t+5<NT;t+=2){
    STEP(pB0,pB1,pA0,pA1,t,true,true,true);     WAIT_BAR(2); RESC(); ROT();
    STEP(pA0,pA1,pB0,pB1,t+1,true,true,true);   WAIT_BAR(2); RESC(); ROT();
  }
  #undef CMASK
  #define CMASK(P0,P1,t) do{int jb_=(t)-(NT-4); if(jb_>=0)cmask(P0,P1,jb_,qrel,hi);}while(0)
  #define ENDW(tt) do{ if((tt)+3<NT){WAIT_BAR(2);} else if((tt)+2<NT){WAIT_BAR(1);} else {WAIT_BAR(0);} }while(0)
  for(;t+1<NT;t+=2){
    STEP(pB0,pB1,pA0,pA1,t,(t+3<NT),(t+1<NT),(t+1<NT));       ENDW(t);   RESC(); ROT();
    STEP(pA0,pA1,pB0,pB1,t+1,(t+4<NT),(t+2<NT),(t+2<NT));     ENDW(t+1); RESC(); ROT();
  }
  STEP(pB0,pB1,pA0,pA1,NT-1,false,false,false); RESC();
  { float sacc=pB0[0]+pB0[1]; _Pragma("unroll") for(int r=2;r<16;++r)sacc+=pB0[r]; _Pragma("unroll") for(int r=0;r<16;++r)sacc+=pB1[r]; l_reg+=sacc;
    pw0=(u32x4){PKW(pB0,0),PKW(pB0,2),PKW(pB0,4),PKW(pB0,6)};pw1=(u32x4){PKW(pB0,8),PKW(pB0,10),PKW(pB0,12),PKW(pB0,14)};pw2=(u32x4){PKW(pB1,0),PKW(pB1,2),PKW(pB1,4),PKW(pB1,6)};pw3=(u32x4){PKW(pB1,8),PKW(pB1,10),PKW(pB1,12),PKW(pB1,14)};
    SBAR(); pv(o,vb0+sl_cur,PAF(0),PAF(1),PAF(2),PAF(3)); }
  #undef PKW
  #undef PAF
  #undef VFR
  #undef PIN
  #undef MX3
  #undef GAPA
  #undef GAPB
  #undef EX
  #undef VRD
  #undef KRD
  #undef STEP
  #undef ENDW
  {auto rr=__builtin_amdgcn_permlane32_swap(__float_as_uint(l_reg),__float_as_uint(l_reg),false,false);l_reg=__uint_as_float(rr[0])+__uint_as_float(rr[1]);}
  if(hi==0)wsf[32+r32]=l_reg;asm volatile("s_waitcnt lgkmcnt(0)":::"memory");
  float rli[16];
  #pragma unroll
  for(int r=0;r<16;++r)rli[r]=__builtin_amdgcn_rcpf(wsf[32+crow(r,hi)]);
  bf16*Ow=O+(rowbase+q0+wid*QBLK)*opitch;
  { bf16*stg=(bf16*)(shm+LDS_OST)+wid*2048;
    #pragma unroll
    for(int r=0;r<16;++r){const int orow=crow(r,hi);
      #pragma unroll
      for(int d0=0;d0<2;++d0)stg[orow*64+d0*32+r32]=__float2bfloat16(o[d0][r]*rli[r]);}
    asm volatile("s_waitcnt lgkmcnt(0)":::"memory");
    #pragma unroll
    for(int i=0;i<4;++i){const int row=i*8+(lane>>3),ch=lane&7; const u32x4 v=*(const u32x4*)(stg+row*64+ch*8); ATTN_STORE16(Ow+(long)row*opitch+ch*8,v);} }
  asm volatile("s_waitcnt lgkmcnt(0)\n\ts_barrier":::"memory");
  #undef DMA_K
  #undef DMA_V
  #undef CMASK
  #undef START
  #undef RESC
  #undef ROT
}

__device__ __forceinline__ void sb_unit(int b,int qb,const bf16*Q,const bf16*__restrict__ K,const bf16*__restrict__ V,bf16*O,int opitch,char*shm){
  const int tid=opaque_tid(),lane=tid&63,r32=lane&31,hi=lane>>5; const int wid=__builtin_amdgcn_readfirstlane(tid>>6);
  const long rowbase=(long)b*SEQ; const int q0=qb*QB;
  const bf16*Qw=Q+(rowbase+q0+wid*QBLK)*DM;
  const bf16*Kh=K+rowbase*DM,*Vh=V+rowbase*DM;
  const unsigned lds0=(unsigned)(uintptr_t)shm;
  const bf16*ksrc=Kh+(long)lane*DM+wid*8;
  const bf16*vsrc=Vh+(long)(16*(wid&3)+(lane>>2))*DM+(wid>>2)*32+(lane&3)*8;
  const unsigned kdst=lds0+LDS_K+wid*1024, vdst=lds0+LDS_V+wid*1024;
  #define DMA_K(t,slot) glds16(ksrc+(long)(t)*KVBLK*DM,(unsigned)__builtin_amdgcn_readfirstlane(kdst+(slot)))
  #define DMA_V(t,slot) glds16(vsrc+(long)(t)*KVBLK*DM,(unsigned)__builtin_amdgcn_readfirstlane(vdst+(slot)))
  const int vb0=(int)(lds0+LDS_V)+((lane>>4)&1)*32+(lane&3)*8+(4*hi+((lane&15)>>2))*64;
  const char*Kbase=shm+LDS_K;
  const int NT=(q0+QB)/KVBLK;
  int j=NT-1;
  DMA_K(j,(j&1)*SLOTB);DMA_V(j,(j&1)*SLOTB);
  bf16x8 qr[4];
  #pragma unroll
  for(int d0=0;d0<4;++d0)qr[d0]=*reinterpret_cast<const bf16x8*>(&Qw[(long)r32*DM+d0*16+hi*8]);
  f32x16 o[2];o[0]=f32x16{};o[1]=f32x16{};
  float R=0.f;
  const int trow=q0+wid*QBLK+r32;
  const int wmax=q0+wid*QBLK+QBLK-1;
  const float selhi=(hi==0)?1.f:0.f;
  volatile int*flg=(volatile int*)(shm+LDS_WS);
  if(lane==0){flg[wid*16]=0;flg[wid*16+8]=0;}
  #pragma unroll 1
  for(;j>=0;--j){
    WAIT_BAR(0);
    { int nd=0; const int rs=((j+1)&1)*8;
      #pragma unroll
      for(int w8=0;w8<8;++w8)nd+=flg[w8*16+rs];
      if(__builtin_amdgcn_readfirstlane(nd)==8)break; }
    if(j>0){DMA_K(j-1,((j-1)&1)*SLOTB);DMA_V(j-1,((j-1)&1)*SLOTB);}
    const int slot=(j&1)*SLOTB;
    if(!(64*j<wmax)){ if(lane==0)flg[wid*16+(j&1)*8]=0; }
    if(64*j<wmax){
      f32x16 p0,p1; const f32x16 zero=f32x16{};
      qkt(p0,p1,Kbase+slot,qr,zero,r32,hi);
      const int thr=trow-64*j-4*hi;
      f32x16 l0,l1;
      #pragma unroll
      for(int r=0;r<16;++r){
        { const float z=p0[r]; const float lg=__builtin_amdgcn_logf(1.f+__builtin_amdgcn_exp2f(-__builtin_fabsf(z))); const float sp=__builtin_fmaxf(-z,0.f)+lg;
          const bool ok=((r&3)+8*(r>>2))<thr; l0[r]=ok?-(sp+z):0.f; p0[r]=ok?-sp:-INFINITY; }
        { const float z=p1[r]; const float lg=__builtin_amdgcn_logf(1.f+__builtin_amdgcn_exp2f(-__builtin_fabsf(z))); const float sp=__builtin_fmaxf(-z,0.f)+lg;
          const bool ok=((r&3)+8*(r>>2)+32)<thr; l1[r]=ok?-(sp+z):0.f; p1[r]=ok?-sp:-INFINITY; }
      }
      float gs[8],pt[8];
      #pragma unroll
      for(int g=0;g<4;++g){ gs[g]=(l0[4*g]+l0[4*g+1])+(l0[4*g+2]+l0[4*g+3]); gs[4+g]=(l1[4*g]+l1[4*g+1])+(l1[4*g+2]+l1[4*g+3]); }
      #pragma unroll
      for(int g=0;g<8;++g){ auto rr=__builtin_amdgcn_permlane32_swap(__float_as_uint(gs[g]),__float_as_uint(gs[g]),false,false); pt[g]=__uint_as_float(rr[0])+__uint_as_float(rr[1]); }
      float base[8]; float run=R;
      #pragma unroll
      for(int g=7;g>=0;--g){ base[g]=run+selhi*(pt[g]-gs[g]); run+=pt[g]; }
      R=run;
      { const int dn=__all(R<=-152.f)?1:0; if(lane==0)flg[wid*16+(j&1)*8]=dn; }
      #pragma unroll
      for(int g=0;g<4;++g){
        { float a=base[g]; p0[4*g+3]=__builtin_amdgcn_exp2f(p0[4*g+3]+a); a+=l0[4*g+3]; p0[4*g+2]=__builtin_amdgcn_exp2f(p0[4*g+2]+a); a+=l0[4*g+2]; p0[4*g+1]=__builtin_amdgcn_exp2f(p0[4*g+1]+a); a+=l0[4*g+1]; p0[4*g]=__builtin_amdgcn_exp2f(p0[4*g]+a); }
        { float a=base[4+g]; p1[4*g+3]=__builtin_amdgcn_exp2f(p1[4*g+3]+a); a+=l1[4*g+3]; p1[4*g+2]=__builtin_amdgcn_exp2f(p1[4*g+2]+a); a+=l1[4*g+2]; p1[4*g+1]=__builtin_amdgcn_exp2f(p1[4*g+1]+a); a+=l1[4*g+1]; p1[4*g]=__builtin_amdgcn_exp2f(p1[4*g]+a); }
      }
      u32x4 pw0,pw1,pw2,pw3;
      pw0=(u32x4){cvtpk_s(p0[0],p0[1]),cvtpk_s(p0[2],p0[3]),cvtpk_s(p0[4],p0[5]),cvtpk_s(p0[6],p0[7])};
      pw1=(u32x4){cvtpk_s(p0[8],p0[9]),cvtpk_s(p0[10],p0[11]),cvtpk_s(p0[12],p0[13]),cvtpk_s(p0[14],p0[15])};
      pw2=(u32x4){cvtpk_s(p1[0],p1[1]),cvtpk_s(p1[2],p1[3]),cvtpk_s(p1[4],p1[5]),cvtpk_s(p1[6],p1[7])};
      pw3=(u32x4){cvtpk_s(p1[8],p1[9]),cvtpk_s(p1[10],p1[11]),cvtpk_s(p1[12],p1[13]),cvtpk_s(p1[14],p1[15])};
      SBAR();
      pv(o,vb0+slot,__builtin_bit_cast(bf16x8,pw0),__builtin_bit_cast(bf16x8,pw1),__builtin_bit_cast(bf16x8,pw2),__builtin_bit_cast(bf16x8,pw3));
    }
  }
  bf16*Ow=O+(rowbase+q0+wid*QBLK)*opitch;
  { bf16*stg=(bf16*)(shm+LDS_OST)+wid*2048;
    #pragma unroll
    for(int r=0;r<16;++r){const int orow=crow(r,hi);
      #pragma unroll
      for(int d0=0;d0<2;++d0)stg[orow*64+d0*32+r32]=__float2bfloat16(o[d0][r]);}
    asm volatile("s_waitcnt lgkmcnt(0)":::"memory");
    #pragma unroll
    for(int i=0;i<4;++i){const int row=i*8+(lane>>3),ch=lane&7; const u32x4 v=*(const u32x4*)(stg+row*64+ch*8); ATTN_STORE16(Ow+(long)row*opitch+ch*8,v);} }
  asm volatile("s_waitcnt lgkmcnt(0)\n\ts_barrier":::"memory");
  #undef DMA_K
  #undef DMA_V
}
constexpr int ATTN_LDS_BYTES=LDS_BYTES;
#undef SBAR
#undef WAIT_BAR
}
#ifndef PROBE_PH
#define PROBE_PH (-1)
#endif
#define PROBE_AMP 8
#ifndef PROBE_SUB
#define PROBE_SUB (-1)
#endif
#define SUBPROBE(id) do { if (PROBE_SUB >= 0 && bx == 0) { __syncthreads(); if (tid == 0) { const unsigned long long now_ = __builtin_amdgcn_s_memrealtime(); \
        const unsigned long long ps_ = ((unsigned long long)MISC[19] << 32) | MISC[18]; \
        if ((id) == PROBE_SUB) { const unsigned long long dl_ = now_ + PROBE_AMP * (now_ - ps_); while (__builtin_amdgcn_s_memrealtime() < dl_) __builtin_amdgcn_s_sleep(8); } \
        const unsigned long long n1_ = __builtin_amdgcn_s_memrealtime(); MISC[18] = (unsigned)n1_; MISC[19] = (unsigned)(n1_ >> 32); } __syncthreads(); } } while (0)
#ifndef QUOTA_A
#define QUOTA_A 5
#endif
#ifndef QUOTA_F
#define QUOTA_F 6
#endif
#ifndef QUOTA_G
#define QUOTA_G 2
#endif
namespace mk {
using nv::NB; using nv::L; using nv::D; using nv::T; using nv::DEPTH; using nv::INC; using nv::EPS;
constexpr int NWAVES = 8;
constexpr size_t MiB = 1u << 20;
constexpr size_t WS_CTL = 0, CTL_ZERO_BYTES = 1 * MiB;
constexpr size_t WS_WIN = 1 * MiB;
constexpr size_t WS_WOUT = WS_WIN + 40 * MiB;
constexpr size_t WS_XN = WS_WOUT + 16 * MiB;
constexpr size_t WS_PROJ = WS_XN + 32 * MiB;
constexpr size_t WS_SBO = WS_PROJ + 80 * MiB;
constexpr size_t WS_O1 = WS_SBO + 8 * MiB;
constexpr size_t WS_O2 = WS_O1 + 16 * MiB;
constexpr size_t WS_Y = WS_O2 + 16 * MiB;
constexpr size_t WS_H = WS_Y + 32 * MiB;
constexpr size_t WS_YS = WS_H + 64 * MiB;
constexpr size_t WS_HB = WS_YS + 64 * MiB;
constexpr size_t WS_ROUTE = WS_HB + 24 * MiB;
constexpr size_t WS_S5 = WS_ROUTE + 2 * MiB;
constexpr size_t WS_W13 = WS_S5 + 160 * MiB;
constexpr size_t WS_W2 = WS_W13 + 256 * MiB;
constexpr size_t WS_END = WS_W2 + 128 * MiB;
static_assert(WS_END <= 1024 * MiB, "d_ws map must fit 1 GiB");
constexpr int CW_TMO = 0, CW_CODE = 1, CW_Q = 1024;
constexpr int CW_BAR = 4096;
constexpr int MAX_BAR_REGIONS = 40;
constexpr int CW_CNT = 143360;
constexpr int RING_OFF = 0, RING_BYTES = 131072;
constexpr int LDSCTL_OFF = 143360, MISC_OFF = LDSCTL_OFF + 320;
constexpr int LDS_BYTES = 147456;

#define GAS __attribute__((address_space(1)))
#define LAS __attribute__((address_space(3)))
typedef unsigned short bf16;
typedef unsigned v4u __attribute__((ext_vector_type(4)));
typedef float f32x4 __attribute__((ext_vector_type(4)));
typedef short bf16x8 __attribute__((ext_vector_type(8)));
typedef GAS unsigned gu32;
typedef GAS unsigned long long gu64;
#define RLX_AGENT __ATOMIC_RELAXED, __HIP_MEMORY_SCOPE_AGENT
#define LDS_WAIT() asm volatile("s_waitcnt lgkmcnt(0)" ::: "memory")
#define VM_WAIT() asm volatile("s_waitcnt vmcnt(0)" ::: "memory")
__device__ __forceinline__ unsigned long long rt() { return __builtin_amdgcn_s_memrealtime(); }
__device__ __forceinline__ unsigned f2bf(float f) { unsigned u = __builtin_bit_cast(unsigned, f); return (u + 0x7fffu + ((u >> 16) & 1u)) >> 16; }
__device__ __forceinline__ unsigned pk2(float lo, float hi) { return f2bf(lo) | (f2bf(hi) << 16); }

#define XB_TMO      128
#define XB_XCNT(j)  (256  + 64 * (j))
#define XB_XSUB(j)  (1280 + 64 * (j))
#define XB_XGEN(j)  (2304 + 64 * (j))
#define XB_TOP      3328
#define XB_TOPGEN   3392
#define XCD_BAR_WORDS 3456
#define XB_SPIN_CAP (1u << 18)

__device__ __forceinline__ unsigned xb_ld(unsigned* p)              { return __hip_atomic_load(p, __ATOMIC_RELAXED, __HIP_MEMORY_SCOPE_AGENT); }
__device__ __forceinline__ unsigned xb_add(unsigned* p, unsigned v) { return __hip_atomic_fetch_add(p, v, __ATOMIC_RELAXED, __HIP_MEMORY_SCOPE_AGENT); }
__device__ __forceinline__ unsigned xb_xcc_id() { return (unsigned)__builtin_amdgcn_s_getreg((3 << 11) | 20) & 0xFu; }
#define XB_SPIN(cond, bar) do { unsigned _sp = 0; while (cond) { __builtin_amdgcn_s_sleep(1); \
    if ((++_sp & 255u) == 0u) { if (xb_ld(&(bar)[XB_TMO])) break; if (_sp > XB_SPIN_CAP) { atomicAdd(&(bar)[XB_TMO], 1u); break; } } } } while (0)

struct XcdBarrier {
    unsigned* bar; unsigned x;
    volatile LAS unsigned* st;
};

__device__ __forceinline__ XcdBarrier xcd_barrier_post(unsigned* bar, volatile LAS unsigned* st) {
    XcdBarrier b; b.bar = bar; b.x = xb_xcc_id(); b.st = st;
    if (threadIdx.x == 0) (void)xb_add(&bar[XB_XCNT(b.x)], 1u);
    return b;
}
__device__ __forceinline__ void xcd_barrier_complete(unsigned* bar, unsigned x, unsigned& nloc, unsigned& nx) {
    const unsigned G = gridDim.x * gridDim.y * gridDim.z;
    unsigned sum, cnt, mine, sp = 0u;
    for (;;) {
        sum = 0u; cnt = 0u; mine = 0u;
#pragma unroll
        for (unsigned j = 0; j < 16; ++j) { const unsigned c = xb_ld(&bar[XB_XCNT(j)]); sum += c; cnt += (c > 0u) ? 1u : 0u; mine = (j == x) ? c : mine; }
        if (sum == G) break;
        __builtin_amdgcn_s_sleep(1);
        if ((++sp & 255u) == 0u) { if (xb_ld(&bar[XB_TMO])) break; if (sp > XB_SPIN_CAP) { atomicAdd(&bar[XB_TMO], 1u); break; } }
    }
    nloc = mine > 0u ? mine : 1u; nx = cnt > 0u ? cnt : 1u;
}

__device__ __forceinline__ void xcd_barrier(const XcdBarrier& b) {
    asm volatile("s_waitcnt vmcnt(0)" ::: "memory");
    __syncthreads();
    if (threadIdx.x == 0) {
        unsigned* bar = b.bar;
        __builtin_amdgcn_s_waitcnt(0);
        unsigned nloc = b.st[0], nx = b.st[1];
        if (nloc == 0u) { xcd_barrier_complete(bar, b.x, nloc, nx); b.st[0] = nloc; b.st[1] = nx; }
        const unsigned old = xb_add(&bar[XB_XSUB(b.x)], 1u);
        const unsigned gen = old / nloc;
        if (old + 1u == (gen + 1u) * nloc) {
            __builtin_amdgcn_fence(__ATOMIC_RELEASE, "agent");
            asm volatile("s_waitcnt vmcnt(0)" ::: "memory");
            const unsigned og = xb_add(&bar[XB_TOP], 1u);
            const unsigned tg = og / nx;
            if (og + 1u == (tg + 1u) * nx) xb_add(&bar[XB_TOPGEN], 1u);
            else XB_SPIN(xb_ld(&bar[XB_TOPGEN]) == tg, bar);
            __builtin_amdgcn_fence(__ATOMIC_ACQUIRE, "agent");
            xb_add(&bar[XB_XGEN(b.x)], 1u);
            asm volatile("s_waitcnt vmcnt(0)" ::: "memory");
        } else {
            XB_SPIN(xb_ld(&bar[XB_XGEN(b.x)]) == gen, bar);
            __builtin_amdgcn_fence(__ATOMIC_ACQUIRE, "agent");
            asm volatile("s_waitcnt vmcnt(0)" ::: "memory");
        }
    }
    __syncthreads();
}
static_assert((CW_BAR + MAX_BAR_REGIONS * XCD_BAR_WORDS) <= CW_CNT && (CW_CNT + 2 * 2048) * 4 <= (int)CTL_ZERO_BYTES, "barrier regions and expert counters inside the memset region");

__device__ __forceinline__ float wave_sum(float v) {
#pragma unroll
    for (int o = 1; o < 64; o <<= 1) v += __shfl_xor(v, o);
    return v;
}
__device__ __forceinline__ void transpose_tile(const float* __restrict__ W, int N, int k0, int n0, bf16* __restrict__ dst, int Kd, LAS float* scr, int lane) {
    const int kr = lane >> 4, n4 = (lane & 15) * 4;
    f32x4 v[16];
#pragma unroll
    for (int i = 0; i < 16; ++i) v[i] = *(const GAS f32x4*)(W + (size_t)(k0 + i * 4 + kr) * N + n0 + n4);
#pragma unroll
    for (int i = 0; i < 16; ++i) { LAS float* s = scr + (i * 4 + kr) * 65 + n4; s[0] = v[i].x; s[1] = v[i].y; s[2] = v[i].z; s[3] = v[i].w; }
    LDS_WAIT(); asm volatile("" ::: "memory");
    const int c = lane & 7;
#pragma unroll
    for (int j = 0; j < 8; ++j) { const int n = (lane >> 3) + 8 * j; const LAS float* s = scr + (8 * c) * 65 + n;
        v4u o; o.x = pk2(s[0 * 65], s[1 * 65]); o.y = pk2(s[2 * 65], s[3 * 65]); o.z = pk2(s[4 * 65], s[5 * 65]); o.w = pk2(s[6 * 65], s[7 * 65]);
        *(GAS v4u*)(dst + (size_t)n * Kd + k0 + 8 * c) = o; }
    LDS_WAIT(); asm volatile("" ::: "memory");
}
struct TileJob { const float* W; bf16* dst; int N, Kd, k0, n0; };
__device__ __forceinline__ void tile_load(const TileJob& j, f32x4 (&v)[16], int lane) {
    const int kr = lane >> 4, n4 = (lane & 15) * 4;
#pragma unroll
    for (int i = 0; i < 16; ++i) v[i] = __builtin_nontemporal_load((const GAS f32x4*)(j.W + (size_t)(j.k0 + i * 4 + kr) * j.N + j.n0 + n4));
}
__device__ __forceinline__ void tile_store(const TileJob& j, const f32x4 (&v)[16], LAS float* scr, int lane) {
    const int kr = lane >> 4, n4 = (lane & 15) * 4;
#pragma unroll
    for (int i = 0; i < 16; ++i) { LAS float* s = scr + (i * 4 + kr) * 65 + n4; s[0] = v[i].x; s[1] = v[i].y; s[2] = v[i].z; s[3] = v[i].w; }
    LDS_WAIT(); asm volatile("" ::: "memory");
    const int c = lane & 7;
#pragma unroll
    for (int q = 0; q < 8; ++q) { const int n = (lane >> 3) + 8 * q; const LAS float* s = scr + (8 * c) * 65 + n;
        v4u o; o.x = pk2(s[0 * 65], s[1 * 65]); o.y = pk2(s[2 * 65], s[3 * 65]); o.z = pk2(s[4 * 65], s[5 * 65]); o.w = pk2(s[6 * 65], s[7 * 65]);
        *(GAS v4u*)(j.dst + (size_t)n * j.Kd + j.k0 + 8 * c) = o; }
    LDS_WAIT(); asm volatile("" ::: "memory");
}
__device__ __forceinline__ void ex_job(const float* const* in, bf16* W13T, bf16* W2T, int le, int r, TileJob& J) {
    if (r < 512) { const int w3 = r >> 8; r &= 255; const int nb = r & 7, kb = r >> 3, n0 = nb * 64;
        J.W = in[w3 ? 27 : 26] + (size_t)le * nv::D * nv::DE; J.N = nv::DE; J.k0 = kb * 64; J.n0 = n0; J.Kd = nv::D;
        J.dst = W13T + ((size_t)le * 1024 + (n0 >> 7) * 256 + w3 * 128 + (n0 & 127)) * nv::D; }
    else { r -= 512; const int nb = r & 31, kb = r >> 5;
        J.W = in[28] + (size_t)le * nv::DE * nv::D; J.N = nv::D; J.k0 = kb * 64; J.n0 = nb * 64; J.Kd = nv::DE; J.dst = W2T + ((size_t)le * nv::D + nb * 64) * nv::DE; }
}
__device__ __forceinline__ void dense_job(const float* const* in, bf16* WinT, bf16* WoutT, int l, int r, TileJob& J) {
    if (r < 2560) { const int nb = r % 80, kb = r / 80; J.W = in[2] + (size_t)l * nv::D * nv::INC; J.N = nv::INC; J.k0 = kb * 64; J.n0 = nb * 64; J.Kd = nv::D; J.dst = WinT + ((size_t)l * nv::INC + nb * 64) * nv::D; }
    else { r -= 2560; const int nb = r & 31, kb = r >> 5; J.W = in[20] + (size_t)l * nv::D * nv::D; J.N = nv::D; J.k0 = kb * 64; J.n0 = nb * 64; J.Kd = nv::D; J.dst = WoutT + ((size_t)l * nv::D + nb * 64) * nv::D; }
}
struct ConvCtx { const float* const* in; bf16* W13T; bf16* W2T; bf16* WinT; bf16* WoutT; bf16* WG; };
constexpr int Q_W2L0 = 8192, Q_DENSE1 = 11776, Q_TOTAL = 36352, Q_BATCH = 16;
__device__ __forceinline__ void q_job(const ConvCtx& C, int qi, TileJob& J) {
    if (qi < Q_W2L0) ex_job(C.in, C.W13T, C.W2T, qi >> 8, 512 + (qi & 255), J);
    else if (qi < Q_DENSE1) dense_job(C.in, C.WinT, C.WoutT, 1, qi - Q_W2L0, J);
    else { const int q2 = qi - Q_DENSE1; const int le = q2 / 768; ex_job(C.in, C.W13T, C.W2T, 32 + le, q2 - le * 768, J); }
}
constexpr int P0_TILES = 20096;
__device__ __forceinline__ void p0_job(const ConvCtx& C, int it, TileJob& J) {
    if (it < 3584) dense_job(C.in, C.WinT, C.WoutT, 0, it, J);
    else if (it < 3712) { const int r = it - 3584, l = r >> 6, q = r & 63, nb = q & 7, kb = q >> 3; J.W = C.in[12] + (size_t)l * 512 * 512; J.N = 512; J.k0 = kb * 64; J.n0 = nb * 64; J.Kd = 512; J.dst = C.WG + ((size_t)l * 512 + nb * 64) * 512; }
    else { const int r = it - 3712; ex_job(C.in, C.W13T, C.W2T, r >> 9, r & 511, J); }
}
__device__ __forceinline__ void convert_batches(const ConvCtx& C, gu32* qctr, int nb, int limit, volatile LAS unsigned* qslot, LAS unsigned char* ring) {
    const int tid = opaque_tid(), lane = tid & 63, wave = __builtin_amdgcn_readfirstlane(tid >> 6);
    LAS float* scr = (LAS float*)(ring + wave * 16640);
#pragma unroll 1
    for (int b = 0; ; ++b) {
        if (limit <= 0 && b >= nb) break;
        __syncthreads();
        if (tid == 0) { unsigned base = Q_TOTAL; if (limit <= 0 || __hip_atomic_load(qctr, RLX_AGENT) < (unsigned)limit) base = __hip_atomic_fetch_add(qctr, (unsigned)Q_BATCH, RLX_AGENT); qslot[0] = base; }
        __syncthreads();
        const int base = (int)qslot[0];
        if (base >= Q_TOTAL) break;
        f32x4 va[16], vb[16]; TileJob ja, jb;
        q_job(C, base + 2 * wave, ja); tile_load(ja, va, lane);
        q_job(C, base + 2 * wave + 1, jb); tile_load(jb, vb, lane);
        tile_store(ja, va, scr, lane); tile_store(jb, vb, scr, lane);
    }
    __syncthreads();
}
__device__ __forceinline__ void rms_row_to_bf16(const float* xrow, const float* g, bf16* orow, int lane) {
    const GAS f32x4* xr = (const GAS f32x4*)xrow + lane; const GAS f32x4* gr = (const GAS f32x4*)g + lane;
    f32x4 v[8]; float s = 0.f;
#pragma unroll
    for (int j = 0; j < 8; ++j) { v[j] = xr[64 * j]; s += (v[j].x * v[j].x + v[j].y * v[j].y) + (v[j].z * v[j].z + v[j].w * v[j].w); }
    const float r = rsqrtf(wave_sum(s) * (1.f / D) + EPS);
    GAS unsigned long long* o8 = (GAS unsigned long long*)orow + lane;
#pragma unroll
    for (int j = 0; j < 8; ++j) { const f32x4 gg = gr[64 * j]; o8[64 * j] = (unsigned long long)pk2(v[j].x * r * gg.x, v[j].y * r * gg.y) | ((unsigned long long)pk2(v[j].z * r * gg.z, v[j].w * r * gg.w) << 32); }
}
}

namespace pg8 {
struct EpiProj {
    static constexpr bool PERM = true, AFTER_DRAIN = false;
    bf16_t* O; int ldc;
    __device__ __forceinline__ void operator()(const f32x4 (&acc)[2][2][4][2], const Unit& u, int wr, int wc, int fr, int fq) const {
        const int row0 = u.pm * BM + wr * 64 + fr; const int colt = u.pn * BM;
        const float sc = (u.pn < 2) ? nv::QS_SB : ((u.pn >= 8 && u.pn < 12) ? nv::QS_DF : 1.f);
        const int col0 = colt + wc * 32 + 8 * fq;
#pragma unroll
        for (int ai = 0; ai < 2; ++ai)
#pragma unroll
            for (int m = 0; m < 4; ++m) { bf16_t* rowp = O + (size_t)(row0 + ai * HALF + m * 16) * ldc + col0;
#pragma unroll
                for (int bj = 0; bj < 2; ++bj) { const f32x4 v0 = acc[ai][bj][m][0] * sc, v1 = acc[ai][bj][m][1] * sc;
                    u32x4 w; w.x = cvt_pk_bf16(v0[0], v0[1]); w.y = cvt_pk_bf16(v0[2], v0[3]); w.z = cvt_pk_bf16(v1[0], v1[1]); w.w = cvt_pk_bf16(v1[2], v1[3]);
                    *(u32x4*)(rowp + bj * HALF) = w; } }
    }
};
struct EpiResF32 {
    static constexpr bool PERM = false, AFTER_DRAIN = false;
    const float* R; float* out; int ldc;
    __device__ __forceinline__ void operator()(const f32x4 (&acc)[2][2][4][2], const Unit& u, int wr, int wc, int fr, int fq) const {
        const int col0 = u.pn * BM + wc * 32 + 4 * fq;
#pragma unroll
        for (int ai = 0; ai < 2; ++ai) { f32x4 rv[4][2][2];
#pragma unroll
            for (int m = 0; m < 4; ++m) { const size_t off = (size_t)(u.pm * BM + ai * HALF + wr * 64 + m * 16 + fr) * ldc + col0;
#pragma unroll
                for (int bj = 0; bj < 2; ++bj)
#pragma unroll
                    for (int n = 0; n < 2; ++n) rv[m][bj][n] = *(const f32x4*)(R + off + bj * HALF + n * 16); }
#pragma unroll
            for (int m = 0; m < 4; ++m) { const size_t off = (size_t)(u.pm * BM + ai * HALF + wr * 64 + m * 16 + fr) * ldc + col0;
#pragma unroll
                for (int bj = 0; bj < 2; ++bj)
#pragma unroll
                    for (int n = 0; n < 2; ++n) *(f32x4*)(out + off + bj * HALF + n * 16) = acc[ai][bj][m][n] + rv[m][bj][n]; }
            asm volatile("" ::: "memory"); }
    }
};
}

namespace s5 {
using mk::bf16; using mk::f32x4; using mk::bf16x8; using mk::v4u;
typedef float f32x16 __attribute__((ext_vector_type(16)));
typedef float f32x2 __attribute__((ext_vector_type(2)));
constexpr int LC_ = 32, NCH = 64, SG = 32, SN = 64, SC = 16;
constexpr size_t OFF_KT = 0;
constexpr size_t OFF_PT = 1u << 20;
constexpr size_t OFF_LP = 9u << 20;
constexpr size_t OFF_LC = 10u << 20;
constexpr size_t OFF_CB = 11u << 20;
constexpr size_t OFF_WG = 12u << 20;
constexpr size_t OFF_YI = 13u << 20;
constexpr size_t OFF_SE = 29u << 20;

__device__ __forceinline__ void cpow(float lr, float li, float dt, float tau, float& pr, float& pi) {
    const float mag = __builtin_amdgcn_exp2f(tau * lr * dt * 1.4426950408889634f);
    double rev = (double)tau * (double)li * (double)dt * 0.15915494309189535; rev -= __builtin_rint(rev);
    const float rv = (float)rev; pr = mag * __builtin_amdgcn_cosf(rv); pi = mag * __builtin_amdgcn_sinf(rv);
}
__device__ __forceinline__ void zoh_f(float lr, float li, float dt, float& fr, float& fi) {
    float br, bi; cpow(lr, li, dt, 1.f, br, bi);
    const float nr = br - 1.f, ni = bi, den = lr * lr + li * li;
    fr = (nr * lr + ni * li) / den; fi = (ni * lr - nr * li) / den;
}
__device__ __forceinline__ void build_tables(const float* const* in, unsigned char* s5ws, int gt, int NTH) {
    const float* lam_re = in[4]; const float* lam_im = in[5]; const float* b_re = in[6]; const float* b_im = in[7]; const float* c_re = in[8]; const float* c_im = in[9]; const float* log_dt = in[11];
    bf16* KT = (bf16*)(s5ws + OFF_KT); bf16* PT = (bf16*)(s5ws + OFF_PT);
#pragma unroll 1
    for (int it = gt; it < 2 * SG * LC_ * SC; it += NTH) { const int c = it & 15, tau = (it >> 4) & 31, lg = it >> 9;
        const float dt = __expf(log_dt[lg]); float acc[16];
#pragma unroll
        for (int q = 0; q < 16; ++q) acc[q] = 0.f;
#pragma unroll 1
        for (int n = 0; n < SN; ++n) { const float lr = lam_re[lg * SN + n], li = lam_im[lg * SN + n];
            float pr, pi, fr, fi; cpow(lr, li, dt, (float)tau, pr, pi); zoh_f(lr, li, dt, fr, fi);
            const float cr = c_re[(lg * SC + c) * SN + n], ci = c_im[(lg * SC + c) * SN + n];
            const float xr = pr * fr - pi * fi, xi = pr * fi + pi * fr;
            const float wr = cr * xr - ci * xi, wi = cr * xi + ci * xr;
            const f32x4* br4 = (const f32x4*)(b_re + (size_t)(lg * SN + n) * SC); const f32x4* bi4 = (const f32x4*)(b_im + (size_t)(lg * SN + n) * SC);
#pragma unroll
            for (int q = 0; q < 4; ++q) { const f32x4 br = br4[q], bi = bi4[q];
                acc[4 * q] += wr * br.x - wi * bi.x; acc[4 * q + 1] += wr * br.y - wi * bi.y; acc[4 * q + 2] += wr * br.z - wi * bi.z; acc[4 * q + 3] += wr * br.w - wi * bi.w; } }
        v4u o0, o1; o0.x = mk::pk2(acc[0], acc[1]); o0.y = mk::pk2(acc[2], acc[3]); o0.z = mk::pk2(acc[4], acc[5]); o0.w = mk::pk2(acc[6], acc[7]);
        o1.x = mk::pk2(acc[8], acc[9]); o1.y = mk::pk2(acc[10], acc[11]); o1.z = mk::pk2(acc[12], acc[13]); o1.w = mk::pk2(acc[14], acc[15]);
        v4u* dst = (v4u*)(KT + (size_t)it * 16); dst[0] = o0; dst[1] = o1; }
#pragma unroll 1
    for (int it = gt; it < 2 * SG * LC_ * SN; it += NTH) { const int n = it & 63, s = (it >> 6) & 31, lg = it >> 11;
        const float dt = __expf(log_dt[lg]); const float lr = lam_re[lg * SN + n], li = lam_im[lg * SN + n];
        float pr, pi, fr, fi; cpow(lr, li, dt, (float)(31 - s), pr, pi); zoh_f(lr, li, dt, fr, fi);
        const float xr = pr * fr - pi * fi, xi = pr * fi + pi * fr;
        float vr[16], vi[16];
        const f32x4* br4 = (const f32x4*)(b_re + (size_t)(lg * SN + n) * SC); const f32x4* bi4 = (const f32x4*)(b_im + (size_t)(lg * SN + n) * SC);
#pragma unroll
        for (int q = 0; q < 4; ++q) { const f32x4 br = br4[q], bi = bi4[q];
            vr[4 * q] = xr * br.x - xi * bi.x; vr[4 * q + 1] = xr * br.y - xi * bi.y; vr[4 * q + 2] = xr * br.z - xi * bi.z; vr[4 * q + 3] = xr * br.w - xi * bi.w;
            vi[4 * q] = xr * bi.x + xi * br.x; vi[4 * q + 1] = xr * bi.y + xi * br.y; vi[4 * q + 2] = xr * bi.z + xi * br.z; vi[4 * q + 3] = xr * bi.w + xi * br.w; }
        bf16* base = PT + ((size_t)(lg * LC_ + s) * 128) * 16;
        v4u o; v4u* d0 = (v4u*)(base + (size_t)n * 16); v4u* d1 = (v4u*)(base + (size_t)(64 + n) * 16);
        o.x = mk::pk2(vr[0], vr[1]); o.y = mk::pk2(vr[2], vr[3]); o.z = mk::pk2(vr[4], vr[5]); o.w = mk::pk2(vr[6], vr[7]); d0[0] = o;
        o.x = mk::pk2(vr[8], vr[9]); o.y = mk::pk2(vr[10], vr[11]); o.z = mk::pk2(vr[12], vr[13]); o.w = mk::pk2(vr[14], vr[15]); d0[1] = o;
        o.x = mk::pk2(vi[0], vi[1]); o.y = mk::pk2(vi[2], vi[3]); o.z = mk::pk2(vi[4], vi[5]); o.w = mk::pk2(vi[6], vi[7]); d1[0] = o;
        o.x = mk::pk2(vi[8], vi[9]); o.y = mk::pk2(vi[10], vi[11]); o.z = mk::pk2(vi[12], vi[13]); o.w = mk::pk2(vi[14], vi[15]); d1[1] = o; }
    f32x4* LPF = (f32x4*)(s5ws + OFF_LP);
#pragma unroll 1
    for (int it = gt; it < 2 * SG * 2 * 2 * 4 * 64; it += NTH) { const int ln = it & 63, i = (it >> 6) & 3, kh = (it >> 8) & 1, mb = (it >> 9) & 1, lg = it >> 10;
        const int t = 16 * mb + (ln & 15), n = 32 * kh + 8 * (ln >> 4) + 2 * i; const float dt = __expf(log_dt[lg]);
        float ar, ai, br, bi; cpow(lam_re[lg * SN + n], lam_im[lg * SN + n], dt, (float)(t + 1), ar, ai); cpow(lam_re[lg * SN + n + 1], lam_im[lg * SN + n + 1], dt, (float)(t + 1), br, bi);
        LPF[it] = (f32x4){ar, ai, br, bi}; }
    f32x2* L32 = (f32x2*)(s5ws + OFF_LC);
#pragma unroll 1
    for (int it = gt; it < 2 * SG * SN; it += NTH) { const int n = it & 63, lg = it >> 6; const float dt = __expf(log_dt[lg]); float pr, pi; cpow(lam_re[lg * SN + n], lam_im[lg * SN + n], dt, 32.f, pr, pi); L32[it] = (f32x2){pr, pi}; }
    v4u* CBF = (v4u*)(s5ws + OFF_CB);
#pragma unroll 1
    for (int it = gt; it < 2 * SG * 4 * 64; it += NTH) { const int ln = it & 63, ks = (it >> 6) & 3, lg = it >> 8; const int c = ln & 15, n0 = 32 * (ks & 1) + 8 * (ln >> 4);
        const float* src = ((ks >> 1) ? c_im : c_re) + (size_t)(lg * SC + c) * SN + n0; const float sg = (ks >> 1) ? -1.f : 1.f;
        v4u o; o.x = mk::pk2(sg * src[0], sg * src[1]); o.y = mk::pk2(sg * src[2], sg * src[3]); o.z = mk::pk2(sg * src[4], sg * src[5]); o.w = mk::pk2(sg * src[6], sg * src[7]); CBF[it] = o; }
}

__device__ __forceinline__ void s5a_unit(int l, int g, int b, int part, const bf16* PROJ, const unsigned char* s5ws, LAS unsigned char* lds) {
    const int tid = opaque_tid(), lane = tid & 63, wave = __builtin_amdgcn_readfirstlane(tid >> 6), r = lane & 31, h = lane >> 5;
    const bf16* KTg = (const bf16*)(s5ws + OFF_KT) + (size_t)(l * SG + g) * 32 * 256;
    const bf16* PTg = (const bf16*)(s5ws + OFF_PT) + (size_t)(l * SG + g) * 32 * 128 * 16;
    float* YI = (float*)(s5ws + OFF_YI); float* SE = (float*)(s5ws + OFF_SE);
#pragma unroll
    for (int i = 0; i < 8; ++i) { const int p = tid + 512 * i, tok = p >> 1, half = p & 1, chunk = tok >> 5, s = tok & 31;
        const v4u v = *(const GAS v4u*)(PROJ + (size_t)(b * 2048 + tok) * 5120 + nv::C_U + g * 16 + 8 * half);
        *(LAS v4u*)(lds + ((s * 64 + chunk) * 32 + 16 * half)) = v; }
    if (part == 0) {
#pragma unroll
    for (int i = 0; i < 2; ++i) { const int p = tid + 512 * i; const v4u v = *(const GAS v4u*)(KTg + (size_t)p * 8); *(LAS v4u*)(lds + 65536 + 512 + p * 16) = v; }
    }
    { unsigned z0 = 0u; asm volatile("" : "+v"(z0));
      if (tid < 32) *(LAS v4u*)(lds + 65536 + tid * 16) = (v4u){z0, z0, z0, z0}; }
    asm volatile("s_waitcnt vmcnt(0) lgkmcnt(0)" ::: "memory"); __syncthreads();
    const int tl = r >> 4, c = r & 15;
    if (part == 0) {
#pragma unroll 1
    for (int nb = 0; nb < 2; ++nb)
#pragma unroll 1
        for (int half = 0; half < 2; ++half) { const int tb = half ? 15 - wave : wave;
            f32x16 acc = {};
            const LAS unsigned char* ap = lds + 65536 + (2 * tb + tl + 1) * 512 + c * 32 + h * 16;
            const LAS unsigned char* bp = lds + (nb * 32 + r) * 32 + 16 * h;
#pragma unroll 2
            for (int s = 0; s <= 2 * tb + 1; ++s) { const bf16x8 a = *(const LAS bf16x8*)(ap - s * 512); const bf16x8 bb = *(const LAS bf16x8*)(bp + s * 2048);
                acc = __builtin_amdgcn_mfma_f32_32x32x16_bf16(a, bb, acc, 0, 0, 0); }
            const int chunk = nb * 32 + r;
#pragma unroll
            for (int q = 0; q < 4; ++q) { const int tq = q >> 1, c0 = 8 * (q & 1) + 4 * h; const int t = chunk * 32 + 2 * tb + tq;
                *(GAS f32x4*)(YI + (size_t)(b * 2048 + t) * 512 + g * 16 + c0) = (f32x4){acc[4 * q], acc[4 * q + 1], acc[4 * q + 2], acc[4 * q + 3]}; } }
    } else {
    { const int mb = wave >> 1, nb = wave & 1; f32x16 acc = {};
        const bf16* ap = PTg + (size_t)(mb * 32 + r) * 16 + 8 * h; const LAS unsigned char* bp = lds + (nb * 32 + r) * 32 + 16 * h;
#pragma unroll 8
        for (int s = 0; s < 32; ++s) { const bf16x8 a = *(const GAS bf16x8*)(ap + (size_t)s * 128 * 16); const bf16x8 bb = *(const LAS bf16x8*)(bp + s * 2048);
            acc = __builtin_amdgcn_mfma_f32_32x32x16_bf16(a, bb, acc, 0, 0, 0); }
        const int chunk = nb * 32 + r;
        LAS float* SEL = (LAS float*)(lds + 98304);
#pragma unroll
        for (int q = 0; q < 4; ++q) { const int rho = mb * 32 + 8 * q + 4 * h;
#pragma unroll
            for (int i = 0; i < 4; ++i) SEL[(rho + i) * 65 + chunk] = acc[4 * q + i]; } }
    asm volatile("s_waitcnt lgkmcnt(0)" ::: "memory"); __syncthreads();
    if (tid < 64) { const int n = tid; const LAS float* SEL = (const LAS float*)(lds + 98304);
        const f32x2 a32 = ((const f32x2*)(s5ws + OFF_LC))[(size_t)(l * SG + g) * SN + n];
        float sr = 0.f, si = 0.f; float* dst = SE + ((size_t)(b * 64) * 32 + g) * 128 + n;
#pragma unroll 4
        for (int k = 0; k < 64; ++k) { dst[(size_t)k * 32 * 128] = sr; dst[(size_t)k * 32 * 128 + 64] = si;
            const float er = SEL[n * 65 + k], ei = SEL[(64 + n) * 65 + k];
            const float nr = a32.x * sr - a32.y * si + er, ni = a32.x * si + a32.y * sr + ei; sr = nr; si = ni; } }
    }
    asm volatile("s_waitcnt lgkmcnt(0)" ::: "memory"); __syncthreads();
}

__device__ __forceinline__ float gelu_tanh(float x) { const float u = 0.7978845608028654f * (x + 0.044715f * x * x * x); const float e = __builtin_amdgcn_exp2f(2.885390081777927f * u);
    const float th = 1.f - 2.f * __builtin_amdgcn_rcpf(e + 1.f); return 0.5f * x * (1.f + th); }
__device__ __forceinline__ bf16x8 pack8(const float (&v)[8]) { v4u o; o.x = mk::pk2(v[0], v[1]); o.y = mk::pk2(v[2], v[3]); o.z = mk::pk2(v[4], v[5]); o.w = mk::pk2(v[6], v[7]); return __builtin_bit_cast(bf16x8, o); }
__device__ __forceinline__ float bflo(unsigned u) { return __uint_as_float(u << 16); }
__device__ __forceinline__ float bfhi(unsigned u) { return __uint_as_float(u & 0xffff0000u); }

#ifndef PROBE_SUB
#define PROBE_SUB (-1)
#endif
#define S5PROBE(id) do { if (PROBE_SUB >= 10 && blockIdx.x == 0 && l == 0) { __syncthreads(); if (threadIdx.x == 0) { const unsigned long long now_ = __builtin_amdgcn_s_memrealtime(); \
        const unsigned long long ps_ = ((unsigned long long)misc[19] << 32) | misc[18]; \
        if ((id) == PROBE_SUB) { const unsigned long long dl_ = now_ + 8 * (now_ - ps_); while (__builtin_amdgcn_s_memrealtime() < dl_) __builtin_amdgcn_s_sleep(8); } \
        const unsigned long long n1_ = __builtin_amdgcn_s_memrealtime(); misc[18] = (unsigned)n1_; misc[19] = (unsigned)(n1_ >> 32); } __syncthreads(); } } while (0)
__device__ __forceinline__ void post_unit(int l, int b, int k, const float* const* in, const bf16* PROJ, const bf16* SBO, const bf16* O1, const bf16* O2, bf16* Y,
                                          const unsigned char* s5ws, LAS unsigned char* lds, volatile LAS unsigned* misc) {
    const int tid = opaque_tid(), lane = tid & 63, wave = __builtin_amdgcn_readfirstlane(tid >> 6);
    const f32x4* LPF = (const f32x4*)(s5ws + OFF_LP) + (size_t)l * SG * 1024; const bf16x8* CBF = (const bf16x8*)(s5ws + OFF_CB) + (size_t)l * SG * 256;
    const bf16* WG = (const bf16*)(s5ws + OFF_WG) + (size_t)l * 512 * 512;
    const float* YI = (const float*)(s5ws + OFF_YI); const float* SE = (const float*)(s5ws + OFF_SE);
    const float* c_re = in[8] + (size_t)l * SG * SC * SN; const float* c_im = in[9] + (size_t)l * SG * SC * SN; const float* dsk = in[10] + l * 512;
    const float* b_glu = in[13] + l * 512; const float* ssm_g = in[14] + l * 512; const float* sb_g = in[3] + l * 512; const float* df_g = in[19] + l * 128;
    LAS float* SIN = (LAS float*)lds; LAS unsigned short* G1 = (LAS unsigned short*)(lds + 16384); LAS unsigned short* OUTT = (LAS unsigned short*)(lds + 49664); LAS float* RS = (LAS float*)(lds + 82944);
    const size_t tok0 = (size_t)b * 2048 + (size_t)k * 32;
    S5PROBE(10);
#pragma unroll
    for (int q = 0; q < 2; ++q) { const int p = tid + 512 * q; *(LAS f32x4*)(SIN + 4 * p) = *(const GAS f32x4*)(SE + ((size_t)(b * 64 + k) * 32) * 128 + 4 * p); }
    asm volatile("s_waitcnt vmcnt(0) lgkmcnt(0)" ::: "memory"); __syncthreads();
    S5PROBE(11);
    { const int row = lane & 15, kg = lane >> 4;
      float yi[4][2][4], uu[4][2][4], dk[4];
#pragma unroll
      for (int gi = 0; gi < 4; ++gi) { const int ch = (wave * 4 + gi) * SC + row; dk[gi] = dsk[ch];
#pragma unroll
          for (int mb = 0; mb < 2; ++mb)
#pragma unroll
              for (int rg = 0; rg < 4; ++rg) { const size_t tok = tok0 + 16 * mb + 4 * kg + rg; yi[gi][mb][rg] = YI[tok * 512 + ch]; uu[gi][mb][rg] = bflo((unsigned)PROJ[tok * 5120 + nv::C_U + ch]); } }
#pragma unroll
      for (int gi = 0; gi < 4; ++gi) { const int g = wave * 4 + gi;
        f32x4 lpv[2][2][4]; bf16x8 cbv[4];
#pragma unroll
        for (int mb = 0; mb < 2; ++mb)
#pragma unroll
            for (int kh = 0; kh < 2; ++kh) { const GAS f32x4* lp = (const GAS f32x4*)(LPF + (((size_t)g * 2 + mb) * 2 + kh) * 256 + lane);
#pragma unroll
                for (int i = 0; i < 4; ++i) lpv[mb][kh][i] = lp[64 * i]; }
#pragma unroll
        for (int ks = 0; ks < 4; ++ks) cbv[ks] = *(const GAS bf16x8*)(CBF + ((size_t)g * 4 + ks) * 64 + lane);
        f32x4 srv[2][2], siv[2][2];
#pragma unroll
        for (int kh = 0; kh < 2; ++kh) { const int n0 = 32 * kh + 8 * kg;
            srv[kh][0] = *(const LAS f32x4*)(SIN + g * 128 + n0); srv[kh][1] = *(const LAS f32x4*)(SIN + g * 128 + n0 + 4);
            siv[kh][0] = *(const LAS f32x4*)(SIN + g * 128 + 64 + n0); siv[kh][1] = *(const LAS f32x4*)(SIN + g * 128 + 64 + n0 + 4); }
#pragma unroll
        for (int mb = 0; mb < 2; ++mb) { f32x4 acc = {0.f, 0.f, 0.f, 0.f};
#pragma unroll
            for (int ks = 0; ks < 4; ++ks) { const int ri = ks >> 1, kh = ks & 1;
                const f32x4 p0 = lpv[mb][kh][0], p1 = lpv[mb][kh][1], p2 = lpv[mb][kh][2], p3 = lpv[mb][kh][3];
                const f32x4 sr0 = srv[kh][0], sr1 = srv[kh][1], si0 = siv[kh][0], si1 = siv[kh][1];
                const float lr[8] = {p0.x, p0.z, p1.x, p1.z, p2.x, p2.z, p3.x, p3.z}, li[8] = {p0.y, p0.w, p1.y, p1.w, p2.y, p2.w, p3.y, p3.w};
                const float sr[8] = {sr0.x, sr0.y, sr0.z, sr0.w, sr1.x, sr1.y, sr1.z, sr1.w}, si[8] = {si0.x, si0.y, si0.z, si0.w, si1.x, si1.y, si1.z, si1.w};
                float w[8];
#pragma unroll
                for (int j = 0; j < 8; ++j) w[j] = ri ? (lr[j] * si[j] + li[j] * sr[j]) : (lr[j] * sr[j] - li[j] * si[j]);
                v4u wp; wp.x = attn_body::cvtpk_s(w[0], w[1]); wp.y = attn_body::cvtpk_s(w[2], w[3]); wp.z = attn_body::cvtpk_s(w[4], w[5]); wp.w = attn_body::cvtpk_s(w[6], w[7]);
                acc = __builtin_amdgcn_mfma_f32_16x16x32_bf16(__builtin_bit_cast(bf16x8, wp), cbv[ks], acc, 0, 0, 0); }
            const int ch = g * SC + row;
#pragma unroll
            for (int rg = 0; rg < 4; ++rg) { const int tt = 16 * mb + 4 * kg + rg;
                const float y = acc[rg] + yi[gi][mb][rg] + dk[gi] * uu[gi][mb][rg];
                G1[tt * 520 + ch] = (unsigned short)mk::f2bf(gelu_tanh(y)); } }
        asm volatile("" ::: "memory"); } }
    asm volatile("s_waitcnt lgkmcnt(0)" ::: "memory"); __syncthreads();
    S5PROBE(12);
    { const int row = lane & 15, kg = lane >> 4; f32x4 acc[2][4]; float bzv[4], sgv[4];
#pragma unroll
      for (int nb = 0; nb < 4; ++nb) { const int j = 64 * wave + 16 * nb + row; bzv[nb] = b_glu[j]; sgv[nb] = ssm_g[j]; }
#pragma unroll
      for (int mb = 0; mb < 2; ++mb)
#pragma unroll
          for (int nb = 0; nb < 4; ++nb) acc[mb][nb] = (f32x4){0.f, 0.f, 0.f, 0.f};
#pragma unroll
      for (int kh = 0; kh < 2; ++kh) {
          bf16x8 bbv[8][4];
#pragma unroll
          for (int k8 = 0; k8 < 8; ++k8)
#pragma unroll
              for (int nb = 0; nb < 4; ++nb) bbv[k8][nb] = *(const GAS bf16x8*)(WG + (size_t)(64 * wave + 16 * nb + row) * 512 + 32 * (8 * kh + k8) + 8 * kg);
#pragma unroll
          for (int k8 = 0; k8 < 8; ++k8) { const int ks = 8 * kh + k8; bf16x8 a[2];
#pragma unroll
              for (int mb = 0; mb < 2; ++mb) a[mb] = *(const LAS bf16x8*)(G1 + (16 * mb + row) * 520 + 32 * ks + 8 * kg);
#pragma unroll
              for (int mb = 0; mb < 2; ++mb)
#pragma unroll
                  for (int nb = 0; nb < 4; ++nb) acc[mb][nb] = __builtin_amdgcn_mfma_f32_16x16x32_bf16(a[mb], bbv[k8][nb], acc[mb][nb], 0, 0, 0); }
          asm volatile("" ::: "memory"); }
      float ss[2][4];
#pragma unroll
      for (int mb = 0; mb < 2; ++mb)
#pragma unroll
          for (int rg = 0; rg < 4; ++rg) ss[mb][rg] = 0.f;
#pragma unroll
      for (int nb = 0; nb < 4; ++nb) { const int j = 64 * wave + 16 * nb + row; const float bz = bzv[nb];
#pragma unroll
          for (int mb = 0; mb < 2; ++mb)
#pragma unroll
              for (int rg = 0; rg < 4; ++rg) { const int tt = 16 * mb + 4 * kg + rg; const float z = acc[mb][nb][rg] + bz; const float g1 = bflo((unsigned)G1[tt * 520 + j]);
                  const float o = g1 * __builtin_amdgcn_rcpf(1.f + __builtin_amdgcn_exp2f(-1.4426950408889634f * z)); acc[mb][nb][rg] = o; ss[mb][rg] += o * o; } }
#pragma unroll
      for (int mb = 0; mb < 2; ++mb)
#pragma unroll
          for (int rg = 0; rg < 4; ++rg) { float v = ss[mb][rg]; v += __shfl_xor(v, 1); v += __shfl_xor(v, 2); v += __shfl_xor(v, 4); v += __shfl_xor(v, 8);
              if (row == 0) RS[wave * 32 + 16 * mb + 4 * kg + rg] = v; }
      asm volatile("s_waitcnt lgkmcnt(0)" ::: "memory"); __syncthreads();
#pragma unroll
      for (int mb = 0; mb < 2; ++mb)
#pragma unroll
          for (int rg = 0; rg < 4; ++rg) { const int tt = 16 * mb + 4 * kg + rg; float tot = 0.f;
#pragma unroll
              for (int w8 = 0; w8 < 8; ++w8) tot += RS[w8 * 32 + tt];
              const float rinv = rsqrtf(tot * (1.f / 512.f) + nv::EPS);
#pragma unroll
              for (int nb = 0; nb < 4; ++nb) { const int j = 64 * wave + 16 * nb + row; OUTT[tt * 520 + j] = (unsigned short)mk::f2bf(acc[mb][nb][rg] * rinv * sgv[nb]); } }
      asm volatile("s_waitcnt lgkmcnt(0)" ::: "memory"); __syncthreads();
#pragma unroll
      for (int i = 0; i < 4; ++i) { const int p = tid + 512 * i, rw = p >> 6, c16 = p & 63; const v4u v = *(const LAS v4u*)(OUTT + rw * 520 + c16 * 8);
          *(GAS v4u*)(Y + (tok0 + rw) * 2048 + 512 + c16 * 8) = v; } }
    S5PROBE(13);
    { float a_ = in[15][l * 64 + lane] * in[16][l * 64 + lane], c_ = in[17][l * 64 + lane] * in[18][l * 64 + lane];
      a_ = mk::wave_sum(a_); c_ = mk::wave_sum(c_);
      const float lam_init = 0.8f - 0.6f * __expf(-0.3f * (float)l); const float lam = __expf(a_) - __expf(c_) + lam_init;
#pragma unroll 4
      for (int i = 0; i < 4; ++i) { const size_t tok = tok0 + 4 * wave + i;
          { const v4u v = *(const GAS v4u*)(SBO + tok * 512 + lane * 8); const f32x4 g0 = *(const GAS f32x4*)(sb_g + lane * 8), g1 = *(const GAS f32x4*)(sb_g + lane * 8 + 4);
            float x[8] = {bflo(v.x), bfhi(v.x), bflo(v.y), bfhi(v.y), bflo(v.z), bfhi(v.z), bflo(v.w), bfhi(v.w)}; float s = 0.f;
#pragma unroll
            for (int j = 0; j < 8; ++j) s += x[j] * x[j];
            const float rinv = rsqrtf(mk::wave_sum(s) * (1.f / 512.f) + nv::EPS);
            v4u o; o.x = mk::pk2(x[0] * rinv * g0.x, x[1] * rinv * g0.y); o.y = mk::pk2(x[2] * rinv * g0.z, x[3] * rinv * g0.w); o.z = mk::pk2(x[4] * rinv * g1.x, x[5] * rinv * g1.y); o.w = mk::pk2(x[6] * rinv * g1.z, x[7] * rinv * g1.w);
            *(GAS v4u*)(Y + tok * 2048 + lane * 8) = o; }
          { const GAS v4u* p1 = (const GAS v4u*)(O1 + tok * 1024 + lane * 16); const GAS v4u* p2 = (const GAS v4u*)(O2 + tok * 1024 + lane * 16);
            const v4u a0 = p1[0], a1 = p1[1], b0 = p2[0], b1 = p2[1];
            float x[16] = {bflo(a0.x) - lam * bflo(b0.x), bfhi(a0.x) - lam * bfhi(b0.x), bflo(a0.y) - lam * bflo(b0.y), bfhi(a0.y) - lam * bfhi(b0.y),
                           bflo(a0.z) - lam * bflo(b0.z), bfhi(a0.z) - lam * bfhi(b0.z), bflo(a0.w) - lam * bflo(b0.w), bfhi(a0.w) - lam * bfhi(b0.w),
                           bflo(a1.x) - lam * bflo(b1.x), bfhi(a1.x) - lam * bfhi(b1.x), bflo(a1.y) - lam * bflo(b1.y), bfhi(a1.y) - lam * bfhi(b1.y),
                           bflo(a1.z) - lam * bflo(b1.z), bfhi(a1.z) - lam * bfhi(b1.z), bflo(a1.w) - lam * bflo(b1.w), bfhi(a1.w) - lam * bfhi(b1.w)};
            float s = 0.f;
#pragma unroll
            for (int j = 0; j < 16; ++j) s += x[j] * x[j];
            s += __shfl_xor(s, 1); s += __shfl_xor(s, 2); s += __shfl_xor(s, 4);
            const float rinv = rsqrtf(s * (1.f / 128.f) + nv::EPS) * (1.f - lam_init);
            const GAS f32x4* gp = (const GAS f32x4*)(df_g + (lane & 7) * 16); const f32x4 g0 = gp[0], g1 = gp[1], g2 = gp[2], g3 = gp[3];
            v4u o0, o1; o0.x = mk::pk2(x[0] * rinv * g0.x, x[1] * rinv * g0.y); o0.y = mk::pk2(x[2] * rinv * g0.z, x[3] * rinv * g0.w); o0.z = mk::pk2(x[4] * rinv * g1.x, x[5] * rinv * g1.y); o0.w = mk::pk2(x[6] * rinv * g1.z, x[7] * rinv * g1.w);
            o1.x = mk::pk2(x[8] * rinv * g2.x, x[9] * rinv * g2.y); o1.y = mk::pk2(x[10] * rinv * g2.z, x[11] * rinv * g2.w); o1.z = mk::pk2(x[12] * rinv * g3.x, x[13] * rinv * g3.y); o1.w = mk::pk2(x[14] * rinv * g3.z, x[15] * rinv * g3.w);
            GAS v4u* yo = (GAS v4u*)(Y + tok * 2048 + 1024 + lane * 16); yo[0] = o0; yo[1] = o1; } } }
    S5PROBE(14);
    asm volatile("s_waitcnt lgkmcnt(0)" ::: "memory"); __syncthreads();
}
}

namespace mk {
struct MArgs { const float* in[30]; float* out; unsigned char* ws; int ph_lo, ph_hi, li, pad; };
constexpr int NPHASE = 1 + 8 * DEPTH;

__global__ void __launch_bounds__(NWAVES * 64, 2) mk_fwd(MArgs args) {
    extern __shared__ __attribute__((aligned(16))) unsigned char lds[];
    LAS unsigned char* ldsl = (LAS unsigned char*)lds;
    volatile LAS unsigned* MISC = (volatile LAS unsigned*)(ldsl + MISC_OFF);
    const int tid = threadIdx.x, wave = __builtin_amdgcn_readfirstlane(tid >> 6);
    const int G = gridDim.x; const int bx = blockIdx.x; const int vcu = (G % 8 == 0) ? (bx % 8) * (G / 8) + bx / 8 : bx;
    unsigned char* ws = args.ws;
    gu32* ctl = (gu32*)(ws + WS_CTL);
    for (int u = tid; u < (LDS_BYTES - LDSCTL_OFF) / 4; u += NWAVES * 64) ((LAS unsigned*)(ldsl + LDSCTL_OFF))[u] = 0u;
    __syncthreads();
    XcdBarrier bar = xcd_barrier_post((unsigned*)(ctl + CW_BAR) + args.li * XCD_BAR_WORDS, MISC + 8);
    const int lo = args.ph_lo, hi = args.ph_hi;
    if (PROBE_PH >= 0 && tid == 0) { const unsigned long long n0_ = __builtin_amdgcn_s_memrealtime(); MISC[16] = (unsigned)n0_; MISC[17] = (unsigned)(n0_ >> 32); }
#ifndef REP_P0
#define REP_P0 1
#endif
#ifndef REP_A
#define REP_A 1
#endif
#ifndef REP_B
#define REP_B 1
#endif
#ifndef REP_C
#define REP_C 1
#endif
#ifndef REP_D0
#define REP_D0 1
#endif
#ifndef REP_F
#define REP_F 1
#endif
#ifndef REP_G
#define REP_G 1
#endif
#ifndef REP_BARX
#define REP_BARX 0
#endif
#ifndef REP_E
#define REP_E 1
#endif
#ifndef REP_H1
#define REP_H1 1
#endif
#define IN(k) (lo <= (k) && (k) < hi)
#define REPEAT(n) for (int rep_ = 0; rep_ < (n); ++rep_, ((rep_ < (n)) ? xcd_barrier(bar) : (void)0))
#define SEAM(k) do { if (IN(k) && IN((k) + 1)) xcd_barrier(bar); \
    if (PROBE_PH >= 0) { if (bx == 0) { if (tid == 0) { const unsigned long long now_ = __builtin_amdgcn_s_memrealtime(); \
            const unsigned long long ps_ = ((unsigned long long)MISC[17] << 32) | MISC[16]; \
            if ((k) == PROBE_PH) { const unsigned long long dl_ = now_ + PROBE_AMP * (now_ - ps_); while (__builtin_amdgcn_s_memrealtime() < dl_) __builtin_amdgcn_s_sleep(8); } \
            const unsigned long long n1_ = __builtin_amdgcn_s_memrealtime(); MISC[16] = (unsigned)n1_; MISC[17] = (unsigned)(n1_ >> 32); } __syncthreads(); } } } while (0)
    bf16* WinT = (bf16*)(ws + WS_WIN); bf16* WoutT = (bf16*)(ws + WS_WOUT); bf16* XN = (bf16*)(ws + WS_XN); bf16* PROJ = (bf16*)(ws + WS_PROJ);
    bf16* Y = (bf16*)(ws + WS_Y); float* H = (float*)(ws + WS_H); bf16* YS = (bf16*)(ws + WS_YS); bf16* HB = (bf16*)(ws + WS_HB);
    bf16* W13T = (bf16*)(ws + WS_W13); bf16* W2T = (bf16*)(ws + WS_W2); int* LIST = (int*)(ws + WS_ROUTE); float* GATEW = (float*)(ws + WS_ROUTE + MiB);
    float* WRT = (float*)(ws + WS_ROUTE + MiB + 256 * 1024);
    LAS int* tab = (LAS int*)(ldsl + LDSCTL_OFF + 1024);
    const ConvCtx CC{args.in, W13T, W2T, WinT, WoutT, (bf16*)(ws + WS_S5 + s5::OFF_WG)};
    const int NGW = G * NWAVES;
#define PHASE_IDS() const int tid_ = opaque_tid(); const int lane = tid_ & 63; const int gw = vcu * NWAVES + wave; (void)gw; (void)lane

    REPEAT(REP_P0) if (IN(0)) { PHASE_IDS();
        LAS float* scr = (LAS float*)(ldsl + RING_OFF + wave * 16640);
#pragma unroll 1
        for (int m = gw; m < T; m += 2 * NGW) {
            const int m2 = (m + NGW < T) ? m + NGW : m;
            const GAS f32x4* xa = (const GAS f32x4*)(args.in[0] + (size_t)m * D) + lane; const GAS f32x4* xb = (const GAS f32x4*)(args.in[0] + (size_t)m2 * D) + lane; const GAS f32x4* gr = (const GAS f32x4*)args.in[1] + lane;
            f32x4 va[8], vb[8]; float sa = 0.f, sb = 0.f;
#pragma unroll
            for (int j = 0; j < 8; ++j) { va[j] = xa[64 * j]; vb[j] = xb[64 * j]; }
#pragma unroll
            for (int j = 0; j < 8; ++j) { sa += (va[j].x * va[j].x + va[j].y * va[j].y) + (va[j].z * va[j].z + va[j].w * va[j].w); sb += (vb[j].x * vb[j].x + vb[j].y * vb[j].y) + (vb[j].z * vb[j].z + vb[j].w * vb[j].w); }
            const float ra = rsqrtf(wave_sum(sa) * (1.f / D) + EPS), rb = rsqrtf(wave_sum(sb) * (1.f / D) + EPS);
            GAS unsigned long long* oa = (GAS unsigned long long*)(XN + (size_t)m * D) + lane; GAS unsigned long long* ob = (GAS unsigned long long*)(XN + (size_t)m2 * D) + lane;
#pragma unroll
            for (int j = 0; j < 8; ++j) { const f32x4 gg = gr[64 * j]; const f32x4 o = va[j] * ra * gg, p = vb[j] * rb * gg;
                oa[64 * j] = (unsigned long long)pk2(o.x, o.y) | ((unsigned long long)pk2(o.z, o.w) << 32); ob[64 * j] = (unsigned long long)pk2(p.x, p.y) | ((unsigned long long)pk2(p.z, p.w) << 32); } }
        for (int it = vcu * (NWAVES * 64) + tid_; it < DEPTH * 48 * D; it += G * NWAVES * 64) { const int d = it & (D - 1), c = (it >> 11) % 48, l = it / (48 * D);
            float w = 0.f; if (c < 4) w = args.in[22][((size_t)l * D + d) * 4 + c]; else if (c < 36) { const int gq = (c - 4) >> 3, e = (c - 4) & 7; w = args.in[24][(((size_t)l * 4 + gq) * D + d) * 8 + e]; }
            WRT[it] = w * args.in[21][(size_t)l * D + d]; }
        s5::build_tables(args.in, ws + WS_S5, vcu * (NWAVES * 64) + tid_, G * NWAVES * 64);
        { f32x4 va[16], vb[16]; TileJob ja, jb; int it = gw;
          if (it < P0_TILES) { p0_job(CC, it, ja); tile_load(ja, va, lane); }
#pragma unroll 1
          for (; it < P0_TILES; it += 2 * NGW) {
              const int i1 = it + NGW, i2 = it + 2 * NGW;
              if (i1 < P0_TILES) { p0_job(CC, i1, jb); tile_load(jb, vb, lane); }
              tile_store(ja, va, scr, lane);
              if (i1 < P0_TILES) { if (i2 < P0_TILES) { p0_job(CC, i2, ja); tile_load(ja, va, lane); } tile_store(jb, vb, scr, lane); }
          } }
    }
    SEAM(0);
    for (int xb_ = 0; xb_ < REP_BARX; ++xb_) xcd_barrier(bar);
    for (int l = 0; l < DEPTH; ++l) {
        const int pb = 1 + 8 * l;
        REPEAT(REP_A) if (IN(pb + 0)) {
            pg8::Gemm g{XN, WinT + (size_t)l * INC * D, T, INC, D}; pg8::StaticOrder S; S.init(T, INC, G, bx);
            pg8::EpiProj E{PROJ, INC};
            pg8::gemm_phase<pg8::EpiProj, pg8::StaticOrder, PG8_ALIGN, PG8_SP2>(ldsl + RING_OFF, g, S, E);
            { const int total = (T / 256) * (INC / 256), nmax = (total + G - 1) / G, nmine = bx < total ? (total - bx + G - 1) / G : 0;
              if (nmine < nmax) convert_batches(CC, ctl + CW_Q, QUOTA_A, 0, MISC + 20, ldsl + RING_OFF); }
        }
        SEAM(pb + 0);
        REPEAT(REP_B) { if (l == 0) SUBPROBE(0);
        if (IN(pb + 1)) {
#pragma unroll 1
            for (int u = vcu; u < 256; u += G) s5::s5a_unit(l, u & 31, (u >> 5) & 3, u >> 7, PROJ, ws + WS_S5, ldsl + RING_OFF);
        }
        if (l == 0) SUBPROBE(1);
        if (IN(pb + 1)) {
            bf16* O1 = (bf16*)(ws + WS_O1); bf16* O2 = (bf16*)(ws + WS_O2);
#pragma unroll 1
            for (int u = vcu; u < 1024; u += G) { const int i = u >> 8, v = u & 255, combo = v >> 1, sub = v & 1;
                const int qb = ((sub ? 0x4352 : 0x6170) >> (4 * i)) & 7;
                const int b = combo >> 5, rem = combo & 31, h = rem >> 2, mp = (rem >> 1) & 1, vh = rem & 1;
                attn_body::attn_unit<8>(b, qb, (const attn_body::bf16*)(PROJ + nv::C_DQ + h * 128 + mp * 64), (const attn_body::bf16*)(PROJ + nv::C_DK + h * 128 + mp * 64),
                                        (const attn_body::bf16*)(PROJ + nv::C_DV + h * 128 + vh * 64), (attn_body::bf16*)((mp ? O2 : O1) + h * 128 + vh * 64), 1024, (char*)lds + RING_OFF); }
        }
        if (l == 0) SUBPROBE(2);
#if !defined(NO_MK_SB)
        if (IN(pb + 1)) {
            bf16* SBO = (bf16*)(ws + WS_SBO);
#pragma unroll 1
            for (int u = vcu; u < 256; u += G) { const int bh = u >> 3, qb = u & 7, b = bh >> 3, h = bh & 7;
                attn_body::sb_unit(b, qb, (const attn_body::bf16*)(PROJ + nv::C_SBQ + h * 64), (const attn_body::bf16*)(PROJ + nv::C_SBK + h * 64),
                                   (const attn_body::bf16*)(PROJ + nv::C_SBV + h * 64), (attn_body::bf16*)(SBO + h * 64), 512, (char*)lds + RING_OFF); }
        }
#endif
        if (l == 0) SUBPROBE(3);
        }
        SEAM(pb + 1);
        REPEAT(REP_C) if (IN(pb + 2)) {
#pragma unroll 1
            for (int u = vcu; u < 256; u += G) s5::post_unit(l, u >> 6, u & 63, args.in, PROJ, (const bf16*)(ws + WS_SBO), (const bf16*)(ws + WS_O1), (const bf16*)(ws + WS_O2), Y, ws + WS_S5, ldsl + RING_OFF, MISC);
        }
        SEAM(pb + 2);
        REPEAT(l == 0 ? REP_D0 : 1) if (IN(pb + 3)) {
            pg8::Gemm g{Y, WoutT + (size_t)l * D * D, T, D, D}; pg8::StaticOrder S; S.init(T, D, G, bx);
            pg8::EpiResF32 E{l == 0 ? args.in[0] : (const float*)H, H, D};
            pg8::gemm_phase<pg8::EpiResF32, pg8::StaticOrder, PG8_ALIGN, PG8_SP2>(ldsl + RING_OFF, g, S, E);
        }
        SEAM(pb + 3);
        gu32* cnt = ctl + CW_CNT + 2048 * l;
        if (IN(pb + 4)) { PHASE_IDS();
            const float* gF = args.in[21] + (size_t)l * D; const float* rgb = args.in[23] + l * 4; const float* reb = args.in[25] + l * 32;
            const float* wrt = WRT + (size_t)l * 48 * D;
            LAS float* PL = (LAS float*)(ldsl + RING_OFF);
            LAS float* PS = (LAS float*)(ldsl + RING_OFF + 24576);
            const int tile = wave >> 2, kq = wave & 3, row = lane & 15, kk = lane >> 4;
#pragma unroll 1
            for (int m0 = 32 * vcu; m0 < T; m0 += 32 * G) {
                if (l == 0) SUBPROBE(20);
                const size_t arow = (size_t)(m0 + 16 * tile + row) * D + kq * 512 + kk * 8;
                const GAS f32x4* ap = (const GAS f32x4*)(H + arow);
                const GAS f32x4* bp = (const GAS f32x4*)(wrt + (size_t)row * D + kq * 512 + kk * 8);
                const GAS f32x4* gp = (const GAS f32x4*)(gF + kq * 512 + kk * 8);
                GAS v4u* xo = (GAS v4u*)(XN + arow);
                f32x4 acc0 = {0.f, 0.f, 0.f, 0.f}, acc1 = acc0, acc2 = acc0; float ssq = 0.f;
#define RT_STEP(AV, B0, B1, B2) do { \
                    acc0 = __builtin_amdgcn_mfma_f32_16x16x4f32(AV.x, B0.x, acc0, 0, 0, 0); acc1 = __builtin_amdgcn_mfma_f32_16x16x4f32(AV.x, B1.x, acc1, 0, 0, 0); acc2 = __builtin_amdgcn_mfma_f32_16x16x4f32(AV.x, B2.x, acc2, 0, 0, 0); \
                    acc0 = __builtin_amdgcn_mfma_f32_16x16x4f32(AV.y, B0.y, acc0, 0, 0, 0); acc1 = __builtin_amdgcn_mfma_f32_16x16x4f32(AV.y, B1.y, acc1, 0, 0, 0); acc2 = __builtin_amdgcn_mfma_f32_16x16x4f32(AV.y, B2.y, acc2, 0, 0, 0); \
                    acc0 = __builtin_amdgcn_mfma_f32_16x16x4f32(AV.z, B0.z, acc0, 0, 0, 0); acc1 = __builtin_amdgcn_mfma_f32_16x16x4f32(AV.z, B1.z, acc1, 0, 0, 0); acc2 = __builtin_amdgcn_mfma_f32_16x16x4f32(AV.z, B2.z, acc2, 0, 0, 0); \
                    acc0 = __builtin_amdgcn_mfma_f32_16x16x4f32(AV.w, B0.w, acc0, 0, 0, 0); acc1 = __builtin_amdgcn_mfma_f32_16x16x4f32(AV.w, B1.w, acc1, 0, 0, 0); acc2 = __builtin_amdgcn_mfma_f32_16x16x4f32(AV.w, B2.w, acc2, 0, 0, 0); } while (0)
                f32x4 av[32];
#pragma unroll
                for (int i = 0; i < 16; ++i) { av[2 * i] = ap[8 * i]; av[2 * i + 1] = ap[8 * i + 1]; }
                const GAS f32x4* bq0 = bp; const GAS f32x4* bq1 = bp + 16 * D / 4; const GAS f32x4* bq2 = bp + 32 * D / 4; const GAS f32x4* gq = gp; GAS v4u* xq = xo;
#pragma unroll
                for (int i = 0; i < 16; ++i) { const f32x4 a0 = av[2 * i], a1 = av[2 * i + 1];
                    asm volatile("" : "+v"(bq0), "+v"(bq1), "+v"(bq2), "+v"(gq), "+v"(xq));
                    const f32x4 b00 = bq0[0], b01 = bq0[1], b10 = bq1[0], b11 = bq1[1], b20 = bq2[0], b21 = bq2[1];
                    const f32x4 g0 = gq[0], g1 = gq[1];
                    ssq += ((a0.x * a0.x + a0.y * a0.y) + (a0.z * a0.z + a0.w * a0.w)) + ((a1.x * a1.x + a1.y * a1.y) + (a1.z * a1.z + a1.w * a1.w));
                    v4u o; o.x = pk2(a0.x * g0.x, a0.y * g0.y); o.y = pk2(a0.z * g0.z, a0.w * g0.w); o.z = pk2(a1.x * g1.x, a1.y * g1.y); o.w = pk2(a1.z * g1.z, a1.w * g1.w); xq[0] = o;
                    RT_STEP(a0, b00, b10, b20); RT_STEP(a1, b01, b11, b21);
                    bq0 += 8; bq1 += 8; bq2 += 8; gq += 8; xq += 4; }
#undef RT_STEP
                ssq += __shfl_xor(ssq, 16); ssq += __shfl_xor(ssq, 32);
                if (kk == 0) PS[(tile * 4 + kq) * 16 + row] = ssq;
#pragma unroll
                for (int rg = 0; rg < 4; ++rg) { LAS float* p = PL + ((tile * 4 + kq) * 16 + 4 * kk + rg) * 48 + row; p[0] = acc0[rg]; p[16] = acc1[rg]; p[32] = acc2[rg]; }
                LDS_WAIT(); __syncthreads();
                if (l == 0) SUBPROBE(21);
                if (wave == 0 && lane < 32) { const int t2 = lane >> 4, rw = lane & 15;
                    float sq = 0.f;
#pragma unroll
                    for (int q = 0; q < 4; ++q) sq += PS[(t2 * 4 + q) * 16 + rw];
                    const float r = rsqrtf(sq * (1.f / D) + EPS);
                    const LAS float* p0 = PL + ((t2 * 4 + 0) * 16 + rw) * 48; const LAS float* p1 = p0 + 16 * 48; const LAS float* p2 = p1 + 16 * 48; const LAS float* p3 = p2 + 16 * 48;
                    float gl[4]; int gi = 0; float gm = -INFINITY;
#pragma unroll
                    for (int q = 0; q < 4; ++q) { gl[q] = ((p0[q] + p1[q]) + (p2[q] + p3[q])) * r + rgb[q]; if (gl[q] > gm) { gm = gl[q]; gi = q; } }
                    const float gtop = 1.f / (expf(gl[0] - gm) + expf(gl[1] - gm) + expf(gl[2] - gm) + expf(gl[3] - gm));
                    float m0v = -INFINITY, m1v = -INFINITY; int i0 = 0, i1 = 0;
#pragma unroll
                    for (int q = 0; q < 8; ++q) { const int c = 4 + gi * 8 + q; const float lv = ((p0[c] + p1[c]) + (p2[c] + p3[c])) * r + reb[gi * 8 + q];
                        if (lv > m0v) { m1v = m0v; i1 = i0; m0v = lv; i0 = q; } else if (lv > m1v) { m1v = lv; i1 = q; } }
                    const float p1e = expf(m1v - m0v); const float w0 = 1.f / (1.f + p1e) * gtop, w1 = p1e / (1.f + p1e) * gtop;
                    const int x0 = gi * 8 + i0, x1 = gi * 8 + i1; const int mr = m0 + lane;
                    const unsigned q0 = __hip_atomic_fetch_add(cnt + 64 * x0, 1u, RLX_AGENT), q1 = __hip_atomic_fetch_add(cnt + 64 * x1, 1u, RLX_AGENT);
                    LIST[x0 * 8192 + q0] = 2 * mr; LIST[x1 * 8192 + q1] = 2 * mr + 1; *(GAS f32x4*)(GATEW + 4 * mr) = (f32x4){w0, r, w1, r}; }
                if (l == 0) SUBPROBE(22);
                LDS_WAIT(); __syncthreads();
            }
            if (l == 1) convert_batches(CC, ctl + CW_Q, 0, Q_TOTAL, MISC + 20, ldsl + RING_OFF);
        }
        SEAM(pb + 4);
#define BUILD_TAB() do { PHASE_IDS(); if (wave == 0) { const int c_ = (lane < 32) ? (int)__hip_atomic_load(cnt + 64 * (lane & 31), RLX_AGENT) : 0; \
            const int mt_ = (c_ + 255) >> 8, hv_ = (c_ + 127) >> 8; int incl = mt_, inh = hv_, inl = mt_ - hv_; \
            _Pragma("unroll") for (int o = 1; o < 32; o <<= 1) { const int t_ = __shfl_up(incl, o), th_ = __shfl_up(inh, o), tl_ = __shfl_up(inl, o); if (lane >= o) { incl += t_; inh += th_; inl += tl_; } } \
            if (lane < 32) { tab[lane] = c_; tab[33 + lane] = incl; tab[66 + lane] = inh; tab[99 + lane] = inl; } if (lane == 0) { tab[32] = 0; tab[65] = 0; tab[98] = 0; } } LDS_WAIT(); __syncthreads(); } while (0)
        REPEAT(REP_F) if (IN(pb + 5)) {
            BUILD_TAB();
            pg8::GroupedOrder S{(const LAS int*)tab, 4, G, bx, 1024u * 2048u * 2u};
            pg8::Gemm g{XN, W13T + (size_t)l * nv::NEXP * 1024 * D, 0, 0, D};
            pg8::EpiMoe1 E{HB, LIST, GATEW};
            pg8::gemm_phase_g<pg8::EpiMoe1, true>(ldsl + RING_OFF, g, S, E, LIST);
            { const int total = tab[64] * 4, nmax = (total + G - 1) / G, nmine = bx < total ? (total - bx + G - 1) / G : 0;
              if (nmine < nmax) convert_batches(CC, ctl + CW_Q, QUOTA_F, 0, MISC + 20, ldsl + RING_OFF); }
            if (l == 0) convert_batches(CC, ctl + CW_Q, 0, Q_W2L0, MISC + 20, ldsl + RING_OFF);
        }
        SEAM(pb + 5);
        REPEAT(REP_G) if (IN(pb + 6)) {
            BUILD_TAB();
            pg8::GroupedOrder S{(const LAS int*)tab, 8, G, bx, 2048u * 512u * 2u};
            pg8::Gemm g{HB, W2T + (size_t)l * nv::NEXP * D * nv::DE, 0, 0, nv::DE};
            pg8::EpiMoe2 E{YS, LIST};
            pg8::gemm_phase_g<pg8::EpiMoe2, false>(ldsl + RING_OFF, g, S, E, LIST);
            { const int total = tab[64] * 8, nmax = (total + G - 1) / G, nmine = bx < total ? (total - bx + G - 1) / G : 0;
              if (nmine < nmax) convert_batches(CC, ctl + CW_Q, QUOTA_G, 0, MISC + 20, ldsl + RING_OFF); }
        }
        SEAM(pb + 6);
        REPEAT(l == 1 ? REP_H1 : 1) if (IN(pb + 7)) { PHASE_IDS();
            const bool fin = (l + 1 == DEPTH); const float* gN = fin ? args.in[29] : args.in[1] + (size_t)(l + 1) * D;
            typedef unsigned u32x2_t __attribute__((ext_vector_type(2)));
#pragma unroll 1
            for (int m = gw; m < T; m += 2 * NGW) {
                const int mb_ = (m + NGW < T) ? m + NGW : m;
                GAS f32x4* hr0 = (GAS f32x4*)(H + (size_t)m * D) + lane; GAS f32x4* hr1 = (GAS f32x4*)(H + (size_t)mb_ * D) + lane; const GAS f32x4* gr = (const GAS f32x4*)gN + lane;
                const GAS u32x2_t* ya0 = (const GAS u32x2_t*)(YS + (size_t)(2 * m) * D) + lane; const GAS u32x2_t* ya1 = (const GAS u32x2_t*)(YS + (size_t)(2 * m + 1) * D) + lane;
                const GAS u32x2_t* yb0 = (const GAS u32x2_t*)(YS + (size_t)(2 * mb_) * D) + lane; const GAS u32x2_t* yb1 = (const GAS u32x2_t*)(YS + (size_t)(2 * mb_ + 1) * D) + lane;
                f32x4 va[8], vb[8]; u32x2_t pa0[8], pa1[8], pb0[8], pb1[8];
#pragma unroll
                for (int j = 0; j < 8; ++j) { va[j] = hr0[64 * j]; vb[j] = hr1[64 * j]; pa0[j] = ya0[64 * j]; pa1[j] = ya1[64 * j]; pb0[j] = yb0[64 * j]; pb1[j] = yb1[64 * j]; }
                float sa = 0.f, sb = 0.f;
#pragma unroll
                for (int j = 0; j < 8; ++j) {
                    va[j].x += __uint_as_float(pa0[j].x << 16) + __uint_as_float(pa1[j].x << 16); va[j].y += __uint_as_float(pa0[j].x & 0xffff0000u) + __uint_as_float(pa1[j].x & 0xffff0000u);
                    va[j].z += __uint_as_float(pa0[j].y << 16) + __uint_as_float(pa1[j].y << 16); va[j].w += __uint_as_float(pa0[j].y & 0xffff0000u) + __uint_as_float(pa1[j].y & 0xffff0000u);
                    vb[j].x += __uint_as_float(pb0[j].x << 16) + __uint_as_float(pb1[j].x << 16); vb[j].y += __uint_as_float(pb0[j].x & 0xffff0000u) + __uint_as_float(pb1[j].x & 0xffff0000u);
                    vb[j].z += __uint_as_float(pb0[j].y << 16) + __uint_as_float(pb1[j].y << 16); vb[j].w += __uint_as_float(pb0[j].y & 0xffff0000u) + __uint_as_float(pb1[j].y & 0xffff0000u);
                    sa += (va[j].x * va[j].x + va[j].y * va[j].y) + (va[j].z * va[j].z + va[j].w * va[j].w); sb += (vb[j].x * vb[j].x + vb[j].y * vb[j].y) + (vb[j].z * vb[j].z + vb[j].w * vb[j].w); }
                const float ra = rsqrtf(wave_sum(sa) * (1.f / D) + EPS), rb = rsqrtf(wave_sum(sb) * (1.f / D) + EPS);
                if (fin) { GAS f32x4* oa = (GAS f32x4*)(args.out + (size_t)m * D) + lane; GAS f32x4* ob = (GAS f32x4*)(args.out + (size_t)mb_ * D) + lane;
#pragma unroll
                    for (int j = 0; j < 8; ++j) { const f32x4 gg = gr[64 * j]; oa[64 * j] = va[j] * ra * gg; ob[64 * j] = vb[j] * rb * gg; } }
                else { GAS unsigned long long* o8a = (GAS unsigned long long*)(XN + (size_t)m * D) + lane; GAS unsigned long long* o8b = (GAS unsigned long long*)(XN + (size_t)mb_ * D) + lane;
#pragma unroll
                    for (int j = 0; j < 8; ++j) { const f32x4 gg = gr[64 * j]; hr0[64 * j] = va[j]; hr1[64 * j] = vb[j]; const f32x4 o = va[j] * ra * gg, p = vb[j] * rb * gg;
                        o8a[64 * j] = (unsigned long long)pk2(o.x, o.y) | ((unsigned long long)pk2(o.z, o.w) << 32); o8b[64 * j] = (unsigned long long)pk2(p.x, p.y) | ((unsigned long long)pk2(p.z, p.w) << 32); } }
            }
        }
        if (IN(pb + 7) && l == 0) convert_batches(CC, ctl + CW_Q, 0, Q_DENSE1, MISC + 20, ldsl + RING_OFF);
        SEAM(pb + 7);
    }
#undef IN
#undef SEAM
}

static int g_grid = 0;
static bool mk_setup() {
    if (g_grid != 0) return g_grid > 0;
    int dev = 0, cus = 0, per_cu = 0;
    if (hipGetDevice(&dev) != hipSuccess || hipDeviceGetAttribute(&cus, hipDeviceAttributeMultiprocessorCount, dev) != hipSuccess) { g_grid = -1; return false; }
    if (hipFuncSetAttribute((const void*)mk_fwd, hipFuncAttributeMaxDynamicSharedMemorySize, LDS_BYTES) != hipSuccess) { fprintf(stderr, "mk: hipFuncSetAttribute failed\n"); g_grid = -1; return false; }
    if (hipOccupancyMaxActiveBlocksPerMultiprocessor(&per_cu, (const void*)mk_fwd, NWAVES * 64, LDS_BYTES) != hipSuccess || per_cu < 1) { fprintf(stderr, "mk: occupancy query says %d\n", per_cu); }
    (void)hipGetLastError();
    g_grid = cus;
    return true;
}
static void mk_launch(const MArgs& base, int lo, int hi, int& li, hipStream_t stream) {
    MArgs a = base; a.ph_lo = lo; a.ph_hi = hi; a.li = li++; a.pad = 0;
    hipLaunchKernelGGL(mk_fwd, dim3(g_grid), dim3(NWAVES * 64), LDS_BYTES, stream, a);
}
}
extern "C" void kernel_launch(void* const* d_in, const int* in_sizes, int n_in, void* d_out, int out_size, void* d_ws, size_t ws_size, hipStream_t stream) {
    using namespace nv;
    if (n_in != 30 || ws_size < mk::WS_END) { fprintf(stderr, "kernel_launch: unexpected n_in %d / ws %zu\n", n_in, ws_size); return; }
    if (!mk::mk_setup()) return;
    const float* x = (const float*)d_in[0];
    const float* norm_mix_g = (const float*)d_in[1]; const float* sb_norm_g = (const float*)d_in[3];
    const float* lam_re = (const float*)d_in[4]; const float* lam_im = (const float*)d_in[5]; const float* b_re = (const float*)d_in[6]; const float* b_im = (const float*)d_in[7];
    const float* c_re = (const float*)d_in[8]; const float* c_im = (const float*)d_in[9]; const float* ssm_d = (const float*)d_in[10]; const float* log_dt = (const float*)d_in[11];
    const float* w_glu = (const float*)d_in[12]; const float* b_glu = (const float*)d_in[13]; const float* ssm_norm_g = (const float*)d_in[14];
    const float* lq1 = (const float*)d_in[15]; const float* lk1 = (const float*)d_in[16]; const float* lq2 = (const float*)d_in[17]; const float* lk2 = (const float*)d_in[18];
    const float* subln = (const float*)d_in[19]; const float* norm_ffn_g = (const float*)d_in[21];
    const float* rgw = (const float*)d_in[22]; const float* rgb = (const float*)d_in[23]; const float* rew = (const float*)d_in[24]; const float* reb = (const float*)d_in[25];
    const float* ew1 = (const float*)d_in[26]; const float* ew3 = (const float*)d_in[27]; const float* ew2 = (const float*)d_in[28]; const float* final_g = (const float*)d_in[29];
    char* ws = (char*)d_ws;
    bf16_t* XN = (bf16_t*)(ws + mk::WS_XN); bf16_t* PROJ = (bf16_t*)(ws + mk::WS_PROJ); bf16_t* SBO = (bf16_t*)(ws + mk::WS_SBO);
    bf16_t* O1 = (bf16_t*)(ws + mk::WS_O1); bf16_t* O2 = (bf16_t*)(ws + mk::WS_O2); bf16_t* Y = (bf16_t*)(ws + mk::WS_Y); float* H = (float*)(ws + mk::WS_H);
    bf16_t* YS = (bf16_t*)(ws + mk::WS_YS);
    float2* ST = (float2*)(ws + mk::WS_S5); float* G1 = (float*)(ws + mk::WS_S5 + 128 * mk::MiB); float* SY = (float*)(ws + mk::WS_S5 + 144 * mk::MiB);
    (void)hipMemsetAsync(ws + mk::WS_CTL, 0, mk::CTL_ZERO_BYTES, stream);
    mk::MArgs a{};
    for (int i = 0; i < 30; ++i) a.in[i] = (const float*)d_in[i];
    a.out = (float*)d_out; a.ws = (unsigned char*)d_ws;
    int li = 0;
    mk::mk_launch(a, 0, mk::NPHASE, li, stream);
}
```
